# Optimizing an MI355X kernel written in HIP

```python
import math
import jax, jax.numpy as jnp
from jax import lax
import numpy as np

D_MODEL = 1024
BATCH = 8
SEQ = 4096
DEPTH = 2

DIFF_HEADS = 4
DIFF_QK_DIM = 32
DIFF_V_DIM = 64
MLA_HEADS = 6
MLA_Q_RANK = 256
MLA_KV_RANK = 128
MLA_NOPE_DIM = 64
MLA_ROPE_DIM = 32
MLA_V_DIM = 64
DIL_HEADS = 6
DIL_HEAD_DIM = 64
DIL_PAIRS = ((128, 1), (512, 4), (2048, 16))
BAND_BLOCK = 64
Q_BLOCK = 128
ROPE_THETA = 10000.0
A_QK_WIDTH = DIFF_HEADS * 2 * DIFF_QK_DIM
A_WIDTH = DIFF_HEADS * DIFF_V_DIM
B_WIDTH = MLA_HEADS * MLA_V_DIM
C_WIDTH = DIL_HEADS * DIL_HEAD_DIM
MIX_WIDTH = A_WIDTH + B_WIDTH + C_WIDTH
IN_WIDTH = 2 * A_QK_WIDTH + A_WIDTH + MLA_Q_RANK + MLA_KV_RANK + MLA_ROPE_DIM + 3 * C_WIDTH
PEER_HEADS = 8
PEER_N_KEYS = 128
PEER_N_EXPERTS = PEER_N_KEYS * PEER_N_KEYS
PEER_QUERY_DIM = 256
PEER_HALF_DIM = PEER_QUERY_DIM // 2
PEER_TOPK = 16
PEER_CHUNK = 128
DEEPNORM_ALPHA = (2 * DEPTH) ** 0.25
DEEPNORM_BETA = (8 * DEPTH) ** -0.25
LN_EPS = 1e-5
NEG_INF = -1e30

kernel_name = 'hybrid_diff_mla_dilated_peer_encoder'


def rms_norm(x, g):
    x32 = x.astype(jnp.float32)
    y = x32 * lax.rsqrt(jnp.mean(x32 * x32, axis=-1, keepdims=True) + LN_EPS)
    return (y * g.astype(jnp.float32)).astype(x.dtype)


def layer_norm(x, g, b):
    x32 = x.astype(jnp.float32)
    xc = x32 - jnp.mean(x32, axis=-1, keepdims=True)
    var = jnp.mean(xc * xc, axis=-1, keepdims=True)
    y = xc * lax.rsqrt(var + LN_EPS) * g.astype(jnp.float32) + b.astype(jnp.float32)
    return y.astype(x.dtype)


def rope(t, pos):
    half = t.shape[-1] // 2
    inv_freq = jnp.exp(-math.log(ROPE_THETA) * jnp.arange(half, dtype=jnp.float32) / half)
    ang = pos.astype(jnp.float32)[:, None] * inv_freq[None, :]
    cos, sin = jnp.cos(ang), jnp.sin(ang)
    t32 = t.astype(jnp.float32)
    t1, t2 = t32[..., :half], t32[..., half:]
    return jnp.concatenate([t1 * cos - t2 * sin, t2 * cos + t1 * sin], axis=-1).astype(t.dtype)


def to_heads(t, n_heads):
    b, s, _ = t.shape
    return t.reshape(b, s, n_heads, -1).transpose(0, 2, 1, 3)


def from_heads(t):
    b, h, s, d = t.shape
    return t.transpose(0, 2, 1, 3).reshape(b, s, h * d)


def dense_attention(q, k, v, scale):
    b, h, s, dk = q.shape
    nb = s // Q_BLOCK
    qb = q.reshape(b, h, nb, Q_BLOCK, dk).transpose(2, 0, 1, 3, 4)

    def block(qi):
        sc = jnp.einsum('bhqd,bhkd->bhqk', qi, k, preferred_element_type=jnp.float32) * scale
        p = jax.nn.softmax(sc, axis=-1)
        return jnp.einsum('bhqk,bhkd->bhqd', p.astype(v.dtype), v)

    o = lax.map(block, qb)
    return o.transpose(1, 2, 0, 3, 4).reshape(b, h, s, v.shape[-1])


def banded_attention(q, k, v, half, scale):
    lead = q.shape[:-2]
    length, dk = q.shape[-2], q.shape[-1]
    dv = v.shape[-1]
    nb = -(-length // BAND_BLOCK)
    lp = nb * BAND_BLOCK
    span = BAND_BLOCK + 2 * half
    pad_q = [(0, 0)] * (q.ndim - 2) + [(0, lp - length), (0, 0)]
    pad_kv = [(0, 0)] * (q.ndim - 2) + [(half, half + lp - length), (0, 0)]
    qb = jnp.pad(q, pad_q).reshape(*lead, nb, BAND_BLOCK, dk)
    starts = jnp.arange(nb) * BAND_BLOCK
    idx = starts[:, None] + jnp.arange(span)[None, :]
    kb = jnp.take(jnp.pad(k, pad_kv), idx, axis=-2)
    vb = jnp.take(jnp.pad(v, pad_kv), idx, axis=-2)
    sc = jnp.einsum('...nqd,...nkd->...nqk', qb, kb, preferred_element_type=jnp.float32) * scale
    t = jnp.arange(BAND_BLOCK)[:, None]
    j = jnp.arange(span)[None, :]
    in_band = jnp.abs(j - half - t) <= half
    key_pos = starts[:, None, None] + j[None] - half
    mask = in_band[None] & (key_pos >= 0) & (key_pos < length)
    sc = jnp.where(mask, sc, NEG_INF)
    lse = jax.nn.logsumexp(sc, axis=-1)
    p = jnp.exp(sc - lse[..., None])
    o = jnp.einsum('...nqk,...nkd->...nqd', p.astype(v.dtype), vb)
    o = o.reshape(*lead, lp, dv)[..., :length, :]
    lse = lse.reshape(*lead, lp)[..., :length]
    return o, lse


def to_strided(t, dil):
    b, h, s, d = t.shape
    return t.reshape(b, h, s // dil, dil, d).swapaxes(2, 3)


def diff_attention(q, k, v, lam, subln_g, lambda_init, pos):
    b, s, _ = q.shape
    q = rope(to_heads(q, 2 * DIFF_HEADS), pos).reshape(b, DIFF_HEADS, 2, s, DIFF_QK_DIM)
    k = rope(to_heads(k, 2 * DIFF_HEADS), pos).reshape(b, DIFF_HEADS, 2, s, DIFF_QK_DIM)
    v = to_heads(v, DIFF_HEADS)
    scale = DIFF_QK_DIM ** -0.5
    o1 = dense_attention(q[:, :, 0], k[:, :, 0], v, scale)
    o2 = dense_attention(q[:, :, 1], k[:, :, 1], v, scale)
    lam32 = lam.astype(jnp.float32)
    lam_full = (jnp.exp(jnp.sum(lam32[0] * lam32[1])) - jnp.exp(jnp.sum(lam32[2] * lam32[3]))
                + lambda_init)
    o = o1 - lam_full.astype(o1.dtype) * o2
    o = rms_norm(o, subln_g) * (1.0 - lambda_init)
    return from_heads(o)


def mla_attention(c_q, c_kv, k_rope, q_norm_g, kv_norm_g, w_uq, w_ukv, pos):
    b, s, _ = c_q.shape
    q = to_heads(rms_norm(c_q, q_norm_g) @ w_uq, MLA_HEADS)
    q = jnp.concatenate([q[..., :MLA_NOPE_DIM], rope(q[..., MLA_NOPE_DIM:], pos)], axis=-1)
    kv = to_heads(rms_norm(c_kv, kv_norm_g) @ w_ukv, MLA_HEADS)
    k_nope, v = kv[..., :MLA_NOPE_DIM], kv[..., MLA_NOPE_DIM:]
    k_pe = rope(k_rope[:, None], pos)
    k = jnp.concatenate([k_nope, jnp.broadcast_to(k_pe, (b, MLA_HEADS, s, MLA_ROPE_DIM))], axis=-1)
    o = dense_attention(q, k, v, (MLA_NOPE_DIM + MLA_ROPE_DIM) ** -0.5)
    return from_heads(o)


def dilated_attention(q, k, v, pos):
    b, s, _ = q.shape
    q = rope(to_heads(q, DIL_HEADS), pos)
    k = rope(to_heads(k, DIL_HEADS), pos)
    v = to_heads(v, DIL_HEADS)
    scale = DIL_HEAD_DIM ** -0.5
    outs, lses = [], []
    for window, dil in DIL_PAIRS:
        half = window // (2 * dil)
        o, lse = banded_attention(to_strided(q, dil), to_strided(k, dil), to_strided(v, dil), half, scale)
        outs.append(o.swapaxes(2, 3).reshape(b, DIL_HEADS, s, DIL_HEAD_DIM))
        lses.append(lse.swapaxes(2, 3).reshape(b, DIL_HEADS, s))
    wts = jax.nn.softmax(jnp.stack(lses), axis=0)
    o = jnp.einsum('pbhs,pbhsd->bhsd', wts.astype(v.dtype), jnp.stack(outs))
    return from_heads(o)


def peer_ffn(x, w_q, sub_keys, u, v):
    b, s, d = x.shape
    xt = x.reshape(-1, PEER_CHUNK, d)
    kk = PEER_TOPK

    def chunk(xc):
        c = xc.shape[0]
        q = (xc @ w_q).reshape(c, PEER_HEADS, 2, PEER_HALF_DIM)
        sc = jnp.einsum('chpd,hpnd->chpn', q, sub_keys, preferred_element_type=jnp.float32)
        top_s, top_i = lax.top_k(sc, kk)
        cand = top_s[:, :, 0, :, None] + top_s[:, :, 1, None, :]
        cand_s, cand_i = lax.top_k(cand.reshape(c, PEER_HEADS, kk * kk), kk)
        i1 = jnp.take_along_axis(top_i[:, :, 0], cand_i // kk, axis=-1)
        i2 = jnp.take_along_axis(top_i[:, :, 1], cand_i % kk, axis=-1)
        experts = i1 * PEER_N_KEYS + i2
        gates = jax.nn.softmax(cand_s, axis=-1)
        ue = jnp.take(u, experts, axis=0)
        ve = jnp.take(v, experts, axis=0)
        act = jax.nn.gelu(jnp.einsum('chkd,cd->chk', ue, xc), approximate=False)
        return jnp.einsum('chk,chkd->cd', gates.astype(xc.dtype) * act, ve)

    return lax.map(chunk, xt).reshape(b, s, d)


def setup_inputs(seed: int = 0) -> dict:
    key = jax.random.key(seed)
    ks = jax.random.split(key, 17)

    def nrm(k, shape, scale):
        return jax.random.normal(k, shape, jnp.float32) * scale

    L = DEPTH
    return {
        'x': nrm(ks[0], (BATCH, SEQ, D_MODEL), 1.0),
        'w_in': nrm(ks[1], (L, D_MODEL, IN_WIDTH), D_MODEL ** -0.5),
        'diff_lambda': nrm(ks[2], (L, 4, DIFF_QK_DIM), 0.1),
        'diff_subln_g': 1.0 + nrm(ks[3], (L, DIFF_V_DIM), 0.02),
        'mla_q_norm_g': 1.0 + nrm(ks[4], (L, MLA_Q_RANK), 0.02),
        'mla_kv_norm_g': 1.0 + nrm(ks[5], (L, MLA_KV_RANK), 0.02),
        'mla_w_uq': nrm(ks[6], (L, MLA_Q_RANK, MLA_HEADS * (MLA_NOPE_DIM + MLA_ROPE_DIM)), MLA_Q_RANK ** -0.5),
        'mla_w_ukv': nrm(ks[7], (L, MLA_KV_RANK, MLA_HEADS * (MLA_NOPE_DIM + MLA_V_DIM)), MLA_KV_RANK ** -0.5),
        'w_o': nrm(ks[8], (L, MIX_WIDTH, D_MODEL), MIX_WIDTH ** -0.5 * DEEPNORM_BETA),
        'ln1_g': 1.0 + nrm(ks[9], (L, D_MODEL), 0.02),
        'ln1_b': nrm(ks[10], (L, D_MODEL), 0.02),
        'peer_w_q': nrm(ks[11], (L, D_MODEL, PEER_HEADS * PEER_QUERY_DIM), D_MODEL ** -0.5),
        'peer_sub_keys': nrm(ks[12], (L, PEER_HEADS, 2, PEER_N_KEYS, PEER_HALF_DIM), PEER_HALF_DIM ** -0.5),
        'peer_u': nrm(ks[13], (L, PEER_N_EXPERTS, D_MODEL), D_MODEL ** -0.5),
        'peer_v': nrm(ks[14], (L, PEER_N_EXPERTS, D_MODEL), DEEPNORM_BETA),
        'ln2_g': 1.0 + nrm(ks[15], (L, D_MODEL), 0.02),
        'ln2_b': nrm(ks[16], (L, D_MODEL), 0.02),
    }


def reference(x, w_in, diff_lambda, diff_subln_g, mla_q_norm_g, mla_kv_norm_g, mla_w_uq, mla_w_ukv,
              w_o, ln1_g, ln1_b, peer_w_q, peer_sub_keys, peer_u, peer_v, ln2_g, ln2_b):
    pos = jnp.arange(x.shape[1], dtype=jnp.int32)
    sizes = (A_QK_WIDTH, A_QK_WIDTH, A_WIDTH, MLA_Q_RANK, MLA_KV_RANK, MLA_ROPE_DIM,
             C_WIDTH, C_WIDTH, C_WIDTH)
    cuts = np.cumsum(sizes)[:-1].tolist()
    for l in range(DEPTH):
        lambda_init = 0.8 - 0.6 * math.exp(-0.3 * (l + 1))
        h = x @ w_in[l]
        a_q, a_k, a_v, b_cq, b_ckv, b_kr, c_q, c_k, c_v = jnp.split(h, cuts, axis=-1)
        out_a = diff_attention(a_q, a_k, a_v, diff_lambda[l], diff_subln_g[l], lambda_init, pos)
        out_b = mla_attention(b_cq, b_ckv, b_kr, mla_q_norm_g[l], mla_kv_norm_g[l],
                              mla_w_uq[l], mla_w_ukv[l], pos)
        out_c = dilated_attention(c_q, c_k, c_v, pos)
        mix = jnp.concatenate([out_a, out_b, out_c], axis=-1) @ w_o[l]
        x = layer_norm(DEEPNORM_ALPHA * x + mix, ln1_g[l], ln1_b[l])
        ffn = peer_ffn(x, peer_w_q[l], peer_sub_keys[l], peer_u[l], peer_v[l])
        x = layer_norm(DEEPNORM_ALPHA * x + ffn, ln2_g[l], ln2_b[l])
    return x
```

```cpp
#define MULTI_LAUNCH 1
#include <hip/hip_runtime.h>
#include <hip/hip_cooperative_groups.h>
#include <math.h>
#include <stdio.h>
#include <string.h>
namespace cg = cooperative_groups;

typedef unsigned short u16;
typedef short bf16x8 __attribute__((ext_vector_type(8)));
typedef short s16x4 __attribute__((ext_vector_type(4)));
typedef float f32x16 __attribute__((ext_vector_type(16)));
typedef float f32x2 __attribute__((ext_vector_type(2)));
typedef __bf16 bf16x2_t __attribute__((ext_vector_type(2)));

#define DI __device__ __forceinline__
#define MFMA(a, b, c) __builtin_amdgcn_mfma_f32_32x32x16_bf16((a), (b), (c), 0, 0, 0)

constexpr int T_ALL = 32768, SEQ = 4096, DM = 1024, INW = 2336, NEXP = 16384;
constexpr int NPAD = 2560;
constexpr float LOG2E = 1.4426950408889634f;
constexpr float ALPHA = 1.41421356237309515f;

struct Params {
  const float* in[17];
  float* out;
  u16 *xb, *winT, *wuqT, *wukvT, *woT, *wqT, *keysb, *ub, *vb;
  float2 *cs32, *cs64;
  u16 *aq, *ak, *av, *bcq, *bckv, *bkr, *cq, *ck, *cv, *mq, *mk, *mv, *cat, *dilo;
  float* dillse;
  u16 *ybuf, *x1;
  int* experts;
  float* gates;
};

DI int otid() { int t = threadIdx.x; asm volatile("" : "+v"(t)); return t; }
DI int obid() { int b = blockIdx.x; asm volatile("" : "+s"(b)); return b; }
DI unsigned pack2(float a, float b) {
  f32x2 v = {a, b};
  return __builtin_bit_cast(unsigned, __builtin_convertvector(v, bf16x2_t));
}
DI float bflo(unsigned w) { return __uint_as_float(w << 16); }
DI float bfhi(unsigned w) { return __uint_as_float(w & 0xffff0000u); }
DI float fexp2(float x) { return __builtin_amdgcn_exp2f(x); }
DI void store8(u16* dst, float a, float b, float c, float d) {
  uint2 v; v.x = pack2(a, b); v.y = pack2(c, d);
  *(uint2*)dst = v;
}
DI void store_tile(u16* dst, const f32x16& v, int hh) {
#pragma unroll
  for (int g = 0; g < 4; ++g) store8(dst + 8 * g + 4 * hh, v[4 * g], v[4 * g + 1], v[4 * g + 2], v[4 * g + 3]);
}
DI void rope32(f32x16& v, const float2* cs, int hh) {
#pragma unroll
  for (int g = 0; g < 2; ++g)
#pragma unroll
    for (int b = 0; b < 4; ++b) {
      float2 c = cs[8 * g + 4 * hh + b];
      float x1 = v[4 * g + b], x2 = v[4 * g + b + 8];
      v[4 * g + b] = x1 * c.x - x2 * c.y;
      v[4 * g + b + 8] = x2 * c.x + x1 * c.y;
    }
}
DI void rope64(f32x16& v0, f32x16& v1, const float2* cs, int hh) {
#pragma unroll
  for (int g = 0; g < 4; ++g)
#pragma unroll
    for (int b = 0; b < 4; ++b) {
      float2 c = cs[8 * g + 4 * hh + b];
      float x1 = v0[4 * g + b], x2 = v1[4 * g + b];
      v0[4 * g + b] = x1 * c.x - x2 * c.y;
      v1[4 * g + b] = x2 * c.x + x1 * c.y;
    }
}
DI float wave_sum(float v) {
#pragma unroll
  for (int o = 32; o; o >>= 1) v += __shfl_xor(v, o);
  return v;
}
DI s16x4 trread(const char* p) {
  return __builtin_amdgcn_ds_read_tr16_b64_v4i16((__attribute__((address_space(3))) s16x4*)(p));
}

DI void convert_bf16(const float* __restrict__ src, u16* __restrict__ dst, size_t n8  ) {
  for (size_t i = (size_t)blockIdx.x * blockDim.x + threadIdx.x; i < n8; i += (size_t)gridDim.x * blockDim.x) {
    float4 a = ((const float4*)src)[2 * i], b = ((const float4*)src)[2 * i + 1];
    uint4 o; o.x = pack2(a.x, a.y); o.y = pack2(a.z, a.w); o.z = pack2(b.x, b.y); o.w = pack2(b.z, b.w);
    ((uint4*)dst)[i] = o;
  }
}
DI void transpose_tile(const float* __restrict__ src, int nsrc, u16* __restrict__ dst, int K, int nt, int ktile, int mode,
                       const float* __restrict__ kscale, float* tile  ) {
  const int tid = otid();
  const int n0 = nt * 64, k0 = ktile * 64;
#pragma unroll
  for (int pass = 0; pass < 2; ++pass) {
    int kk = (tid >> 4) + pass * 32, nn = (tid & 15) * 4;
    int np = n0 + nn;
    int col = np; float sc = 1.f;
    if (mode == 0) {
      if (np < 1184) col = np; else if (np < 1216) col = -1; else if (np < 2368) col = np - 32; else col = -1;
      if (col >= 0 && col < 256) sc = 0.17677669529663687f * LOG2E;
      else if (col >= 1184 && col < 1568) sc = 0.125f * LOG2E;
    } else if (mode == 1) {
      if (np >= 576) col = -1;
      sc = 0.10206207261596575f * LOG2E;
    }
    float4 v = make_float4(0.f, 0.f, 0.f, 0.f);
    if (col >= 0 && col < nsrc) v = *(const float4*)(src + (size_t)(k0 + kk) * nsrc + col);
    float ks = kscale ? kscale[k0 + kk] : 1.f;
    sc *= ks;
    tile[kk * 65 + nn + 0] = v.x * sc; tile[kk * 65 + nn + 1] = v.y * sc;
    tile[kk * 65 + nn + 2] = v.z * sc; tile[kk * 65 + nn + 3] = v.w * sc;
  }
  __syncthreads();
  {
    int nn = tid >> 3, k8 = (tid & 7) * 8;
    float f[8];
#pragma unroll
    for (int e = 0; e < 8; ++e) f[e] = tile[(k8 + e) * 65 + nn];
    uint4 o; o.x = pack2(f[0], f[1]); o.y = pack2(f[2], f[3]); o.z = pack2(f[4], f[5]); o.w = pack2(f[6], f[7]);
    *(uint4*)(dst + (size_t)(n0 + nn) * K + k0 + k8) = o;
  }
  __syncthreads();
}

DI void phase_prep(const Params& p, char* lds) {
  convert_bf16(p.in[0], p.xb, (size_t)T_ALL * DM / 8);
  convert_bf16(p.in[12], p.keysb, (size_t)2 * 16 * 128 * 128 / 8);
  convert_bf16(p.in[13], p.ub, (size_t)NEXP * DM / 8);
  convert_bf16(p.in[14], p.vb, (size_t)NEXP * DM / 8);
  for (int i = blockIdx.x * blockDim.x + threadIdx.x; i < SEQ * 48; i += gridDim.x * blockDim.x) {
    int pos = i / 48, r = i % 48;
    if (r < 16) {
      float ang = (float)pos * expf(-logf(10000.0f) * (float)r / 16.f);
      p.cs32[pos * 16 + r] = make_float2(cosf(ang), sinf(ang));
    } else {
      int q = r - 16;
      float ang = (float)pos * expf(-logf(10000.0f) * (float)q / 32.f);
      p.cs64[pos * 32 + q] = make_float2(cosf(ang), sinf(ang));
    }
  }
  float* tile = (float*)lds;
  for (int u = blockIdx.x; u < 2960; u += gridDim.x) {
    if (u < 1280) {
      int l = u / 640, r = u % 640;
      transpose_tile(p.in[1] + (size_t)l * DM * INW, INW, p.winT + (size_t)l * NPAD * 1024, 1024, r / 16, r % 16, 0, nullptr, tile);
    } else if (u < 1376) {
      int v = u - 1280; int l = v / 48, r = v % 48;
      transpose_tile(p.in[6] + (size_t)l * 256 * 576, 576, p.wuqT + (size_t)l * 768 * 256, 256, r / 4, r % 4, 1, p.in[4] + l * 256, tile);
    } else if (u < 1424) {
      int v = u - 1376; int l = v / 24, r = v % 24;
      transpose_tile(p.in[7] + (size_t)l * 128 * 768, 768, p.wukvT + (size_t)l * 768 * 128, 128, r / 2, r % 2, 2, p.in[5] + l * 128, tile);
    } else if (u < 1936) {
      int v = u - 1424; int l = v / 256, r = v % 256;
      transpose_tile(p.in[8] + (size_t)l * DM * DM, DM, p.woT + (size_t)l * DM * DM, 1024, r / 16, r % 16, 3, nullptr, tile);
    } else {
      int v = u - 1936; int l = v / 512, r = v % 512;
      transpose_tile(p.in[11] + (size_t)l * DM * 2048, 2048, p.wqT + (size_t)l * 2048 * DM, 1024, r / 16, r % 16, 3, nullptr, tile);
    }
  }
}

constexpr int G_ROWB = 144;
constexpr int G_X1B = 256 * G_ROWB;
constexpr int G_X2B = 128 * G_ROWB;
constexpr int G_STAGE = G_X1B + G_X2B;
constexpr int LDS_BYTES = 2 * G_STAGE + 4096;

template <int K>
DI void gemm_core(const u16* __restrict__ X1, int ld1, const u16* __restrict__ X2, int ld2, f32x16 (&acc)[2][2], char* lds) {
  const int tid = otid(), lane = tid & 63, wave = tid >> 6;
  const int wn = wave & 3, wm = wave >> 2, r = lane & 31, hh = lane >> 5;
  constexpr int NK = K / 64;
  uint4 g1[4], g2[2];
  const int lrow = tid >> 3, lch = tid & 7;
#pragma unroll
  for (int i = 0; i < 2; ++i)
#pragma unroll
    for (int j = 0; j < 2; ++j)
#pragma unroll
      for (int e = 0; e < 16; ++e) acc[i][j][e] = 0.f;
  const u16* p1 = X1 + (size_t)lrow * ld1 + lch * 8;
  const u16* p2 = X2 + (size_t)lrow * ld2 + lch * 8;
#pragma unroll
  for (int e = 0; e < 4; ++e) g1[e] = *(const uint4*)(p1 + (size_t)(64 * e) * ld1);
#pragma unroll
  for (int e = 0; e < 2; ++e) g2[e] = *(const uint4*)(p2 + (size_t)(64 * e) * ld2);
  {
    char* b = lds;
#pragma unroll
    for (int e = 0; e < 4; ++e) *(uint4*)(b + (lrow + 64 * e) * G_ROWB + lch * 16) = g1[e];
#pragma unroll
    for (int e = 0; e < 2; ++e) *(uint4*)(b + G_X1B + (lrow + 64 * e) * G_ROWB + lch * 16) = g2[e];
  }
  __syncthreads();
  for (int kt = 0; kt < NK; ++kt) {
    if (kt + 1 < NK) {
#pragma unroll
      for (int e = 0; e < 4; ++e) g1[e] = *(const uint4*)(p1 + (size_t)(64 * e) * ld1 + (kt + 1) * 64);
#pragma unroll
      for (int e = 0; e < 2; ++e) g2[e] = *(const uint4*)(p2 + (size_t)(64 * e) * ld2 + (kt + 1) * 64);
    }
    const char* b1 = lds + (kt & 1) * G_STAGE + (wn * 64 + r) * G_ROWB + hh * 16;
    const char* b2 = lds + (kt & 1) * G_STAGE + G_X1B + (wm * 64 + r) * G_ROWB + hh * 16;
#pragma unroll
    for (int s = 0; s < 4; ++s) {
      bf16x8 a0 = *(const bf16x8*)(b1 + s * 32), a1 = *(const bf16x8*)(b1 + 32 * G_ROWB + s * 32);
      bf16x8 c0 = *(const bf16x8*)(b2 + s * 32), c1 = *(const bf16x8*)(b2 + 32 * G_ROWB + s * 32);
      acc[0][0] = MFMA(a0, c0, acc[0][0]);
      acc[0][1] = MFMA(a0, c1, acc[0][1]);
      acc[1][0] = MFMA(a1, c0, acc[1][0]);
      acc[1][1] = MFMA(a1, c1, acc[1][1]);
    }
    if (kt + 1 < NK) {
      char* b = lds + ((kt + 1) & 1) * G_STAGE;
#pragma unroll
      for (int e = 0; e < 4; ++e) *(uint4*)(b + (lrow + 64 * e) * G_ROWB + lch * 16) = g1[e];
#pragma unroll
      for (int e = 0; e < 2; ++e) *(uint4*)(b + G_X1B + (lrow + 64 * e) * G_ROWB + lch * 16) = g2[e];
    }
    __syncthreads();
  }
}

DI void phase_gemm1(const Params& p, int layer, char* lds) {
  const int tid = otid(), lane = tid & 63, wave = tid >> 6;
  const int wn = wave & 3, wm = wave >> 2, r = lane & 31, hh = lane >> 5;
  for (int item = blockIdx.x; item < 2560; item += gridDim.x) {
    const int mt = item / 10, nt = item % 10;
    f32x16 acc[2][2];
    gemm_core<1024>(p.winT + ((size_t)layer * NPAD + nt * 256) * 1024, 1024, p.xb + (size_t)mt * 128 * 1024, 1024, acc, lds);
    const int n64 = nt * 256 + wn * 64;
#pragma unroll
    for (int j = 0; j < 2; ++j) {
      const int t = mt * 128 + wm * 64 + j * 32 + r;
      const int b = t >> 12, s = t & 4095;
      if (n64 < 512) {
        u16* base = (n64 < 256) ? p.aq : p.ak;
        const int hh0 = (n64 & 255) >> 5;
        const float2* cs = p.cs32 + s * 16;
#pragma unroll
        for (int i = 0; i < 2; ++i) {
          rope32(acc[i][j], cs, hh);
          store_tile(base + ((size_t)(b * 8 + hh0 + i) * SEQ + s) * 32, acc[i][j], hh);
        }
      } else if (n64 < 768) {
        const int head = (n64 - 512) >> 6;
#pragma unroll
        for (int i = 0; i < 2; ++i) store_tile(p.av + ((size_t)(b * 4 + head) * SEQ + s) * 64 + i * 32, acc[i][j], hh);
      } else if (n64 < 1024) {
#pragma unroll
        for (int i = 0; i < 2; ++i) store_tile(p.bcq + (size_t)t * 256 + (n64 - 768) + i * 32, acc[i][j], hh);
      } else if (n64 < 1152) {
#pragma unroll
        for (int i = 0; i < 2; ++i) store_tile(p.bckv + (size_t)t * 128 + (n64 - 1024) + i * 32, acc[i][j], hh);
      } else if (n64 == 1152) {
        rope32(acc[0][j], p.cs32 + s * 16, hh);
        store_tile(p.bkr + (size_t)t * 32, acc[0][j], hh);
      } else if (n64 < 1984) {
        const bool isq = n64 < 1600;
        const int head = (n64 - (isq ? 1216 : 1600)) >> 6;
        u16* base = isq ? p.cq : p.ck;
        rope64(acc[0][j], acc[1][j], p.cs64 + s * 32, hh);
#pragma unroll
        for (int i = 0; i < 2; ++i) store_tile(base + ((size_t)(b * 6 + head) * SEQ + s) * 64 + i * 32, acc[i][j], hh);
      } else if (n64 < 2368) {
        const int head = (n64 - 1984) >> 6;
#pragma unroll
        for (int i = 0; i < 2; ++i) store_tile(p.cv + ((size_t)(b * 6 + head) * SEQ + s) * 64 + i * 32, acc[i][j], hh);
      }
    }
  }
}

DI void phase_mla_up(const Params& p, int layer, char* lds) {
  const int tid = otid(), lane = tid & 63, wave = tid >> 6;
  const int wn = wave & 3, wm = wave >> 2, r = lane & 31, hh = lane >> 5;
  float* rinv_s = (float*)(lds + 2 * G_STAGE);
  for (int item = blockIdx.x; item < 1536; item += gridDim.x) {
    const int which = item / 768;
    const int it = item % 768, mt = it / 3, nt = it % 3;
    {
      const int tok = tid >> 2, part = tid & 3;
      float ss = 0.f;
      if (which == 0) {
        const uint4* row = (const uint4*)(p.bcq + (size_t)(mt * 128 + tok) * 256 + part * 64);
#pragma unroll
        for (int c = 0; c < 8; ++c) {
          uint4 v = row[c];
          ss += bflo(v.x) * bflo(v.x) + bfhi(v.x) * bfhi(v.x) + bflo(v.y) * bflo(v.y) + bfhi(v.y) * bfhi(v.y) +
                bflo(v.z) * bflo(v.z) + bfhi(v.z) * bfhi(v.z) + bflo(v.w) * bflo(v.w) + bfhi(v.w) * bfhi(v.w);
        }
      } else {
        const uint4* row = (const uint4*)(p.bckv + (size_t)(mt * 128 + tok) * 128 + part * 32);
#pragma unroll
        for (int c = 0; c < 4; ++c) {
          uint4 v = row[c];
          ss += bflo(v.x) * bflo(v.x) + bfhi(v.x) * bfhi(v.x) + bflo(v.y) * bflo(v.y) + bfhi(v.y) * bfhi(v.y) +
                bflo(v.z) * bflo(v.z) + bfhi(v.z) * bfhi(v.z) + bflo(v.w) * bflo(v.w) + bfhi(v.w) * bfhi(v.w);
        }
      }
      ss += __shfl_xor(ss, 1);
      ss += __shfl_xor(ss, 2);
      if (part == 0) rinv_s[tok] = rsqrtf(ss / (which == 0 ? 256.f : 128.f) + 1e-5f);
    }
    f32x16 acc[2][2];
    if (which == 0)
      gemm_core<256>(p.wuqT + ((size_t)layer * 768 + nt * 256) * 256, 256, p.bcq + (size_t)mt * 128 * 256, 256, acc, lds);
    else
      gemm_core<128>(p.wukvT + ((size_t)layer * 768 + nt * 256) * 128, 128, p.bckv + (size_t)mt * 128 * 128, 128, acc, lds);
    const int n64 = nt * 256 + wn * 64;
#pragma unroll
    for (int j = 0; j < 2; ++j) {
      const int tl = wm * 64 + j * 32 + r;
      const int t = mt * 128 + tl;
      const int b = t >> 12, s = t & 4095;
      const float ri = rinv_s[tl];
#pragma unroll
      for (int i = 0; i < 2; ++i) {
        const int n32 = n64 + i * 32;
        f32x16 v = acc[i][j];
#pragma unroll
        for (int e = 0; e < 16; ++e) v[e] *= ri;
        if (which == 0) {
          if (n32 < 576) {
            const int head = n32 / 96, dpart = (n32 % 96) >> 5;
            if (dpart == 2) rope32(v, p.cs32 + s * 16, hh);
            store_tile(p.mq + ((size_t)(b * 6 + head) * SEQ + s) * 96 + dpart * 32, v, hh);
          }
        } else {
          const int head = n32 >> 7, d32 = (n32 & 127) >> 5;
          u16* base = (d32 < 2) ? p.mk : p.mv;
          store_tile(base + ((size_t)(b * 6 + head) * SEQ + s) * 64 + (d32 & 1) * 32, v, hh);
        }
      }
    }
    __syncthreads();
  }
}

DI bf16x8 packP(const f32x16& S, int s2) {
  uint4 u;
  u.x = pack2(S[8 * s2 + 0], S[8 * s2 + 1]); u.y = pack2(S[8 * s2 + 2], S[8 * s2 + 3]);
  u.z = pack2(S[8 * s2 + 4], S[8 * s2 + 5]); u.w = pack2(S[8 * s2 + 6], S[8 * s2 + 7]);
  return __builtin_bit_cast(bf16x8, u);
}
DI float max16(const f32x16& S) {
  float a = fmaxf(fmaxf(S[0], S[1]), fmaxf(S[2], S[3]));
  float b = fmaxf(fmaxf(S[4], S[5]), fmaxf(S[6], S[7]));
  float c = fmaxf(fmaxf(S[8], S[9]), fmaxf(S[10], S[11]));
  float d = fmaxf(fmaxf(S[12], S[13]), fmaxf(S[14], S[15]));
  return fmaxf(fmaxf(a, b), fmaxf(c, d));
}

template <bool MLA>
DI void attn_dense_item(const Params& p, int layer, int item, float lam_full, float lam_init, char* lds) {
  constexpr int NS = MLA ? 1 : 2;
  constexpr int DK = MLA ? 96 : 32;
  constexpr int KSTR = MLA ? 208 : 80;
  constexpr int KB = 64 * KSTR;
  constexpr int STAGE = NS * KB + 8192;
  constexpr int NKS = DK / 16;
  const int tid = otid(), lane = tid & 63, wave = tid >> 6, r = lane & 31, hh = lane >> 5;
  int b, head, qb;
  if (MLA) { b = item / 96; head = (item / 16) % 6; qb = item & 15; }
  else { b = item / 64; head = (item / 16) & 3; qb = item & 15; }
  const int q0 = qb * 256 + wave * 32;
  const u16 *kg0, *kg1, *vg;
  bf16x8 Q[NS][NKS];
  if (MLA) {
    const u16* qp = p.mq + ((size_t)(b * 6 + head) * SEQ + q0 + r) * 96 + hh * 8;
#pragma unroll
    for (int s = 0; s < NKS; ++s) Q[0][s] = *(const bf16x8*)(qp + s * 16);
    kg0 = p.mk + (size_t)(b * 6 + head) * SEQ * 64;
    kg1 = p.bkr + (size_t)b * SEQ * 32;
    vg = p.mv + (size_t)(b * 6 + head) * SEQ * 64;
  } else {
#pragma unroll
    for (int st = 0; st < NS; ++st) {
      const u16* qp = p.aq + ((size_t)(b * 8 + head * 2 + st) * SEQ + q0 + r) * 32 + hh * 8;
#pragma unroll
      for (int s = 0; s < NKS; ++s) Q[st][s] = *(const bf16x8*)(qp + s * 16);
    }
    kg0 = p.ak + (size_t)(b * 8 + head * 2) * SEQ * 32;
    kg1 = p.ak + (size_t)(b * 8 + head * 2 + 1) * SEQ * 32;
    vg = p.av + (size_t)(b * 4 + head) * SEQ * 64;
  }
  f32x16 O[NS][2];
  float m[NS], l[NS];
#pragma unroll
  for (int st = 0; st < NS; ++st) {
    m[st] = -1e30f; l[st] = 0.f;
#pragma unroll
    for (int e = 0; e < 16; ++e) { O[st][0][e] = 0.f; O[st][1][e] = 0.f; }
  }
  uint4 gk, gv, gp;
  auto gload = [&](int kt) {
    const int k0 = kt * 64;
    if (MLA) {
      gk = *(const uint4*)(kg0 + (size_t)(k0 + (tid >> 3)) * 64 + (tid & 7) * 8);
      if (tid < 256) gp = *(const uint4*)(kg1 + (size_t)(k0 + (tid >> 2)) * 32 + (tid & 3) * 8);
    } else {
      const u16* kb = (tid < 256) ? kg0 : kg1;
      const int c = tid & 255;
      gk = *(const uint4*)(kb + (size_t)(k0 + (c >> 2)) * 32 + (c & 3) * 8);
    }
    gv = *(const uint4*)(vg + (size_t)(k0 + (tid >> 3)) * 64 + (tid & 7) * 8);
  };
  auto swrite = [&](int sb) {
    char* base = lds + sb * STAGE;
    if (MLA) {
      *(uint4*)(base + (tid >> 3) * KSTR + (tid & 7) * 16) = gk;
      if (tid < 256) *(uint4*)(base + (tid >> 2) * KSTR + 128 + (tid & 3) * 16) = gp;
    } else {
      const int c = tid & 255;
      *(uint4*)(base + (tid >> 8) * KB + (c >> 2) * KSTR + (c & 3) * 16) = gk;
    }
    const int row = tid >> 3;
    *(uint4*)(base + NS * KB + row * 128 + (((tid & 7) * 16) ^ (((row >> 1) & 1) << 6))) = gv;
  };
  const int tq = (lane & 15) >> 2, tp = lane & 3, tg1 = (lane >> 4) & 1, swz = (tq >> 1) & 1;
  const int voff = (4 * hh + tq) * 128 + 32 * tg1 + 8 * tp;

  gload(0); swrite(0);
  __syncthreads();
  for (int kt = 0; kt < 64; ++kt) {
    if (kt + 1 < 64) gload(kt + 1);
    const char* base = lds + (kt & 1) * STAGE;
    const char* vb = base + NS * KB + voff;
#pragma unroll
    for (int st = 0; st < NS; ++st) {
      f32x16 S0, S1;
#pragma unroll
      for (int e = 0; e < 16; ++e) { S0[e] = 0.f; S1[e] = 0.f; }
      const char* kb = base + st * KB + r * KSTR + hh * 16;
#pragma unroll
      for (int s = 0; s < NKS; ++s) {
        bf16x8 a0 = *(const bf16x8*)(kb + s * 32);
        bf16x8 a1 = *(const bf16x8*)(kb + 32 * KSTR + s * 32);
        S0 = MFMA(a0, Q[st][s], S0);
        S1 = MFMA(a1, Q[st][s], S1);
      }
      float mx = fmaxf(max16(S0), max16(S1));
      mx = fmaxf(mx, __shfl_xor(mx, 32));
      if (__any(mx > m[st])) {
        const float mn = fmaxf(m[st], mx);
        const float al = fexp2(m[st] - mn);
        m[st] = mn; l[st] *= al;
#pragma unroll
        for (int e = 0; e < 16; ++e) { O[st][0][e] *= al; O[st][1][e] *= al; }
      }
      float ps = 0.f;
#pragma unroll
      for (int e = 0; e < 16; ++e) { S0[e] = fexp2(S0[e] - m[st]); S1[e] = fexp2(S1[e] - m[st]); ps += S0[e] + S1[e]; }
      l[st] += ps;
      bf16x8 P[2][2];
      P[0][0] = packP(S0, 0); P[0][1] = packP(S0, 1); P[1][0] = packP(S1, 0); P[1][1] = packP(S1, 1);
#pragma unroll
      for (int i2 = 0; i2 < 2; ++i2)
#pragma unroll
        for (int u = 0; u < 2; ++u)
#pragma unroll
          for (int s2 = 0; s2 < 2; ++s2) {
            const char* a = vb + (32 * u + 16 * s2) * 128 + 64 * (i2 ^ swz);
            s16x4 lo = trread(a), hi = trread(a + 8 * 128);
            bf16x8 vf = __builtin_shufflevector(lo, hi, 0, 1, 2, 3, 4, 5, 6, 7);
            O[st][i2] = MFMA(vf, P[u][s2], O[st][i2]);
          }
    }
    if (kt + 1 < 64) swrite((kt + 1) & 1);
    __syncthreads();
  }
  const int t = b * SEQ + q0 + r;
  if (MLA) {
    const float inv = 1.f / (l[0] + __shfl_xor(l[0], 32));
#pragma unroll
    for (int i2 = 0; i2 < 2; ++i2) {
#pragma unroll
      for (int e = 0; e < 16; ++e) O[0][i2][e] *= inv;
      store_tile(p.cat + (size_t)t * 1024 + 256 + head * 64 + i2 * 32, O[0][i2], hh);
    }
  } else {
    const float inv1 = 1.f / (l[0] + __shfl_xor(l[0], 32));
    const float inv2 = lam_full / (l[NS - 1] + __shfl_xor(l[NS - 1], 32));
    float ss = 0.f;
#pragma unroll
    for (int i2 = 0; i2 < 2; ++i2)
#pragma unroll
      for (int e = 0; e < 16; ++e) {
        float o = O[0][i2][e] * inv1 - O[NS - 1][i2][e] * inv2;
        O[0][i2][e] = o; ss += o * o;
      }
    ss += __shfl_xor(ss, 32);
    const float rn = rsqrtf(ss * (1.f / 64.f) + 1e-5f) * (1.f - lam_init);
    const float* g = p.in[3] + layer * 64;
#pragma unroll
    for (int i2 = 0; i2 < 2; ++i2) {
#pragma unroll
      for (int gq = 0; gq < 4; ++gq)
#pragma unroll
        for (int bq = 0; bq < 4; ++bq) O[0][i2][4 * gq + bq] *= rn * g[i2 * 32 + 8 * gq + 4 * hh + bq];
      store_tile(p.cat + (size_t)t * 1024 + head * 64 + i2 * 32, O[0][i2], hh);
    }
  }
}

DI void attn_dilated_item(const Params& p, int item, char* lds) {
  const int tid = otid(), lane = tid & 63, wave = tid >> 6, r = lane & 31, hh = lane >> 5;
  const int pair = item / 768, rem = item % 768, bh = rem >> 4, sub = rem & 15;
  const int dil = (pair == 0) ? 1 : (pair == 1 ? 4 : 16);
  const int L = SEQ / dil;
  int cls, blk;
  if (pair == 0) { cls = 0; blk = sub; } else if (pair == 1) { cls = sub & 3; blk = sub >> 2; } else { cls = sub; blk = 0; }
  const int i0 = blk * 256;
  const u16* kg = p.ck + (size_t)bh * SEQ * 64;
  const u16* vg = p.cv + (size_t)bh * SEQ * 64;
  constexpr int KROW = 144;
  char* Kl = lds;
  char* Vl = lds + 384 * KROW;
#pragma unroll
  for (int e = 0; e < 6; ++e) {
    const int c = tid + e * 512;
    const int row = c >> 3, ch = c & 7;
    const int kk = i0 - 64 + row;
    uint4 kv = make_uint4(0, 0, 0, 0), vv = make_uint4(0, 0, 0, 0);
    if (kk >= 0 && kk < L) {
      const size_t pos = (size_t)(cls + dil * kk);
      kv = *(const uint4*)(kg + pos * 64 + ch * 8);
      vv = *(const uint4*)(vg + pos * 64 + ch * 8);
    }
    *(uint4*)(Kl + row * KROW + ch * 16) = kv;
    *(uint4*)(Vl + row * 128 + ((ch * 16) ^ (((row >> 1) & 1) << 6))) = vv;
  }
  const int qq = i0 + 32 * wave + r;
  const int pq = cls + dil * qq;
  bf16x8 Q[4];
  {
    const u16* qp = p.cq + ((size_t)bh * SEQ + pq) * 64 + hh * 8;
#pragma unroll
    for (int s = 0; s < 4; ++s) Q[s] = *(const bf16x8*)(qp + s * 16);
  }
  __syncthreads();
  f32x16 O[2];
#pragma unroll
  for (int e = 0; e < 16; ++e) { O[0][e] = 0.f; O[1][e] = 0.f; }
  float m = -1e30f, l = 0.f;
  const int tq = (lane & 15) >> 2, tp = lane & 3, tg1 = (lane >> 4) & 1, swz = (tq >> 1) & 1;
  const int voff = (4 * hh + tq) * 128 + 32 * tg1 + 8 * tp;
#pragma unroll
  for (int j = 0; j < 5; ++j) {
    const int rb = 32 * wave + 32 * j;
    f32x16 S;
#pragma unroll
    for (int e = 0; e < 16; ++e) S[e] = 0.f;
    const char* kb = Kl + (rb + r) * KROW + hh * 16;
#pragma unroll
    for (int s = 0; s < 4; ++s) S = MFMA(*(const bf16x8*)(kb + s * 32), Q[s], S);
    unsigned vmask = 0;
#pragma unroll
    for (int e = 0; e < 16; ++e) {
      const int cr = (e & 3) + 8 * (e >> 2) + 4 * hh;
      const int kk = i0 - 64 + rb + cr;
      bool ok = (kk >= 0) && (kk < L);
      if (j == 0) ok = ok && (cr >= r);
      if (j == 4) ok = ok && (cr <= r);
      vmask |= ok ? (1u << e) : 0u;
      S[e] = ok ? S[e] : -1e30f;
    }
    float mx = max16(S);
    mx = fmaxf(mx, __shfl_xor(mx, 32));
    if (__any(mx > m)) {
      const float mn = fmaxf(m, mx);
      const float al = fexp2(m - mn);
      m = mn; l *= al;
#pragma unroll
      for (int e = 0; e < 16; ++e) { O[0][e] *= al; O[1][e] *= al; }
    }
    float ps = 0.f;
#pragma unroll
    for (int e = 0; e < 16; ++e) { S[e] = ((vmask >> e) & 1) ? fexp2(S[e] - m) : 0.f; ps += S[e]; }
    l += ps;
    bf16x8 P0 = packP(S, 0), P1 = packP(S, 1);
    const char* vb = Vl + rb * 128 + voff;
#pragma unroll
    for (int i2 = 0; i2 < 2; ++i2)
#pragma unroll
      for (int s2 = 0; s2 < 2; ++s2) {
        const char* a = vb + (16 * s2) * 128 + 64 * (i2 ^ swz);
        s16x4 lo = trread(a), hi = trread(a + 8 * 128);
        bf16x8 vf = __builtin_shufflevector(lo, hi, 0, 1, 2, 3, 4, 5, 6, 7);
        O[i2] = MFMA(vf, s2 == 0 ? P0 : P1, O[i2]);
      }
  }
  const float lt = l + __shfl_xor(l, 32);
  const float inv = 1.f / lt;
  const int b = bh / 6, head = bh % 6;
  const int t = b * SEQ + pq;
#pragma unroll
  for (int i2 = 0; i2 < 2; ++i2) {
#pragma unroll
    for (int e = 0; e < 16; ++e) O[i2][e] *= inv;
    store_tile(p.dilo + ((size_t)pair * T_ALL + t) * 384 + head * 64 + i2 * 32, O[i2], hh);
  }
  if (hh == 0) p.dillse[((size_t)pair * T_ALL + t) * 6 + head] = m + __log2f(lt);
  __syncthreads();
}

DI void phase_attn(const Params& p, int layer, char* lds) {
  const float* lam = p.in[2] + layer * 128;
  float s1 = 0.f, s2 = 0.f;
  for (int i = 0; i < 32; ++i) { s1 += lam[i] * lam[32 + i]; s2 += lam[64 + i] * lam[96 + i]; }
  const float lam_init = 0.8f - 0.6f * expf(-0.3f * (float)(layer + 1));
  const float lam_full = expf(s1) - expf(s2) + lam_init;
  for (int item = blockIdx.x; item < 3584; item += gridDim.x) {
    if (item < 512) attn_dense_item<false>(p, layer, item, lam_full, lam_init, lds);
    else if (item < 1280) attn_dense_item<true>(p, layer, item - 512, lam_full, lam_init, lds);
    else attn_dilated_item(p, item - 1280, lds);
  }
}

DI void phase_outproj(const Params& p, int layer, char* lds) {
  const int tid = otid(), lane = tid & 63, wave = tid >> 6;
  const int wn = wave & 3, wm = wave >> 2, r = lane & 31, hh = lane >> 5;
  for (int mt = blockIdx.x; mt < 256; mt += gridDim.x) {
    {
      const int t = mt * 128 + (tid >> 2), quarter = tid & 3;
#pragma unroll 1
      for (int cc = 0; cc < 12; ++cc) {
        const int c = quarter * 12 + cc;
        const int head = c >> 3;
        float l0 = p.dillse[((size_t)0 * T_ALL + t) * 6 + head];
        float l1 = p.dillse[((size_t)1 * T_ALL + t) * 6 + head];
        float l2 = p.dillse[((size_t)2 * T_ALL + t) * 6 + head];
        float mx = fmaxf(l0, fmaxf(l1, l2));
        float w0 = fexp2(l0 - mx), w1 = fexp2(l1 - mx), w2 = fexp2(l2 - mx);
        float inv = 1.f / (w0 + w1 + w2);
        w0 *= inv; w1 *= inv; w2 *= inv;
        uint4 a = *(const uint4*)(p.dilo + ((size_t)0 * T_ALL + t) * 384 + c * 8);
        uint4 bq = *(const uint4*)(p.dilo + ((size_t)1 * T_ALL + t) * 384 + c * 8);
        uint4 cq = *(const uint4*)(p.dilo + ((size_t)2 * T_ALL + t) * 384 + c * 8);
        uint4 o;
        o.x = pack2(w0 * bflo(a.x) + w1 * bflo(bq.x) + w2 * bflo(cq.x), w0 * bfhi(a.x) + w1 * bfhi(bq.x) + w2 * bfhi(cq.x));
        o.y = pack2(w0 * bflo(a.y) + w1 * bflo(bq.y) + w2 * bflo(cq.y), w0 * bfhi(a.y) + w1 * bfhi(bq.y) + w2 * bfhi(cq.y));
        o.z = pack2(w0 * bflo(a.z) + w1 * bflo(bq.z) + w2 * bflo(cq.z), w0 * bfhi(a.z) + w1 * bfhi(bq.z) + w2 * bfhi(cq.z));
        o.w = pack2(w0 * bflo(a.w) + w1 * bflo(bq.w) + w2 * bflo(cq.w), w0 * bfhi(a.w) + w1 * bfhi(bq.w) + w2 * bfhi(cq.w));
        *(uint4*)(p.cat + (size_t)t * 1024 + 640 + c * 8) = o;
      }
    }
    __syncthreads();
    for (int nt = 0; nt < 4; ++nt) {
      f32x16 acc[2][2];
      gemm_core<1024>(p.woT + ((size_t)layer * 1024 + nt * 256) * 1024, 1024, p.cat + (size_t)mt * 128 * 1024, 1024, acc, lds);
#pragma unroll
      for (int j = 0; j < 2; ++j) {
        const int t = mt * 128 + wm * 64 + j * 32 + r;
#pragma unroll
        for (int i = 0; i < 2; ++i) {
          const int n0 = nt * 256 + wn * 64 + i * 32;
#pragma unroll
          for (int g = 0; g < 4; ++g) {
            const size_t off = (size_t)t * 1024 + n0 + 8 * g + 4 * hh;
            uint2 xv = *(const uint2*)(p.xb + off);
            store8(p.ybuf + off, ALPHA * bflo(xv.x) + acc[i][j][4 * g], ALPHA * bfhi(xv.x) + acc[i][j][4 * g + 1],
                   ALPHA * bflo(xv.y) + acc[i][j][4 * g + 2], ALPHA * bfhi(xv.y) + acc[i][j][4 * g + 3]);
          }
        }
      }
    }
    __syncthreads();
    const float* g1 = p.in[9] + layer * 1024;
    const float* b1 = p.in[10] + layer * 1024;
    for (int rr = 0; rr < 16; ++rr) {
      const int t = mt * 128 + wave * 16 + rr;
      const uint4* yp = (const uint4*)(p.ybuf + (size_t)t * 1024 + lane * 16);
      uint4 v0 = yp[0], v1 = yp[1];
      float y[16] = {bflo(v0.x), bfhi(v0.x), bflo(v0.y), bfhi(v0.y), bflo(v0.z), bfhi(v0.z), bflo(v0.w), bfhi(v0.w),
                     bflo(v1.x), bfhi(v1.x), bflo(v1.y), bfhi(v1.y), bflo(v1.z), bfhi(v1.z), bflo(v1.w), bfhi(v1.w)};
      float s = 0.f;
#pragma unroll
      for (int e = 0; e < 16; ++e) s += y[e];
      const float mean = wave_sum(s) * (1.f / 1024.f);
      float vs = 0.f;
#pragma unroll
      for (int e = 0; e < 16; ++e) { y[e] -= mean; vs += y[e] * y[e]; }
      const float rstd = rsqrtf(wave_sum(vs) * (1.f / 1024.f) + 1e-5f);
      float o[16];
#pragma unroll
      for (int e = 0; e < 16; ++e) o[e] = y[e] * rstd * g1[lane * 16 + e] + b1[lane * 16 + e];
      uint4 w0, w1;
      w0.x = pack2(o[0], o[1]); w0.y = pack2(o[2], o[3]); w0.z = pack2(o[4], o[5]); w0.w = pack2(o[6], o[7]);
      w1.x = pack2(o[8], o[9]); w1.y = pack2(o[10], o[11]); w1.z = pack2(o[12], o[13]); w1.w = pack2(o[14], o[15]);
      uint4* xp = (uint4*)(p.x1 + (size_t)t * 1024 + lane * 16);
      xp[0] = w0; xp[1] = w1;
    }
    __syncthreads();
  }
}

DI void ins16(float (&L)[16], float v) {
#pragma unroll
  for (int k = 15; k >= 1; --k) L[k] = __builtin_amdgcn_fmed3f(v, L[k - 1], L[k]);
  L[0] = fmaxf(L[0], v);
}
constexpr int QS_STR = 528;

DI void phase_peer_route(const Params& p, int layer, char* lds) {
  const int tid = otid(), lane = tid & 63, wave = tid >> 6;
  const int wn = wave & 3, wm = wave >> 2, r = lane & 31, hh = lane >> 5;
  char* Qs = lds;
  unsigned* Ls = (unsigned*)(lds + 128 * QS_STR);
  for (int item = blockIdx.x; item < 2048; item += gridDim.x) {
    const int mt = item >> 3, head = item & 7;
    f32x16 acc[2][2];
    gemm_core<1024>(p.wqT + ((size_t)layer * 2048 + head * 256) * 1024, 1024, p.x1 + (size_t)mt * 128 * 1024, 1024, acc, lds);
#pragma unroll
    for (int j = 0; j < 2; ++j)
#pragma unroll
      for (int i = 0; i < 2; ++i)
#pragma unroll
        for (int g = 0; g < 4; ++g) {
          uint2 v; v.x = pack2(acc[i][j][4 * g], acc[i][j][4 * g + 1]); v.y = pack2(acc[i][j][4 * g + 2], acc[i][j][4 * g + 3]);
          *(uint2*)(Qs + (wm * 64 + j * 32 + r) * QS_STR + (wn * 64 + i * 32 + 8 * g + 4 * hh) * 2) = v;
        }
    __syncthreads();
    {
      const int pp = wave >> 2, tg = wave & 3;
      bf16x8 Bq[8];
      const char* qrow = Qs + (tg * 32 + r) * QS_STR + (pp * 128 + hh * 8) * 2;
#pragma unroll
      for (int s = 0; s < 8; ++s) Bq[s] = *(const bf16x8*)(qrow + s * 32);
      const u16* kbase = p.keysb + ((size_t)(layer * 16 + head * 2 + pp) * 128) * 128;
      float Lst[16];
#pragma unroll
      for (int k = 0; k < 16; ++k) Lst[k] = -3.0e38f;
#pragma unroll
      for (int kt = 0; kt < 4; ++kt) {
        f32x16 S;
#pragma unroll
        for (int e = 0; e < 16; ++e) S[e] = 0.f;
        const u16* krow = kbase + (size_t)(kt * 32 + r) * 128 + hh * 8;
#pragma unroll
        for (int s = 0; s < 8; ++s) S = MFMA(*(const bf16x8*)(krow + s * 16), Bq[s], S);
#pragma unroll
        for (int e = 0; e < 16; ++e) {
          const int kidx = kt * 32 + (e & 3) + 8 * (e >> 2) + 4 * hh;
          const float v = __uint_as_float((__float_as_uint(S[e]) & ~127u) | (unsigned)(127 - kidx));
          ins16(Lst, v);
        }
      }
      float Pl[16];
#pragma unroll
      for (int k = 0; k < 16; ++k) Pl[k] = __shfl_xor(Lst[k], 32);
#pragma unroll
      for (int k = 0; k < 16; ++k) ins16(Lst, Pl[k]);
      if (hh == 0) {
        unsigned* dst = Ls + ((tg * 32 + r) * 2 + pp) * 16;
#pragma unroll
        for (int k = 0; k < 16; ++k) dst[k] = __float_as_uint(Lst[k]);
      }
    }
    __syncthreads();
    if (tid < 128) {
      const unsigned* la = Ls + (tid * 2) * 16;
      float A[16], B[16];
#pragma unroll
      for (int k = 0; k < 16; ++k) { A[k] = __uint_as_float(la[k]); B[k] = __uint_as_float(la[16 + k]); }
      float C[16];
#pragma unroll
      for (int k = 0; k < 16; ++k) C[k] = -3.0e38f;
#pragma unroll
      for (int i = 0; i < 16; ++i)
#pragma unroll
        for (int j = 0; j < 16; ++j)
          if ((i + 1) * (j + 1) <= 16) {
            const float sm = A[i] + B[j];
            const float v = __uint_as_float((__float_as_uint(sm) & ~255u) | (unsigned)(255 - (i * 16 + j)));
            ins16(C, v);
          }
      const int t = mt * 128 + tid;
      float e[16], sum = 0.f;
#pragma unroll
      for (int k = 0; k < 16; ++k) { e[k] = __expf(C[k] - C[0]); sum += e[k]; }
      const float inv = 1.f / sum;
      int* ed = p.experts + (size_t)t * 128 + head * 16;
      float* gd = p.gates + (size_t)t * 128 + head * 16;
#pragma unroll
      for (int k = 0; k < 16; ++k) {
        const unsigned code = 255u - (__float_as_uint(C[k]) & 255u);
        const int i1 = 127 - (int)(la[code >> 4] & 127u);
        const int i2 = 127 - (int)(la[16 + (code & 15)] & 127u);
        ed[k] = i1 * 128 + i2;
        gd[k] = e[k] * inv;
      }
    }
    __syncthreads();
  }
}

DI float gelu_exact(float d) { return 0.5f * d * (1.f + erff(d * 0.70710678118654752f)); }

DI void phase_peer_ffn(const Params& p, int layer, char* lds) {
  const int tid = otid(), lane = tid & 63, wave = tid >> 6;
  const float* g2 = p.in[15] + layer * 1024;
  const float* b2 = p.in[16] + layer * 1024;
  for (int t = blockIdx.x * 8 + wave; t < T_ALL; t += gridDim.x * 8) {
    const uint4 xa = *(const uint4*)(p.x1 + (size_t)t * 1024 + lane * 8);
    const uint4 xc = *(const uint4*)(p.x1 + (size_t)t * 1024 + 512 + lane * 8);
    const unsigned xw[8] = {xa.x, xa.y, xa.z, xa.w, xc.x, xc.y, xc.z, xc.w};
    float acc[16];
#pragma unroll
    for (int e = 0; e < 16; ++e) acc[e] = 0.f;
    const int ev0 = p.experts[(size_t)t * 128 + lane], ev1 = p.experts[(size_t)t * 128 + 64 + lane];
    const float gv0 = p.gates[(size_t)t * 128 + lane], gv1 = p.gates[(size_t)t * 128 + 64 + lane];
#pragma unroll 1
    for (int k4 = 0; k4 < 128; k4 += 4) {
      uint4 ua[4], uc[4], va[4], vc[4];
      float gk[4];
#pragma unroll
      for (int q = 0; q < 4; ++q) {
        const int k = k4 + q;
        const int e = (k < 64) ? __builtin_amdgcn_readlane(ev0, k & 63) : __builtin_amdgcn_readlane(ev1, k & 63);
        gk[q] = __int_as_float((k < 64) ? __builtin_amdgcn_readlane(__float_as_int(gv0), k & 63)
                                        : __builtin_amdgcn_readlane(__float_as_int(gv1), k & 63));
        const u16* ur = p.ub + (size_t)e * 1024;
        const u16* vr = p.vb + (size_t)e * 1024;
        ua[q] = *(const uint4*)(ur + lane * 8); uc[q] = *(const uint4*)(ur + 512 + lane * 8);
        va[q] = *(const uint4*)(vr + lane * 8); vc[q] = *(const uint4*)(vr + 512 + lane * 8);
      }
#pragma unroll
      for (int q = 0; q < 4; ++q) {
        const unsigned uw[8] = {ua[q].x, ua[q].y, ua[q].z, ua[q].w, uc[q].x, uc[q].y, uc[q].z, uc[q].w};
        float d = 0.f;
#pragma unroll
        for (int e = 0; e < 8; ++e)
          d = __builtin_amdgcn_fdot2_f32_bf16(__builtin_bit_cast(bf16x2_t, uw[e]), __builtin_bit_cast(bf16x2_t, xw[e]), d, false);
        d = wave_sum(d);
        const float cf = gk[q] * gelu_exact(d);
        const unsigned vw[8] = {va[q].x, va[q].y, va[q].z, va[q].w, vc[q].x, vc[q].y, vc[q].z, vc[q].w};
#pragma unroll
        for (int e = 0; e < 8; ++e) {
          acc[2 * e] = fmaf(cf, bflo(vw[e]), acc[2 * e]);
          acc[2 * e + 1] = fmaf(cf, bfhi(vw[e]), acc[2 * e + 1]);
        }
      }
    }
    float y[16];
    float s = 0.f;
#pragma unroll
    for (int e = 0; e < 8; ++e) {
      y[2 * e] = ALPHA * bflo(xw[e]) + acc[2 * e];
      y[2 * e + 1] = ALPHA * bfhi(xw[e]) + acc[2 * e + 1];
      s += y[2 * e] + y[2 * e + 1];
    }
    const float mean = wave_sum(s) * (1.f / 1024.f);
    float vs = 0.f;
#pragma unroll
    for (int e = 0; e < 16; ++e) { y[e] -= mean; vs += y[e] * y[e]; }
    const float rstd = rsqrtf(wave_sum(vs) * (1.f / 1024.f) + 1e-5f);
    float o[16];
#pragma unroll
    for (int e = 0; e < 16; ++e) {
      const int d = (e < 8) ? (lane * 8 + e) : (512 + lane * 8 + (e - 8));
      o[e] = y[e] * rstd * g2[d] + b2[d];
    }
    if (layer == 1) {
      float4* oa = (float4*)(p.out + (size_t)t * 1024 + lane * 8);
      float4* oc = (float4*)(p.out + (size_t)t * 1024 + 512 + lane * 8);
      oa[0] = make_float4(o[0], o[1], o[2], o[3]); oa[1] = make_float4(o[4], o[5], o[6], o[7]);
      oc[0] = make_float4(o[8], o[9], o[10], o[11]); oc[1] = make_float4(o[12], o[13], o[14], o[15]);
    } else {
      uint4 w0, w1;
      w0.x = pack2(o[0], o[1]); w0.y = pack2(o[2], o[3]); w0.z = pack2(o[4], o[5]); w0.w = pack2(o[6], o[7]);
      w1.x = pack2(o[8], o[9]); w1.y = pack2(o[10], o[11]); w1.z = pack2(o[12], o[13]); w1.w = pack2(o[14], o[15]);
      *(uint4*)(p.xb + (size_t)t * 1024 + lane * 8) = w0;
      *(uint4*)(p.xb + (size_t)t * 1024 + 512 + lane * 8) = w1;
    }
  }
}

__global__ __launch_bounds__(512) void mega(Params p, int ph_lo, int ph_hi) {
  extern __shared__ __attribute__((aligned(16))) char lds[];
  cg::grid_group grid = cg::this_grid();
  for (int ph = ph_lo; ph < ph_hi; ++ph) {
    if (ph == 0) {
      phase_prep(p, lds);
    } else {
      const int layer = (ph - 1) / 6, sub = (ph - 1) % 6;
      if (sub == 0) {
        if (layer == 1) {
          convert_bf16(p.in[13] + (size_t)NEXP * DM, p.ub, (size_t)NEXP * DM / 8);
          convert_bf16(p.in[14] + (size_t)NEXP * DM, p.vb, (size_t)NEXP * DM / 8);
        }
        phase_gemm1(p, layer, lds);
      } else if (sub == 1) phase_mla_up(p, layer, lds);
      else if (sub == 2) phase_attn(p, layer, lds);
      else if (sub == 3) phase_outproj(p, layer, lds);
      else if (sub == 4) phase_peer_route(p, layer, lds);
      else phase_peer_ffn(p, layer, lds);
    }
    if (ph + 1 < ph_hi) grid.sync();
  }
}

extern "C" void kernel_launch(void* const* d_in, const int* in_sizes, int n_in, void* d_out, int out_size, void* d_ws,
                              size_t ws_size, hipStream_t stream) {
  Params p;
  memset(&p, 0, sizeof(p));
  for (int i = 0; i < 17; ++i) p.in[i] = (const float*)d_in[i];
  p.out = (float*)d_out;
  char* w = (char*)d_ws;
  size_t off = 0;
  auto alloc = [&](size_t bytes) { char* r = w + off; off += (bytes + 255) & ~(size_t)255; return r; };
  p.xb = (u16*)alloc((size_t)T_ALL * DM * 2);
  p.winT = (u16*)alloc((size_t)2 * NPAD * 1024 * 2);
  p.wuqT = (u16*)alloc((size_t)2 * 768 * 256 * 2);
  p.wukvT = (u16*)alloc((size_t)2 * 768 * 128 * 2);
  p.woT = (u16*)alloc((size_t)2 * 1024 * 1024 * 2);
  p.wqT = (u16*)alloc((size_t)2 * 2048 * 1024 * 2);
  p.keysb = (u16*)alloc((size_t)2 * 16 * 128 * 128 * 2);
  p.ub = (u16*)alloc((size_t)NEXP * DM * 2);
  p.vb = (u16*)alloc((size_t)NEXP * DM * 2);
  p.cs32 = (float2*)alloc((size_t)SEQ * 16 * 8);
  p.cs64 = (float2*)alloc((size_t)SEQ * 32 * 8);
  p.cat = (u16*)alloc((size_t)T_ALL * 1024 * 2);
  const size_t r1 = off;
  p.aq = (u16*)alloc((size_t)T_ALL * 256 * 2);
  p.ak = (u16*)alloc((size_t)T_ALL * 256 * 2);
  p.av = (u16*)alloc((size_t)T_ALL * 256 * 2);
  p.bcq = (u16*)alloc((size_t)T_ALL * 256 * 2);
  p.bckv = (u16*)alloc((size_t)T_ALL * 128 * 2);
  p.bkr = (u16*)alloc((size_t)T_ALL * 32 * 2);
  p.cq = (u16*)alloc((size_t)T_ALL * 384 * 2);
  p.ck = (u16*)alloc((size_t)T_ALL * 384 * 2);
  p.cv = (u16*)alloc((size_t)T_ALL * 384 * 2);
  p.mq = (u16*)alloc((size_t)T_ALL * 576 * 2);
  p.mk = (u16*)alloc((size_t)T_ALL * 384 * 2);
  p.mv = (u16*)alloc((size_t)T_ALL * 384 * 2);
  off = r1;
  p.ybuf = (u16*)alloc((size_t)T_ALL * 1024 * 2);
  p.x1 = (u16*)alloc((size_t)T_ALL * 1024 * 2);
  p.experts = (int*)alloc((size_t)T_ALL * 128 * 4);
  p.gates = (float*)alloc((size_t)T_ALL * 128 * 4);
  p.dilo = (u16*)d_out;
  p.dillse = (float*)((char*)d_out + (size_t)3 * T_ALL * 384 * 2);

#ifdef MULTI_LAUNCH
  hipFuncSetAttribute((const void*)mega, hipFuncAttributeMaxDynamicSharedMemorySize, LDS_BYTES);
  for (int ph = 0; ph < 13; ++ph) {
    hipLaunchKernelGGL(mega, dim3(256), dim3(512), LDS_BYTES, stream, p, ph, ph + 1);
  }
#else
  static int grid_blocks = 0;
  if (!grid_blocks) {
    int dev = 0, cus = 0, per_cu = 0;
    hipGetDevice(&dev);
    hipDeviceGetAttribute(&cus, hipDeviceAttributeMultiprocessorCount, dev);
    hipFuncSetAttribute((const void*)mega, hipFuncAttributeMaxDynamicSharedMemorySize, LDS_BYTES);
    hipOccupancyMaxActiveBlocksPerMultiprocessor(&per_cu, mega, 512, LDS_BYTES);
    if (per_cu > 1) per_cu = 1;
    grid_blocks = cus * per_cu;
  }
  int lo = 0, hi = 13;
  void* args[] = {&p, &lo, &hi};
  hipError_t e = hipLaunchCooperativeKernel((void*)mega, dim3(grid_blocks), dim3(512), args, LDS_BYTES, stream);
  if (e != hipSuccess) fprintf(stderr, "cooperative launch failed: %s (grid %d)\n", hipGetErrorString(e), grid_blocks);
#endif
}
```

```cpp
#include <hip/hip_runtime.h>
#include <hip/hip_cooperative_groups.h>
#include <math.h>
#include <stdio.h>
#include <string.h>
namespace cg = cooperative_groups;

typedef unsigned short u16;
typedef short bf16x8 __attribute__((ext_vector_type(8)));
typedef short s16x4 __attribute__((ext_vector_type(4)));
typedef float f32x16 __attribute__((ext_vector_type(16)));
typedef float f32x2 __attribute__((ext_vector_type(2)));
typedef __bf16 bf16x2_t __attribute__((ext_vector_type(2)));

#define DI __device__ __forceinline__
#define MFMA(a, b, c) __builtin_amdgcn_mfma_f32_32x32x16_bf16((a), (b), (c), 0, 0, 0)

constexpr int T_ALL = 32768, SEQ = 4096, DM = 1024, INW = 2336, NEXP = 16384;
constexpr int NPAD = 2560;
constexpr float LOG2E = 1.4426950408889634f;
constexpr float ALPHA = 1.41421356237309515f;

struct Params {
  const float* in[17];
  float* out;
  u16 *xb, *winT, *wuqT, *wukvT, *woT, *wqT, *keysb, *ub, *vb;
  float2 *cs32, *cs64;
  u16 *aq, *ak, *av, *bcq, *bckv, *bkr, *cq, *ck, *cv, *mq, *mk, *mv, *cat, *dilo;
  float* dillse;
  u16 *ybuf, *x1;
  int* experts;
  float* gates;
};

DI int otid() { int t = threadIdx.x; asm volatile("" : "+v"(t)); return t; }
DI int obid() { int b = blockIdx.x; asm volatile("" : "+s"(b)); return b; }
DI unsigned pack2(float a, float b) {
  f32x2 v = {a, b};
  return __builtin_bit_cast(unsigned, __builtin_convertvector(v, bf16x2_t));
}
DI float bflo(unsigned w) { return __uint_as_float(w << 16); }
DI float bfhi(unsigned w) { return __uint_as_float(w & 0xffff0000u); }
DI float fexp2(float x) { return __builtin_amdgcn_exp2f(x); }
DI void store8(u16* dst, float a, float b, float c, float d) {
  uint2 v; v.x = pack2(a, b); v.y = pack2(c, d);
  *(uint2*)dst = v;
}
DI void store_tile(u16* dst, const f32x16& v, int hh) {
#pragma unroll
  for (int g = 0; g < 4; ++g) store8(dst + 8 * g + 4 * hh, v[4 * g], v[4 * g + 1], v[4 * g + 2], v[4 * g + 3]);
}
DI void rope32(f32x16& v, const float2* cs, int hh) {
#pragma unroll
  for (int g = 0; g < 2; ++g)
#pragma unroll
    for (int b = 0; b < 4; ++b) {
      float2 c = cs[8 * g + 4 * hh + b];
      float x1 = v[4 * g + b], x2 = v[4 * g + b + 8];
      v[4 * g + b] = x1 * c.x - x2 * c.y;
      v[4 * g + b + 8] = x2 * c.x + x1 * c.y;
    }
}
DI void rope64(f32x16& v0, f32x16& v1, const float2* cs, int hh) {
#pragma unroll
  for (int g = 0; g < 4; ++g)
#pragma unroll
    for (int b = 0; b < 4; ++b) {
      float2 c = cs[8 * g + 4 * hh + b];
      float x1 = v0[4 * g + b], x2 = v1[4 * g + b];
      v0[4 * g + b] = x1 * c.x - x2 * c.y;
      v1[4 * g + b] = x2 * c.x + x1 * c.y;
    }
}
DI float wave_sum(float v) {
#pragma unroll
  for (int o = 32; o; o >>= 1) v += __shfl_xor(v, o);
  return v;
}
DI s16x4 trread(const char* p) {
  return __builtin_amdgcn_ds_read_tr16_b64_v4i16((__attribute__((address_space(3))) s16x4*)(p));
}

DI void convert_bf16(const float* __restrict__ src, u16* __restrict__ dst, size_t n8  ) {
  for (size_t i = (size_t)blockIdx.x * blockDim.x + threadIdx.x; i < n8; i += (size_t)gridDim.x * blockDim.x) {
    float4 a = ((const float4*)src)[2 * i], b = ((const float4*)src)[2 * i + 1];
    uint4 o; o.x = pack2(a.x, a.y); o.y = pack2(a.z, a.w); o.z = pack2(b.x, b.y); o.w = pack2(b.z, b.w);
    ((uint4*)dst)[i] = o;
  }
}
DI void transpose_tile(const float* __restrict__ src, int nsrc, u16* __restrict__ dst, int K, int nt, int ktile, int mode,
                       const float* __restrict__ kscale, float* tile  ) {
  const int tid = otid();
  const int n0 = nt * 64, k0 = ktile * 64;
#pragma unroll
  for (int pass = 0; pass < 2; ++pass) {
    int kk = (tid >> 4) + pass * 32, nn = (tid & 15) * 4;
    int np = n0 + nn;
    int col = np; float sc = 1.f;
    if (mode == 0) {
      if (np < 1184) col = np; else if (np < 1216) col = -1; else if (np < 2368) col = np - 32; else col = -1;
      if (col >= 0 && col < 256) sc = 0.17677669529663687f * LOG2E;
      else if (col >= 1184 && col < 1568) sc = 0.125f * LOG2E;
    } else if (mode == 1) {
      if (np >= 576) col = -1;
      sc = 0.10206207261596575f * LOG2E;
    }
    float4 v = make_float4(0.f, 0.f, 0.f, 0.f);
    if (col >= 0 && col < nsrc) v = *(const float4*)(src + (size_t)(k0 + kk) * nsrc + col);
    float ks = kscale ? kscale[k0 + kk] : 1.f;
    sc *= ks;
    tile[kk * 65 + nn + 0] = v.x * sc; tile[kk * 65 + nn + 1] = v.y * sc;
    tile[kk * 65 + nn + 2] = v.z * sc; tile[kk * 65 + nn + 3] = v.w * sc;
  }
  __syncthreads();
  {
    int nn = tid >> 3, k8 = (tid & 7) * 8;
    float f[8];
#pragma unroll
    for (int e = 0; e < 8; ++e) f[e] = tile[(k8 + e) * 65 + nn];
    uint4 o; o.x = pack2(f[0], f[1]); o.y = pack2(f[2], f[3]); o.z = pack2(f[4], f[5]); o.w = pack2(f[6], f[7]);
    *(uint4*)(dst + (size_t)(n0 + nn) * K + k0 + k8) = o;
  }
  __syncthreads();
}

DI void phase_prep(const Params& p, char* lds) {
  convert_bf16(p.in[0], p.xb, (size_t)T_ALL * DM / 8);
  convert_bf16(p.in[12], p.keysb, (size_t)2 * 16 * 128 * 128 / 8);
  convert_bf16(p.in[13], p.ub, (size_t)NEXP * DM / 8);
  convert_bf16(p.in[14], p.vb, (size_t)NEXP * DM / 8);
  for (int i = blockIdx.x * blockDim.x + threadIdx.x; i < SEQ * 48; i += gridDim.x * blockDim.x) {
    int pos = i / 48, r = i % 48;
    if (r < 16) {
      float ang = (float)pos * expf(-logf(10000.0f) * (float)r / 16.f);
      p.cs32[pos * 16 + r] = make_float2(cosf(ang), sinf(ang));
    } else {
      int q = r - 16;
      float ang = (float)pos * expf(-logf(10000.0f) * (float)q / 32.f);
      p.cs64[pos * 32 + q] = make_float2(cosf(ang), sinf(ang));
    }
  }
  float* tile = (float*)lds;
  for (int u = blockIdx.x; u < 2960; u += gridDim.x) {
    if (u < 1280) {
      int l = u / 640, r = u % 640;
      transpose_tile(p.in[1] + (size_t)l * DM * INW, INW, p.winT + (size_t)l * NPAD * 1024, 1024, r / 16, r % 16, 0, nullptr, tile);
    } else if (u < 1376) {
      int v = u - 1280; int l = v / 48, r = v % 48;
      transpose_tile(p.in[6] + (size_t)l * 256 * 576, 576, p.wuqT + (size_t)l * 768 * 256, 256, r / 4, r % 4, 1, p.in[4] + l * 256, tile);
    } else if (u < 1424) {
      int v = u - 1376; int l = v / 24, r = v % 24;
      transpose_tile(p.in[7] + (size_t)l * 128 * 768, 768, p.wukvT + (size_t)l * 768 * 128, 128, r / 2, r % 2, 2, p.in[5] + l * 128, tile);
    } else if (u < 1936) {
      int v = u - 1424; int l = v / 256, r = v % 256;
      transpose_tile(p.in[8] + (size_t)l * DM * DM, DM, p.woT + (size_t)l * DM * DM, 1024, r / 16, r % 16, 3, nullptr, tile);
    } else {
      int v = u - 1936; int l = v / 512, r = v % 512;
      transpose_tile(p.in[11] + (size_t)l * DM * 2048, 2048, p.wqT + (size_t)l * 2048 * DM, 1024, r / 16, r % 16, 3, nullptr, tile);
    }
  }
}

constexpr int G_ROWB = 144;
constexpr int G_X1B = 256 * G_ROWB;
constexpr int G_X2B = 128 * G_ROWB;
constexpr int G_STAGE = G_X1B + G_X2B;
constexpr int LDS_BYTES = 2 * G_STAGE + 4096;

template <int K>
DI void gemm_core(const u16* __restrict__ X1, int ld1, const u16* __restrict__ X2, int ld2, f32x16 (&acc)[2][2], char* lds) {
  const int tid = otid(), lane = tid & 63, wave = tid >> 6;
  const int wn = wave & 3, wm = wave >> 2, r = lane & 31, hh = lane >> 5;
  constexpr int NK = K / 64;
  uint4 g1[4], g2[2];
  const int lrow = tid >> 3, lch = tid & 7;
#pragma unroll
  for (int i = 0; i < 2; ++i)
#pragma unroll
    for (int j = 0; j < 2; ++j)
#pragma unroll
      for (int e = 0; e < 16; ++e) acc[i][j][e] = 0.f;
  const u16* p1 = X1 + (size_t)lrow * ld1 + lch * 8;
  const u16* p2 = X2 + (size_t)lrow * ld2 + lch * 8;
#pragma unroll
  for (int e = 0; e < 4; ++e) g1[e] = *(const uint4*)(p1 + (size_t)(64 * e) * ld1);
#pragma unroll
  for (int e = 0; e < 2; ++e) g2[e] = *(const uint4*)(p2 + (size_t)(64 * e) * ld2);
  {
    char* b = lds;
#pragma unroll
    for (int e = 0; e < 4; ++e) *(uint4*)(b + (lrow + 64 * e) * G_ROWB + lch * 16) = g1[e];
#pragma unroll
    for (int e = 0; e < 2; ++e) *(uint4*)(b + G_X1B + (lrow + 64 * e) * G_ROWB + lch * 16) = g2[e];
  }
  __syncthreads();
  for (int kt = 0; kt < NK; ++kt) {
    if (kt + 1 < NK) {
#pragma unroll
      for (int e = 0; e < 4; ++e) g1[e] = *(const uint4*)(p1 + (size_t)(64 * e) * ld1 + (kt + 1) * 64);
#pragma unroll
      for (int e = 0; e < 2; ++e) g2[e] = *(const uint4*)(p2 + (size_t)(64 * e) * ld2 + (kt + 1) * 64);
    }
    const char* b1 = lds + (kt & 1) * G_STAGE + (wn * 64 + r) * G_ROWB + hh * 16;
    const char* b2 = lds + (kt & 1) * G_STAGE + G_X1B + (wm * 64 + r) * G_ROWB + hh * 16;
#pragma unroll
    for (int s = 0; s < 4; ++s) {
      bf16x8 a0 = *(const bf16x8*)(b1 + s * 32), a1 = *(const bf16x8*)(b1 + 32 * G_ROWB + s * 32);
      bf16x8 c0 = *(const bf16x8*)(b2 + s * 32), c1 = *(const bf16x8*)(b2 + 32 * G_ROWB + s * 32);
      acc[0][0] = MFMA(a0, c0, acc[0][0]);
      acc[0][1] = MFMA(a0, c1, acc[0][1]);
      acc[1][0] = MFMA(a1, c0, acc[1][0]);
      acc[1][1] = MFMA(a1, c1, acc[1][1]);
    }
    if (kt + 1 < NK) {
      char* b = lds + ((kt + 1) & 1) * G_STAGE;
#pragma unroll
      for (int e = 0; e < 4; ++e) *(uint4*)(b + (lrow + 64 * e) * G_ROWB + lch * 16) = g1[e];
#pragma unroll
      for (int e = 0; e < 2; ++e) *(uint4*)(b + G_X1B + (lrow + 64 * e) * G_ROWB + lch * 16) = g2[e];
    }
    __syncthreads();
  }
}

DI void phase_gemm1(const Params& p, int layer, char* lds) {
  const int tid = otid(), lane = tid & 63, wave = tid >> 6;
  const int wn = wave & 3, wm = wave >> 2, r = lane & 31, hh = lane >> 5;
  for (int item = blockIdx.x; item < 2560; item += gridDim.x) {
    const int mt = item / 10, nt = item % 10;
    f32x16 acc[2][2];
    gemm_core<1024>(p.winT + ((size_t)layer * NPAD + nt * 256) * 1024, 1024, p.xb + (size_t)mt * 128 * 1024, 1024, acc, lds);
    const int n64 = nt * 256 + wn * 64;
#pragma unroll
    for (int j = 0; j < 2; ++j) {
      const int t = mt * 128 + wm * 64 + j * 32 + r;
      const int b = t >> 12, s = t & 4095;
      if (n64 < 512) {
        u16* base = (n64 < 256) ? p.aq : p.ak;
        const int hh0 = (n64 & 255) >> 5;
        const float2* cs = p.cs32 + s * 16;
#pragma unroll
        for (int i = 0; i < 2; ++i) {
          rope32(acc[i][j], cs, hh);
          store_tile(base + ((size_t)(b * 8 + hh0 + i) * SEQ + s) * 32, acc[i][j], hh);
        }
      } else if (n64 < 768) {
        const int head = (n64 - 512) >> 6;
#pragma unroll
        for (int i = 0; i < 2; ++i) store_tile(p.av + ((size_t)(b * 4 + head) * SEQ + s) * 64 + i * 32, acc[i][j], hh);
      } else if (n64 < 1024) {
#pragma unroll
        for (int i = 0; i < 2; ++i) store_tile(p.bcq + (size_t)t * 256 + (n64 - 768) + i * 32, acc[i][j], hh);
      } else if (n64 < 1152) {
#pragma unroll
        for (int i = 0; i < 2; ++i) store_tile(p.bckv + (size_t)t * 128 + (n64 - 1024) + i * 32, acc[i][j], hh);
      } else if (n64 == 1152) {
        rope32(acc[0][j], p.cs32 + s * 16, hh);
        store_tile(p.bkr + (size_t)t * 32, acc[0][j], hh);
      } else if (n64 < 1984) {
        const bool isq = n64 < 1600;
        const int head = (n64 - (isq ? 1216 : 1600)) >> 6;
        u16* base = isq ? p.cq : p.ck;
        rope64(acc[0][j], acc[1][j], p.cs64 + s * 32, hh);
#pragma unroll
        for (int i = 0; i < 2; ++i) store_tile(base + ((size_t)(b * 6 + head) * SEQ + s) * 64 + i * 32, acc[i][j], hh);
      } else if (n64 < 2368) {
        const int head = (n64 - 1984) >> 6;
#pragma unroll
        for (int i = 0; i < 2; ++i) store_tile(p.cv + ((size_t)(b * 6 + head) * SEQ + s) * 64 + i * 32, acc[i][j], hh);
      }
    }
  }
}

DI void phase_mla_up(const Params& p, int layer, char* lds) {
  const int tid = otid(), lane = tid & 63, wave = tid >> 6;
  const int wn = wave & 3, wm = wave >> 2, r = lane & 31, hh = lane >> 5;
  float* rinv_s = (float*)(lds + 2 * G_STAGE);
  for (int item = blockIdx.x; item < 1536; item += gridDim.x) {
    const int which = item / 768;
    const int it = item % 768, mt = it / 3, nt = it % 3;
    {
      const int tok = tid >> 2, part = tid & 3;
      float ss = 0.f;
      if (which == 0) {
        const uint4* row = (const uint4*)(p.bcq + (size_t)(mt * 128 + tok) * 256 + part * 64);
#pragma unroll
        for (int c = 0; c < 8; ++c) {
          uint4 v = row[c];
          ss += bflo(v.x) * bflo(v.x) + bfhi(v.x) * bfhi(v.x) + bflo(v.y) * bflo(v.y) + bfhi(v.y) * bfhi(v.y) +
                bflo(v.z) * bflo(v.z) + bfhi(v.z) * bfhi(v.z) + bflo(v.w) * bflo(v.w) + bfhi(v.w) * bfhi(v.w);
        }
      } else {
        const uint4* row = (const uint4*)(p.bckv + (size_t)(mt * 128 + tok) * 128 + part * 32);
#pragma unroll
        for (int c = 0; c < 4; ++c) {
          uint4 v = row[c];
          ss += bflo(v.x) * bflo(v.x) + bfhi(v.x) * bfhi(v.x) + bflo(v.y) * bflo(v.y) + bfhi(v.y) * bfhi(v.y) +
                bflo(v.z) * bflo(v.z) + bfhi(v.z) * bfhi(v.z) + bflo(v.w) * bflo(v.w) + bfhi(v.w) * bfhi(v.w);
        }
      }
      ss += __shfl_xor(ss, 1);
      ss += __shfl_xor(ss, 2);
      if (part == 0) rinv_s[tok] = rsqrtf(ss / (which == 0 ? 256.f : 128.f) + 1e-5f);
    }
    f32x16 acc[2][2];
    if (which == 0)
      gemm_core<256>(p.wuqT + ((size_t)layer * 768 + nt * 256) * 256, 256, p.bcq + (size_t)mt * 128 * 256, 256, acc, lds);
    else
      gemm_core<128>(p.wukvT + ((size_t)layer * 768 + nt * 256) * 128, 128, p.bckv + (size_t)mt * 128 * 128, 128, acc, lds);
    const int n64 = nt * 256 + wn * 64;
#pragma unroll
    for (int j = 0; j < 2; ++j) {
      const int tl = wm * 64 + j * 32 + r;
      const int t = mt * 128 + tl;
      const int b = t >> 12, s = t & 4095;
      const float ri = rinv_s[tl];
#pragma unroll
      for (int i = 0; i < 2; ++i) {
        const int n32 = n64 + i * 32;
        f32x16 v = acc[i][j];
#pragma unroll
        for (int e = 0; e < 16; ++e) v[e] *= ri;
        if (which == 0) {
          if (n32 < 576) {
            const int head = n32 / 96, dpart = (n32 % 96) >> 5;
            if (dpart == 2) rope32(v, p.cs32 + s * 16, hh);
            store_tile(p.mq + ((size_t)(b * 6 + head) * SEQ + s) * 96 + dpart * 32, v, hh);
          }
        } else {
          const int head = n32 >> 7, d32 = (n32 & 127) >> 5;
          u16* base = (d32 < 2) ? p.mk : p.mv;
          store_tile(base + ((size_t)(b * 6 + head) * SEQ + s) * 64 + (d32 & 1) * 32, v, hh);
        }
      }
    }
    __syncthreads();
  }
}

DI bf16x8 packP(const f32x16& S, int s2) {
  uint4 u;
  u.x = pack2(S[8 * s2 + 0], S[8 * s2 + 1]); u.y = pack2(S[8 * s2 + 2], S[8 * s2 + 3]);
  u.z = pack2(S[8 * s2 + 4], S[8 * s2 + 5]); u.w = pack2(S[8 * s2 + 6], S[8 * s2 + 7]);
  return __builtin_bit_cast(bf16x8, u);
}
DI float max16(const f32x16& S) {
  float a = fmaxf(fmaxf(S[0], S[1]), fmaxf(S[2], S[3]));
  float b = fmaxf(fmaxf(S[4], S[5]), fmaxf(S[6], S[7]));
  float c = fmaxf(fmaxf(S[8], S[9]), fmaxf(S[10], S[11]));
  float d = fmaxf(fmaxf(S[12], S[13]), fmaxf(S[14], S[15]));
  return fmaxf(fmaxf(a, b), fmaxf(c, d));
}

template <bool MLA>
DI void attn_dense_item(const Params& p, int layer, int item, float lam_full, float lam_init, char* lds) {
  constexpr int NS = MLA ? 1 : 2;
  constexpr int DK = MLA ? 96 : 32;
  constexpr int KSTR = MLA ? 208 : 80;
  constexpr int KB = 64 * KSTR;
  constexpr int STAGE = NS * KB + 8192;
  constexpr int NKS = DK / 16;
  const int tid = otid(), lane = tid & 63, wave = tid >> 6, r = lane & 31, hh = lane >> 5;
  int b, head, qb;
  if (MLA) { b = item / 96; head = (item / 16) % 6; qb = item & 15; }
  else { b = item / 64; head = (item / 16) & 3; qb = item & 15; }
  const int q0 = qb * 256 + wave * 32;
  const u16 *kg0, *kg1, *vg;
  bf16x8 Q[NS][NKS];
  if (MLA) {
    const u16* qp = p.mq + ((size_t)(b * 6 + head) * SEQ + q0 + r) * 96 + hh * 8;
#pragma unroll
    for (int s = 0; s < NKS; ++s) Q[0][s] = *(const bf16x8*)(qp + s * 16);
    kg0 = p.mk + (size_t)(b * 6 + head) * SEQ * 64;
    kg1 = p.bkr + (size_t)b * SEQ * 32;
    vg = p.mv + (size_t)(b * 6 + head) * SEQ * 64;
  } else {
#pragma unroll
    for (int st = 0; st < NS; ++st) {
      const u16* qp = p.aq + ((size_t)(b * 8 + head * 2 + st) * SEQ + q0 + r) * 32 + hh * 8;
#pragma unroll
      for (int s = 0; s < NKS; ++s) Q[st][s] = *(const bf16x8*)(qp + s * 16);
    }
    kg0 = p.ak + (size_t)(b * 8 + head * 2) * SEQ * 32;
    kg1 = p.ak + (size_t)(b * 8 + head * 2 + 1) * SEQ * 32;
    vg = p.av + (size_t)(b * 4 + head) * SEQ * 64;
  }
  f32x16 O[NS][2];
  float m[NS], l[NS];
#pragma unroll
  for (int st = 0; st < NS; ++st) {
    m[st] = -1e30f; l[st] = 0.f;
#pragma unroll
    for (int e = 0; e < 16; ++e) { O[st][0][e] = 0.f; O[st][1][e] = 0.f; }
  }
  uint4 gk, gv, gp;
  auto gload = [&](int kt) {
    const int k0 = kt * 64;
    if (MLA) {
      gk = *(const uint4*)(kg0 + (size_t)(k0 + (tid >> 3)) * 64 + (tid & 7) * 8);
      if (tid < 256) gp = *(const uint4*)(kg1 + (size_t)(k0 + (tid >> 2)) * 32 + (tid & 3) * 8);
    } else {
      const u16* kb = (tid < 256) ? kg0 : kg1;
      const int c = tid & 255;
      gk = *(const uint4*)(kb + (size_t)(k0 + (c >> 2)) * 32 + (c & 3) * 8);
    }
    gv = *(const uint4*)(vg + (size_t)(k0 + (tid >> 3)) * 64 + (tid & 7) * 8);
  };
  auto swrite = [&](int sb) {
    char* base = lds + sb * STAGE;
    if (MLA) {
      *(uint4*)(base + (tid >> 3) * KSTR + (tid & 7) * 16) = gk;
      if (tid < 256) *(uint4*)(base + (tid >> 2) * KSTR + 128 + (tid & 3) * 16) = gp;
    } else {
      const int c = tid & 255;
      *(uint4*)(base + (tid >> 8) * KB + (c >> 2) * KSTR + (c & 3) * 16) = gk;
    }
    const int row = tid >> 3;
    *(uint4*)(base + NS * KB + row * 128 + (((tid & 7) * 16) ^ (((row >> 1) & 1) << 6))) = gv;
  };
  const int tq = (lane & 15) >> 2, tp = lane & 3, tg1 = (lane >> 4) & 1, swz = (tq >> 1) & 1;
  const int voff = (4 * hh + tq) * 128 + 32 * tg1 + 8 * tp;

  gload(0); swrite(0);
  __syncthreads();
  for (int kt = 0; kt < 64; ++kt) {
    if (kt + 1 < 64) gload(kt + 1);
    const char* base = lds + (kt & 1) * STAGE;
    const char* vb = base + NS * KB + voff;
#pragma unroll
    for (int st = 0; st < NS; ++st) {
      f32x16 S0, S1;
#pragma unroll
      for (int e = 0; e < 16; ++e) { S0[e] = 0.f; S1[e] = 0.f; }
      const char* kb = base + st * KB + r * KSTR + hh * 16;
#pragma unroll
      for (int s = 0; s < NKS; ++s) {
        bf16x8 a0 = *(const bf16x8*)(kb + s * 32);
        bf16x8 a1 = *(const bf16x8*)(kb + 32 * KSTR + s * 32);
        S0 = MFMA(a0, Q[st][s], S0);
        S1 = MFMA(a1, Q[st][s], S1);
      }
      float mx = fmaxf(max16(S0), max16(S1));
      mx = fmaxf(mx, __shfl_xor(mx, 32));
      if (__any(mx > m[st])) {
        const float mn = fmaxf(m[st], mx);
        const float al = fexp2(m[st] - mn);
        m[st] = mn; l[st] *= al;
#pragma unroll
        for (int e = 0; e < 16; ++e) { O[st][0][e] *= al; O[st][1][e] *= al; }
      }
      float ps = 0.f;
#pragma unroll
      for (int e = 0; e < 16; ++e) { S0[e] = fexp2(S0[e] - m[st]); S1[e] = fexp2(S1[e] - m[st]); ps += S0[e] + S1[e]; }
      l[st] += ps;
      bf16x8 P[2][2];
      P[0][0] = packP(S0, 0); P[0][1] = packP(S0, 1); P[1][0] = packP(S1, 0); P[1][1] = packP(S1, 1);
#pragma unroll
      for (int i2 = 0; i2 < 2; ++i2)
#pragma unroll
        for (int u = 0; u < 2; ++u)
#pragma unroll
          for (int s2 = 0; s2 < 2; ++s2) {
            const char* a = vb + (32 * u + 16 * s2) * 128 + 64 * (i2 ^ swz);
            s16x4 lo = trread(a), hi = trread(a + 8 * 128);
            bf16x8 vf = __builtin_shufflevector(lo, hi, 0, 1, 2, 3, 4, 5, 6, 7);
            O[st][i2] = MFMA(vf, P[u][s2], O[st][i2]);
          }
    }
    if (kt + 1 < 64) swrite((kt + 1) & 1);
    __syncthreads();
  }
  const int t = b * SEQ + q0 + r;
  if (MLA) {
    const float inv = 1.f / (l[0] + __shfl_xor(l[0], 32));
#pragma unroll
    for (int i2 = 0; i2 < 2; ++i2) {
#pragma unroll
      for (int e = 0; e < 16; ++e) O[0][i2][e] *= inv;
      store_tile(p.cat + (size_t)t * 1024 + 256 + head * 64 + i2 * 32, O[0][i2], hh);
    }
  } else {
    const float inv1 = 1.f / (l[0] + __shfl_xor(l[0], 32));
    const float inv2 = lam_full / (l[NS - 1] + __shfl_xor(l[NS - 1], 32));
    float ss = 0.f;
#pragma unroll
    for (int i2 = 0; i2 < 2; ++i2)
#pragma unroll
      for (int e = 0; e < 16; ++e) {
        float o = O[0][i2][e] * inv1 - O[NS - 1][i2][e] * inv2;
        O[0][i2][e] = o; ss += o * o;
      }
    ss += __shfl_xor(ss, 32);
    const float rn = rsqrtf(ss * (1.f / 64.f) + 1e-5f) * (1.f - lam_init);
    const float* g = p.in[3] + layer * 64;
#pragma unroll
    for (int i2 = 0; i2 < 2; ++i2) {
#pragma unroll
      for (int gq = 0; gq < 4; ++gq)
#pragma unroll
        for (int bq = 0; bq < 4; ++bq) O[0][i2][4 * gq + bq] *= rn * g[i2 * 32 + 8 * gq + 4 * hh + bq];
      store_tile(p.cat + (size_t)t * 1024 + head * 64 + i2 * 32, O[0][i2], hh);
    }
  }
}

DI void attn_dilated_item(const Params& p, int item, char* lds) {
  const int tid = otid(), lane = tid & 63, wave = tid >> 6, r = lane & 31, hh = lane >> 5;
  const int pair = item / 768, rem = item % 768, bh = rem >> 4, sub = rem & 15;
  const int dil = (pair == 0) ? 1 : (pair == 1 ? 4 : 16);
  const int L = SEQ / dil;
  int cls, blk;
  if (pair == 0) { cls = 0; blk = sub; } else if (pair == 1) { cls = sub & 3; blk = sub >> 2; } else { cls = sub; blk = 0; }
  const int i0 = blk * 256;
  const u16* kg = p.ck + (size_t)bh * SEQ * 64;
  const u16* vg = p.cv + (size_t)bh * SEQ * 64;
  constexpr int KROW = 144;
  char* Kl = lds;
  char* Vl = lds + 384 * KROW;
#pragma unroll
  for (int e = 0; e < 6; ++e) {
    const int c = tid + e * 512;
    const int row = c >> 3, ch = c & 7;
    const int kk = i0 - 64 + row;
    uint4 kv = make_uint4(0, 0, 0, 0), vv = make_uint4(0, 0, 0, 0);
    if (kk >= 0 && kk < L) {
      const size_t pos = (size_t)(cls + dil * kk);
      kv = *(const uint4*)(kg + pos * 64 + ch * 8);
      vv = *(const uint4*)(vg + pos * 64 + ch * 8);
    }
    *(uint4*)(Kl + row * KROW + ch * 16) = kv;
    *(uint4*)(Vl + row * 128 + ((ch * 16) ^ (((row >> 1) & 1) << 6))) = vv;
  }
  const int qq = i0 + 32 * wave + r;
  const int pq = cls + dil * qq;
  bf16x8 Q[4];
  {
    const u16* qp = p.cq + ((size_t)bh * SEQ + pq) * 64 + hh * 8;
#pragma unroll
    for (int s = 0; s < 4; ++s) Q[s] = *(const bf16x8*)(qp + s * 16);
  }
  __syncthreads();
  f32x16 O[2];
#pragma unroll
  for (int e = 0; e < 16; ++e) { O[0][e] = 0.f; O[1][e] = 0.f; }
  float m = -1e30f, l = 0.f;
  const int tq = (lane & 15) >> 2, tp = lane & 3, tg1 = (lane >> 4) & 1, swz = (tq >> 1) & 1;
  const int voff = (4 * hh + tq) * 128 + 32 * tg1 + 8 * tp;
#pragma unroll
  for (int j = 0; j < 5; ++j) {
    const int rb = 32 * wave + 32 * j;
    f32x16 S;
#pragma unroll
    for (int e = 0; e < 16; ++e) S[e] = 0.f;
    const char* kb = Kl + (rb + r) * KROW + hh * 16;
#pragma unroll
    for (int s = 0; s < 4; ++s) S = MFMA(*(const bf16x8*)(kb + s * 32), Q[s], S);
    unsigned vmask = 0;
#pragma unroll
    for (int e = 0; e < 16; ++e) {
      const int cr = (e & 3) + 8 * (e >> 2) + 4 * hh;
      const int kk = i0 - 64 + rb + cr;
      bool ok = (kk >= 0) && (kk < L);
      if (j == 0) ok = ok && (cr >= r);
      if (j == 4) ok = ok && (cr <= r);
      vmask |= ok ? (1u << e) : 0u;
      S[e] = ok ? S[e] : -1e30f;
    }
    float mx = max16(S);
    mx = fmaxf(mx, __shfl_xor(mx, 32));
    if (__any(mx > m)) {
      const float mn = fmaxf(m, mx);
      const float al = fexp2(m - mn);
      m = mn; l *= al;
#pragma unroll
      for (int e = 0; e < 16; ++e) { O[0][e] *= al; O[1][e] *= al; }
    }
    float ps = 0.f;
#pragma unroll
    for (int e = 0; e < 16; ++e) { S[e] = ((vmask >> e) & 1) ? fexp2(S[e] - m) : 0.f; ps += S[e]; }
    l += ps;
    bf16x8 P0 = packP(S, 0), P1 = packP(S, 1);
    const char* vb = Vl + rb * 128 + voff;
#pragma unroll
    for (int i2 = 0; i2 < 2; ++i2)
#pragma unroll
      for (int s2 = 0; s2 < 2; ++s2) {
        const char* a = vb + (16 * s2) * 128 + 64 * (i2 ^ swz);
        s16x4 lo = trread(a), hi = trread(a + 8 * 128);
        bf16x8 vf = __builtin_shufflevector(lo, hi, 0, 1, 2, 3, 4, 5, 6, 7);
        O[i2] = MFMA(vf, s2 == 0 ? P0 : P1, O[i2]);
      }
  }
  const float lt = l + __shfl_xor(l, 32);
  const float inv = 1.f / lt;
  const int b = bh / 6, head = bh % 6;
  const int t = b * SEQ + pq;
#pragma unroll
  for (int i2 = 0; i2 < 2; ++i2) {
#pragma unroll
    for (int e = 0; e < 16; ++e) O[i2][e] *= inv;
    store_tile(p.dilo + ((size_t)pair * T_ALL + t) * 384 + head * 64 + i2 * 32, O[i2], hh);
  }
  if (hh == 0) p.dillse[((size_t)pair * T_ALL + t) * 6 + head] = m + __log2f(lt);
  __syncthreads();
}

DI void phase_attn(const Params& p, int layer, char* lds) {
  const float* lam = p.in[2] + layer * 128;
  float s1 = 0.f, s2 = 0.f;
  for (int i = 0; i < 32; ++i) { s1 += lam[i] * lam[32 + i]; s2 += lam[64 + i] * lam[96 + i]; }
  const float lam_init = 0.8f - 0.6f * expf(-0.3f * (float)(layer + 1));
  const float lam_full = expf(s1) - expf(s2) + lam_init;
  for (int item = blockIdx.x; item < 3584; item += gridDim.x) {
    if (item < 512) attn_dense_item<false>(p, layer, item, lam_full, lam_init, lds);
    else if (item < 1280) attn_dense_item<true>(p, layer, item - 512, lam_full, lam_init, lds);
    else attn_dilated_item(p, item - 1280, lds);
  }
}

DI void phase_outproj(const Params& p, int layer, char* lds) {
  const int tid = otid(), lane = tid & 63, wave = tid >> 6;
  const int wn = wave & 3, wm = wave >> 2, r = lane & 31, hh = lane >> 5;
  for (int mt = blockIdx.x; mt < 256; mt += gridDim.x) {
    {
      const int t = mt * 128 + (tid >> 2), quarter = tid & 3;
#pragma unroll 1
      for (int cc = 0; cc < 12; ++cc) {
        const int c = quarter * 12 + cc;
        const int head = c >> 3;
        float l0 = p.dillse[((size_t)0 * T_ALL + t) * 6 + head];
        float l1 = p.dillse[((size_t)1 * T_ALL + t) * 6 + head];
        float l2 = p.dillse[((size_t)2 * T_ALL + t) * 6 + head];
        float mx = fmaxf(l0, fmaxf(l1, l2));
        float w0 = fexp2(l0 - mx), w1 = fexp2(l1 - mx), w2 = fexp2(l2 - mx);
        float inv = 1.f / (w0 + w1 + w2);
        w0 *= inv; w1 *= inv; w2 *= inv;
        uint4 a = *(const uint4*)(p.dilo + ((size_t)0 * T_ALL + t) * 384 + c * 8);
        uint4 bq = *(const uint4*)(p.dilo + ((size_t)1 * T_ALL + t) * 384 + c * 8);
        uint4 cq = *(const uint4*)(p.dilo + ((size_t)2 * T_ALL + t) * 384 + c * 8);
        uint4 o;
        o.x = pack2(w0 * bflo(a.x) + w1 * bflo(bq.x) + w2 * bflo(cq.x), w0 * bfhi(a.x) + w1 * bfhi(bq.x) + w2 * bfhi(cq.x));
        o.y = pack2(w0 * bflo(a.y) + w1 * bflo(bq.y) + w2 * bflo(cq.y), w0 * bfhi(a.y) + w1 * bfhi(bq.y) + w2 * bfhi(cq.y));
        o.z = pack2(w0 * bflo(a.z) + w1 * bflo(bq.z) + w2 * bflo(cq.z), w0 * bfhi(a.z) + w1 * bfhi(bq.z) + w2 * bfhi(cq.z));
        o.w = pack2(w0 * bflo(a.w) + w1 * bflo(bq.w) + w2 * bflo(cq.w), w0 * bfhi(a.w) + w1 * bfhi(bq.w) + w2 * bfhi(cq.w));
        *(uint4*)(p.cat + (size_t)t * 1024 + 640 + c * 8) = o;
      }
    }
    __syncthreads();
    for (int nt = 0; nt < 4; ++nt) {
      f32x16 acc[2][2];
      gemm_core<1024>(p.woT + ((size_t)layer * 1024 + nt * 256) * 1024, 1024, p.cat + (size_t)mt * 128 * 1024, 1024, acc, lds);
#pragma unroll
      for (int j = 0; j < 2; ++j) {
        const int t = mt * 128 + wm * 64 + j * 32 + r;
#pragma unroll
        for (int i = 0; i < 2; ++i) {
          const int n0 = nt * 256 + wn * 64 + i * 32;
#pragma unroll
          for (int g = 0; g < 4; ++g) {
            const size_t off = (size_t)t * 1024 + n0 + 8 * g + 4 * hh;
            uint2 xv = *(const uint2*)(p.xb + off);
            store8(p.ybuf + off, ALPHA * bflo(xv.x) + acc[i][j][4 * g], ALPHA * bfhi(xv.x) + acc[i][j][4 * g + 1],
                   ALPHA * bflo(xv.y) + acc[i][j][4 * g + 2], ALPHA * bfhi(xv.y) + acc[i][j][4 * g + 3]);
          }
        }
      }
    }
    __syncthreads();
    const float* g1 = p.in[9] + layer * 1024;
    const float* b1 = p.in[10] + layer * 1024;
    for (int rr = 0; rr < 16; ++rr) {
      const int t = mt * 128 + wave * 16 + rr;
      const uint4* yp = (const uint4*)(p.ybuf + (size_t)t * 1024 + lane * 16);
      uint4 v0 = yp[0], v1 = yp[1];
      float y[16] = {bflo(v0.x), bfhi(v0.x), bflo(v0.y), bfhi(v0.y), bflo(v0.z), bfhi(v0.z), bflo(v0.w), bfhi(v0.w),
                     bflo(v1.x), bfhi(v1.x), bflo(v1.y), bfhi(v1.y), bflo(v1.z), bfhi(v1.z), bflo(v1.w), bfhi(v1.w)};
      float s = 0.f;
#pragma unroll
      for (int e = 0; e < 16; ++e) s += y[e];
      const float mean = wave_sum(s) * (1.f / 1024.f);
      float vs = 0.f;
#pragma unroll
      for (int e = 0; e < 16; ++e) { y[e] -= mean; vs += y[e] * y[e]; }
      const float rstd = rsqrtf(wave_sum(vs) * (1.f / 1024.f) + 1e-5f);
      float o[16];
#pragma unroll
      for (int e = 0; e < 16; ++e) o[e] = y[e] * rstd * g1[lane * 16 + e] + b1[lane * 16 + e];
      uint4 w0, w1;
      w0.x = pack2(o[0], o[1]); w0.y = pack2(o[2], o[3]); w0.z = pack2(o[4], o[5]); w0.w = pack2(o[6], o[7]);
      w1.x = pack2(o[8], o[9]); w1.y = pack2(o[10], o[11]); w1.z = pack2(o[12], o[13]); w1.w = pack2(o[14], o[15]);
      uint4* xp = (uint4*)(p.x1 + (size_t)t * 1024 + lane * 16);
      xp[0] = w0; xp[1] = w1;
    }
    __syncthreads();
  }
}

DI void ins16(float (&L)[16], float v) {
#pragma unroll
  for (int k = 15; k >= 1; --k) L[k] = __builtin_amdgcn_fmed3f(v, L[k - 1], L[k]);
  L[0] = fmaxf(L[0], v);
}
constexpr int QS_STR = 528;

DI void phase_peer_route(const Params& p, int layer, char* lds) {
  const int tid = otid(), lane = tid & 63, wave = tid >> 6;
  const int wn = wave & 3, wm = wave >> 2, r = lane & 31, hh = lane >> 5;
  char* Qs = lds;
  unsigned* Ls = (unsigned*)(lds + 128 * QS_STR);
  for (int item = blockIdx.x; item < 2048; item += gridDim.x) {
    const int mt = item >> 3, head = item & 7;
    f32x16 acc[2][2];
    gemm_core<1024>(p.wqT + ((size_t)layer * 2048 + head * 256) * 1024, 1024, p.x1 + (size_t)mt * 128 * 1024, 1024, acc, lds);
#pragma unroll
    for (int j = 0; j < 2; ++j)
#pragma unroll
      for (int i = 0; i < 2; ++i)
#pragma unroll
        for (int g = 0; g < 4; ++g) {
          uint2 v; v.x = pack2(acc[i][j][4 * g], acc[i][j][4 * g + 1]); v.y = pack2(acc[i][j][4 * g + 2], acc[i][j][4 * g + 3]);
          *(uint2*)(Qs + (wm * 64 + j * 32 + r) * QS_STR + (wn * 64 + i * 32 + 8 * g + 4 * hh) * 2) = v;
        }
    __syncthreads();
    {
      const int pp = wave >> 2, tg = wave & 3;
      bf16x8 Bq[8];
      const char* qrow = Qs + (tg * 32 + r) * QS_STR + (pp * 128 + hh * 8) * 2;
#pragma unroll
      for (int s = 0; s < 8; ++s) Bq[s] = *(const bf16x8*)(qrow + s * 32);
      const u16* kbase = p.keysb + ((size_t)(layer * 16 + head * 2 + pp) * 128) * 128;
      float Lst[16];
#pragma unroll
      for (int k = 0; k < 16; ++k) Lst[k] = -3.0e38f;
#pragma unroll
      for (int kt = 0; kt < 4; ++kt) {
        f32x16 S;
#pragma unroll
        for (int e = 0; e < 16; ++e) S[e] = 0.f;
        const u16* krow = kbase + (size_t)(kt * 32 + r) * 128 + hh * 8;
#pragma unroll
        for (int s = 0; s < 8; ++s) S = MFMA(*(const bf16x8*)(krow + s * 16), Bq[s], S);
#pragma unroll
        for (int e = 0; e < 16; ++e) {
          const int kidx = kt * 32 + (e & 3) + 8 * (e >> 2) + 4 * hh;
          const float v = __uint_as_float((__float_as_uint(S[e]) & ~127u) | (unsigned)(127 - kidx));
          ins16(Lst, v);
        }
      }
      float Pl[16];
#pragma unroll
      for (int k = 0; k < 16; ++k) Pl[k] = __shfl_xor(Lst[k], 32);
#pragma unroll
      for (int k = 0; k < 16; ++k) ins16(Lst, Pl[k]);
      if (hh == 0) {
        unsigned* dst = Ls + ((tg * 32 + r) * 2 + pp) * 16;
#pragma unroll
        for (int k = 0; k < 16; ++k) dst[k] = __float_as_uint(Lst[k]);
      }
    }
    __syncthreads();
    if (tid < 128) {
      const unsigned* la = Ls + (tid * 2) * 16;
      float A[16], B[16];
#pragma unroll
      for (int k = 0; k < 16; ++k) { A[k] = __uint_as_float(la[k]); B[k] = __uint_as_float(la[16 + k]); }
      float C[16];
#pragma unroll
      for (int k = 0; k < 16; ++k) C[k] = -3.0e38f;
#pragma unroll
      for (int i = 0; i < 16; ++i)
#pragma unroll
        for (int j = 0; j < 16; ++j)
          if ((i + 1) * (j + 1) <= 16) {
            const float sm = A[i] + B[j];
            const float v = __uint_as_float((__float_as_uint(sm) & ~255u) | (unsigned)(255 - (i * 16 + j)));
            ins16(C, v);
          }
      const int t = mt * 128 + tid;
      float e[16], sum = 0.f;
#pragma unroll
      for (int k = 0; k < 16; ++k) { e[k] = __expf(C[k] - C[0]); sum += e[k]; }
      const float inv = 1.f / sum;
      int* ed = p.experts + (size_t)t * 128 + head * 16;
      float* gd = p.gates + (size_t)t * 128 + head * 16;
#pragma unroll
      for (int k = 0; k < 16; ++k) {
        const unsigned code = 255u - (__float_as_uint(C[k]) & 255u);
        const int i1 = 127 - (int)(la[code >> 4] & 127u);
        const int i2 = 127 - (int)(la[16 + (code & 15)] & 127u);
        ed[k] = i1 * 128 + i2;
        gd[k] = e[k] * inv;
      }
    }
    __syncthreads();
  }
}

DI float gelu_exact(float d) { return 0.5f * d * (1.f + erff(d * 0.70710678118654752f)); }

DI void phase_peer_ffn(const Params& p, int layer, char* lds) {
  const int tid = otid(), lane = tid & 63, wave = tid >> 6;
  const float* g2 = p.in[15] + layer * 1024;
  const float* b2 = p.in[16] + layer * 1024;
  for (int t = blockIdx.x * 8 + wave; t < T_ALL; t += gridDim.x * 8) {
    const uint4 xa = *(const uint4*)(p.x1 + (size_t)t * 1024 + lane * 8);
    const uint4 xc = *(const uint4*)(p.x1 + (size_t)t * 1024 + 512 + lane * 8);
    const unsigned xw[8] = {xa.x, xa.y, xa.z, xa.w, xc.x, xc.y, xc.z, xc.w};
    float acc[16];
#pragma unroll
    for (int e = 0; e < 16; ++e) acc[e] = 0.f;
    const int ev0 = p.experts[(size_t)t * 128 + lane], ev1 = p.experts[(size_t)t * 128 + 64 + lane];
    const float gv0 = p.gates[(size_t)t * 128 + lane], gv1 = p.gates[(size_t)t * 128 + 64 + lane];
#pragma unroll 1
    for (int k4 = 0; k4 < 128; k4 += 4) {
      uint4 ua[4], uc[4], va[4], vc[4];
      float gk[4];
#pragma unroll
      for (int q = 0; q < 4; ++q) {
        const int k = k4 + q;
        const int e = (k < 64) ? __builtin_amdgcn_readlane(ev0, k & 63) : __builtin_amdgcn_readlane(ev1, k & 63);
        gk[q] = __int_as_float((k < 64) ? __builtin_amdgcn_readlane(__float_as_int(gv0), k & 63)
                                        : __builtin_amdgcn_readlane(__float_as_int(gv1), k & 63));
        const u16* ur = p.ub + (size_t)e * 1024;
        const u16* vr = p.vb + (size_t)e * 1024;
        ua[q] = *(const uint4*)(ur + lane * 8); uc[q] = *(const uint4*)(ur + 512 + lane * 8);
        va[q] = *(const uint4*)(vr + lane * 8); vc[q] = *(const uint4*)(vr + 512 + lane * 8);
      }
#pragma unroll
      for (int q = 0; q < 4; ++q) {
        const unsigned uw[8] = {ua[q].x, ua[q].y, ua[q].z, ua[q].w, uc[q].x, uc[q].y, uc[q].z, uc[q].w};
        float d = 0.f;
#pragma unroll
        for (int e = 0; e < 8; ++e)
          d = __builtin_amdgcn_fdot2_f32_bf16(__builtin_bit_cast(bf16x2_t, uw[e]), __builtin_bit_cast(bf16x2_t, xw[e]), d, false);
        d = wave_sum(d);
        const float cf = gk[q] * gelu_exact(d);
        const unsigned vw[8] = {va[q].x, va[q].y, va[q].z, va[q].w, vc[q].x, vc[q].y, vc[q].z, vc[q].w};
#pragma unroll
        for (int e = 0; e < 8; ++e) {
          acc[2 * e] = fmaf(cf, bflo(vw[e]), acc[2 * e]);
          acc[2 * e + 1] = fmaf(cf, bfhi(vw[e]), acc[2 * e + 1]);
        }
      }
    }
    float y[16];
    float s = 0.f;
#pragma unroll
    for (int e = 0; e < 8; ++e) {
      y[2 * e] = ALPHA * bflo(xw[e]) + acc[2 * e];
      y[2 * e + 1] = ALPHA * bfhi(xw[e]) + acc[2 * e + 1];
      s += y[2 * e] + y[2 * e + 1];
    }
    const float mean = wave_sum(s) * (1.f / 1024.f);
    float vs = 0.f;
#pragma unroll
    for (int e = 0; e < 16; ++e) { y[e] -= mean; vs += y[e] * y[e]; }
    const float rstd = rsqrtf(wave_sum(vs) * (1.f / 1024.f) + 1e-5f);
    float o[16];
#pragma unroll
    for (int e = 0; e < 16; ++e) {
      const int d = (e < 8) ? (lane * 8 + e) : (512 + lane * 8 + (e - 8));
      o[e] = y[e] * rstd * g2[d] + b2[d];
    }
    if (layer == 1) {
      float4* oa = (float4*)(p.out + (size_t)t * 1024 + lane * 8);
      float4* oc = (float4*)(p.out + (size_t)t * 1024 + 512 + lane * 8);
      oa[0] = make_float4(o[0], o[1], o[2], o[3]); oa[1] = make_float4(o[4], o[5], o[6], o[7]);
      oc[0] = make_float4(o[8], o[9], o[10], o[11]); oc[1] = make_float4(o[12], o[13], o[14], o[15]);
    } else {
      uint4 w0, w1;
      w0.x = pack2(o[0], o[1]); w0.y = pack2(o[2], o[3]); w0.z = pack2(o[4], o[5]); w0.w = pack2(o[6], o[7]);
      w1.x = pack2(o[8], o[9]); w1.y = pack2(o[10], o[11]); w1.z = pack2(o[12], o[13]); w1.w = pack2(o[14], o[15]);
      *(uint4*)(p.xb + (size_t)t * 1024 + lane * 8) = w0;
      *(uint4*)(p.xb + (size_t)t * 1024 + 512 + lane * 8) = w1;
    }
  }
}

__global__ __launch_bounds__(512) void mega(Params p, int ph_lo, int ph_hi) {
  extern __shared__ __attribute__((aligned(16))) char lds[];
  cg::grid_group grid = cg::this_grid();
  for (int ph = ph_lo; ph < ph_hi; ++ph) {
    if (ph == 0) {
      phase_prep(p, lds);
    } else {
      const int layer = (ph - 1) / 6, sub = (ph - 1) % 6;
      if (sub == 0) {
        if (layer == 1) {
          convert_bf16(p.in[13] + (size_t)NEXP * DM, p.ub, (size_t)NEXP * DM / 8);
          convert_bf16(p.in[14] + (size_t)NEXP * DM, p.vb, (size_t)NEXP * DM / 8);
        }
        phase_gemm1(p, layer, lds);
      } else if (sub == 1) phase_mla_up(p, layer, lds);
      else if (sub == 2) phase_attn(p, layer, lds);
      else if (sub == 3) phase_outproj(p, layer, lds);
      else if (sub == 4) phase_peer_route(p, layer, lds);
      else phase_peer_ffn(p, layer, lds);
    }
    if (ph + 1 < ph_hi) grid.sync();
  }
}

extern "C" void kernel_launch(void* const* d_in, const int* in_sizes, int n_in, void* d_out, int out_size, void* d_ws,
                              size_t ws_size, hipStream_t stream) {
  Params p;
  memset(&p, 0, sizeof(p));
  for (int i = 0; i < 17; ++i) p.in[i] = (const float*)d_in[i];
  p.out = (float*)d_out;
  char* w = (char*)d_ws;
  size_t off = 0;
  auto alloc = [&](size_t bytes) { char* r = w + off; off += (bytes + 255) & ~(size_t)255; return r; };
  p.xb = (u16*)alloc((size_t)T_ALL * DM * 2);
  p.winT = (u16*)alloc((size_t)2 * NPAD * 1024 * 2);
  p.wuqT = (u16*)alloc((size_t)2 * 768 * 256 * 2);
  p.wukvT = (u16*)alloc((size_t)2 * 768 * 128 * 2);
  p.woT = (u16*)alloc((size_t)2 * 1024 * 1024 * 2);
  p.wqT = (u16*)alloc((size_t)2 * 2048 * 1024 * 2);
  p.keysb = (u16*)alloc((size_t)2 * 16 * 128 * 128 * 2);
  p.ub = (u16*)alloc((size_t)NEXP * DM * 2);
  p.vb = (u16*)alloc((size_t)NEXP * DM * 2);
  p.cs32 = (float2*)alloc((size_t)SEQ * 16 * 8);
  p.cs64 = (float2*)alloc((size_t)SEQ * 32 * 8);
  p.cat = (u16*)alloc((size_t)T_ALL * 1024 * 2);
  const size_t r1 = off;
  p.aq = (u16*)alloc((size_t)T_ALL * 256 * 2);
  p.ak = (u16*)alloc((size_t)T_ALL * 256 * 2);
  p.av = (u16*)alloc((size_t)T_ALL * 256 * 2);
  p.bcq = (u16*)alloc((size_t)T_ALL * 256 * 2);
  p.bckv = (u16*)alloc((size_t)T_ALL * 128 * 2);
  p.bkr = (u16*)alloc((size_t)T_ALL * 32 * 2);
  p.cq = (u16*)alloc((size_t)T_ALL * 384 * 2);
  p.ck = (u16*)alloc((size_t)T_ALL * 384 * 2);
  p.cv = (u16*)alloc((size_t)T_ALL * 384 * 2);
  p.mq = (u16*)alloc((size_t)T_ALL * 576 * 2);
  p.mk = (u16*)alloc((size_t)T_ALL * 384 * 2);
  p.mv = (u16*)alloc((size_t)T_ALL * 384 * 2);
  off = r1;
  p.ybuf = (u16*)alloc((size_t)T_ALL * 1024 * 2);
  p.x1 = (u16*)alloc((size_t)T_ALL * 1024 * 2);
  p.experts = (int*)alloc((size_t)T_ALL * 128 * 4);
  p.gates = (float*)alloc((size_t)T_ALL * 128 * 4);
  p.dilo = (u16*)d_out;
  p.dillse = (float*)((char*)d_out + (size_t)3 * T_ALL * 384 * 2);

#ifdef MULTI_LAUNCH
  hipFuncSetAttribute((const void*)mega, hipFuncAttributeMaxDynamicSharedMemorySize, LDS_BYTES);
  for (int ph = 0; ph < 13; ++ph) {
    hipLaunchKernelGGL(mega, dim3(256), dim3(512), LDS_BYTES, stream, p, ph, ph + 1);
  }
#else
  static int grid_blocks = 0;
  if (!grid_blocks) {
    int dev = 0, cus = 0, per_cu = 0;
    hipGetDevice(&dev);
    hipDeviceGetAttribute(&cus, hipDeviceAttributeMultiprocessorCount, dev);
    hipFuncSetAttribute((const void*)mega, hipFuncAttributeMaxDynamicSharedMemorySize, LDS_BYTES);
    hipOccupancyMaxActiveBlocksPerMultiprocessor(&per_cu, mega, 512, LDS_BYTES);
    if (per_cu > 1) per_cu = 1;
    grid_blocks = cus * per_cu;
  }
  int lo = 0, hi = 13;
  void* args[] = {&p, &lo, &hi};
  hipError_t e = hipLaunchCooperativeKernel((void*)mega, dim3(grid_blocks), dim3(512), args, LDS_BYTES, stream);
  if (e != hipSuccess) fprintf(stderr, "cooperative launch failed: %s (grid %d)\n", hipGetErrorString(e), grid_blocks);
#endif
}
```

```cpp
#include <hip/hip_runtime.h>
#include <hip/hip_cooperative_groups.h>
#include <math.h>
#include <stdio.h>
#include <string.h>
namespace cg = cooperative_groups;

typedef unsigned short u16;
typedef short bf16x8 __attribute__((ext_vector_type(8)));
typedef short s16x4 __attribute__((ext_vector_type(4)));
typedef float f32x16 __attribute__((ext_vector_type(16)));
typedef float f32x2 __attribute__((ext_vector_type(2)));
typedef __bf16 bf16x2_t __attribute__((ext_vector_type(2)));

#define DI __device__ __forceinline__
#define MFMA(a, b, c) __builtin_amdgcn_mfma_f32_32x32x16_bf16((a), (b), (c), 0, 0, 0)

constexpr int T_ALL = 32768, SEQ = 4096, DM = 1024, INW = 2336, NEXP = 16384;
constexpr int NPAD = 2560;
constexpr float LOG2E = 1.4426950408889634f;
constexpr float ALPHA = 1.41421356237309515f;

struct Params {
  const float* in[17];
  float* out;
  u16 *xb, *winT, *wuqT, *wukvT, *woT, *wqT, *keysb;
  unsigned char *ub, *vb;
  float *us, *vs;
  float2 *cs32, *cs64;
  u16 *aq, *ak, *av, *bcq, *bckv, *bkr, *cq, *ck, *cv, *mq, *mk, *mv, *cat, *dilo;
  float* dillse;
  u16 *ybuf, *x1;
  int* experts;
  float* gates;
};

DI int otid() { int t = threadIdx.x; asm volatile("" : "+v"(t)); return t; }
DI int obid() { int b = blockIdx.x; asm volatile("" : "+s"(b)); return b; }
DI unsigned pack2(float a, float b) {
  f32x2 v = {a, b};
  return __builtin_bit_cast(unsigned, __builtin_convertvector(v, bf16x2_t));
}
DI float bflo(unsigned w) { return __uint_as_float(w << 16); }
DI float bfhi(unsigned w) { return __uint_as_float(w & 0xffff0000u); }
DI float fexp2(float x) { return __builtin_amdgcn_exp2f(x); }
DI void store8(u16* dst, float a, float b, float c, float d) {
  uint2 v; v.x = pack2(a, b); v.y = pack2(c, d);
  *(uint2*)dst = v;
}
DI void store_tile(u16* dst, const f32x16& v, int hh) {
#pragma unroll
  for (int g = 0; g < 4; ++g) store8(dst + 8 * g + 4 * hh, v[4 * g], v[4 * g + 1], v[4 * g + 2], v[4 * g + 3]);
}
DI void rope32(f32x16& v, const float2* cs, int hh) {
#pragma unroll
  for (int g = 0; g < 2; ++g)
#pragma unroll
    for (int b = 0; b < 4; ++b) {
      float2 c = cs[8 * g + 4 * hh + b];
      float x1 = v[4 * g + b], x2 = v[4 * g + b + 8];
      v[4 * g + b] = x1 * c.x - x2 * c.y;
      v[4 * g + b + 8] = x2 * c.x + x1 * c.y;
    }
}
DI void rope64(f32x16& v0, f32x16& v1, const float2* cs, int hh) {
#pragma unroll
  for (int g = 0; g < 4; ++g)
#pragma unroll
    for (int b = 0; b < 4; ++b) {
      float2 c = cs[8 * g + 4 * hh + b];
      float x1 = v0[4 * g + b], x2 = v1[4 * g + b];
      v0[4 * g + b] = x1 * c.x - x2 * c.y;
      v1[4 * g + b] = x2 * c.x + x1 * c.y;
    }
}
DI float wave_sum(float v) {
#pragma unroll
  for (int o = 32; o; o >>= 1) v += __shfl_xor(v, o);
  return v;
}
DI s16x4 trread(const char* p) {
  return __builtin_amdgcn_ds_read_tr16_b64_v4i16((__attribute__((address_space(3))) s16x4*)(p));
}

DI void convert_bf16(const float* __restrict__ src, u16* __restrict__ dst, size_t n8  ) {
  const size_t i0 = (size_t)obid() * 512 + otid();
  for (size_t i = i0; i < n8; i += (size_t)gridDim.x * 512) {
    float4 a = ((const float4*)src)[2 * i], b = ((const float4*)src)[2 * i + 1];
    uint4 o; o.x = pack2(a.x, a.y); o.y = pack2(a.z, a.w); o.z = pack2(b.x, b.y); o.w = pack2(b.z, b.w);
    ((uint4*)dst)[i] = o;
  }
}
DI void transpose_tile(const float* __restrict__ src, int nsrc, u16* __restrict__ dst, int K, int nt, int ktile, int mode,
                       const float* __restrict__ kscale, float* tile  ) {
  const int tid = otid();
  const int n0 = nt * 64, k0 = ktile * 64;
#pragma unroll
  for (int pass = 0; pass < 2; ++pass) {
    int kk = (tid >> 4) + pass * 32, nn = (tid & 15) * 4;
    int np = n0 + nn;
    int col = np; float sc = 1.f;
    if (mode == 0) {
      if (np < 1184) col = np; else if (np < 1216) col = -1; else if (np < 2368) col = np - 32; else col = -1;
      if (col >= 0 && col < 256) sc = 0.17677669529663687f * LOG2E;
      else if (col >= 1184 && col < 1568) sc = 0.125f * LOG2E;
    } else if (mode == 1) {
      if (np >= 576) col = -1;
      sc = 0.10206207261596575f * LOG2E;
    }
    float4 v = make_float4(0.f, 0.f, 0.f, 0.f);
    if (col >= 0 && col < nsrc) v = *(const float4*)(src + (size_t)(k0 + kk) * nsrc + col);
    float ks = kscale ? kscale[k0 + kk] : 1.f;
    sc *= ks;
    tile[kk * 65 + nn + 0] = v.x * sc; tile[kk * 65 + nn + 1] = v.y * sc;
    tile[kk * 65 + nn + 2] = v.z * sc; tile[kk * 65 + nn + 3] = v.w * sc;
  }
  __syncthreads();
  {
    int nn = tid >> 3, k8 = (tid & 7) * 8;
    float f[8];
#pragma unroll
    for (int e = 0; e < 8; ++e) f[e] = tile[(k8 + e) * 65 + nn];
    uint4 o; o.x = pack2(f[0], f[1]); o.y = pack2(f[2], f[3]); o.z = pack2(f[4], f[5]); o.w = pack2(f[6], f[7]);
    *(uint4*)(dst + (size_t)(n0 + nn) * K + k0 + k8) = o;
  }
  __syncthreads();
}

DI void convert_rows_fp8(const float* __restrict__ src, unsigned char* __restrict__ dst, float* __restrict__ inv_scale, int nrows) {
  const int tid = otid(), lane = tid & 63, wave = tid >> 6;
  for (int row = obid() * 8 + wave; row < nrows; row += gridDim.x * 8) {
    const float4* rp = (const float4*)(src + (size_t)row * 1024 + lane * 16);
    const float4 a = rp[0], b = rp[1], c = rp[2], d = rp[3];
    float mx = fmaxf(fmaxf(fmaxf(fabsf(a.x), fabsf(a.y)), fmaxf(fabsf(a.z), fabsf(a.w))),
                     fmaxf(fmaxf(fabsf(b.x), fabsf(b.y)), fmaxf(fabsf(b.z), fabsf(b.w))));
    mx = fmaxf(mx, fmaxf(fmaxf(fmaxf(fabsf(c.x), fabsf(c.y)), fmaxf(fabsf(c.z), fabsf(c.w))),
                         fmaxf(fmaxf(fabsf(d.x), fabsf(d.y)), fmaxf(fabsf(d.z), fabsf(d.w)))));
#pragma unroll
    for (int o = 32; o; o >>= 1) mx = fmaxf(mx, __shfl_xor(mx, o));
    const float sc = (mx > 0.f) ? 448.f / mx : 1.f;
    uint4 o4; int w;
    w = 0; w = __builtin_amdgcn_cvt_pk_fp8_f32(a.x * sc, a.y * sc, w, false); w = __builtin_amdgcn_cvt_pk_fp8_f32(a.z * sc, a.w * sc, w, true); o4.x = w;
    w = 0; w = __builtin_amdgcn_cvt_pk_fp8_f32(b.x * sc, b.y * sc, w, false); w = __builtin_amdgcn_cvt_pk_fp8_f32(b.z * sc, b.w * sc, w, true); o4.y = w;
    w = 0; w = __builtin_amdgcn_cvt_pk_fp8_f32(c.x * sc, c.y * sc, w, false); w = __builtin_amdgcn_cvt_pk_fp8_f32(c.z * sc, c.w * sc, w, true); o4.z = w;
    w = 0; w = __builtin_amdgcn_cvt_pk_fp8_f32(d.x * sc, d.y * sc, w, false); w = __builtin_amdgcn_cvt_pk_fp8_f32(d.z * sc, d.w * sc, w, true); o4.w = w;
    *(uint4*)(dst + (size_t)row * 1024 + lane * 16) = o4;
    if (lane == 0) inv_scale[row] = (mx > 0.f) ? mx * (1.f / 448.f) : 1.f;
  }
}

DI void phase_prep(const Params& p, char* lds) {
  convert_bf16(p.in[0], p.xb, (size_t)T_ALL * DM / 8);
  convert_bf16(p.in[12], p.keysb, (size_t)2 * 16 * 128 * 128 / 8);
  convert_rows_fp8(p.in[13], p.ub, p.us, 2 * NEXP);
  convert_rows_fp8(p.in[14], p.vb, p.vs, 2 * NEXP);
  for (int i = obid() * 512 + otid(); i < SEQ * 48; i += gridDim.x * 512) {
    int pos = i / 48, r = i % 48;
    if (r < 16) {
      float ang = (float)pos * expf(-logf(10000.0f) * (float)r / 16.f);
      p.cs32[pos * 16 + r] = make_float2(cosf(ang), sinf(ang));
    } else {
      int q = r - 16;
      float ang = (float)pos * expf(-logf(10000.0f) * (float)q / 32.f);
      p.cs64[pos * 32 + q] = make_float2(cosf(ang), sinf(ang));
    }
  }
  float* tile = (float*)lds;
  for (int u = obid(); u < 2960; u += gridDim.x) {
    if (u < 1280) {
      int l = u / 640, r = u % 640;
      transpose_tile(p.in[1] + (size_t)l * DM * INW, INW, p.winT + (size_t)l * NPAD * 1024, 1024, r / 16, r % 16, 0, nullptr, tile);
    } else if (u < 1376) {
      int v = u - 1280; int l = v / 48, r = v % 48;
      transpose_tile(p.in[6] + (size_t)l * 256 * 576, 576, p.wuqT + (size_t)l * 768 * 256, 256, r / 4, r % 4, 1, p.in[4] + l * 256, tile);
    } else if (u < 1424) {
      int v = u - 1376; int l = v / 24, r = v % 24;
      transpose_tile(p.in[7] + (size_t)l * 128 * 768, 768, p.wukvT + (size_t)l * 768 * 128, 128, r / 2, r % 2, 2, p.in[5] + l * 128, tile);
    } else if (u < 1936) {
      int v = u - 1424; int l = v / 256, r = v % 256;
      transpose_tile(p.in[8] + (size_t)l * DM * DM, DM, p.woT + (size_t)l * DM * DM, 1024, r / 16, r % 16, 3, nullptr, tile);
    } else {
      int v = u - 1936; int l = v / 512, r = v % 512;
      transpose_tile(p.in[11] + (size_t)l * DM * 2048, 2048, p.wqT + (size_t)l * 2048 * DM, 1024, r / 16, r % 16, 3, nullptr, tile);
    }
  }
}

constexpr int G_ROWB = 144;
constexpr int G_X1B = 256 * G_ROWB;
constexpr int G_X2B = 128 * G_ROWB;
constexpr int G_STAGE = G_X1B + G_X2B;
constexpr int LDS_BYTES = 2 * G_STAGE + 4096;

template <int K>
DI void gemm_core(const u16* __restrict__ X1, int ld1, const u16* __restrict__ X2, int ld2, f32x16 (&acc)[2][2], char* lds) {
  const int tid = otid(), lane = tid & 63, wave = tid >> 6;
  const int wn = wave & 3, wm = wave >> 2, r = lane & 31, hh = lane >> 5;
  constexpr int NK = K / 64;
  uint4 g1[4], g2[2];
  const int lrow = tid >> 3, lch = tid & 7;
#pragma unroll
  for (int i = 0; i < 2; ++i)
#pragma unroll
    for (int j = 0; j < 2; ++j)
#pragma unroll
      for (int e = 0; e < 16; ++e) acc[i][j][e] = 0.f;
  const u16* p1 = X1 + (size_t)lrow * ld1 + lch * 8;
  const u16* p2 = X2 + (size_t)lrow * ld2 + lch * 8;
#pragma unroll
  for (int e = 0; e < 4; ++e) g1[e] = *(const uint4*)(p1 + (size_t)(64 * e) * ld1);
#pragma unroll
  for (int e = 0; e < 2; ++e) g2[e] = *(const uint4*)(p2 + (size_t)(64 * e) * ld2);
  {
    char* b = lds;
#pragma unroll
    for (int e = 0; e < 4; ++e) *(uint4*)(b + (lrow + 64 * e) * G_ROWB + lch * 16) = g1[e];
#pragma unroll
    for (int e = 0; e < 2; ++e) *(uint4*)(b + G_X1B + (lrow + 64 * e) * G_ROWB + lch * 16) = g2[e];
  }
  __syncthreads();
  for (int kt = 0; kt < NK; ++kt) {
    if (kt + 1 < NK) {
#pragma unroll
      for (int e = 0; e < 4; ++e) g1[e] = *(const uint4*)(p1 + (size_t)(64 * e) * ld1 + (kt + 1) * 64);
#pragma unroll
      for (int e = 0; e < 2; ++e) g2[e] = *(const uint4*)(p2 + (size_t)(64 * e) * ld2 + (kt + 1) * 64);
    }
    const char* b1 = lds + (kt & 1) * G_STAGE + (wn * 64 + r) * G_ROWB + hh * 16;
    const char* b2 = lds + (kt & 1) * G_STAGE + G_X1B + (wm * 64 + r) * G_ROWB + hh * 16;
#pragma unroll
    for (int s = 0; s < 4; ++s) {
      bf16x8 a0 = *(const bf16x8*)(b1 + s * 32), a1 = *(const bf16x8*)(b1 + 32 * G_ROWB + s * 32);
      bf16x8 c0 = *(const bf16x8*)(b2 + s * 32), c1 = *(const bf16x8*)(b2 + 32 * G_ROWB + s * 32);
      acc[0][0] = MFMA(a0, c0, acc[0][0]);
      acc[0][1] = MFMA(a0, c1, acc[0][1]);
      acc[1][0] = MFMA(a1, c0, acc[1][0]);
      acc[1][1] = MFMA(a1, c1, acc[1][1]);
    }
    if (kt + 1 < NK) {
      char* b = lds + ((kt + 1) & 1) * G_STAGE;
#pragma unroll
      for (int e = 0; e < 4; ++e) *(uint4*)(b + (lrow + 64 * e) * G_ROWB + lch * 16) = g1[e];
#pragma unroll
      for (int e = 0; e < 2; ++e) *(uint4*)(b + G_X1B + (lrow + 64 * e) * G_ROWB + lch * 16) = g2[e];
    }
    __syncthreads();
  }
}

DI void phase_gemm1(const Params& p, int layer, char* lds) {
  const int tid = otid(), lane = tid & 63, wave = tid >> 6;
  const int wn = wave & 3, wm = wave >> 2, r = lane & 31, hh = lane >> 5;
  for (int item = obid(); item < 2560; item += gridDim.x) {
    const int mt = item / 10, nt = item % 10;
    f32x16 acc[2][2];
    gemm_core<1024>(p.winT + ((size_t)layer * NPAD + nt * 256) * 1024, 1024, p.xb + (size_t)mt * 128 * 1024, 1024, acc, lds);
    const int n64 = nt * 256 + wn * 64;
#pragma unroll
    for (int j = 0; j < 2; ++j) {
      const int t = mt * 128 + wm * 64 + j * 32 + r;
      const int b = t >> 12, s = t & 4095;
      if (n64 < 512) {
        u16* base = (n64 < 256) ? p.aq : p.ak;
        const int hh0 = (n64 & 255) >> 5;
        const float2* cs = p.cs32 + s * 16;
#pragma unroll
        for (int i = 0; i < 2; ++i) {
          rope32(acc[i][j], cs, hh);
          store_tile(base + ((size_t)(b * 8 + hh0 + i) * SEQ + s) * 32, acc[i][j], hh);
        }
      } else if (n64 < 768) {
        const int head = (n64 - 512) >> 6;
#pragma unroll
        for (int i = 0; i < 2; ++i) store_tile(p.av + ((size_t)(b * 4 + head) * SEQ + s) * 64 + i * 32, acc[i][j], hh);
      } else if (n64 < 1024) {
#pragma unroll
        for (int i = 0; i < 2; ++i) store_tile(p.bcq + (size_t)t * 256 + (n64 - 768) + i * 32, acc[i][j], hh);
      } else if (n64 < 1152) {
#pragma unroll
        for (int i = 0; i < 2; ++i) store_tile(p.bckv + (size_t)t * 128 + (n64 - 1024) + i * 32, acc[i][j], hh);
      } else if (n64 == 1152) {
        rope32(acc[0][j], p.cs32 + s * 16, hh);
        store_tile(p.bkr + (size_t)t * 32, acc[0][j], hh);
      } else if (n64 < 1984) {
        const bool isq = n64 < 1600;
        const int head = (n64 - (isq ? 1216 : 1600)) >> 6;
        u16* base = isq ? p.cq : p.ck;
        rope64(acc[0][j], acc[1][j], p.cs64 + s * 32, hh);
#pragma unroll
        for (int i = 0; i < 2; ++i) store_tile(base + ((size_t)(b * 6 + head) * SEQ + s) * 64 + i * 32, acc[i][j], hh);
      } else if (n64 < 2368) {
        const int head = (n64 - 1984) >> 6;
#pragma unroll
        for (int i = 0; i < 2; ++i) store_tile(p.cv + ((size_t)(b * 6 + head) * SEQ + s) * 64 + i * 32, acc[i][j], hh);
      }
    }
  }
}

DI void phase_mla_up(const Params& p, int layer, char* lds) {
  const int tid = otid(), lane = tid & 63, wave = tid >> 6;
  const int wn = wave & 3, wm = wave >> 2, r = lane & 31, hh = lane >> 5;
  float* rinv_s = (float*)(lds + 2 * G_STAGE);
  for (int item = obid(); item < 1536; item += gridDim.x) {
    const int which = item / 768;
    const int it = item % 768, mt = it / 3, nt = it % 3;
    {
      const int tok = tid >> 2, part = tid & 3;
      float ss = 0.f;
      if (which == 0) {
        const uint4* row = (const uint4*)(p.bcq + (size_t)(mt * 128 + tok) * 256 + part * 64);
#pragma unroll
        for (int c = 0; c < 8; ++c) {
          uint4 v = row[c];
          ss += bflo(v.x) * bflo(v.x) + bfhi(v.x) * bfhi(v.x) + bflo(v.y) * bflo(v.y) + bfhi(v.y) * bfhi(v.y) +
                bflo(v.z) * bflo(v.z) + bfhi(v.z) * bfhi(v.z) + bflo(v.w) * bflo(v.w) + bfhi(v.w) * bfhi(v.w);
        }
      } else {
        const uint4* row = (const uint4*)(p.bckv + (size_t)(mt * 128 + tok) * 128 + part * 32);
#pragma unroll
        for (int c = 0; c < 4; ++c) {
          uint4 v = row[c];
          ss += bflo(v.x) * bflo(v.x) + bfhi(v.x) * bfhi(v.x) + bflo(v.y) * bflo(v.y) + bfhi(v.y) * bfhi(v.y) +
                bflo(v.z) * bflo(v.z) + bfhi(v.z) * bfhi(v.z) + bflo(v.w) * bflo(v.w) + bfhi(v.w) * bfhi(v.w);
        }
      }
      ss += __shfl_xor(ss, 1);
      ss += __shfl_xor(ss, 2);
      if (part == 0) rinv_s[tok] = rsqrtf(ss / (which == 0 ? 256.f : 128.f) + 1e-5f);
    }
    f32x16 acc[2][2];
    if (which == 0)
      gemm_core<256>(p.wuqT + ((size_t)layer * 768 + nt * 256) * 256, 256, p.bcq + (size_t)mt * 128 * 256, 256, acc, lds);
    else
      gemm_core<128>(p.wukvT + ((size_t)layer * 768 + nt * 256) * 128, 128, p.bckv + (size_t)mt * 128 * 128, 128, acc, lds);
    const int n64 = nt * 256 + wn * 64;
#pragma unroll
    for (int j = 0; j < 2; ++j) {
      const int tl = wm * 64 + j * 32 + r;
      const int t = mt * 128 + tl;
      const int b = t >> 12, s = t & 4095;
      const float ri = rinv_s[tl];
#pragma unroll
      for (int i = 0; i < 2; ++i) {
        const int n32 = n64 + i * 32;
        f32x16 v = acc[i][j];
#pragma unroll
        for (int e = 0; e < 16; ++e) v[e] *= ri;
        if (which == 0) {
          if (n32 < 576) {
            const int head = n32 / 96, dpart = (n32 % 96) >> 5;
            if (dpart == 2) rope32(v, p.cs32 + s * 16, hh);
            store_tile(p.mq + ((size_t)(b * 6 + head) * SEQ + s) * 96 + dpart * 32, v, hh);
          }
        } else {
          const int head = n32 >> 7, d32 = (n32 & 127) >> 5;
          u16* base = (d32 < 2) ? p.mk : p.mv;
          store_tile(base + ((size_t)(b * 6 + head) * SEQ + s) * 64 + (d32 & 1) * 32, v, hh);
        }
      }
    }
    __syncthreads();
  }
}

DI bf16x8 packP(const f32x16& S, int s2) {
  uint4 u;
  u.x = pack2(S[8 * s2 + 0], S[8 * s2 + 1]); u.y = pack2(S[8 * s2 + 2], S[8 * s2 + 3]);
  u.z = pack2(S[8 * s2 + 4], S[8 * s2 + 5]); u.w = pack2(S[8 * s2 + 6], S[8 * s2 + 7]);
  return __builtin_bit_cast(bf16x8, u);
}
DI float max16(const f32x16& S) {
  float a = fmaxf(fmaxf(S[0], S[1]), fmaxf(S[2], S[3]));
  float b = fmaxf(fmaxf(S[4], S[5]), fmaxf(S[6], S[7]));
  float c = fmaxf(fmaxf(S[8], S[9]), fmaxf(S[10], S[11]));
  float d = fmaxf(fmaxf(S[12], S[13]), fmaxf(S[14], S[15]));
  return fmaxf(fmaxf(a, b), fmaxf(c, d));
}

template <bool MLA>
DI void attn_dense_item(const Params& p, int layer, int item, float lam_full, float lam_init, char* lds) {
  constexpr int NS = MLA ? 1 : 2;
  constexpr int DK = MLA ? 96 : 32;
  constexpr int KSTR = MLA ? 208 : 80;
  constexpr int KB = 64 * KSTR;
  constexpr int STAGE = NS * KB + 8192;
  constexpr int NKS = DK / 16;
  const int tid = otid(), lane = tid & 63, wave = tid >> 6, r = lane & 31, hh = lane >> 5;
  int b, head, qb;
  if (MLA) { b = item / 96; head = (item / 16) % 6; qb = item & 15; }
  else { b = item / 64; head = (item / 16) & 3; qb = item & 15; }
  const int q0 = qb * 256 + wave * 32;
  const u16 *kg0, *kg1, *vg;
  bf16x8 Q[NS][NKS];
  if (MLA) {
    const u16* qp = p.mq + ((size_t)(b * 6 + head) * SEQ + q0 + r) * 96 + hh * 8;
#pragma unroll
    for (int s = 0; s < NKS; ++s) Q[0][s] = *(const bf16x8*)(qp + s * 16);
    kg0 = p.mk + (size_t)(b * 6 + head) * SEQ * 64;
    kg1 = p.bkr + (size_t)b * SEQ * 32;
    vg = p.mv + (size_t)(b * 6 + head) * SEQ * 64;
  } else {
#pragma unroll
    for (int st = 0; st < NS; ++st) {
      const u16* qp = p.aq + ((size_t)(b * 8 + head * 2 + st) * SEQ + q0 + r) * 32 + hh * 8;
#pragma unroll
      for (int s = 0; s < NKS; ++s) Q[st][s] = *(const bf16x8*)(qp + s * 16);
    }
    kg0 = p.ak + (size_t)(b * 8 + head * 2) * SEQ * 32;
    kg1 = p.ak + (size_t)(b * 8 + head * 2 + 1) * SEQ * 32;
    vg = p.av + (size_t)(b * 4 + head) * SEQ * 64;
  }
  f32x16 O[NS][2];
  float m[NS], l[NS];
#pragma unroll
  for (int st = 0; st < NS; ++st) {
    m[st] = -1e30f; l[st] = 0.f;
#pragma unroll
    for (int e = 0; e < 16; ++e) { O[st][0][e] = 0.f; O[st][1][e] = 0.f; }
  }
  uint4 gk, gv, gp;
  auto gload = [&](int kt) {
    const int k0 = kt * 64;
    if (MLA) {
      gk = *(const uint4*)(kg0 + (size_t)(k0 + (tid >> 3)) * 64 + (tid & 7) * 8);
      if (tid < 256) gp = *(const uint4*)(kg1 + (size_t)(k0 + (tid >> 2)) * 32 + (tid & 3) * 8);
    } else {
      const u16* kb = (tid < 256) ? kg0 : kg1;
      const int c = tid & 255;
      gk = *(const uint4*)(kb + (size_t)(k0 + (c >> 2)) * 32 + (c & 3) * 8);
    }
    gv = *(const uint4*)(vg + (size_t)(k0 + (tid >> 3)) * 64 + (tid & 7) * 8);
  };
  auto swrite = [&](int sb) {
    char* base = lds + sb * STAGE;
    if (MLA) {
      *(uint4*)(base + (tid >> 3) * KSTR + (tid & 7) * 16) = gk;
      if (tid < 256) *(uint4*)(base + (tid >> 2) * KSTR + 128 + (tid & 3) * 16) = gp;
    } else {
      const int c = tid & 255;
      *(uint4*)(base + (tid >> 8) * KB + (c >> 2) * KSTR + (c & 3) * 16) = gk;
    }
    const int row = tid >> 3;
    *(uint4*)(base + NS * KB + row * 128 + (((tid & 7) * 16) ^ (((row >> 1) & 1) << 6))) = gv;
  };
  const int tq = (lane & 15) >> 2, tp = lane & 3, tg1 = (lane >> 4) & 1, swz = (tq >> 1) & 1;
  const int voff = (4 * hh + tq) * 128 + 32 * tg1 + 8 * tp;

  gload(0); swrite(0);
  __syncthreads();
  for (int kt = 0; kt < 64; ++kt) {
    if (kt + 1 < 64) gload(kt + 1);
    const char* base = lds + (kt & 1) * STAGE;
    const char* vb = base + NS * KB + voff;
#pragma unroll
    for (int st = 0; st < NS; ++st) {
      f32x16 S0, S1;
#pragma unroll
      for (int e = 0; e < 16; ++e) { S0[e] = 0.f; S1[e] = 0.f; }
      const char* kb = base + st * KB + r * KSTR + hh * 16;
#pragma unroll
      for (int s = 0; s < NKS; ++s) {
        bf16x8 a0 = *(const bf16x8*)(kb + s * 32);
        bf16x8 a1 = *(const bf16x8*)(kb + 32 * KSTR + s * 32);
        S0 = MFMA(a0, Q[st][s], S0);
        S1 = MFMA(a1, Q[st][s], S1);
      }
      float mx = fmaxf(max16(S0), max16(S1));
      mx = fmaxf(mx, __shfl_xor(mx, 32));
      if (__any(mx > m[st])) {
        const float mn = fmaxf(m[st], mx);
        const float al = fexp2(m[st] - mn);
        m[st] = mn; l[st] *= al;
#pragma unroll
        for (int e = 0; e < 16; ++e) { O[st][0][e] *= al; O[st][1][e] *= al; }
      }
      float ps = 0.f;
#pragma unroll
      for (int e = 0; e < 16; ++e) { S0[e] = fexp2(S0[e] - m[st]); S1[e] = fexp2(S1[e] - m[st]); ps += S0[e] + S1[e]; }
      l[st] += ps;
      bf16x8 P[2][2];
      P[0][0] = packP(S0, 0); P[0][1] = packP(S0, 1); P[1][0] = packP(S1, 0); P[1][1] = packP(S1, 1);
#pragma unroll
      for (int i2 = 0; i2 < 2; ++i2)
#pragma unroll
        for (int u = 0; u < 2; ++u)
#pragma unroll
          for (int s2 = 0; s2 < 2; ++s2) {
            const char* a = vb + (32 * u + 16 * s2) * 128 + 64 * (i2 ^ swz);
            s16x4 lo = trread(a), hi = trread(a + 8 * 128);
            bf16x8 vf = __builtin_shufflevector(lo, hi, 0, 1, 2, 3, 4, 5, 6, 7);
            O[st][i2] = MFMA(vf, P[u][s2], O[st][i2]);
          }
    }
    if (kt + 1 < 64) swrite((kt + 1) & 1);
    __syncthreads();
  }
  const int t = b * SEQ + q0 + r;
  if (MLA) {
    const float inv = 1.f / (l[0] + __shfl_xor(l[0], 32));
#pragma unroll
    for (int i2 = 0; i2 < 2; ++i2) {
#pragma unroll
      for (int e = 0; e < 16; ++e) O[0][i2][e] *= inv;
      store_tile(p.cat + (size_t)t * 1024 + 256 + head * 64 + i2 * 32, O[0][i2], hh);
    }
  } else {
    const float inv1 = 1.f / (l[0] + __shfl_xor(l[0], 32));
    const float inv2 = lam_full / (l[NS - 1] + __shfl_xor(l[NS - 1], 32));
    float ss = 0.f;
#pragma unroll
    for (int i2 = 0; i2 < 2; ++i2)
#pragma unroll
      for (int e = 0; e < 16; ++e) {
        float o = O[0][i2][e] * inv1 - O[NS - 1][i2][e] * inv2;
        O[0][i2][e] = o; ss += o * o;
      }
    ss += __shfl_xor(ss, 32);
    const float rn = rsqrtf(ss * (1.f / 64.f) + 1e-5f) * (1.f - lam_init);
    const float* g = p.in[3] + layer * 64;
#pragma unroll
    for (int i2 = 0; i2 < 2; ++i2) {
#pragma unroll
      for (int gq = 0; gq < 4; ++gq)
#pragma unroll
        for (int bq = 0; bq < 4; ++bq) O[0][i2][4 * gq + bq] *= rn * g[i2 * 32 + 8 * gq + 4 * hh + bq];
      store_tile(p.cat + (size_t)t * 1024 + head * 64 + i2 * 32, O[0][i2], hh);
    }
  }
}

DI void attn_dilated_item(const Params& p, int item, char* lds) {
  const int tid = otid(), lane = tid & 63, wave = tid >> 6, r = lane & 31, hh = lane >> 5;
  const int pair = item / 768, rem = item % 768, bh = rem >> 4, sub = rem & 15;
  const int dil = (pair == 0) ? 1 : (pair == 1 ? 4 : 16);
  const int L = SEQ / dil;
  int cls, blk;
  if (pair == 0) { cls = 0; blk = sub; } else if (pair == 1) { cls = sub & 3; blk = sub >> 2; } else { cls = sub; blk = 0; }
  const int i0 = blk * 256;
  const u16* kg = p.ck + (size_t)bh * SEQ * 64;
  const u16* vg = p.cv + (size_t)bh * SEQ * 64;
  constexpr int KROW = 144;
  char* Kl = lds;
  char* Vl = lds + 384 * KROW;
#pragma unroll
  for (int e = 0; e < 6; ++e) {
    const int c = tid + e * 512;
    const int row = c >> 3, ch = c & 7;
    const int kk = i0 - 64 + row;
    uint4 kv = make_uint4(0, 0, 0, 0), vv = make_uint4(0, 0, 0, 0);
    if (kk >= 0 && kk < L) {
      const size_t pos = (size_t)(cls + dil * kk);
      kv = *(const uint4*)(kg + pos * 64 + ch * 8);
      vv = *(const uint4*)(vg + pos * 64 + ch * 8);
    }
    *(uint4*)(Kl + row * KROW + ch * 16) = kv;
    *(uint4*)(Vl + row * 128 + ((ch * 16) ^ (((row >> 1) & 1) << 6))) = vv;
  }
  const int qq = i0 + 32 * wave + r;
  const int pq = cls + dil * qq;
  bf16x8 Q[4];
  {
    const u16* qp = p.cq + ((size_t)bh * SEQ + pq) * 64 + hh * 8;
#pragma unroll
    for (int s = 0; s < 4; ++s) Q[s] = *(const bf16x8*)(qp + s * 16);
  }
  __syncthreads();
  f32x16 O[2];
#pragma unroll
  for (int e = 0; e < 16; ++e) { O[0][e] = 0.f; O[1][e] = 0.f; }
  float m = -1e30f, l = 0.f;
  const int tq = (lane & 15) >> 2, tp = lane & 3, tg1 = (lane >> 4) & 1, swz = (tq >> 1) & 1;
  const int voff = (4 * hh + tq) * 128 + 32 * tg1 + 8 * tp;
#pragma unroll
  for (int j = 0; j < 5; ++j) {
    const int rb = 32 * wave + 32 * j;
    f32x16 S;
#pragma unroll
    for (int e = 0; e < 16; ++e) S[e] = 0.f;
    const char* kb = Kl + (rb + r) * KROW + hh * 16;
#pragma unroll
    for (int s = 0; s < 4; ++s) S = MFMA(*(const bf16x8*)(kb + s * 32), Q[s], S);
    unsigned vmask = 0;
#pragma unroll
    for (int e = 0; e < 16; ++e) {
      const int cr = (e & 3) + 8 * (e >> 2) + 4 * hh;
      const int kk = i0 - 64 + rb + cr;
      bool ok = (kk >= 0) && (kk < L);
      if (j == 0) ok = ok && (cr >= r);
      if (j == 4) ok = ok && (cr <= r);
      vmask |= ok ? (1u << e) : 0u;
      S[e] = ok ? S[e] : -1e30f;
    }
    float mx = max16(S);
    mx = fmaxf(mx, __shfl_xor(mx, 32));
    if (__any(mx > m)) {
      const float mn = fmaxf(m, mx);
      const float al = fexp2(m - mn);
      m = mn; l *= al;
#pragma unroll
      for (int e = 0; e < 16; ++e) { O[0][e] *= al; O[1][e] *= al; }
    }
    float ps = 0.f;
#pragma unroll
    for (int e = 0; e < 16; ++e) { S[e] = ((vmask >> e) & 1) ? fexp2(S[e] - m) : 0.f; ps += S[e]; }
    l += ps;
    bf16x8 P0 = packP(S, 0), P1 = packP(S, 1);
    const char* vb = Vl + rb * 128 + voff;
#pragma unroll
    for (int i2 = 0; i2 < 2; ++i2)
#pragma unroll
      for (int s2 = 0; s2 < 2; ++s2) {
        const char* a = vb + (16 * s2) * 128 + 64 * (i2 ^ swz);
        s16x4 lo = trread(a), hi = trread(a + 8 * 128);
        bf16x8 vf = __builtin_shufflevector(lo, hi, 0, 1, 2, 3, 4, 5, 6, 7);
        O[i2] = MFMA(vf, s2 == 0 ? P0 : P1, O[i2]);
      }
  }
  const float lt = l + __shfl_xor(l, 32);
  const float inv = 1.f / lt;
  const int b = bh / 6, head = bh % 6;
  const int t = b * SEQ + pq;
#pragma unroll
  for (int i2 = 0; i2 < 2; ++i2) {
#pragma unroll
    for (int e = 0; e < 16; ++e) O[i2][e] *= inv;
    store_tile(p.dilo + ((size_t)pair * T_ALL + t) * 384 + head * 64 + i2 * 32, O[i2], hh);
  }
  if (hh == 0) p.dillse[((size_t)pair * T_ALL + t) * 6 + head] = m + __log2f(lt);
  __syncthreads();
}

DI void phase_attn(const Params& p, int layer, char* lds) {
  const float* lam = p.in[2] + layer * 128;
  float s1 = 0.f, s2 = 0.f;
  for (int i = 0; i < 32; ++i) { s1 += lam[i] * lam[32 + i]; s2 += lam[64 + i] * lam[96 + i]; }
  const float lam_init = 0.8f - 0.6f * expf(-0.3f * (float)(layer + 1));
  const float lam_full = expf(s1) - expf(s2) + lam_init;
  for (int item = obid(); item < 3584; item += gridDim.x) {
    if (item < 512) attn_dense_item<false>(p, layer, item, lam_full, lam_init, lds);
    else if (item < 1280) attn_dense_item<true>(p, layer, item - 512, lam_full, lam_init, lds);
    else attn_dilated_item(p, item - 1280, lds);
  }
}

DI void phase_outproj(const Params& p, int layer, char* lds) {
  const int tid = otid(), lane = tid & 63, wave = tid >> 6;
  const int wn = wave & 3, wm = wave >> 2, r = lane & 31, hh = lane >> 5;
  for (int mt = obid(); mt < 256; mt += gridDim.x) {
    {
      const int t = mt * 128 + (tid >> 2), quarter = tid & 3;
#pragma unroll 1
      for (int cc = 0; cc < 12; ++cc) {
        const int c = quarter * 12 + cc;
        const int head = c >> 3;
        float l0 = p.dillse[((size_t)0 * T_ALL + t) * 6 + head];
        float l1 = p.dillse[((size_t)1 * T_ALL + t) * 6 + head];
        float l2 = p.dillse[((size_t)2 * T_ALL + t) * 6 + head];
        float mx = fmaxf(l0, fmaxf(l1, l2));
        float w0 = fexp2(l0 - mx), w1 = fexp2(l1 - mx), w2 = fexp2(l2 - mx);
        float inv = 1.f / (w0 + w1 + w2);
        w0 *= inv; w1 *= inv; w2 *= inv;
        uint4 a = *(const uint4*)(p.dilo + ((size_t)0 * T_ALL + t) * 384 + c * 8);
        uint4 bq = *(const uint4*)(p.dilo + ((size_t)1 * T_ALL + t) * 384 + c * 8);
        uint4 cq = *(const uint4*)(p.dilo + ((size_t)2 * T_ALL + t) * 384 + c * 8);
        uint4 o;
        o.x = pack2(w0 * bflo(a.x) + w1 * bflo(bq.x) + w2 * bflo(cq.x), w0 * bfhi(a.x) + w1 * bfhi(bq.x) + w2 * bfhi(cq.x));
        o.y = pack2(w0 * bflo(a.y) + w1 * bflo(bq.y) + w2 * bflo(cq.y), w0 * bfhi(a.y) + w1 * bfhi(bq.y) + w2 * bfhi(cq.y));
        o.z = pack2(w0 * bflo(a.z) + w1 * bflo(bq.z) + w2 * bflo(cq.z), w0 * bfhi(a.z) + w1 * bfhi(bq.z) + w2 * bfhi(cq.z));
        o.w = pack2(w0 * bflo(a.w) + w1 * bflo(bq.w) + w2 * bflo(cq.w), w0 * bfhi(a.w) + w1 * bfhi(bq.w) + w2 * bfhi(cq.w));
        *(uint4*)(p.cat + (size_t)t * 1024 + 640 + c * 8) = o;
      }
    }
    __syncthreads();
    for (int nt = 0; nt < 4; ++nt) {
      f32x16 acc[2][2];
      gemm_core<1024>(p.woT + ((size_t)layer * 1024 + nt * 256) * 1024, 1024, p.cat + (size_t)mt * 128 * 1024, 1024, acc, lds);
#pragma unroll
      for (int j = 0; j < 2; ++j) {
        const int t = mt * 128 + wm * 64 + j * 32 + r;
#pragma unroll
        for (int i = 0; i < 2; ++i) {
          const int n0 = nt * 256 + wn * 64 + i * 32;
#pragma unroll
          for (int g = 0; g < 4; ++g) {
            const size_t off = (size_t)t * 1024 + n0 + 8 * g + 4 * hh;
            uint2 xv = *(const uint2*)(p.xb + off);
            store8(p.ybuf + off, ALPHA * bflo(xv.x) + acc[i][j][4 * g], ALPHA * bfhi(xv.x) + acc[i][j][4 * g + 1],
                   ALPHA * bflo(xv.y) + acc[i][j][4 * g + 2], ALPHA * bfhi(xv.y) + acc[i][j][4 * g + 3]);
          }
        }
      }
    }
    __syncthreads();
    const float* g1 = p.in[9] + layer * 1024;
    const float* b1 = p.in[10] + layer * 1024;
    for (int rr = 0; rr < 16; ++rr) {
      const int t = mt * 128 + wave * 16 + rr;
      const uint4* yp = (const uint4*)(p.ybuf + (size_t)t * 1024 + lane * 16);
      uint4 v0 = yp[0], v1 = yp[1];
      float y[16] = {bflo(v0.x), bfhi(v0.x), bflo(v0.y), bfhi(v0.y), bflo(v0.z), bfhi(v0.z), bflo(v0.w), bfhi(v0.w),
                     bflo(v1.x), bfhi(v1.x), bflo(v1.y), bfhi(v1.y), bflo(v1.z), bfhi(v1.z), bflo(v1.w), bfhi(v1.w)};
      float s = 0.f;
#pragma unroll
      for (int e = 0; e < 16; ++e) s += y[e];
      const float mean = wave_sum(s) * (1.f / 1024.f);
      float vs = 0.f;
#pragma unroll
      for (int e = 0; e < 16; ++e) { y[e] -= mean; vs += y[e] * y[e]; }
      const float rstd = rsqrtf(wave_sum(vs) * (1.f / 1024.f) + 1e-5f);
      float o[16];
#pragma unroll
      for (int e = 0; e < 16; ++e) o[e] = y[e] * rstd * g1[lane * 16 + e] + b1[lane * 16 + e];
      uint4 w0, w1;
      w0.x = pack2(o[0], o[1]); w0.y = pack2(o[2], o[3]); w0.z = pack2(o[4], o[5]); w0.w = pack2(o[6], o[7]);
      w1.x = pack2(o[8], o[9]); w1.y = pack2(o[10], o[11]); w1.z = pack2(o[12], o[13]); w1.w = pack2(o[14], o[15]);
      uint4* xp = (uint4*)(p.x1 + (size_t)t * 1024 + lane * 16);
      xp[0] = w0; xp[1] = w1;
    }
    __syncthreads();
  }
}

DI void ins16(float (&L)[16], float v) {
#pragma unroll
  for (int k = 15; k >= 1; --k) L[k] = __builtin_amdgcn_fmed3f(v, L[k - 1], L[k]);
  L[0] = fmaxf(L[0], v);
}
constexpr int QS_STR = 528;

DI void phase_peer_route(const Params& p, int layer, char* lds) {
  const int tid = otid(), lane = tid & 63, wave = tid >> 6;
  const int wn = wave & 3, wm = wave >> 2, r = lane & 31, hh = lane >> 5;
  char* Qs = lds;
  unsigned* Ls = (unsigned*)(lds + 128 * QS_STR);
  for (int item = obid(); item < 2048; item += gridDim.x) {
    const int mt = item >> 3, head = item & 7;
    f32x16 acc[2][2];
    gemm_core<1024>(p.wqT + ((size_t)layer * 2048 + head * 256) * 1024, 1024, p.x1 + (size_t)mt * 128 * 1024, 1024, acc, lds);
#pragma unroll
    for (int j = 0; j < 2; ++j)
#pragma unroll
      for (int i = 0; i < 2; ++i)
#pragma unroll
        for (int g = 0; g < 4; ++g) {
          uint2 v; v.x = pack2(acc[i][j][4 * g], acc[i][j][4 * g + 1]); v.y = pack2(acc[i][j][4 * g + 2], acc[i][j][4 * g + 3]);
          *(uint2*)(Qs + (wm * 64 + j * 32 + r) * QS_STR + (wn * 64 + i * 32 + 8 * g + 4 * hh) * 2) = v;
        }
    __syncthreads();
    {
      const int pp = wave >> 2, tg = wave & 3;
      bf16x8 Bq[8];
      const char* qrow = Qs + (tg * 32 + r) * QS_STR + (pp * 128 + hh * 8) * 2;
#pragma unroll
      for (int s = 0; s < 8; ++s) Bq[s] = *(const bf16x8*)(qrow + s * 32);
      const u16* kbase = p.keysb + ((size_t)(layer * 16 + head * 2 + pp) * 128) * 128;
      float Lst[16];
#pragma unroll
      for (int k = 0; k < 16; ++k) Lst[k] = -3.0e38f;
#pragma unroll
      for (int kt = 0; kt < 4; ++kt) {
        f32x16 S;
#pragma unroll
        for (int e = 0; e < 16; ++e) S[e] = 0.f;
        const u16* krow = kbase + (size_t)(kt * 32 + r) * 128 + hh * 8;
#pragma unroll
        for (int s = 0; s < 8; ++s) S = MFMA(*(const bf16x8*)(krow + s * 16), Bq[s], S);
#pragma unroll
        for (int e = 0; e < 16; ++e) {
          const int kidx = kt * 32 + (e & 3) + 8 * (e >> 2) + 4 * hh;
          const float v = __uint_as_float((__float_as_uint(S[e]) & ~127u) | (unsigned)(127 - kidx));
          ins16(Lst, v);
        }
      }
      float Pl[16];
#pragma unroll
      for (int k = 0; k < 16; ++k) Pl[k] = __shfl_xor(Lst[k], 32);
#pragma unroll
      for (int k = 0; k < 16; ++k) ins16(Lst, Pl[k]);
      if (hh == 0) {
        unsigned* dst = Ls + ((tg * 32 + r) * 2 + pp) * 16;
#pragma unroll
        for (int k = 0; k < 16; ++k) dst[k] = __float_as_uint(Lst[k]);
      }
    }
    __syncthreads();
    if (tid < 128) {
      const unsigned* la = Ls + (tid * 2) * 16;
      float A[16], B[16];
#pragma unroll
      for (int k = 0; k < 16; ++k) { A[k] = __uint_as_float(la[k]); B[k] = __uint_as_float(la[16 + k]); }
      float C[16];
#pragma unroll
      for (int k = 0; k < 16; ++k) C[k] = -3.0e38f;
#pragma unroll
      for (int i = 0; i < 16; ++i)
#pragma unroll
        for (int j = 0; j < 16; ++j)
          if ((i + 1) * (j + 1) <= 16) {
            const float sm = A[i] + B[j];
            const float v = __uint_as_float((__float_as_uint(sm) & ~255u) | (unsigned)(255 - (i * 16 + j)));
            ins16(C, v);
          }
      const int t = mt * 128 + tid;
      float e[16], sum = 0.f;
#pragma unroll
      for (int k = 0; k < 16; ++k) { e[k] = __expf(C[k] - C[0]); sum += e[k]; }
      const float inv = 1.f / sum;
      int* ed = p.experts + (size_t)t * 128 + head * 16;
      float* gd = p.gates + (size_t)t * 128 + head * 16;
#pragma unroll
      for (int k = 0; k < 16; ++k) {
        const unsigned code = 255u - (__float_as_uint(C[k]) & 255u);
        const int i1 = 127 - (int)(la[code >> 4] & 127u);
        const int i2 = 127 - (int)(la[16 + (code & 15)] & 127u);
        ed[k] = i1 * 128 + i2;
        gd[k] = e[k] * inv;
      }
    }
    __syncthreads();
  }
}

DI float gelu_exact(float d) { return 0.5f * d * (1.f + erff(d * 0.70710678118654752f)); }

DI float row_allsum(float v) {
  v += __builtin_bit_cast(float, __builtin_amdgcn_update_dpp(0, __builtin_bit_cast(int, v), 0x128, 0xf, 0xf, false));
  v += __builtin_bit_cast(float, __builtin_amdgcn_update_dpp(0, __builtin_bit_cast(int, v), 0x124, 0xf, 0xf, false));
  v += __builtin_bit_cast(float, __builtin_amdgcn_update_dpp(0, __builtin_bit_cast(int, v), 0x122, 0xf, 0xf, false));
  v += __builtin_bit_cast(float, __builtin_amdgcn_update_dpp(0, __builtin_bit_cast(int, v), 0x121, 0xf, 0xf, false));
  return v;
}

DI void phase_peer_ffn(const Params& p, int layer, char* lds) {
  const int tid = otid(), lane = tid & 63, wave = tid >> 6, grp16 = lane >> 4, l16 = lane & 15;
  uint2* list = (uint2*)(lds + wave * 4096);
  float* dl = (float*)(lds + 32768 + wave * 2048);
  const float* g2 = p.in[15] + layer * 1024;
  const float* b2 = p.in[16] + layer * 1024;
  const unsigned char* ub = p.ub + (size_t)layer * NEXP * DM + l16 * 16;
  const unsigned char* vb = p.vb + (size_t)layer * NEXP * DM + l16 * 16;
  const float* us = p.us + layer * NEXP;
  const float* vs = p.vs + layer * NEXP;
  const unsigned ltmask16 = (1u << l16) - 1u;
  uint2* mylist = list + grp16 * 128;
  float* mydl = dl + grp16 * 128;
  for (int grp = obid() * 8 + wave; grp < T_ALL / 4; grp += gridDim.x * 8) {
    const int t = grp * 4 + grp16;
    {
      int ev[8]; unsigned gv[8];
      {
        const int4 e0 = *(const int4*)(p.experts + (size_t)t * 128 + l16 * 8);
        const int4 e1 = *(const int4*)(p.experts + (size_t)t * 128 + l16 * 8 + 4);
        const uint4 g0 = *(const uint4*)(p.gates + (size_t)t * 128 + l16 * 8);
        const uint4 g1 = *(const uint4*)(p.gates + (size_t)t * 128 + l16 * 8 + 4);
        ev[0] = e0.x; ev[1] = e0.y; ev[2] = e0.z; ev[3] = e0.w; ev[4] = e1.x; ev[5] = e1.y; ev[6] = e1.z; ev[7] = e1.w;
        gv[0] = g0.x; gv[1] = g0.y; gv[2] = g0.z; gv[3] = g0.w; gv[4] = g1.x; gv[5] = g1.y; gv[6] = g1.z; gv[7] = g1.w;
      }
      int pos[8];
#pragma unroll
      for (int s2 = 0; s2 < 8; ++s2) pos[s2] = 0;
      int running = 0;
#pragma unroll 1
      for (int b = 0; b < 64; ++b) {
#pragma unroll
        for (int s2 = 0; s2 < 8; ++s2) {
          const bool mt = (ev[s2] >> 8) == b;
          const unsigned m = (unsigned)(__ballot(mt) >> (grp16 * 16)) & 0xffffu;
          if (mt) pos[s2] = running + __popc(m & ltmask16);
          running += __popc(m);
        }
      }
#pragma unroll
      for (int s2 = 0; s2 < 8; ++s2) mylist[pos[s2]] = make_uint2((unsigned)ev[s2], gv[s2]);
    }
    __builtin_amdgcn_sched_barrier(0);
    {
      unsigned xw[4][8];
#pragma unroll
      for (int n = 0; n < 4; ++n) {
        const uint4 xa = *(const uint4*)(p.x1 + (size_t)t * 1024 + n * 256 + l16 * 16);
        const uint4 xc = *(const uint4*)(p.x1 + (size_t)t * 1024 + n * 256 + l16 * 16 + 8);
        xw[n][0] = xa.x; xw[n][1] = xa.y; xw[n][2] = xa.z; xw[n][3] = xa.w;
        xw[n][4] = xc.x; xw[n][5] = xc.y; xw[n][6] = xc.z; xw[n][7] = xc.w;
      }
      uint4 ra[4], rb[4], rc[4];
#define LD_ROW(buf, tab, i)                                                                     \
  {                                                                                             \
    const unsigned char* r_ = (tab) + (size_t)mylist[(i)].x * 1024;                             \
    buf[0] = *(const uint4*)r_; buf[1] = *(const uint4*)(r_ + 256);                             \
    buf[2] = *(const uint4*)(r_ + 512); buf[3] = *(const uint4*)(r_ + 768);                     \
  }
#define PASS1(buf, i)                                                                           \
  {                                                                                             \
    float d_ = 0.f;                                                                             \
    _Pragma("unroll") for (int n = 0; n < 4; ++n) {                                             \
      const unsigned uw_[4] = {buf[n].x, buf[n].y, buf[n].z, buf[n].w};                         \
      _Pragma("unroll") for (int e = 0; e < 4; ++e) {                                           \
        d_ = __builtin_amdgcn_fdot2_f32_bf16(__builtin_amdgcn_cvt_scalef32_pk_bf16_fp8(uw_[e], 1.0f, false), __builtin_bit_cast(bf16x2_t, xw[n][2 * e]), d_, false); \
        d_ = __builtin_amdgcn_fdot2_f32_bf16(__builtin_amdgcn_cvt_scalef32_pk_bf16_fp8(uw_[e], 1.0f, true), __builtin_bit_cast(bf16x2_t, xw[n][2 * e + 1]), d_, false); \
      }                                                                                         \
    }                                                                                           \
    d_ = row_allsum(d_);                                                                        \
    if (l16 == 0) mydl[(i)] = d_;                                                               \
  }
      LD_ROW(ra, ub, 0)
      LD_ROW(rb, ub, 1)
#pragma unroll 1
      for (int i = 0; i < 126; i += 3) {
        LD_ROW(rc, ub, i + 2)
        PASS1(ra, i)
        LD_ROW(ra, ub, i + 3)
        PASS1(rb, i + 1)
        LD_ROW(rb, ub, i + 4)
        PASS1(rc, i + 2)
      }
      PASS1(ra, 126)
      PASS1(rb, 127)
    }
    __builtin_amdgcn_sched_barrier(0);
#pragma unroll 2
    for (int k = 0; k < 8; ++k) {
      const int idx = l16 + 16 * k;
      const uint2 en = mylist[idx];
      const float d = mydl[idx] * us[en.x];
      mylist[idx].y = __float_as_uint(__uint_as_float(en.y) * gelu_exact(d) * vs[en.x]);
    }
    __builtin_amdgcn_sched_barrier(0);
    {
      f32x2 acc[4][8];
#pragma unroll
      for (int n = 0; n < 4; ++n)
#pragma unroll
        for (int e = 0; e < 8; ++e) { acc[n][e][0] = 0.f; acc[n][e][1] = 0.f; }
      uint4 ra[4], rb[4], rc[4];
#define PASS2(buf, i)                                                                           \
  {                                                                                             \
    const float c_ = __uint_as_float(mylist[(i)].y);                                            \
    _Pragma("unroll") for (int n = 0; n < 4; ++n) {                                             \
      const unsigned vw_[4] = {buf[n].x, buf[n].y, buf[n].z, buf[n].w};                         \
      _Pragma("unroll") for (int k = 0; k < 4; ++k) {                                           \
        acc[n][2 * k] = __builtin_amdgcn_cvt_pk_f32_fp8(vw_[k], false) * c_ + acc[n][2 * k];    \
        acc[n][2 * k + 1] = __builtin_amdgcn_cvt_pk_f32_fp8(vw_[k], true) * c_ + acc[n][2 * k + 1]; \
      }                                                                                         \
    }                                                                                           \
  }
      LD_ROW(ra, vb, 0)
      LD_ROW(rb, vb, 1)
#pragma unroll 1
      for (int i = 0; i < 126; i += 3) {
        LD_ROW(rc, vb, i + 2)
        PASS2(ra, i)
        LD_ROW(ra, vb, i + 3)
        PASS2(rb, i + 1)
        LD_ROW(rb, vb, i + 4)
        PASS2(rc, i + 2)
      }
      PASS2(ra, 126)
      PASS2(rb, 127)
      float sm = 0.f;
#pragma unroll
      for (int n = 0; n < 4; ++n) {
        const uint4 xa = *(const uint4*)(p.x1 + (size_t)t * 1024 + n * 256 + l16 * 16);
        const uint4 xc = *(const uint4*)(p.x1 + (size_t)t * 1024 + n * 256 + l16 * 16 + 8);
        const unsigned xq[8] = {xa.x, xa.y, xa.z, xa.w, xc.x, xc.y, xc.z, xc.w};
#pragma unroll
        for (int e = 0; e < 8; ++e) {
          acc[n][e][0] = ALPHA * bflo(xq[e]) + acc[n][e][0];
          acc[n][e][1] = ALPHA * bfhi(xq[e]) + acc[n][e][1];
          sm += acc[n][e][0] + acc[n][e][1];
        }
      }
      const float mean = row_allsum(sm) * (1.f / 1024.f);
      float vsum = 0.f;
#pragma unroll
      for (int n = 0; n < 4; ++n)
#pragma unroll
        for (int e = 0; e < 8; ++e) {
          acc[n][e][0] -= mean; acc[n][e][1] -= mean;
          vsum += acc[n][e][0] * acc[n][e][0] + acc[n][e][1] * acc[n][e][1];
        }
      const float rstd = rsqrtf(row_allsum(vsum) * (1.f / 1024.f) + 1e-5f);
#pragma unroll
      for (int n = 0; n < 4; ++n) {
        const int d0 = n * 256 + l16 * 16;
        float o[16];
#pragma unroll
        for (int q = 0; q < 4; ++q) {
          const float4 gg = *(const float4*)(g2 + d0 + 4 * q);
          const float4 bb = *(const float4*)(b2 + d0 + 4 * q);
          o[4 * q + 0] = acc[n][2 * q][0] * rstd * gg.x + bb.x;
          o[4 * q + 1] = acc[n][2 * q][1] * rstd * gg.y + bb.y;
          o[4 * q + 2] = acc[n][2 * q + 1][0] * rstd * gg.z + bb.z;
          o[4 * q + 3] = acc[n][2 * q + 1][1] * rstd * gg.w + bb.w;
        }
        if (layer == 1) {
          float4* oa = (float4*)(p.out + (size_t)t * 1024 + d0);
          oa[0] = make_float4(o[0], o[1], o[2], o[3]); oa[1] = make_float4(o[4], o[5], o[6], o[7]);
          oa[2] = make_float4(o[8], o[9], o[10], o[11]); oa[3] = make_float4(o[12], o[13], o[14], o[15]);
        } else {
          uint4 w0, w1;
          w0.x = pack2(o[0], o[1]); w0.y = pack2(o[2], o[3]); w0.z = pack2(o[4], o[5]); w0.w = pack2(o[6], o[7]);
          w1.x = pack2(o[8], o[9]); w1.y = pack2(o[10], o[11]); w1.z = pack2(o[12], o[13]); w1.w = pack2(o[14], o[15]);
          *(uint4*)(p.xb + (size_t)t * 1024 + d0) = w0;
          *(uint4*)(p.xb + (size_t)t * 1024 + d0 + 8) = w1;
        }
        __builtin_amdgcn_sched_barrier(0);
      }
    }
  }
}

#ifndef REP_SUB
#define REP_SUB -1
#endif
#ifndef REP_N
#define REP_N 0
#endif
DI void run_phase(const Params& p, int ph, char* lds) {
  if (ph == 0) {
    phase_prep(p, lds);
  } else {
    const int layer = (ph - 1) / 6, sub = (ph - 1) % 6;
    if (sub == 0) {
      phase_gemm1(p, layer, lds);
    } else if (sub == 1) phase_mla_up(p, layer, lds);
    else if (sub == 2) phase_attn(p, layer, lds);
    else if (sub == 3) phase_outproj(p, layer, lds);
    else if (sub == 4) phase_peer_route(p, layer, lds);
    else phase_peer_ffn(p, layer, lds);
  }
}
__global__ __launch_bounds__(512) void mega(Params p, int ph_lo, int ph_hi) {
  extern __shared__ __attribute__((aligned(16))) char lds[];
  cg::grid_group grid = cg::this_grid();
  for (int ph = ph_lo; ph < ph_hi; ++ph) {
    int reps = 1;
    if (REP_SUB == 6) { if (ph == 0) reps += REP_N; }
    else if (REP_SUB >= 0 && ph > 0 && (ph - 1) % 6 == REP_SUB) reps += REP_N;
    for (int rp = 0; rp < reps; ++rp) {
      run_phase(p, ph, lds);
      if (rp + 1 < reps) grid.sync();
    }
    if (ph + 1 < ph_hi) grid.sync();
  }
}

extern "C" void kernel_launch(void* const* d_in, const int* in_sizes, int n_in, void* d_out, int out_size, void* d_ws,
                              size_t ws_size, hipStream_t stream) {
  Params p;
  memset(&p, 0, sizeof(p));
  for (int i = 0; i < 17; ++i) p.in[i] = (const float*)d_in[i];
  p.out = (float*)d_out;
  char* w = (char*)d_ws;
  size_t off = 0;
  auto alloc = [&](size_t bytes) { char* r = w + off; off += (bytes + 255) & ~(size_t)255; return r; };
  p.xb = (u16*)alloc((size_t)T_ALL * DM * 2);
  p.winT = (u16*)alloc((size_t)2 * NPAD * 1024 * 2);
  p.wuqT = (u16*)alloc((size_t)2 * 768 * 256 * 2);
  p.wukvT = (u16*)alloc((size_t)2 * 768 * 128 * 2);
  p.woT = (u16*)alloc((size_t)2 * 1024 * 1024 * 2);
  p.wqT = (u16*)alloc((size_t)2 * 2048 * 1024 * 2);
  p.keysb = (u16*)alloc((size_t)2 * 16 * 128 * 128 * 2);
  p.ub = (unsigned char*)alloc((size_t)2 * NEXP * DM);
  p.vb = (unsigned char*)alloc((size_t)2 * NEXP * DM);
  p.us = (float*)alloc((size_t)2 * NEXP * 4);
  p.vs = (float*)alloc((size_t)2 * NEXP * 4);
  p.cs32 = (float2*)alloc((size_t)SEQ * 16 * 8);
  p.cs64 = (float2*)alloc((size_t)SEQ * 32 * 8);
  p.cat = (u16*)alloc((size_t)T_ALL * 1024 * 2);
  const size_t r1 = off;
  p.aq = (u16*)alloc((size_t)T_ALL * 256 * 2);
  p.ak = (u16*)alloc((size_t)T_ALL * 256 * 2);
  p.av = (u16*)alloc((size_t)T_ALL * 256 * 2);
  p.bcq = (u16*)alloc((size_t)T_ALL * 256 * 2);
  p.bckv = (u16*)alloc((size_t)T_ALL * 128 * 2);
  p.bkr = (u16*)alloc((size_t)T_ALL * 32 * 2);
  p.cq = (u16*)alloc((size_t)T_ALL * 384 * 2);
  p.ck = (u16*)alloc((size_t)T_ALL * 384 * 2);
  p.cv = (u16*)alloc((size_t)T_ALL * 384 * 2);
  p.mq = (u16*)alloc((size_t)T_ALL * 576 * 2);
  p.mk = (u16*)alloc((size_t)T_ALL * 384 * 2);
  p.mv = (u16*)alloc((size_t)T_ALL * 384 * 2);
  off = r1;
  p.ybuf = (u16*)alloc((size_t)T_ALL * 1024 * 2);
  p.x1 = (u16*)alloc((size_t)T_ALL * 1024 * 2);
  p.experts = (int*)alloc((size_t)T_ALL * 128 * 4);
  p.gates = (float*)alloc((size_t)T_ALL * 128 * 4);
  p.dilo = (u16*)d_out;
  p.dillse = (float*)((char*)d_out + (size_t)3 * T_ALL * 384 * 2);

#ifdef MULTI_LAUNCH
  hipFuncSetAttribute((const void*)mega, hipFuncAttributeMaxDynamicSharedMemorySize, LDS_BYTES);
  for (int ph = 0; ph < 13; ++ph) {
    hipLaunchKernelGGL(mega, dim3(256), dim3(512), LDS_BYTES, stream, p, ph, ph + 1);
  }
#else
  static int grid_blocks = 0;
  if (!grid_blocks) {
    int dev = 0, cus = 0, per_cu = 0;
    hipGetDevice(&dev);
    hipDeviceGetAttribute(&cus, hipDeviceAttributeMultiprocessorCount, dev);
    hipFuncSetAttribute((const void*)mega, hipFuncAttributeMaxDynamicSharedMemorySize, LDS_BYTES);
    hipOccupancyMaxActiveBlocksPerMultiprocessor(&per_cu, mega, 512, LDS_BYTES);
    if (per_cu > 1) per_cu = 1;
    grid_blocks = cus * per_cu;
  }
  int lo = 0, hi = 13;
  void* args[] = {&p, &lo, &hi};
  hipError_t e = hipLaunchCooperativeKernel((void*)mega, dim3(grid_blocks), dim3(512), args, LDS_BYTES, stream);
  if (e != hipSuccess) fprintf(stderr, "cooperative launch failed: %s (grid %d)\n", hipGetErrorString(e), grid_blocks);
#endif
}
```

```cpp
#include <hip/hip_runtime.h>
#include <hip/hip_cooperative_groups.h>
#include <math.h>
#include <stdio.h>
#include <string.h>
namespace cg = cooperative_groups;

typedef unsigned short u16;
typedef short bf16x8 __attribute__((ext_vector_type(8)));
typedef short s16x4 __attribute__((ext_vector_type(4)));
typedef float f32x16 __attribute__((ext_vector_type(16)));
typedef float f32x2 __attribute__((ext_vector_type(2)));
typedef __bf16 bf16x2_t __attribute__((ext_vector_type(2)));

#define DI __device__ __forceinline__
#define MFMA(a, b, c) __builtin_amdgcn_mfma_f32_32x32x16_bf16((a), (b), (c), 0, 0, 0)

constexpr int T_ALL = 32768, SEQ = 4096, DM = 1024, INW = 2336, NEXP = 16384;
constexpr int NPAD = 2560;
constexpr int NUP = 1536, KUP = 384;
constexpr float LOG2E = 1.4426950408889634f;
constexpr float ALPHA = 1.41421356237309515f;

struct Params {
  const float* in[17];
  float* out;
  u16 *xb, *winT, *wupT, *woT, *wqT, *keysb;
  unsigned char *ub, *vb;
  float *us, *vs;
  float2 *cs32, *cs64;
  u16 *aq, *ak, *av, *bc, *bkr, *cq, *ck, *cv, *mq, *mk, *mv, *cat, *dilo;
  float* dillse;
  u16 *ybuf, *x1, *qbuf;
  int* experts;
  float* gates;
  float *sumsq, *stats;
  unsigned* bar;
  int wave, pad_;
};

DI int otid(int wave) { int lane; asm volatile("v_mbcnt_lo_u32_b32 %0, -1, 0\n\tv_mbcnt_hi_u32_b32 %0, -1, %0" : "=v"(lane)); asm volatile("" : "+s"(wave)); return (wave << 6) | lane; }
DI int obid() { int b = blockIdx.x; asm volatile("" : "+s"(b)); return b; }
DI unsigned pack2(float a, float b) {
  f32x2 v = {a, b};
  return __builtin_bit_cast(unsigned, __builtin_convertvector(v, bf16x2_t));
}
DI float bflo(unsigned w) { return __uint_as_float(w << 16); }
DI float bfhi(unsigned w) { return __uint_as_float(w & 0xffff0000u); }
DI float fexp2(float x) { return __builtin_amdgcn_exp2f(x); }
DI void store8(u16* dst, float a, float b, float c, float d) {
  uint2 v; v.x = pack2(a, b); v.y = pack2(c, d);
  *(uint2*)dst = v;
}
DI void store_tile(u16* dst, const f32x16& v, int hh) {
#pragma unroll
  for (int g = 0; g < 4; ++g) store8(dst + 8 * g + 4 * hh, v[4 * g], v[4 * g + 1], v[4 * g + 2], v[4 * g + 3]);
}
DI void rope32(f32x16& v, const float2* cs, int hh) {
#pragma unroll
  for (int g = 0; g < 2; ++g)
#pragma unroll
    for (int b = 0; b < 4; ++b) {
      float2 c = cs[8 * g + 4 * hh + b];
      float x1 = v[4 * g + b], x2 = v[4 * g + b + 8];
      v[4 * g + b] = x1 * c.x - x2 * c.y;
      v[4 * g + b + 8] = x2 * c.x + x1 * c.y;
    }
}
DI void rope64(f32x16& v0, f32x16& v1, const float2* cs, int hh) {
#pragma unroll
  for (int g = 0; g < 4; ++g)
#pragma unroll
    for (int b = 0; b < 4; ++b) {
      float2 c = cs[8 * g + 4 * hh + b];
      float x1 = v0[4 * g + b], x2 = v1[4 * g + b];
      v0[4 * g + b] = x1 * c.x - x2 * c.y;
      v1[4 * g + b] = x2 * c.x + x1 * c.y;
    }
}
DI float wave_sum(float v) {
#pragma unroll
  for (int o = 32; o; o >>= 1) v += __shfl_xor(v, o);
  return v;
}
DI s16x4 trread(const char* p) {
  return __builtin_amdgcn_ds_read_tr16_b64_v4i16((__attribute__((address_space(3))) s16x4*)(p));
}


constexpr int LDS_BYTES = 131072 + 1024;

namespace pg8 {
#define PG8_LAS __attribute__((address_space(3)))
typedef unsigned short bf16_t;
typedef float f32x4 __attribute__((ext_vector_type(4)));
constexpr int BM = 256, BK = 64, HALF = 128, HTB = HALF * BK * 2, STAGE_BYTES = 8 * HTB, NXCD = 8, WGM = 8;
__host__ __device__ __forceinline__ int lds_byte(int r, int c) { const int st = (r >> 4) * 2 + (c >> 5), rr = r & 15, cc = c & 31, ob = rr * 64 + cc * 2; return st * 1024 + (ob ^ (((ob >> 9) & 1) << 5)); }
__host__ __device__ __forceinline__ void stage_rc(int b, int& R, int& C) { const int st = b / 1024, sb = b % 1024, swz = sb ^ (((sb >> 9) & 1) << 5); R = (st >> 1) * 16 + swz / 64; C = (st & 1) * 32 + (swz % 64) / 2; }
__host__ __device__ __forceinline__ int perm32(int rho) { const int n = rho >> 4, i = rho & 15; return 8 * (i >> 2) + 4 * n + (i & 3); }
struct Unit { int pm, pn; };
struct Gemm { const bf16_t* A; const bf16_t* Bt; int M, N, K; };
struct StaticOrder {
    int nM, nN, nwg, G, c;
    __host__ __device__ void init(int M, int N, int G_, int c_) { nM = M / BM; nN = N / BM; nwg = nM * nN; G = G_; c = c_; }
    __host__ __device__ bool next(int i, Unit& u) const {
        const long L = (long)i * G + c; if (L >= nwg) return false;
        int wgid = (int)L; { const int q = nwg / NXCD, r = nwg % NXCD, xcd = wgid % NXCD, off = wgid / NXCD; wgid = (xcd < r ? xcd * (q + 1) : r * (q + 1) + (xcd - r) * q) + off; }
        const int nig = WGM * nN, gid = wgid / nig, fm = gid * WGM, gsz = (nM - fm) < WGM ? (nM - fm) : WGM;
        u.pm = fm + ((wgid % nig) % gsz); u.pn = (wgid % nig) / gsz; return true;
    }
    __device__ __forceinline__ void a_ready(const Unit&) const {}
    __device__ __forceinline__ void done(const Unit&) const {}
};
template <class Epi, class Sched>
__device__ __forceinline__ void gemm_phase(int wv, PG8_LAS unsigned char* lds, const Gemm g, const Sched& S, const Epi& E) {
    const int tid = otid(wv), wid = __builtin_amdgcn_readfirstlane(tid >> 6), lane = tid & 63, wr = wid >> 2, wc = wid & 3, fr = lane & 15, fq = lane >> 4;
    const int K = g.K, nt = K / BK;
    unsigned voffA[2], voffB[2];
#pragma unroll
    for (int i = 0; i < 2; ++i) { int R, C; stage_rc(tid * 16 + i * 8192, R, C); const int Rb = Epi::PERM ? ((R & ~31) + perm32(R & 31)) : R;
        voffA[i] = (unsigned)(R * K + C) * 2u; voffB[i] = (unsigned)(Rb * K + C) * 2u; }
    const size_t kstep = (size_t)(BK * 2);
    const size_t hstep = (size_t)HALF * K * 2;
    const size_t tstep = 2 * hstep;
    const unsigned ldsw = (unsigned)wid * 1024u;
    const int aoff = lds_byte(wr * 64 + fr, fq * 8), boff = lds_byte(wc * 32 + fr, fq * 8);
#define PG8_SA(b, h) (((b) * 2 + (h)) * HTB)
#define PG8_SB(b, h) ((4 + (b) * 2 + (h)) * HTB)
#define PG8_STAGE(bufoff, gbase, voff) do { _Pragma("unroll") for (int _i = 0; _i < 2; ++_i) \
        __builtin_amdgcn_global_load_lds((const unsigned*)((const char*)(gbase) + (voff)[_i]), (PG8_LAS unsigned*)(lds + (bufoff) + ldsw + _i * 8192), 16, 0, 0); } while (0)
#define PG8_LDA(dst, b, h) do { _Pragma("unroll") for (int m = 0; m < 4; ++m) _Pragma("unroll") for (int k = 0; k < 2; ++k) dst[m][k] = *(const PG8_LAS bf16x8*)(lds + PG8_SA(b, h) + aoff + m * 2048 + k * 1024); } while (0)
#define PG8_LDB(dst, b, h) do { _Pragma("unroll") for (int n = 0; n < 2; ++n) _Pragma("unroll") for (int k = 0; k < 2; ++k) dst[n][k] = *(const PG8_LAS bf16x8*)(lds + PG8_SB(b, h) + boff + n * 2048 + k * 1024); } while (0)
#define PG8_MMA(ai, bj, At, Bt) do { __builtin_amdgcn_s_setprio(1); _Pragma("unroll") for (int m = 0; m < 4; ++m) _Pragma("unroll") for (int n = 0; n < 2; ++n) _Pragma("unroll") for (int k = 0; k < 2; ++k) \
        acc[ai][bj][m][n] = __builtin_amdgcn_mfma_f32_16x16x32_bf16(Bt[n][k], At[m][k], acc[ai][bj][m][n], 0, 0, 0); __builtin_amdgcn_s_setprio(0); } while (0)
#define PG8_WAIT_V(n) asm volatile("s_waitcnt vmcnt(" #n ")" ::: "memory")
#define PG8_WAIT_L(n) asm volatile("s_waitcnt lgkmcnt(" #n ")" ::: "memory")
#define PG8_BAR __builtin_amdgcn_s_barrier()
#define PG8_SCHED __builtin_amdgcn_sched_barrier(0)
    Unit cur, nxt; int ui = 0;
    if (!S.next(0, cur)) return;
    f32x4 acc[2][2][4][2];
#pragma unroll
    for (int a = 0; a < 2; ++a)
#pragma unroll
        for (int b = 0; b < 2; ++b)
#pragma unroll
            for (int m = 0; m < 4; ++m)
#pragma unroll
                for (int n = 0; n < 2; ++n) acc[a][b][m][n] = (f32x4){0.f, 0.f, 0.f, 0.f};
    bf16x8 At[4][2], B0[2][2], B1[2][2];
    const char* cA = (const char*)g.A + (size_t)cur.pm * tstep; const char* cB = (const char*)g.Bt + (size_t)cur.pn * tstep;
    S.a_ready(cur);
    PG8_STAGE(PG8_SB(0, 0), cB, voffB); PG8_STAGE(PG8_SA(0, 0), cA, voffA); PG8_STAGE(PG8_SB(0, 1), cB + hstep, voffB); PG8_STAGE(PG8_SA(0, 1), cA + hstep, voffA);
    if (wr == 1) PG8_BAR;
    PG8_WAIT_V(4); PG8_BAR;
    PG8_STAGE(PG8_SB(1, 0), cB + kstep, voffB); PG8_STAGE(PG8_SA(1, 0), cA + kstep, voffA); PG8_STAGE(PG8_SB(1, 1), cB + hstep + kstep, voffB);
    PG8_WAIT_V(6); PG8_BAR;
    for (;;) {
        const bool has_next = S.next(ui + 1, nxt);
        const char* nA = has_next ? (const char*)g.A + (size_t)nxt.pm * tstep : cA; const char* nB = has_next ? (const char*)g.Bt + (size_t)nxt.pn * tstep : cB;
#pragma unroll 1
        for (int t = 0; t < nt; t += 2) {
            const bool last = (t == nt - 2);
            const char* a1 = cA + (size_t)(t + 1) * kstep;
            const char* a2 = last ? nA : cA + (size_t)(t + 2) * kstep; const char* b2 = last ? nB : cB + (size_t)(t + 2) * kstep;
            const char* a3 = a2 + kstep; const char* b3 = b2 + kstep;
            if (last && has_next) S.a_ready(nxt);
            PG8_LDB(B0, 0, 0); PG8_SCHED; PG8_LDA(At, 0, 0); PG8_STAGE(PG8_SA(1, 1), a1 + hstep, voffA);
            PG8_WAIT_L(8); PG8_BAR; PG8_WAIT_L(0); PG8_MMA(0, 0, At, B0); PG8_BAR; PG8_SCHED;
            PG8_LDB(B1, 0, 1); PG8_STAGE(PG8_SB(0, 0), b2, voffB);
            PG8_BAR; PG8_WAIT_L(0); PG8_MMA(0, 1, At, B1); PG8_BAR;
            PG8_LDA(At, 0, 1); PG8_STAGE(PG8_SA(0, 0), a2, voffA);
            PG8_BAR; PG8_WAIT_L(0); PG8_MMA(1, 0, At, B0); PG8_BAR; PG8_SCHED;
            PG8_STAGE(PG8_SB(0, 1), b2 + hstep, voffB);
            PG8_WAIT_V(6); PG8_BAR; PG8_MMA(1, 1, At, B1); PG8_BAR;
            PG8_LDB(B0, 1, 0); PG8_SCHED; PG8_LDA(At, 1, 0); PG8_STAGE(PG8_SA(0, 1), a2 + hstep, voffA);
            PG8_WAIT_L(8); PG8_BAR; PG8_WAIT_L(0); PG8_MMA(0, 0, At, B0); PG8_BAR; PG8_SCHED;
            PG8_LDB(B1, 1, 1); PG8_STAGE(PG8_SB(1, 0), b3, voffB);
            PG8_BAR; PG8_WAIT_L(0); PG8_MMA(0, 1, At, B1); PG8_BAR;
            PG8_LDA(At, 1, 1); PG8_STAGE(PG8_SA(1, 0), a3, voffA);
            PG8_BAR; PG8_WAIT_L(0); PG8_MMA(1, 0, At, B0); PG8_BAR; PG8_SCHED;
            PG8_STAGE(PG8_SB(1, 1), b3 + hstep, voffB);
            PG8_WAIT_V(6); PG8_BAR; PG8_MMA(1, 1, At, B1); PG8_BAR;
        }
        if constexpr (!Epi::AFTER_DRAIN) { E(acc, cur, wr, wc, fr, fq); S.done(cur); }
        if (!has_next) break;
#pragma unroll
        for (int a = 0; a < 2; ++a)
#pragma unroll
            for (int b = 0; b < 2; ++b)
#pragma unroll
                for (int m = 0; m < 4; ++m)
#pragma unroll
                    for (int n = 0; n < 2; ++n) acc[a][b][m][n] = (f32x4){0.f, 0.f, 0.f, 0.f};
        cur = nxt; cA = nA; cB = nB; ++ui;
    }
    PG8_WAIT_V(0);
    if (wr == 0) PG8_BAR;
    PG8_BAR;
    if constexpr (Epi::AFTER_DRAIN) { E.fused(acc, cur, wr, wc, fr, fq, lds, wid, lane); S.done(cur); }
#undef PG8_SA
#undef PG8_SB
#undef PG8_STAGE
#undef PG8_LDA
#undef PG8_LDB
#undef PG8_MMA
#undef PG8_WAIT_V
#undef PG8_WAIT_L
#undef PG8_BAR
#undef PG8_SCHED
}
}
using pg8::f32x4;
using pg8::Unit;

DI void convert_bf16(int wv, const float* __restrict__ src, u16* __restrict__ dst, size_t n8  ) {
  const size_t i0 = (size_t)obid() * 512 + otid(wv);
  for (size_t i = i0; i < n8; i += (size_t)gridDim.x * 512) {
    float4 a = ((const float4*)src)[2 * i], b = ((const float4*)src)[2 * i + 1];
    uint4 o; o.x = pack2(a.x, a.y); o.y = pack2(a.z, a.w); o.z = pack2(b.x, b.y); o.w = pack2(b.z, b.w);
    ((uint4*)dst)[i] = o;
  }
}
typedef float f32x32 __attribute__((ext_vector_type(32)));
typedef unsigned u32x6 __attribute__((ext_vector_type(6)));
typedef unsigned u32x16 __attribute__((ext_vector_type(16)));
typedef __bf16 bf16x32_t __attribute__((ext_vector_type(32)));
constexpr int ROWB = 768;
DI void convert_rows_fp6(int wv, const float* __restrict__ src, unsigned char* __restrict__ dst, float* __restrict__ inv_scale, int nrows) {
  const int tid = otid(wv), lane = tid & 63, wave = tid >> 6, g = lane & 31;
  for (int row = (obid() * 8 + wave) * 2 + (lane >> 5); row < nrows; row += gridDim.x * 16) {
    const float4* rp = (const float4*)(src + (size_t)row * 1024 + g * 32);
    float4 v[8];
#pragma unroll
    for (int i = 0; i < 8; ++i) v[i] = rp[i];
    float mx = 0.f;
#pragma unroll
    for (int i = 0; i < 8; ++i) mx = fmaxf(mx, fmaxf(fmaxf(fabsf(v[i].x), fabsf(v[i].y)), fmaxf(fabsf(v[i].z), fabsf(v[i].w))));
#pragma unroll
    for (int o = 16; o; o >>= 1) mx = fmaxf(mx, __shfl_xor(mx, o));
    const float sc = (mx > 0.f) ? 7.0f / mx : 1.f;
    unsigned long long lo = 0ull, mid = 0ull, hi = 0ull;
    u32x6 q;
    {
      const float xs[32] = {v[0].x, v[0].y, v[0].z, v[0].w, v[1].x, v[1].y, v[1].z, v[1].w, v[2].x, v[2].y, v[2].z, v[2].w, v[3].x, v[3].y, v[3].z, v[3].w,
                            v[4].x, v[4].y, v[4].z, v[4].w, v[5].x, v[5].y, v[5].z, v[5].w, v[6].x, v[6].y, v[6].z, v[6].w, v[7].x, v[7].y, v[7].z, v[7].w};
      unsigned code[32];
#pragma unroll
      for (int i = 0; i < 32; ++i) {
        const float a = fabsf(xs[i] * sc);
        float c = (a < 2.f) ? rintf(a * 8.f) : (a < 4.f ? 16.f + rintf((a - 2.f) * 4.f) : 24.f + rintf((a - 4.f) * 2.f));
        c = fminf(c, 31.f);
        code[i] = (unsigned)c | ((xs[i] < 0.f) ? 32u : 0u);
      }
#pragma unroll
      for (int h = 0; h < 2; ++h) {
        unsigned long long a0 = 0ull, a1 = 0ull;
#pragma unroll
        for (int i = 0; i < 16; ++i) {
          const int bit = 6 * i;
          const unsigned long long cv = code[16 * h + i];
          if (bit < 64) a0 |= cv << bit;
          if (bit + 6 > 64) a1 |= (bit >= 64) ? (cv << (bit - 64)) : (cv >> (64 - bit));
        }
        q[3 * h + 0] = (unsigned)a0; q[3 * h + 1] = (unsigned)(a0 >> 32); q[3 * h + 2] = (unsigned)a1;
      }
    }
    (void)lo; (void)mid; (void)hi;
    unsigned char* dp = dst + (size_t)row * ROWB + g * 24;
    *(uint2*)dp = make_uint2(q[0], q[1]);
    *(uint2*)(dp + 8) = make_uint2(q[2], q[3]);
    *(uint2*)(dp + 16) = make_uint2(q[4], q[5]);
    if (g == 0) inv_scale[row] = (mx > 0.f) ? mx * (1.f / 7.0f) : 1.f;
  }
}

DI int rope32_d(int pos) { return 4 * (pos >> 3) + (pos & 3) + 16 * ((pos >> 2) & 1); }
DI int map_gemm1(int np) {
  const int G = np >> 5, pos = np & 31;
  if (G < 8) return G * 32 + rope32_d(pos);
  if (G < 16) return 256 + (G - 8) * 32 + rope32_d(pos);
  if (G < 36) return G * 32 + pos;
  if (G == 36) return 1152 + rope32_d(pos);
  if (G == 37) return -1;
  if (G < 62) {
    const int hg = (G < 50) ? (G - 38) : (G - 50);
    const int base = (G < 50) ? 1184 : 1568;
    return base + (hg >> 1) * 64 + 16 * (hg & 1) + 4 * (pos >> 3) + (pos & 3) + 32 * ((pos >> 2) & 1);
  }
  if (G < 74) return 1952 + (G - 62) * 32 + pos;
  return -1;
}
DI int map_up(int np, int& which) {
  const int G = np >> 5, pos = np & 31;
  if (G < 18) { which = 0; const int head = G / 3, part = G % 3; return head * 96 + part * 32 + (part == 2 ? rope32_d(pos) : pos); }
  if (G < 42) { which = 1; return (G - 18) * 32 + pos; }
  which = -1; return -1;
}
DI void transpose_tile(const Params& p, int layer, int mode, u16* __restrict__ dst, int ldd, int nt, int kt, float* tile) {
  const int tid = otid(p.wave);
  const int n0 = nt * 64, k0 = kt * 64;
#pragma unroll
  for (int pass = 0; pass < 2; ++pass) {
    const int kk = (tid >> 4) + pass * 32, nn = (tid & 15) * 4;
    const int np = n0 + nn;
    const float* src = nullptr; int nsrc = 0, col = -1, ksrc = k0 + kk; float sc = 1.f;
    if (mode == 0) {
      col = map_gemm1(np); src = p.in[1] + (size_t)layer * DM * INW; nsrc = INW;
      if (col >= 0 && col < 256) sc = 0.17677669529663687f * LOG2E;
      else if (col >= 1184 && col < 1568) sc = 0.125f * LOG2E;
    } else if (mode == 1) {
      int which; col = map_up(np, which);
      if (which == 0 && k0 < 256) { src = p.in[6] + (size_t)layer * 256 * 576; nsrc = 576; sc = 0.10206207261596575f * LOG2E * p.in[4][layer * 256 + ksrc]; }
      else if (which == 1 && k0 >= 256) { ksrc -= 256; src = p.in[7] + (size_t)layer * 128 * 768; nsrc = 768; sc = p.in[5][layer * 128 + ksrc]; }
      else col = -1;
    } else if (mode == 3) {
      col = np; src = p.in[8] + (size_t)layer * DM * DM; nsrc = DM;
    } else {
      col = np; src = p.in[11] + (size_t)layer * DM * 2048; nsrc = 2048;
    }
    float4 v = make_float4(0.f, 0.f, 0.f, 0.f);
    if (col >= 0) v = *(const float4*)(src + (size_t)ksrc * nsrc + col);
    tile[kk * 65 + nn + 0] = v.x * sc; tile[kk * 65 + nn + 1] = v.y * sc;
    tile[kk * 65 + nn + 2] = v.z * sc; tile[kk * 65 + nn + 3] = v.w * sc;
  }
  __syncthreads();
  {
    const int nn = tid >> 3, k8 = (tid & 7) * 8;
    float f[8];
#pragma unroll
    for (int e = 0; e < 8; ++e) f[e] = tile[(k8 + e) * 65 + nn];
    uint4 o; o.x = pack2(f[0], f[1]); o.y = pack2(f[2], f[3]); o.z = pack2(f[4], f[5]); o.w = pack2(f[6], f[7]);
    *(uint4*)(dst + (size_t)(n0 + nn) * ldd + k0 + k8) = o;
  }
  __syncthreads();
}

DI void phase_prep(const Params& p, char* lds) {
  convert_bf16(p.wave, p.in[0], p.xb, (size_t)T_ALL * DM / 8);
  convert_bf16(p.wave, p.in[12], p.keysb, (size_t)2 * 16 * 128 * 128 / 8);
  convert_rows_fp6(p.wave, p.in[13], p.ub, p.us, 2 * NEXP);
  convert_rows_fp6(p.wave, p.in[14], p.vb, p.vs, 2 * NEXP);
  for (int i = obid() * 512 + otid(p.wave); i < SEQ * 48; i += gridDim.x * 512) {
    int pos = i / 48, r = i % 48;
    if (r < 16) {
      float ang = (float)pos * expf(-logf(10000.0f) * (float)r / 16.f);
      p.cs32[pos * 16 + r] = make_float2(cosf(ang), sinf(ang));
    } else {
      int q = r - 16;
      float ang = (float)pos * expf(-logf(10000.0f) * (float)q / 32.f);
      p.cs64[pos * 32 + q] = make_float2(cosf(ang), sinf(ang));
    }
  }
  float* tile = (float*)lds;
  for (int u = obid(); u < 3104; u += gridDim.x) {
    const int layer = u / 1552, r = u % 1552;
    if (r < 640) transpose_tile(p, layer, 0, p.winT + (size_t)layer * NPAD * 1024, 1024, r / 16, r % 16, tile);
    else if (r < 784) { const int v = r - 640; transpose_tile(p, layer, 1, p.wupT + (size_t)layer * NUP * KUP, KUP, v / 6, v % 6, tile); }
    else if (r < 1040) { const int v = r - 784; transpose_tile(p, layer, 3, p.woT + (size_t)layer * DM * DM, 1024, v / 16, v % 16, tile); }
    else { const int v = r - 1040; transpose_tile(p, layer, 4, p.wqT + (size_t)layer * 2048 * DM, 1024, v / 16, v % 16, tile); }
  }
}

DI void store16(u16* dst, const f32x4& a, const f32x4& b) {
  uint4 w; w.x = pack2(a[0], a[1]); w.y = pack2(a[2], a[3]); w.z = pack2(b[0], b[1]); w.w = pack2(b[2], b[3]);
  *(uint4*)dst = w;
}
DI void rope4(f32x4& v0, f32x4& v1, const float2* cs) {
  const float4 c01 = *(const float4*)cs, c23 = *(const float4*)(cs + 2);
  const float co[4] = {c01.x, c01.z, c23.x, c23.z}, si[4] = {c01.y, c01.w, c23.y, c23.w};
#pragma unroll
  for (int k = 0; k < 4; ++k) {
    const float x1 = v0[k], x2 = v1[k];
    v0[k] = x1 * co[k] - x2 * si[k];
    v1[k] = x2 * co[k] + x1 * si[k];
  }
}
struct EpiGemm1 {
  static constexpr bool PERM = true, AFTER_DRAIN = false;
  u16 *aq, *ak, *av, *bc, *bkr, *cq, *ck, *cv; const float2 *cs32, *cs64; float* sumsq;
  DI void operator()(const f32x4 (&acc)[2][2][4][2], const Unit& u, int wr, int wc, int fr, int fq) const {
#pragma unroll
    for (int bj = 0; bj < 2; ++bj) {
      const int G = u.pn * 8 + bj * 4 + wc;
#pragma unroll
      for (int ai = 0; ai < 2; ++ai)
#pragma unroll
        for (int m = 0; m < 4; ++m) {
          const int t = u.pm * 256 + ai * 128 + wr * 64 + m * 16 + fr;
          const int b = t >> 12, s = t & 4095;
          f32x4 v0 = acc[ai][bj][m][0], v1 = acc[ai][bj][m][1];
          if (G < 16 || G == 36) {
            rope4(v0, v1, cs32 + s * 16 + 4 * fq);
            u16* dst = (G < 8) ? aq + ((size_t)(b * 8 + G) * SEQ + s) * 32
                     : (G < 16) ? ak + ((size_t)(b * 8 + G - 8) * SEQ + s) * 32 : bkr + (size_t)t * 32;
            store8(dst + 4 * fq, v0[0], v0[1], v0[2], v0[3]);
            store8(dst + 16 + 4 * fq, v1[0], v1[1], v1[2], v1[3]);
          } else if (G < 24) {
            store16(av + ((size_t)(b * 4 + ((G - 16) >> 1)) * SEQ + s) * 64 + ((G - 16) & 1) * 32 + 8 * fq, v0, v1);
          } else if (G < 36) {
            store16(bc + (size_t)t * KUP + (G - 24) * 32 + 8 * fq, v0, v1);
            float ps = v0[0] * v0[0] + v0[1] * v0[1] + v0[2] * v0[2] + v0[3] * v0[3] + v1[0] * v1[0] + v1[1] * v1[1] + v1[2] * v1[2] + v1[3] * v1[3];
            ps += __shfl_xor(ps, 16); ps += __shfl_xor(ps, 32);
            if (fq == 0) sumsq[(size_t)t * 12 + (G - 24)] = ps;
          } else if (G == 37) {
          } else if (G < 62) {
            const bool isq = G < 50; const int hg = G - (isq ? 38 : 50), head = hg >> 1, gsel = hg & 1;
            rope4(v0, v1, cs64 + s * 32 + 16 * gsel + 4 * fq);
            u16* dst = (isq ? cq : ck) + ((size_t)(b * 6 + head) * SEQ + s) * 64 + 16 * gsel + 4 * fq;
            store8(dst, v0[0], v0[1], v0[2], v0[3]);
            store8(dst + 32, v1[0], v1[1], v1[2], v1[3]);
          } else if (G < 74) {
            store16(cv + ((size_t)(b * 6 + ((G - 62) >> 1)) * SEQ + s) * 64 + ((G - 62) & 1) * 32 + 8 * fq, v0, v1);
          }
          __builtin_amdgcn_sched_barrier(0);
        }
    }
  }
};
struct EpiUp {
  static constexpr bool PERM = true, AFTER_DRAIN = false;
  u16 *mq, *mk, *mv; const float2* cs32; const float* sumsq;
  DI void operator()(const f32x4 (&acc)[2][2][4][2], const Unit& u, int wr, int wc, int fr, int fq) const {
#pragma unroll
    for (int ai = 0; ai < 2; ++ai)
#pragma unroll
      for (int m = 0; m < 4; ++m) {
        const int t = u.pm * 256 + ai * 128 + wr * 64 + m * 16 + fr;
        const int b = t >> 12, s = t & 4095;
        const float4 sa = *(const float4*)(sumsq + (size_t)t * 12), sb = *(const float4*)(sumsq + (size_t)t * 12 + 4), sc = *(const float4*)(sumsq + (size_t)t * 12 + 8);
        const float rq = rsqrtf((((sa.x + sa.y) + (sa.z + sa.w)) + ((sb.x + sb.y) + (sb.z + sb.w))) * (1.f / 256.f) + 1e-5f);
        const float rkv = rsqrtf(((sc.x + sc.y) + (sc.z + sc.w)) * (1.f / 128.f) + 1e-5f);
#pragma unroll
        for (int bj = 0; bj < 2; ++bj) {
          const int G = u.pn * 8 + bj * 4 + wc;
          f32x4 v0 = acc[ai][bj][m][0], v1 = acc[ai][bj][m][1];
          if (G < 18) {
            const int head = G / 3, part = G % 3;
            v0 *= rq; v1 *= rq;
            u16* dst = mq + ((size_t)(b * 6 + head) * SEQ + s) * 96;
            if (part < 2) store16(dst + part * 32 + 8 * fq, v0, v1);
            else {
              rope4(v0, v1, cs32 + s * 16 + 4 * fq);
              store8(dst + 64 + 4 * fq, v0[0], v0[1], v0[2], v0[3]);
              store8(dst + 80 + 4 * fq, v1[0], v1[1], v1[2], v1[3]);
            }
          } else if (G < 42) {
            const int g = G - 18, head = g >> 2, part = g & 3;
            v0 *= rkv; v1 *= rkv;
            store16((part < 2 ? mk : mv) + ((size_t)(b * 6 + head) * SEQ + s) * 64 + (part & 1) * 32 + 8 * fq, v0, v1);
          }
        }
        __builtin_amdgcn_sched_barrier(0);
      }
  }
};
struct EpiOut {
  static constexpr bool PERM = true, AFTER_DRAIN = false;
  const u16* xb; u16* ybuf; float* stats;
  DI void operator()(const f32x4 (&acc)[2][2][4][2], const Unit& u, int wr, int wc, int fr, int fq) const {
#pragma unroll
    for (int ai = 0; ai < 2; ++ai)
#pragma unroll
      for (int m = 0; m < 4; ++m) {
        const int t = u.pm * 256 + ai * 128 + wr * 64 + m * 16 + fr;
        float s1 = 0.f, s2 = 0.f;
#pragma unroll
        for (int bj = 0; bj < 2; ++bj) {
          const size_t off = (size_t)t * 1024 + u.pn * 256 + bj * 128 + wc * 32 + 8 * fq;
          const uint4 xv = *(const uint4*)(xb + off);
          f32x4 y0, y1;
          y0[0] = ALPHA * bflo(xv.x) + acc[ai][bj][m][0][0]; y0[1] = ALPHA * bfhi(xv.x) + acc[ai][bj][m][0][1];
          y0[2] = ALPHA * bflo(xv.y) + acc[ai][bj][m][0][2]; y0[3] = ALPHA * bfhi(xv.y) + acc[ai][bj][m][0][3];
          y1[0] = ALPHA * bflo(xv.z) + acc[ai][bj][m][1][0]; y1[1] = ALPHA * bfhi(xv.z) + acc[ai][bj][m][1][1];
          y1[2] = ALPHA * bflo(xv.w) + acc[ai][bj][m][1][2]; y1[3] = ALPHA * bfhi(xv.w) + acc[ai][bj][m][1][3];
          s1 += (y0[0] + y0[1]) + (y0[2] + y0[3]) + (y1[0] + y1[1]) + (y1[2] + y1[3]);
          s2 += y0[0] * y0[0] + y0[1] * y0[1] + y0[2] * y0[2] + y0[3] * y0[3] + y1[0] * y1[0] + y1[1] * y1[1] + y1[2] * y1[2] + y1[3] * y1[3];
          store16(ybuf + off, y0, y1);
        }
        s1 += __shfl_xor(s1, 16); s1 += __shfl_xor(s1, 32);
        s2 += __shfl_xor(s2, 16); s2 += __shfl_xor(s2, 32);
        if (fq == 0) { stats[(size_t)t * 32 + u.pn * 4 + wc] = s1; stats[(size_t)t * 32 + 16 + u.pn * 4 + wc] = s2; }
      }
  }
};
struct EpiQ {
  static constexpr bool PERM = true, AFTER_DRAIN = false;
  u16* qbuf;
  DI void operator()(const f32x4 (&acc)[2][2][4][2], const Unit& u, int wr, int wc, int fr, int fq) const {
#pragma unroll
    for (int ai = 0; ai < 2; ++ai)
#pragma unroll
      for (int m = 0; m < 4; ++m) {
        const int t = u.pm * 256 + ai * 128 + wr * 64 + m * 16 + fr;
#pragma unroll
        for (int bj = 0; bj < 2; ++bj)
          store16(qbuf + (size_t)t * 2048 + u.pn * 256 + bj * 128 + wc * 32 + 8 * fq, acc[ai][bj][m][0], acc[ai][bj][m][1]);
      }
  }
};
template <class Epi>
DI void run_gemm(int wv, const u16* A, const u16* Bt, int N, int K, const Epi& E, char* lds) {
  pg8::Gemm g; g.A = A; g.Bt = Bt; g.M = T_ALL; g.N = N; g.K = K;
  pg8::StaticOrder S; S.init(T_ALL, N, gridDim.x, obid());
  pg8::gemm_phase(wv, (PG8_LAS unsigned char*)lds, g, S, E);
  __syncthreads();
}
DI bf16x8 packP(const f32x16& S, int s2) {
  uint4 u;
  u.x = pack2(S[8 * s2 + 0], S[8 * s2 + 1]); u.y = pack2(S[8 * s2 + 2], S[8 * s2 + 3]);
  u.z = pack2(S[8 * s2 + 4], S[8 * s2 + 5]); u.w = pack2(S[8 * s2 + 6], S[8 * s2 + 7]);
  return __builtin_bit_cast(bf16x8, u);
}

DI float fadd_s(float a, float b) { float r; asm("v_add_f32 %0, %1, %2" : "=v"(r) : "v"(a), "v"(b)); return r; }
DI float exp_sum16(f32x16& S) {
#pragma unroll
  for (int e = 0; e < 16; ++e) S[e] = fexp2(S[e]);
  const float a0 = fadd_s(S[0], S[1]), a1 = fadd_s(S[2], S[3]), a2 = fadd_s(S[4], S[5]), a3 = fadd_s(S[6], S[7]);
  const float a4 = fadd_s(S[8], S[9]), a5 = fadd_s(S[10], S[11]), a6 = fadd_s(S[12], S[13]), a7 = fadd_s(S[14], S[15]);
  const float b0 = fadd_s(a0, a1), b1 = fadd_s(a2, a3), b2 = fadd_s(a4, a5), b3 = fadd_s(a6, a7);
  return fadd_s(fadd_s(b0, b1), fadd_s(b2, b3));
}
DI float max3f(float a, float b, float c) { return __builtin_fmaxf(__builtin_fmaxf(a, b), c); }
DI float max16(const f32x16& S) {
  const float a = max3f(S[0], S[1], S[2]), b = max3f(S[3], S[4], S[5]), c = max3f(S[6], S[7], S[8]);
  const float d = max3f(S[9], S[10], S[11]), e = max3f(S[12], S[13], S[14]);
  return max3f(max3f(a, b, c), max3f(d, e, S[15]), a);
}

template <bool MLA, bool SAFE, int NQ  >
DI bool attn_dense_item(const Params& p, int layer, int item, float lam_full, float lam_init, char* lds) {
  constexpr int NKT = MLA ? 1 : 2;
  constexpr int DK = MLA ? 96 : 32;
  constexpr int KSTR = MLA ? 208 : 80;
  constexpr int KB = 64 * KSTR;
  constexpr int STAGE = NKT * KB + 8192;
  constexpr int NKS = DK / 16;
  constexpr float THR = 8.f;
  const int tid = otid(p.wave), lane = tid & 63, wave = tid >> 6, r = lane & 31, hh = lane >> 5;
  const int strm = MLA ? 0 : (wave & 1);
  int b, head, q0;
  if (MLA) { b = item / 96; head = (item / 16) % 6; q0 = (item & 15) * 256 + wave * 32; }
  else if (NQ == 2) { b = item / 64; head = (item / 16) & 3; q0 = (item & 15) * 256 + (wave >> 1) * 64; }
  else { b = item / 128; head = (item / 32) & 3; q0 = (item & 31) * 128 + (wave >> 1) * 32; }
  const u16 *kg0, *kg1, *vg;
  bf16x8 Q[NQ][NKS];
  if (MLA) {
    const u16* qp = p.mq + ((size_t)(b * 6 + head) * SEQ + q0 + r) * 96 + hh * 8;
#pragma unroll
    for (int s = 0; s < NKS; ++s) Q[0][s] = *(const bf16x8*)(qp + s * 16);
    kg0 = p.mk + (size_t)(b * 6 + head) * SEQ * 64;
    kg1 = p.bkr + (size_t)b * SEQ * 32;
    vg = p.mv + (size_t)(b * 6 + head) * SEQ * 64;
  } else {
#pragma unroll
    for (int qi = 0; qi < NQ; ++qi) {
      const u16* qp = p.aq + ((size_t)(b * 8 + head * 2 + strm) * SEQ + q0 + qi * 32 + r) * 32 + hh * 8;
#pragma unroll
      for (int s = 0; s < NKS; ++s) Q[qi][s] = *(const bf16x8*)(qp + s * 16);
    }
    kg0 = p.ak + (size_t)(b * 8 + head * 2) * SEQ * 32;
    kg1 = p.ak + (size_t)(b * 8 + head * 2 + 1) * SEQ * 32;
    vg = p.av + (size_t)(b * 4 + head) * SEQ * 64;
  }
  f32x16 O[NQ][2];
  float mu[NQ], mt[NQ], l[NQ];
#pragma unroll
  for (int qi = 0; qi < NQ; ++qi) {
    l[qi] = 0.f;
#pragma unroll
    for (int e = 0; e < 16; ++e) { O[qi][0][e] = 0.f; O[qi][1][e] = 0.f; }
  }
  const int offk = MLA ? (tid >> 3) * 64 + (tid & 7) * 8 : ((tid & 255) >> 2) * 32 + (tid & 3) * 8;
  const int offp = (tid >> 2) * 32 + (tid & 3) * 8;
  const int offv = (tid >> 3) * 64 + (tid & 7) * 8;
  uint4 gk, gv, gp;
  auto gload = [&](int kt) {
    const int k0 = kt * 64;
    if (MLA) {
      gk = *(const uint4*)(kg0 + (size_t)k0 * 64 + offk);
      if (tid < 256) gp = *(const uint4*)(kg1 + (size_t)k0 * 32 + offp);
    } else {
      const u16* kb = (p.wave < 4) ? kg0 : kg1;
      gk = *(const uint4*)(kb + (size_t)k0 * 32 + offk);
    }
    gv = *(const uint4*)(vg + (size_t)k0 * 64 + offv);
  };
  auto swrite = [&](int sb) {
    char* base = lds + sb * STAGE;
    if (MLA) {
      *(uint4*)(base + (tid >> 3) * KSTR + (tid & 7) * 16) = gk;
      if (tid < 256) *(uint4*)(base + (tid >> 2) * KSTR + 128 + (tid & 3) * 16) = gp;
    } else {
      const int c = tid & 255;
      *(uint4*)(base + (tid >> 8) * KB + (c >> 2) * KSTR + (c & 3) * 16) = gk;
    }
    const int row = tid >> 3;
    *(uint4*)(base + NKT * KB + row * 128 + (((tid & 7) * 16) ^ (((row >> 1) & 1) << 6))) = gv;
  };
  const int tq = (lane & 15) >> 2, tp = lane & 3, tg1 = (lane >> 4) & 1, swz = (tq >> 1) & 1;
  const int voff = NKT * KB + (4 * hh + tq) * 128 + 32 * tg1 + 8 * tp;
  const int koff = strm * KB + r * KSTR + hh * 16;
#define VFRAG(i2, u, s2) ({ const char* a_ = vb + (32 * (u) + 16 * (s2)) * 128 + 64 * ((i2) ^ swz); \
    const s16x4 lo_ = trread(a_), hi_ = trread(a_ + 8 * 128); (bf16x8)__builtin_shufflevector(lo_, hi_, 0, 1, 2, 3, 4, 5, 6, 7); })
#define QXFRAG(m_) __builtin_bit_cast(bf16x8, make_uint4(hh == 0 ? (pack2(-(m_), 0.f) & 0xffffu) : 0u, 0u, 0u, 0u))

  gload(0); swrite(0);
  __syncthreads();
  bf16x8 QX[NQ];
  const bf16x8 KX = __builtin_bit_cast(bf16x8, make_uint4(hh == 0 ? 0x3F80u : 0u, 0u, 0u, 0u));
  {
    const char* kb_ = lds + koff;
#pragma unroll
    for (int qi = 0; qi < NQ; ++qi) {
      f32x16 A0 = (f32x16)(0.f), A1 = (f32x16)(0.f);
#pragma unroll
      for (int s = 0; s < NKS; ++s) { A0 = MFMA(*(const bf16x8*)(kb_ + s * 32), Q[qi][s], A0); A1 = MFMA(*(const bf16x8*)(kb_ + 32 * KSTR + s * 32), Q[qi][s], A1); }
      float mx = fmaxf(max16(A0), max16(A1));
      mx = fmaxf(mx, __shfl_xor(mx, 32));
      mu[qi] = bflo(pack2(mx, 0.f)); mt[qi] = mx;
      QX[qi] = QXFRAG(mu[qi]);
    }
  }
#pragma unroll 1
  for (int kt = 0; kt < 64; ++kt) {
    if (kt + 1 < 64) gload(kt + 1);
    const char* base = lds + (kt & 1) * STAGE;
    const char* vb = base + voff;
    bf16x8 KF[2][NKS];
    const char* kbs_ = base + koff;
    if (!SAFE) {
#pragma unroll
      for (int s = 0; s < NKS; ++s) { KF[0][s] = *(const bf16x8*)(kbs_ + s * 32); KF[1][s] = *(const bf16x8*)(kbs_ + 32 * KSTR + s * 32); }
    }
    if (SAFE) {
      bool need = false;
#pragma unroll
      for (int qi = 0; qi < NQ; ++qi) { mt[qi] = fmaxf(mt[qi], __shfl_xor(mt[qi], 32)); need = need || (mt[qi] > mu[qi] + THR); }
      if (__any(need)) {
#pragma unroll
        for (int qi = 0; qi < NQ; ++qi) {
          const float mn = bflo(pack2(fmaxf(mt[qi], mu[qi]), 0.f));
          const float al = fexp2(mu[qi] - mn);
          mu[qi] = mn; l[qi] *= al;
#pragma unroll
          for (int e = 0; e < 16; ++e) { O[qi][0][e] *= al; O[qi][1][e] *= al; }
          QX[qi] = QXFRAG(mu[qi]);
        }
      }
    }
    __builtin_amdgcn_sched_barrier(0);
#pragma unroll
    for (int qi = 0; qi < NQ; ++qi) {
      f32x16 A0, A1;
      __builtin_amdgcn_s_setprio(1);
      A0 = MFMA(KX, QX[qi], (f32x16)(0.f)); A1 = MFMA(KX, QX[qi], (f32x16)(0.f));
#pragma unroll
      for (int s = 0; s < NKS; ++s) {
        if (!SAFE) { A0 = MFMA(KF[0][s], Q[qi][s], A0); A1 = MFMA(KF[1][s], Q[qi][s], A1); }
        else { A0 = MFMA(*(const bf16x8*)(kbs_ + s * 32), Q[qi][s], A0); A1 = MFMA(*(const bf16x8*)(kbs_ + 32 * KSTR + s * 32), Q[qi][s], A1); }
      }
      __builtin_amdgcn_s_setprio(0);
      bf16x8 V0[2][2];
      if (!SAFE) {
#pragma unroll
        for (int i2 = 0; i2 < 2; ++i2)
#pragma unroll
          for (int s2 = 0; s2 < 2; ++s2) V0[i2][s2] = VFRAG(i2, 0, s2);
      }
      __builtin_amdgcn_sched_barrier(0);
      if (SAFE) mt[qi] = fmaxf(mt[qi], mu[qi] + fmaxf(max16(A0), max16(A1)));
      bf16x8 P0[2], P1[2];
      l[qi] += exp_sum16(A0);
      P0[0] = packP(A0, 0); P0[1] = packP(A0, 1);
      bf16x8 V1[2][2];
      if (!SAFE) {
#pragma unroll
        for (int i2 = 0; i2 < 2; ++i2)
#pragma unroll
          for (int s2 = 0; s2 < 2; ++s2) V1[i2][s2] = VFRAG(i2, 1, s2);
      }
      __builtin_amdgcn_sched_barrier(0);
#pragma unroll
      for (int i2 = 0; i2 < 2; ++i2)
#pragma unroll
        for (int s2 = 0; s2 < 2; ++s2) O[qi][i2] = MFMA(SAFE ? VFRAG(i2, 0, s2) : V0[i2][s2], P0[s2], O[qi][i2]);
      l[qi] += exp_sum16(A1);
      P1[0] = packP(A1, 0); P1[1] = packP(A1, 1);
      __builtin_amdgcn_sched_barrier(0);
#pragma unroll
      for (int i2 = 0; i2 < 2; ++i2)
#pragma unroll
        for (int s2 = 0; s2 < 2; ++s2) O[qi][i2] = MFMA(SAFE ? VFRAG(i2, 1, s2) : V1[i2][s2], P1[s2], O[qi][i2]);
      __builtin_amdgcn_sched_barrier(0);
    }
    if (kt + 1 < 64) swrite((kt + 1) & 1);
    __syncthreads();
  }
#undef VFRAG
#undef QXFRAG
  float lt[NQ];
  bool bad = false;
#pragma unroll
  for (int qi = 0; qi < NQ; ++qi) { lt[qi] = l[qi] + __shfl_xor(l[qi], 32); bad = bad || !(lt[qi] < 1.0e37f); }
  if (!SAFE) {
    if (__syncthreads_or(bad)) return true;
  }
  if (MLA) {
    const int t = b * SEQ + q0 + r;
    const float inv = 1.f / lt[0];
#pragma unroll
    for (int i2 = 0; i2 < 2; ++i2) {
#pragma unroll
      for (int e = 0; e < 16; ++e) O[0][i2][e] *= inv;
      store_tile(p.cat + (size_t)t * 1024 + 256 + head * 64 + i2 * 32, O[0][i2], hh);
    }
  } else {
    float* xch = (float*)lds + (((wave >> 1) * NQ) * 64 + lane) * 33;
    if (strm == 1) {
#pragma unroll
      for (int qi = 0; qi < NQ; ++qi) {
        const float sc = lam_full / lt[qi];
#pragma unroll
        for (int i2 = 0; i2 < 2; ++i2)
#pragma unroll
          for (int e = 0; e < 16; ++e) xch[qi * 64 * 33 + i2 * 16 + e] = O[qi][i2][e] * sc;
      }
    }
    __syncthreads();
    if (strm == 0) {
      const float* g = p.in[3] + layer * 64;
#pragma unroll
      for (int qi = 0; qi < NQ; ++qi) {
        const int t = b * SEQ + q0 + qi * 32 + r;
        const float inv1 = 1.f / lt[qi];
        float ss = 0.f;
#pragma unroll
        for (int i2 = 0; i2 < 2; ++i2)
#pragma unroll
          for (int e = 0; e < 16; ++e) {
            const float o = O[qi][i2][e] * inv1 - xch[qi * 64 * 33 + i2 * 16 + e];
            O[qi][i2][e] = o; ss += o * o;
          }
        ss += __shfl_xor(ss, 32);
        const float rn = rsqrtf(ss * (1.f / 64.f) + 1e-5f) * (1.f - lam_init);
#pragma unroll
        for (int i2 = 0; i2 < 2; ++i2) {
#pragma unroll
          for (int gq = 0; gq < 4; ++gq)
#pragma unroll
            for (int bq = 0; bq < 4; ++bq) O[qi][i2][4 * gq + bq] *= rn * g[i2 * 32 + 8 * gq + 4 * hh + bq];
          store_tile(p.cat + (size_t)t * 1024 + head * 64 + i2 * 32, O[qi][i2], hh);
        }
      }
    }
    __syncthreads();
  }
  return false;
}


constexpr int MLA_KSTR = 208, MLA_KB = 64 * MLA_KSTR;
template <int PAR>
DI void mla_split_step(const char* kb, const char* vb0, const char* vb1, const bf16x8 (&Q0)[6], const bf16x8 (&Q1)[6],
                       const bf16x8& QX0, const bf16x8& QX1, const bf16x8& KX, f32x16& A0, f32x16& A1, f32x16& B0, f32x16& B1,
                       f32x16& O00, f32x16& O01, f32x16& O10, f32x16& O11, float& l0, float& l1) {
  constexpr int KS = PAR ^ 1, VS = PAR;
#define FEXP_(x) fexp2(x)
#define KFR_(s) (*(const bf16x8*)(kb + KS * MLA_KB + (s) * 32))
#define VFR_(i2, s2) ({ const char* a_ = ((i2) ? vb1 : vb0) + VS * 8192 + (16 * (s2)) * 128; \
    const s16x4 lo_ = trread(a_), hi_ = trread(a_ + 8 * 128); (bf16x8)__builtin_shufflevector(lo_, hi_, 0, 1, 2, 3, 4, 5, 6, 7); })
  const bf16x8 kf0 = KFR_(0);
  __builtin_amdgcn_sched_barrier(0);
  B0 = MFMA(KX, QX0, (f32x16)(0.f));
  A0[0] = FEXP_(A0[0]);
  A0[1] = FEXP_(A0[1]);
  __builtin_amdgcn_sched_barrier(0);
  B1 = MFMA(KX, QX1, (f32x16)(0.f));
  const bf16x8 kf1 = KFR_(1);
  A0[2] = FEXP_(A0[2]);
  A0[3] = FEXP_(A0[3]);
  const unsigned pw0_0 = pack2(A0[0], A0[1]);
  const float t0_0 = fadd_s(A0[0], A0[1]);
  __builtin_amdgcn_sched_barrier(0);
  B0 = MFMA(kf0, Q0[0], B0);
  const bf16x8 vf00 = VFR_(0, 0);
  A0[4] = FEXP_(A0[4]);
  A0[5] = FEXP_(A0[5]);
  const unsigned pw0_1 = pack2(A0[2], A0[3]);
  const float t0_1 = fadd_s(A0[2], A0[3]);
  __builtin_amdgcn_sched_barrier(0);
  B1 = MFMA(kf0, Q1[0], B1);
  const bf16x8 vf10 = VFR_(1, 0);
  A0[6] = FEXP_(A0[6]);
  A0[7] = FEXP_(A0[7]);
  const unsigned pw0_2 = pack2(A0[4], A0[5]);
  const float t0_2 = fadd_s(A0[4], A0[5]);
  const float s0_0_0 = fadd_s(t0_0, t0_1);
  __builtin_amdgcn_sched_barrier(0);
  B0 = MFMA(kf1, Q0[1], B0);
  A1[0] = FEXP_(A1[0]);
  A1[1] = FEXP_(A1[1]);
  const unsigned pw0_3 = pack2(A0[6], A0[7]);
  const bf16x8 P00 = __builtin_bit_cast(bf16x8, make_uint4(pw0_0, pw0_1, pw0_2, pw0_3));
  const float t0_3 = fadd_s(A0[6], A0[7]);
  __builtin_amdgcn_sched_barrier(0);
  O00 = MFMA(vf00, P00, O00);
  const bf16x8 kf2 = KFR_(2);
  A1[2] = FEXP_(A1[2]);
  A1[3] = FEXP_(A1[3]);
  const unsigned pw1_0 = pack2(A1[0], A1[1]);
  const float s0_0_1 = fadd_s(t0_2, t0_3);
  const float t1_0 = fadd_s(A1[0], A1[1]);
  __builtin_amdgcn_sched_barrier(0);
  O01 = MFMA(vf10, P00, O01);
  A1[4] = FEXP_(A1[4]);
  A1[5] = FEXP_(A1[5]);
  const unsigned pw1_1 = pack2(A1[2], A1[3]);
  const float s0_1_0 = fadd_s(s0_0_0, s0_0_1);
  const float t1_1 = fadd_s(A1[2], A1[3]);
  __builtin_amdgcn_sched_barrier(0);
  B1 = MFMA(kf1, Q1[1], B1);
  A1[6] = FEXP_(A1[6]);
  A1[7] = FEXP_(A1[7]);
  const unsigned pw1_2 = pack2(A1[4], A1[5]);
  const float t1_2 = fadd_s(A1[4], A1[5]);
  const float s1_0_0 = fadd_s(t1_0, t1_1);
  __builtin_amdgcn_sched_barrier(0);
  B0 = MFMA(kf2, Q0[2], B0);
  A0[8] = FEXP_(A0[8]);
  A0[9] = FEXP_(A0[9]);
  const unsigned pw1_3 = pack2(A1[6], A1[7]);
  const bf16x8 P10 = __builtin_bit_cast(bf16x8, make_uint4(pw1_0, pw1_1, pw1_2, pw1_3));
  const float t1_3 = fadd_s(A1[6], A1[7]);
  __builtin_amdgcn_sched_barrier(0);
  O10 = MFMA(vf00, P10, O10);
  const bf16x8 kf3 = KFR_(3);
  A0[10] = FEXP_(A0[10]);
  A0[11] = FEXP_(A0[11]);
  const unsigned pw0_4 = pack2(A0[8], A0[9]);
  const float t0_4 = fadd_s(A0[8], A0[9]);
  const float s1_0_1 = fadd_s(t1_2, t1_3);
  __builtin_amdgcn_sched_barrier(0);
  O11 = MFMA(vf10, P10, O11);
  const bf16x8 vf01 = VFR_(0, 1);
  A0[12] = FEXP_(A0[12]);
  A0[13] = FEXP_(A0[13]);
  const unsigned pw0_5 = pack2(A0[10], A0[11]);
  const float t0_5 = fadd_s(A0[10], A0[11]);
  const float s1_1_0 = fadd_s(s1_0_0, s1_0_1);
  __builtin_amdgcn_sched_barrier(0);
  B1 = MFMA(kf2, Q1[2], B1);
  const bf16x8 vf11 = VFR_(1, 1);
  A0[14] = FEXP_(A0[14]);
  A0[15] = FEXP_(A0[15]);
  const unsigned pw0_6 = pack2(A0[12], A0[13]);
  const float t0_6 = fadd_s(A0[12], A0[13]);
  const float s0_0_2 = fadd_s(t0_4, t0_5);
  __builtin_amdgcn_sched_barrier(0);
  B0 = MFMA(kf3, Q0[3], B0);
  A1[8] = FEXP_(A1[8]);
  A1[9] = FEXP_(A1[9]);
  const unsigned pw0_7 = pack2(A0[14], A0[15]);
  const bf16x8 P01 = __builtin_bit_cast(bf16x8, make_uint4(pw0_4, pw0_5, pw0_6, pw0_7));
  const float t0_7 = fadd_s(A0[14], A0[15]);
  __builtin_amdgcn_sched_barrier(0);
  O00 = MFMA(vf01, P01, O00);
  const bf16x8 kf4 = KFR_(4);
  A1[10] = FEXP_(A1[10]);
  A1[11] = FEXP_(A1[11]);
  const unsigned pw1_4 = pack2(A1[8], A1[9]);
  const float s0_0_3 = fadd_s(t0_6, t0_7);
  const float t1_4 = fadd_s(A1[8], A1[9]);
  __builtin_amdgcn_sched_barrier(0);
  O01 = MFMA(vf11, P01, O01);
  A1[12] = FEXP_(A1[12]);
  A1[13] = FEXP_(A1[13]);
  const unsigned pw1_5 = pack2(A1[10], A1[11]);
  const float s0_1_1 = fadd_s(s0_0_2, s0_0_3);
  const float t1_5 = fadd_s(A1[10], A1[11]);
  __builtin_amdgcn_sched_barrier(0);
  B1 = MFMA(kf3, Q1[3], B1);
  A1[14] = FEXP_(A1[14]);
  A1[15] = FEXP_(A1[15]);
  const unsigned pw1_6 = pack2(A1[12], A1[13]);
  const float s0_2_0 = fadd_s(s0_1_0, s0_1_1);
  const float t1_6 = fadd_s(A1[12], A1[13]);
  const float s1_0_2 = fadd_s(t1_4, t1_5);
  __builtin_amdgcn_sched_barrier(0);
  B0 = MFMA(kf4, Q0[4], B0);
  const unsigned pw1_7 = pack2(A1[14], A1[15]);
  const bf16x8 P11 = __builtin_bit_cast(bf16x8, make_uint4(pw1_4, pw1_5, pw1_6, pw1_7));
  l0 = fadd_s(l0, s0_2_0);
  const float t1_7 = fadd_s(A1[14], A1[15]);
  __builtin_amdgcn_sched_barrier(0);
  O10 = MFMA(vf01, P11, O10);
  const bf16x8 kf5 = KFR_(5);
  const float s1_0_3 = fadd_s(t1_6, t1_7);
  __builtin_amdgcn_sched_barrier(0);
  O11 = MFMA(vf11, P11, O11);
  const float s1_1_1 = fadd_s(s1_0_2, s1_0_3);
  __builtin_amdgcn_sched_barrier(0);
  B1 = MFMA(kf4, Q1[4], B1);
  const float s1_2_0 = fadd_s(s1_1_0, s1_1_1);
  __builtin_amdgcn_sched_barrier(0);
  B0 = MFMA(kf5, Q0[5], B0);
  l1 = fadd_s(l1, s1_2_0);
  __builtin_amdgcn_sched_barrier(0);
  B1 = MFMA(kf5, Q1[5], B1);
  __builtin_amdgcn_sched_barrier(0);

#undef KFR_
#undef VFR_
#undef FEXP_
}

DI bool attn_mla_split(const Params& p, int layer, int item, char* lds) {
  constexpr int KSTR = MLA_KSTR, KB = MLA_KB;
  const int tid = otid(p.wave), lane = tid & 63, wave = tid >> 6, r = lane & 31, hh = lane >> 5;
  const int qb = p.wave & 3, kh = p.wave >> 2;
  const int b = item / 96, head = (item / 16) % 6, q0 = (item & 15) * 256 + qb * 64;
  bf16x8 Q0[6], Q1[6];
  {
    const u16* qp = p.mq + ((size_t)(b * 6 + head) * SEQ + q0 + r) * 96 + hh * 8;
#pragma unroll
    for (int s = 0; s < 6; ++s) { Q0[s] = *(const bf16x8*)(qp + s * 16); Q1[s] = *(const bf16x8*)(qp + 32 * 96 + s * 16); }
  }
  const u16* kg0 = p.mk + (size_t)(b * 6 + head) * SEQ * 64;
  const u16* kg1 = p.bkr + (size_t)b * SEQ * 32;
  const u16* vg = p.mv + (size_t)(b * 6 + head) * SEQ * 64;
  f32x16 O00 = (f32x16)(0.f), O01 = (f32x16)(0.f), O10 = (f32x16)(0.f), O11 = (f32x16)(0.f);
  float l0 = 0.f, l1 = 0.f;
  const int offk = (tid >> 3) * 64 + (tid & 7) * 8, offp = (tid >> 2) * 32 + (tid & 3) * 8, offv = offk;
  uint4 gk, gv, gp;
  auto gloadK = [&](int kt) {
    gk = *(const uint4*)(kg0 + (size_t)kt * 4096 + offk);
    if (tid < 256) gp = *(const uint4*)(kg1 + (size_t)kt * 2048 + offp);
  };
  auto gloadV = [&](int kt) { gv = *(const uint4*)(vg + (size_t)kt * 4096 + offv); };
  auto swriteK = [&](int s) {
    char* base = lds + s * KB;
    *(uint4*)(base + (tid >> 3) * KSTR + (tid & 7) * 16) = gk;
    if (tid < 256) *(uint4*)(base + (tid >> 2) * KSTR + 128 + (tid & 3) * 16) = gp;
  };
  auto swriteV = [&](int s) {
    const int row = tid >> 3;
    *(uint4*)(lds + 2 * KB + s * 8192 + row * 128 + (((tid & 7) * 16) ^ (((row >> 1) & 1) << 6))) = gv;
  };
  const int tq = (lane & 15) >> 2, tp = lane & 3, tg1 = (lane >> 4) & 1, swz = (tq >> 1) & 1;
  const char* vb0 = lds + 2 * KB + (32 * kh + 4 * hh + tq) * 128 + 32 * tg1 + 8 * tp + 64 * swz;
  const char* vb1 = lds + 2 * KB + (32 * kh + 4 * hh + tq) * 128 + 32 * tg1 + 8 * tp + 64 * (swz ^ 1);
  const char* kb = lds + (32 * kh + r) * KSTR + hh * 16;
  gloadK(0); gloadV(0); swriteK(0); swriteV(0);
  gloadK(1); swriteK(1);
  __syncthreads();
  const bf16x8 KX = __builtin_bit_cast(bf16x8, make_uint4(hh == 0 ? 0x3F80u : 0u, 0u, 0u, 0u));
  f32x16 A0 = (f32x16)(0.f), A1 = (f32x16)(0.f), B0, B1;
  float mu0, mu1;
  {
    f32x16 X0 = (f32x16)(0.f), X1 = (f32x16)(0.f);
    const char* kx = kb + (kh ? -32 * KSTR : 32 * KSTR);
#pragma unroll
    for (int s = 0; s < 6; ++s) {
      const bf16x8 ko = *(const bf16x8*)(kb + s * 32), kq = *(const bf16x8*)(kx + s * 32);
      A0 = MFMA(ko, Q0[s], A0); A1 = MFMA(ko, Q1[s], A1); X0 = MFMA(kq, Q0[s], X0); X1 = MFMA(kq, Q1[s], X1);
    }
    float m0 = fmaxf(max16(A0), max16(X0)), m1 = fmaxf(max16(A1), max16(X1));
    m0 = fmaxf(m0, __shfl_xor(m0, 32)); m1 = fmaxf(m1, __shfl_xor(m1, 32));
    mu0 = bflo(pack2(m0, 0.f)); mu1 = bflo(pack2(m1, 0.f));
  }
#pragma unroll
  for (int e = 0; e < 16; ++e) { A0[e] -= mu0; A1[e] -= mu1; }
  const bf16x8 QX0 = __builtin_bit_cast(bf16x8, make_uint4(hh == 0 ? (pack2(-mu0, 0.f) & 0xffffu) : 0u, 0u, 0u, 0u));
  const bf16x8 QX1 = __builtin_bit_cast(bf16x8, make_uint4(hh == 0 ? (pack2(-mu1, 0.f) & 0xffffu) : 0u, 0u, 0u, 0u));
#pragma unroll 1
  for (int t = 0; t < 64; t += 2) {
    if (t + 2 < 64) gloadK(t + 2);
    gloadV(t + 1);
    mla_split_step<0>(kb, vb0, vb1, Q0, Q1, QX0, QX1, KX, A0, A1, B0, B1, O00, O01, O10, O11, l0, l1);
    if (t + 2 < 64) swriteK(0);
    swriteV(1);
    __syncthreads();
    if (t + 3 < 64) gloadK(t + 3);
    if (t + 2 < 64) gloadV(t + 2);
    mla_split_step<1>(kb, vb0, vb1, Q0, Q1, QX0, QX1, KX, B0, B1, A0, A1, O00, O01, O10, O11, l0, l1);
    if (t + 3 < 64) swriteK(1);
    if (t + 2 < 64) swriteV(0);
    __syncthreads();
  }
  float* xs = (float*)lds + (wave * 64 + lane) * 33;
  const float* xr = (const float*)lds + ((wave ^ 4) * 64 + lane) * 33;
  if (kh == 0) {
#pragma unroll
    for (int e = 0; e < 16; ++e) { xs[e] = O10[e]; xs[16 + e] = O11[e]; }
    xs[32] = l1;
  } else {
#pragma unroll
    for (int e = 0; e < 16; ++e) { xs[e] = O00[e]; xs[16 + e] = O01[e]; }
    xs[32] = l0;
  }
  __syncthreads();
  if (kh == 0) {
#pragma unroll
    for (int e = 0; e < 16; ++e) { O00[e] += xr[e]; O01[e] += xr[16 + e]; }
    l0 += xr[32];
  } else {
#pragma unroll
    for (int e = 0; e < 16; ++e) { O10[e] += xr[e]; O11[e] += xr[16 + e]; }
    l1 += xr[32];
  }
  const float lp = kh ? l1 : l0;
  const float lt = lp + __shfl_xor(lp, 32);
  if (__syncthreads_or(!(lt < 1.0e37f))) return true;
  const int tok = b * SEQ + q0 + kh * 32 + r;
  const float inv = 1.f / lt;
  u16* dst = p.cat + (size_t)tok * 1024 + 256 + head * 64;
  if (kh == 0) {
#pragma unroll
    for (int e = 0; e < 16; ++e) { O00[e] *= inv; O01[e] *= inv; }
    store_tile(dst, O00, hh); store_tile(dst + 32, O01, hh);
  } else {
#pragma unroll
    for (int e = 0; e < 16; ++e) { O10[e] *= inv; O11[e] *= inv; }
    store_tile(dst, O10, hh); store_tile(dst + 32, O11, hh);
  }
  return false;
}

struct DilItem { int pair, bh, dil, L, cls, i0; };
DI DilItem dil_decode(int item) {
  DilItem d;
  d.pair = item / 768; const int rem = item % 768; d.bh = rem >> 4; const int sub = rem & 15;
  d.dil = (d.pair == 0) ? 1 : (d.pair == 1 ? 4 : 16);
  d.L = SEQ / d.dil;
  int blk;
  if (d.pair == 0) { d.cls = 0; blk = sub; } else if (d.pair == 1) { d.cls = sub & 3; blk = sub >> 2; } else { d.cls = sub; blk = 0; }
  d.i0 = blk * 256;
  return d;
}
DI void dil_fetch(const Params& p, const DilItem& d, int tid, uint4 (&kr)[6], uint4 (&vr)[6]) {
  const u16* kg = p.ck + (size_t)d.bh * SEQ * 64;
  const u16* vg = p.cv + (size_t)d.bh * SEQ * 64;
#pragma unroll
  for (int e = 0; e < 6; ++e) {
    const int c = tid + e * 512;
    const int row = c >> 3, ch = c & 7;
    const int kk = d.i0 - 64 + row;
    kr[e] = make_uint4(0, 0, 0, 0); vr[e] = make_uint4(0, 0, 0, 0);
    if (kk >= 0 && kk < d.L) {
      const size_t pos = (size_t)(d.cls + d.dil * kk);
      kr[e] = *(const uint4*)(kg + pos * 64 + ch * 8);
      vr[e] = *(const uint4*)(vg + pos * 64 + ch * 8);
    }
  }
}
DI void attn_dilated_items(const Params& p, char* lds) {
  const int tid = otid(p.wave), lane = tid & 63, wave = tid >> 6, r = lane & 31, hh = lane >> 5;
  constexpr int KROW = 144;
  char* Kl = lds;
  char* Vl = lds + 384 * KROW;
  uint4 kr[6], vr[6];
  int item = obid();
  if (item < 2304) { const DilItem d0 = dil_decode(item); dil_fetch(p, d0, tid, kr, vr); }
#pragma unroll 1
  for (; item < 2304; item += gridDim.x) {
  const DilItem d = dil_decode(item);
  const int pair = d.pair, bh = d.bh, dil = d.dil, L = d.L, cls = d.cls, i0 = d.i0;
#pragma unroll
  for (int e = 0; e < 6; ++e) {
    const int c = tid + e * 512;
    const int row = c >> 3, ch = c & 7;
    *(uint4*)(Kl + row * KROW + ch * 16) = kr[e];
    *(uint4*)(Vl + row * 128 + ((ch * 16) ^ (((row >> 1) & 1) << 6))) = vr[e];
  }
  if (item + (int)gridDim.x < 2304) { const DilItem dn = dil_decode(item + gridDim.x); dil_fetch(p, dn, tid, kr, vr); }
  const int qq = i0 + 32 * wave + r;
  const int pq = cls + dil * qq;
  bf16x8 Q[4];
  {
    const u16* qp = p.cq + ((size_t)bh * SEQ + pq) * 64 + hh * 8;
#pragma unroll
    for (int s = 0; s < 4; ++s) Q[s] = *(const bf16x8*)(qp + s * 16);
  }
  __syncthreads();
  f32x16 O[2];
#pragma unroll
  for (int e = 0; e < 16; ++e) { O[0][e] = 0.f; O[1][e] = 0.f; }
  float m = -1e30f, l = 0.f;
  const int tq = (lane & 15) >> 2, tp = lane & 3, tg1 = (lane >> 4) & 1, swz = (tq >> 1) & 1;
  const int voff = (4 * hh + tq) * 128 + 32 * tg1 + 8 * tp;
#pragma unroll
  for (int j = 0; j < 5; ++j) {
    const int rb = 32 * wave + 32 * j;
    f32x16 S;
#pragma unroll
    for (int e = 0; e < 16; ++e) S[e] = 0.f;
    const char* kb = Kl + (rb + r) * KROW + hh * 16;
#pragma unroll
    for (int s = 0; s < 4; ++s) S = MFMA(*(const bf16x8*)(kb + s * 32), Q[s], S);
    unsigned vmask = 0;
#pragma unroll
    for (int e = 0; e < 16; ++e) {
      const int cr = (e & 3) + 8 * (e >> 2) + 4 * hh;
      const int kk = i0 - 64 + rb + cr;
      bool ok = (kk >= 0) && (kk < L);
      if (j == 0) ok = ok && (cr >= r);
      if (j == 4) ok = ok && (cr <= r);
      vmask |= ok ? (1u << e) : 0u;
      S[e] = ok ? S[e] : -1e30f;
    }
    float mx = max16(S);
    mx = fmaxf(mx, __shfl_xor(mx, 32));
    if (__any(mx > m)) {
      const float mn = fmaxf(m, mx);
      const float al = fexp2(m - mn);
      m = mn; l *= al;
#pragma unroll
      for (int e = 0; e < 16; ++e) { O[0][e] *= al; O[1][e] *= al; }
    }
    float ps = 0.f;
#pragma unroll
    for (int e = 0; e < 16; ++e) { S[e] = ((vmask >> e) & 1) ? fexp2(S[e] - m) : 0.f; ps += S[e]; }
    l += ps;
    bf16x8 P0 = packP(S, 0), P1 = packP(S, 1);
    const char* vb = Vl + rb * 128 + voff;
#pragma unroll
    for (int i2 = 0; i2 < 2; ++i2)
#pragma unroll
      for (int s2 = 0; s2 < 2; ++s2) {
        const char* a = vb + (16 * s2) * 128 + 64 * (i2 ^ swz);
        s16x4 lo = trread(a), hi = trread(a + 8 * 128);
        bf16x8 vf = __builtin_shufflevector(lo, hi, 0, 1, 2, 3, 4, 5, 6, 7);
        O[i2] = MFMA(vf, s2 == 0 ? P0 : P1, O[i2]);
      }
  }
  const float lt = l + __shfl_xor(l, 32);
  const float inv = 1.f / lt;
  const int b = bh / 6, head = bh % 6;
  const int t = b * SEQ + pq;
#pragma unroll
  for (int i2 = 0; i2 < 2; ++i2) {
#pragma unroll
    for (int e = 0; e < 16; ++e) O[i2][e] *= inv;
    store_tile(p.dilo + ((size_t)pair * T_ALL + t) * 384 + head * 64 + i2 * 32, O[i2], hh);
  }
  if (hh == 0) p.dillse[((size_t)pair * T_ALL + t) * 6 + head] = m + __log2f(lt);
  __syncthreads();
  }
}


DI void phase_gemm1(const Params& p, int layer, char* lds) {
  EpiGemm1 E; E.aq = p.aq; E.ak = p.ak; E.av = p.av; E.bc = p.bc; E.bkr = p.bkr; E.cq = p.cq; E.ck = p.ck; E.cv = p.cv;
  E.cs32 = p.cs32; E.cs64 = p.cs64; E.sumsq = p.sumsq;
  run_gemm(p.wave, p.xb, p.winT + (size_t)layer * NPAD * 1024, NPAD, 1024, E, lds);
}
DI void phase_up_dil(const Params& p, int layer, char* lds) {
  EpiUp E; E.mq = p.mq; E.mk = p.mk; E.mv = p.mv; E.cs32 = p.cs32; E.sumsq = p.sumsq;
  run_gemm(p.wave, p.bc, p.wupT + (size_t)layer * NUP * KUP, NUP, KUP, E, lds);
  attn_dilated_items(p, lds);
}
DI void phase_attn(const Params& p, int layer, char* lds) {
  const float* lam = p.in[2] + layer * 128;
  float s1 = 0.f, s2 = 0.f;
  for (int i = 0; i < 32; ++i) { s1 += lam[i] * lam[32 + i]; s2 += lam[64 + i] * lam[96 + i]; }
  const float lam_init = 0.8f - 0.6f * expf(-0.3f * (float)(layer + 1));
  const float lam_full = expf(s1) - expf(s2) + lam_init;
  unsigned redo = 0u;
  {
    int k = 0;
    for (int item = obid(); item < 1280; item += gridDim.x, ++k) {
      bool bad;
      if (item < 768) bad = attn_mla_split(p, layer, item, lds);
      else bad = attn_dense_item<false, false, 2>(p, layer, item - 768, lam_full, lam_init, lds);
      redo |= bad ? (1u << k) : 0u;
    }
  }
  redo = __builtin_amdgcn_readfirstlane(redo);
  if (redo) {
    int k = 0;
    for (int item = obid(); item < 1280; item += gridDim.x, ++k) {
      if (!((redo >> k) & 1u)) continue;
      if (item < 768) attn_dense_item<true, true, 1>(p, layer, item, lam_full, lam_init, lds);
      else {
        const int j = item - 768, o = (j / 64) * 128 + ((j / 16) & 3) * 32 + 2 * (j & 15);
        attn_dense_item<false, true, 1>(p, layer, o, lam_full, lam_init, lds);
        attn_dense_item<false, true, 1>(p, layer, o + 1, lam_full, lam_init, lds);
      }
    }
  }
  for (int i = obid() * 512 + otid(p.wave); i < T_ALL * 48; i += gridDim.x * 512) {
    const int t = i / 48, c = i % 48, head = c >> 3;
    const float l0 = p.dillse[((size_t)0 * T_ALL + t) * 6 + head];
    const float l1 = p.dillse[((size_t)1 * T_ALL + t) * 6 + head];
    const float l2 = p.dillse[((size_t)2 * T_ALL + t) * 6 + head];
    const float mx = fmaxf(l0, fmaxf(l1, l2));
    float w0 = fexp2(l0 - mx), w1 = fexp2(l1 - mx), w2 = fexp2(l2 - mx);
    const float inv = 1.f / (w0 + w1 + w2);
    w0 *= inv; w1 *= inv; w2 *= inv;
    const uint4 a = *(const uint4*)(p.dilo + ((size_t)0 * T_ALL + t) * 384 + c * 8);
    const uint4 bq = *(const uint4*)(p.dilo + ((size_t)1 * T_ALL + t) * 384 + c * 8);
    const uint4 cq = *(const uint4*)(p.dilo + ((size_t)2 * T_ALL + t) * 384 + c * 8);
    uint4 o;
    o.x = pack2(w0 * bflo(a.x) + w1 * bflo(bq.x) + w2 * bflo(cq.x), w0 * bfhi(a.x) + w1 * bfhi(bq.x) + w2 * bfhi(cq.x));
    o.y = pack2(w0 * bflo(a.y) + w1 * bflo(bq.y) + w2 * bflo(cq.y), w0 * bfhi(a.y) + w1 * bfhi(bq.y) + w2 * bfhi(cq.y));
    o.z = pack2(w0 * bflo(a.z) + w1 * bflo(bq.z) + w2 * bflo(cq.z), w0 * bfhi(a.z) + w1 * bfhi(bq.z) + w2 * bfhi(cq.z));
    o.w = pack2(w0 * bflo(a.w) + w1 * bflo(bq.w) + w2 * bflo(cq.w), w0 * bfhi(a.w) + w1 * bfhi(bq.w) + w2 * bfhi(cq.w));
    *(uint4*)(p.cat + (size_t)t * 1024 + 640 + c * 8) = o;
  }
}
DI void phase_outproj(const Params& p, int layer, char* lds) {
  EpiOut E; E.xb = p.xb; E.ybuf = p.ybuf; E.stats = p.stats;
  run_gemm(p.wave, p.cat, p.woT + (size_t)layer * DM * DM, DM, DM, E, lds);
}
DI void phase_ln1(const Params& p, int layer, char* lds) {
  const int tid = otid(p.wave), lane = tid & 63, wave = tid >> 6;
  const float* g1 = p.in[9] + layer * 1024 + lane * 16;
  const float* b1 = p.in[10] + layer * 1024 + lane * 16;
  float gg[16], bb[16];
#pragma unroll
  for (int q = 0; q < 4; ++q) {
    const float4 a = *(const float4*)(g1 + 4 * q), b = *(const float4*)(b1 + 4 * q);
    gg[4 * q] = a.x; gg[4 * q + 1] = a.y; gg[4 * q + 2] = a.z; gg[4 * q + 3] = a.w;
    bb[4 * q] = b.x; bb[4 * q + 1] = b.y; bb[4 * q + 2] = b.z; bb[4 * q + 3] = b.w;
  }
  for (int t = obid() * 8 + wave; t < T_ALL; t += gridDim.x * 8) {
    const uint4* yp = (const uint4*)(p.ybuf + (size_t)t * 1024 + lane * 16);
    const uint4 v0 = yp[0], v1 = yp[1];
    float pv = (lane < 32) ? p.stats[(size_t)t * 32 + lane] : 0.f;
    pv += __shfl_xor(pv, 8); pv += __shfl_xor(pv, 4); pv += __shfl_xor(pv, 2); pv += __shfl_xor(pv, 1);
    const float mean = __shfl(pv, 0) * (1.f / 1024.f);
    const float rstd = rsqrtf(fmaxf(__shfl(pv, 16) * (1.f / 1024.f) - mean * mean, 0.f) + 1e-5f);
    const float y[16] = {bflo(v0.x), bfhi(v0.x), bflo(v0.y), bfhi(v0.y), bflo(v0.z), bfhi(v0.z), bflo(v0.w), bfhi(v0.w),
                         bflo(v1.x), bfhi(v1.x), bflo(v1.y), bfhi(v1.y), bflo(v1.z), bfhi(v1.z), bflo(v1.w), bfhi(v1.w)};
    float o[16];
#pragma unroll
    for (int e = 0; e < 16; ++e) o[e] = (y[e] - mean) * rstd * gg[e] + bb[e];
    uint4 w0, w1;
    w0.x = pack2(o[0], o[1]); w0.y = pack2(o[2], o[3]); w0.z = pack2(o[4], o[5]); w0.w = pack2(o[6], o[7]);
    w1.x = pack2(o[8], o[9]); w1.y = pack2(o[10], o[11]); w1.z = pack2(o[12], o[13]); w1.w = pack2(o[14], o[15]);
    uint4* xp = (uint4*)(p.x1 + (size_t)t * 1024 + lane * 16);
    xp[0] = w0; xp[1] = w1;
  }
}
DI void phase_qgemm(const Params& p, int layer, char* lds) {
  EpiQ E; E.qbuf = p.qbuf;
  run_gemm(p.wave, p.x1, p.wqT + (size_t)layer * 2048 * DM, 2048, DM, E, lds);
}

template <int P0>
DI void ins_from(float (&L)[16], float v) {
#pragma unroll
  for (int k = 15; k > P0; --k) L[k] = __builtin_amdgcn_fmed3f(v, L[k - 1], L[k]);
  L[P0] = fmaxf(L[P0], v);
}
template <int I, int J>
DI void cand_row(float (&C)[16], const float (&A)[16], const float (&B)[16]) {
  if constexpr ((I + 1) * (J + 1) <= 16) {
    const float sm = A[I] + B[J];
    const float v = __uint_as_float((__float_as_uint(sm) & ~255u) | (unsigned)(255 - (I * 16 + J)));
    ins_from<(I + 1) * (J + 1) - 1>(C, v);
    cand_row<I, J + 1>(C, A, B);
  }
}
template <int I>
DI void cand_all(float (&C)[16], const float (&A)[16], const float (&B)[16]) {
  if constexpr (I < 16) { cand_row<I, 0>(C, A, B); cand_all<I + 1>(C, A, B); }
}
DI void ins16(float (&L)[16], float v) {
#pragma unroll
  for (int k = 15; k >= 1; --k) L[k] = __builtin_amdgcn_fmed3f(v, L[k - 1], L[k]);
  L[0] = fmaxf(L[0], v);
}
constexpr int QS_STR = 528;

DI void phase_peer_route(const Params& p, int layer, char* lds) {
  const int tid = otid(p.wave), lane = tid & 63, wave = tid >> 6;
  const int r = lane & 31, hh = lane >> 5;
  char* Qs = lds;
  unsigned* Ls = (unsigned*)(lds + 128 * QS_STR);
  for (int item = obid(); item < 2048; item += gridDim.x) {
    const int mt = item >> 3, head = item & 7;
#pragma unroll
    for (int e = 0; e < 8; ++e) {
      const int c = tid + e * 512, row = c >> 5, ch = c & 31;
      *(uint4*)(Qs + row * QS_STR + ch * 16) = *(const uint4*)(p.qbuf + (size_t)(mt * 128 + row) * 2048 + head * 256 + ch * 8);
    }
    __syncthreads();
    {
      const int pp = wave >> 2, tg = wave & 3;
      bf16x8 Bq[8];
      const char* qrow = Qs + (tg * 32 + r) * QS_STR + (pp * 128 + hh * 8) * 2;
#pragma unroll
      for (int s = 0; s < 8; ++s) Bq[s] = *(const bf16x8*)(qrow + s * 32);
      const u16* kbase = p.keysb + ((size_t)(layer * 16 + head * 2 + pp) * 128) * 128;
      float Lst[16];
#pragma unroll
      for (int k = 0; k < 16; ++k) Lst[k] = -3.0e38f;
#pragma unroll
      for (int kt = 0; kt < 4; ++kt) {
        f32x16 S;
#pragma unroll
        for (int e = 0; e < 16; ++e) S[e] = 0.f;
        const u16* krow = kbase + (size_t)(kt * 32 + r) * 128 + hh * 8;
#pragma unroll
        for (int s = 0; s < 8; ++s) S = MFMA(*(const bf16x8*)(krow + s * 16), Bq[s], S);
#pragma unroll
        for (int e = 0; e < 16; ++e) {
          const int kidx = kt * 32 + (e & 3) + 8 * (e >> 2) + 4 * hh;
          const float v = __uint_as_float((__float_as_uint(S[e]) & ~127u) | (unsigned)(127 - kidx));
          ins16(Lst, v);
        }
      }
      float Pl[16];
#pragma unroll
      for (int k = 0; k < 16; ++k) Pl[k] = __shfl_xor(Lst[k], 32);
#pragma unroll
      for (int k = 0; k < 16; ++k) ins16(Lst, Pl[k]);
      if (hh == 0) {
        unsigned* dst = Ls + ((tg * 32 + r) * 2 + pp) * 16;
#pragma unroll
        for (int k = 0; k < 16; ++k) dst[k] = __float_as_uint(Lst[k]);
      }
    }
    __syncthreads();
    if (tid < 128) {
      const unsigned* la = Ls + (tid * 2) * 16;
      float A[16], B[16];
#pragma unroll
      for (int k = 0; k < 16; ++k) { A[k] = __uint_as_float(la[k]); B[k] = __uint_as_float(la[16 + k]); }
      float C[16];
#pragma unroll
      for (int k = 0; k < 16; ++k) C[k] = -3.0e38f;
      cand_all<0>(C, A, B);
      const int t = mt * 128 + tid;
      float e[16], sum = 0.f;
#pragma unroll
      for (int k = 0; k < 16; ++k) { e[k] = __expf(C[k] - C[0]); sum += e[k]; }
      const float inv = 1.f / sum;
      int* ed = p.experts + (size_t)t * 128 + head * 16;
      float* gd = p.gates + (size_t)t * 128 + head * 16;
#pragma unroll
      for (int k = 0; k < 16; ++k) {
        const unsigned code = 255u - (__float_as_uint(C[k]) & 255u);
        const int i1 = 127 - (int)(la[code >> 4] & 127u);
        const int i2 = 127 - (int)(la[16 + (code & 15)] & 127u);
        ed[k] = i1 * 128 + i2;
        gd[k] = e[k] * inv;
      }
    }
    __syncthreads();
  }
}


DI float gelu_exact(float d) { return 0.5f * d * (1.f + erff(d * 0.70710678118654752f)); }

DI float row_allsum(float v) {
  v += __builtin_bit_cast(float, __builtin_amdgcn_update_dpp(0, __builtin_bit_cast(int, v), 0x128, 0xf, 0xf, false));
  v += __builtin_bit_cast(float, __builtin_amdgcn_update_dpp(0, __builtin_bit_cast(int, v), 0x124, 0xf, 0xf, false));
  v += __builtin_bit_cast(float, __builtin_amdgcn_update_dpp(0, __builtin_bit_cast(int, v), 0x122, 0xf, 0xf, false));
  v += __builtin_bit_cast(float, __builtin_amdgcn_update_dpp(0, __builtin_bit_cast(int, v), 0x121, 0xf, 0xf, false));
  return v;
}

DI void phase_peer_ffn(const Params& p, int layer, char* lds) {
  const int tid = otid(p.wave), lane = tid & 63, wave = tid >> 6, grp16 = lane >> 4, l16 = lane & 15;
  uint2* list = (uint2*)(lds + wave * 4096);
  float* dl = (float*)(lds + 32768 + wave * 2048);
  const float* g2 = p.in[15] + layer * 1024;
  const float* b2 = p.in[16] + layer * 1024;
  const unsigned char* ub = p.ub + (size_t)layer * NEXP * ROWB + l16 * 48;
  const unsigned char* vb = p.vb + (size_t)layer * NEXP * ROWB + l16 * 48;
  const float* us = p.us + layer * NEXP;
  const float* vs = p.vs + layer * NEXP;
  const unsigned ltmask16 = (1u << l16) - 1u;
  uint2* mylist = list + grp16 * 128;
  float* mydl = dl + grp16 * 128;
  for (int grp = obid() * 8 + wave; grp < T_ALL / 4; grp += gridDim.x * 8) {
    const int t = grp * 4 + grp16;
    {
      int ev[8]; unsigned gv[8];
      {
        const int4 e0 = *(const int4*)(p.experts + (size_t)t * 128 + l16 * 8);
        const int4 e1 = *(const int4*)(p.experts + (size_t)t * 128 + l16 * 8 + 4);
        const uint4 g0 = *(const uint4*)(p.gates + (size_t)t * 128 + l16 * 8);
        const uint4 g1 = *(const uint4*)(p.gates + (size_t)t * 128 + l16 * 8 + 4);
        ev[0] = e0.x; ev[1] = e0.y; ev[2] = e0.z; ev[3] = e0.w; ev[4] = e1.x; ev[5] = e1.y; ev[6] = e1.z; ev[7] = e1.w;
        gv[0] = g0.x; gv[1] = g0.y; gv[2] = g0.z; gv[3] = g0.w; gv[4] = g1.x; gv[5] = g1.y; gv[6] = g1.z; gv[7] = g1.w;
      }
      int pos[8];
#pragma unroll
      for (int s2 = 0; s2 < 8; ++s2) pos[s2] = 0;
      int running = 0;
#pragma unroll 1
      for (int b = 0; b < 16; ++b) {
#pragma unroll
        for (int s2 = 0; s2 < 8; ++s2) {
          const bool mt = (ev[s2] >> 10) == b;
          const unsigned m = (unsigned)(__ballot(mt) >> (grp16 * 16)) & 0xffffu;
          if (mt) pos[s2] = running + __popc(m & ltmask16);
          running += __popc(m);
        }
      }
#pragma unroll
      for (int s2 = 0; s2 < 8; ++s2) mylist[pos[s2]] = make_uint2((unsigned)ev[s2], gv[s2]);
    }
    __builtin_amdgcn_sched_barrier(0);
#define LD_ROW(buf, tab, i)                                                                     \
  {                                                                                             \
    const unsigned char* r_ = (tab) + (size_t)mylist[(i)].x * ROWB;                             \
    buf[0] = *(const uint4*)r_; buf[1] = *(const uint4*)(r_ + 16); buf[2] = *(const uint4*)(r_ + 32); \
  }
#define ROW_Q0(buf) ((u32x6){buf[0].x, buf[0].y, buf[0].z, buf[0].w, buf[1].x, buf[1].y})
#define ROW_Q1(buf) ((u32x6){buf[1].z, buf[1].w, buf[2].x, buf[2].y, buf[2].z, buf[2].w})
    {
      unsigned xw[32];
#pragma unroll
      for (int n = 0; n < 8; ++n) {
        const uint4 xa = *(const uint4*)(p.x1 + (size_t)t * 1024 + l16 * 64 + n * 8);
        xw[4 * n] = xa.x; xw[4 * n + 1] = xa.y; xw[4 * n + 2] = xa.z; xw[4 * n + 3] = xa.w;
      }
      uint4 r0[3], r1[3], r2[3], r3[3], r4[3], r5[3];
#define PASS1(buf, i)                                                                           \
  {                                                                                             \
    u32x16 u0_ = __builtin_bit_cast(u32x16, __builtin_amdgcn_cvt_scalef32_pk32_bf16_fp6(ROW_Q0(buf), 1.0f)); \
    u32x16 u1_ = __builtin_bit_cast(u32x16, __builtin_amdgcn_cvt_scalef32_pk32_bf16_fp6(ROW_Q1(buf), 1.0f)); \
    float da_ = 0.f, db_ = 0.f;                                                                 \
    _Pragma("unroll") for (int e = 0; e < 16; ++e) {                                            \
      unsigned wa_ = u0_[e], wb_ = u1_[e];                                                      \
      asm volatile("" : "+v"(wa_), "+v"(wb_));     \
      da_ = __builtin_amdgcn_fdot2_f32_bf16(__builtin_bit_cast(bf16x2_t, wa_), __builtin_bit_cast(bf16x2_t, xw[e]), da_, false); \
      db_ = __builtin_amdgcn_fdot2_f32_bf16(__builtin_bit_cast(bf16x2_t, wb_), __builtin_bit_cast(bf16x2_t, xw[16 + e]), db_, false); \
    }                                                                                           \
    const float d_ = row_allsum(da_ + db_);                                                     \
    if (l16 == 0) mydl[(i)] = d_;                                                               \
  }
      LD_ROW(r0, ub, 0) LD_ROW(r1, ub, 1) LD_ROW(r2, ub, 2) LD_ROW(r3, ub, 3) LD_ROW(r4, ub, 4)
#pragma unroll 1
      for (int i = 0; i < 126; i += 6) {
        LD_ROW(r5, ub, i + 5)
        PASS1(r0, i)
        LD_ROW(r0, ub, i + 6)
        PASS1(r1, i + 1)
        LD_ROW(r1, ub, i + 7)
        PASS1(r2, i + 2)
        LD_ROW(r2, ub, min(i + 8, 127))
        PASS1(r3, i + 3)
        LD_ROW(r3, ub, min(i + 9, 127))
        PASS1(r4, i + 4)
        LD_ROW(r4, ub, min(i + 10, 127))
        PASS1(r5, i + 5)
      }
      PASS1(r0, 126)
      PASS1(r1, 127)
    }
    __builtin_amdgcn_sched_barrier(0);
#pragma unroll 2
    for (int k = 0; k < 8; ++k) {
      const int idx = l16 + 16 * k;
      const uint2 en = mylist[idx];
      const float d = mydl[idx] * us[en.x];
      mylist[idx].y = __float_as_uint(__uint_as_float(en.y) * gelu_exact(d) * vs[en.x]);
    }
    __builtin_amdgcn_sched_barrier(0);
    {
      f32x2 acc[32];
#pragma unroll
      for (int e = 0; e < 32; ++e) { acc[e][0] = 0.f; acc[e][1] = 0.f; }
      uint4 r0[3], r1[3], r2[3], r3[3], r4[3], r5[3];
#define PASS2(buf, i)                                                                           \
  {                                                                                             \
    const float c_ = __uint_as_float(mylist[(i)].y);                                            \
    {                                                                                           \
      f32x32 v0_ = __builtin_amdgcn_cvt_scalef32_pk32_f32_fp6(ROW_Q0(buf), 1.0f);               \
      asm volatile("" : "+v"(v0_));                                                             \
      _Pragma("unroll") for (int e = 0; e < 16; ++e) acc[e] = (f32x2){v0_[2 * e], v0_[2 * e + 1]} * c_ + acc[e]; \
    }                                                                                           \
    __builtin_amdgcn_sched_barrier(0);                                                          \
    {                                                                                           \
      f32x32 v1_ = __builtin_amdgcn_cvt_scalef32_pk32_f32_fp6(ROW_Q1(buf), 1.0f);               \
      asm volatile("" : "+v"(v1_));                                                             \
      _Pragma("unroll") for (int e = 0; e < 16; ++e) acc[16 + e] = (f32x2){v1_[2 * e], v1_[2 * e + 1]} * c_ + acc[16 + e]; \
    }                                                                                           \
    __builtin_amdgcn_sched_barrier(0);                                                          \
  }
      LD_ROW(r0, vb, 0) LD_ROW(r1, vb, 1) LD_ROW(r2, vb, 2) LD_ROW(r3, vb, 3) LD_ROW(r4, vb, 4)
#pragma unroll 1
      for (int i = 0; i < 126; i += 6) {
        LD_ROW(r5, vb, i + 5)
        PASS2(r0, i)
        LD_ROW(r0, vb, i + 6)
        PASS2(r1, i + 1)
        LD_ROW(r1, vb, i + 7)
        PASS2(r2, i + 2)
        LD_ROW(r2, vb, min(i + 8, 127))
        PASS2(r3, i + 3)
        LD_ROW(r3, vb, min(i + 9, 127))
        PASS2(r4, i + 4)
        LD_ROW(r4, vb, min(i + 10, 127))
        PASS2(r5, i + 5)
      }
      PASS2(r0, 126)
      PASS2(r1, 127)
      float sm = 0.f;
#pragma unroll
      for (int n = 0; n < 8; ++n) {
        const uint4 xa = *(const uint4*)(p.x1 + (size_t)t * 1024 + l16 * 64 + n * 8);
        const unsigned xq[4] = {xa.x, xa.y, xa.z, xa.w};
#pragma unroll
        for (int e = 0; e < 4; ++e) {
          acc[4 * n + e][0] = ALPHA * bflo(xq[e]) + acc[4 * n + e][0];
          acc[4 * n + e][1] = ALPHA * bfhi(xq[e]) + acc[4 * n + e][1];
          sm += acc[4 * n + e][0] + acc[4 * n + e][1];
        }
      }
      const float mean = row_allsum(sm) * (1.f / 1024.f);
      float vsum = 0.f;
#pragma unroll
      for (int e = 0; e < 32; ++e) {
        acc[e][0] -= mean; acc[e][1] -= mean;
        vsum += acc[e][0] * acc[e][0] + acc[e][1] * acc[e][1];
      }
      const float rstd = rsqrtf(row_allsum(vsum) * (1.f / 1024.f) + 1e-5f);
#pragma unroll
      for (int n = 0; n < 4; ++n) {
        const int d0 = l16 * 64 + n * 16;
        float o[16];
#pragma unroll
        for (int q = 0; q < 4; ++q) {
          const float4 gg = *(const float4*)(g2 + d0 + 4 * q);
          const float4 bb = *(const float4*)(b2 + d0 + 4 * q);
          o[4 * q + 0] = acc[8 * n + 2 * q][0] * rstd * gg.x + bb.x;
          o[4 * q + 1] = acc[8 * n + 2 * q][1] * rstd * gg.y + bb.y;
          o[4 * q + 2] = acc[8 * n + 2 * q + 1][0] * rstd * gg.z + bb.z;
          o[4 * q + 3] = acc[8 * n + 2 * q + 1][1] * rstd * gg.w + bb.w;
        }
        if (layer == 1) {
          float4* oa = (float4*)(p.out + (size_t)t * 1024 + d0);
          oa[0] = make_float4(o[0], o[1], o[2], o[3]); oa[1] = make_float4(o[4], o[5], o[6], o[7]);
          oa[2] = make_float4(o[8], o[9], o[10], o[11]); oa[3] = make_float4(o[12], o[13], o[14], o[15]);
        } else {
          uint4 w0, w1;
          w0.x = pack2(o[0], o[1]); w0.y = pack2(o[2], o[3]); w0.z = pack2(o[4], o[5]); w0.w = pack2(o[6], o[7]);
          w1.x = pack2(o[8], o[9]); w1.y = pack2(o[10], o[11]); w1.z = pack2(o[12], o[13]); w1.w = pack2(o[14], o[15]);
          *(uint4*)(p.xb + (size_t)t * 1024 + d0) = w0;
          *(uint4*)(p.xb + (size_t)t * 1024 + d0 + 8) = w1;
        }
        __builtin_amdgcn_sched_barrier(0);
      }
    }
  }
}

#define XB_TMO      128
#define XB_XCNT(j)  (256  + 64 * (j))
#define XB_XSUB(j)  (1280 + 64 * (j))
#define XB_XGEN(j)  (2304 + 64 * (j))
#define XB_TOP      3328
#define XB_TOPGEN   3392
#define XCD_BAR_WORDS 3456
#define XB_SPIN_CAP (1u << 22)
#define LAS __attribute__((address_space(3)))
DI unsigned xb_ld(unsigned* p) { return __hip_atomic_load(p, __ATOMIC_RELAXED, __HIP_MEMORY_SCOPE_AGENT); }
DI unsigned xb_add(unsigned* p, unsigned v) { return __hip_atomic_fetch_add(p, v, __ATOMIC_RELAXED, __HIP_MEMORY_SCOPE_AGENT); }
DI unsigned xb_xcc_id() { return (unsigned)__builtin_amdgcn_s_getreg((3 << 11) | 20) & 0xFu; }
#define XB_SPIN(cond, bar) do { unsigned _sp = 0; while (cond) { __builtin_amdgcn_s_sleep(1); \
    if ((++_sp & 255u) == 0u) { if (xb_ld(&(bar)[XB_TMO])) break; if (_sp > XB_SPIN_CAP) { atomicAdd(&(bar)[XB_TMO], 1u); break; } } } } while (0)
struct XcdBarrier { unsigned* bar; unsigned x; volatile LAS unsigned* st; };
DI XcdBarrier xcd_barrier_post(unsigned* bar, volatile LAS unsigned* st, bool leader) {
  XcdBarrier b; b.bar = bar; b.x = xb_xcc_id(); b.st = st;
  if (leader) (void)xb_add(&bar[XB_XCNT(b.x)], 1u);
  return b;
}
DI void xcd_barrier_complete(unsigned* bar, unsigned x, unsigned& nloc, unsigned& nx) {
  const unsigned G = gridDim.x;
  unsigned sum, cnt, mine, sp = 0u;
  for (;;) {
    sum = 0u; cnt = 0u; mine = 0u;
#pragma unroll
    for (unsigned j = 0; j < 16; ++j) { const unsigned c = xb_ld(&bar[XB_XCNT(j)]); sum += c; cnt += (c > 0u) ? 1u : 0u; mine = (j == x) ? c : mine; }
    if (sum == G) break;
    __builtin_amdgcn_s_sleep(1);
    if ((++sp & 255u) == 0u) { if (xb_ld(&bar[XB_TMO])) break; if (sp > XB_SPIN_CAP) { atomicAdd(&bar[XB_TMO], 1u); break; } }
  }
  nloc = mine > 0u ? mine : 1u; nx = cnt > 0u ? cnt : 1u;
}
DI void xcd_barrier(const XcdBarrier& b, bool leader) {
  asm volatile("s_waitcnt vmcnt(0)" ::: "memory");
  __syncthreads();
  if (leader) {
    unsigned* bar = b.bar;
    __builtin_amdgcn_s_waitcnt(0);
    unsigned nloc = b.st[0], nx = b.st[1];
    if (nloc == 0u) { xcd_barrier_complete(bar, b.x, nloc, nx); b.st[0] = nloc; b.st[1] = nx; }
    const unsigned old = xb_add(&bar[XB_XSUB(b.x)], 1u);
    const unsigned gen = old / nloc;
    if (old + 1u == (gen + 1u) * nloc) {
      __builtin_amdgcn_fence(__ATOMIC_RELEASE, "agent");
      asm volatile("s_waitcnt vmcnt(0)" ::: "memory");
      const unsigned og = xb_add(&bar[XB_TOP], 1u);
      const unsigned tg = og / nx;
      if (og + 1u == (tg + 1u) * nx) xb_add(&bar[XB_TOPGEN], 1u);
      else XB_SPIN(xb_ld(&bar[XB_TOPGEN]) == tg, bar);
      __builtin_amdgcn_fence(__ATOMIC_ACQUIRE, "agent");
      xb_add(&bar[XB_XGEN(b.x)], 1u);
      asm volatile("s_waitcnt vmcnt(0)" ::: "memory");
    } else {
      XB_SPIN(xb_ld(&bar[XB_XGEN(b.x)]) == gen, bar);
      __builtin_amdgcn_fence(__ATOMIC_ACQUIRE, "agent");
      asm volatile("s_waitcnt vmcnt(0)" ::: "memory");
    }
  }
  __syncthreads();
}

#ifndef REP_SUB
#define REP_SUB -1
#endif
#ifndef REP_N
#define REP_N 0
#endif
constexpr int NSUB = 8;
constexpr int NPHASE = 1 + 2 * NSUB;
template <int PH>
DI void run_phase(const Params& p, char* lds) {
  if (PH == 0) {
    phase_prep(p, lds);
  } else {
    constexpr int layer = (PH - 1) / NSUB, sub = (PH - 1) % NSUB;
    if (sub == 0) phase_gemm1(p, layer, lds);
    else if (sub == 1) phase_up_dil(p, layer, lds);
    else if (sub == 2) phase_attn(p, layer, lds);
    else if (sub == 3) phase_outproj(p, layer, lds);
    else if (sub == 4) phase_ln1(p, layer, lds);
    else if (sub == 5) phase_qgemm(p, layer, lds);
    else if (sub == 6) phase_peer_route(p, layer, lds);
    else phase_peer_ffn(p, layer, lds);
  }
}
template <int PH>
DI void do_phase(const Params& p, int ph_lo, int ph_hi, char* lds, cg::grid_group& grid, const XcdBarrier& xb) {
  if (ph_lo <= PH && PH < ph_hi) {
    constexpr int extra = (REP_SUB == 8) ? (PH == 0 ? REP_N : 0) : ((REP_SUB >= 0 && PH > 0 && (PH - 1) % NSUB == REP_SUB) ? REP_N : 0);
#pragma unroll
    for (int rp = 0; rp < 1 + extra; ++rp) {
      run_phase<PH>(p, lds);
      if (rp < extra) xcd_barrier(xb, otid(p.wave) == 0);
    }
    if (PH + 1 < ph_hi) {
      if (PH == 0) grid.sync();
      else xcd_barrier(xb, otid(p.wave) == 0);
    }
  }
}
__global__ __launch_bounds__(512) void mega(Params p, int ph_lo, int ph_hi) {
  extern __shared__ __attribute__((aligned(16))) char lds[];
  cg::grid_group grid = cg::this_grid();
  p.wave = __builtin_amdgcn_readfirstlane(threadIdx.x >> 6);
  volatile LAS unsigned* st = (volatile LAS unsigned*)(LAS char*)(lds + 131072 + 1008);
  if (threadIdx.x == 0) { st[0] = 0u; st[1] = 0u; }
  __syncthreads();
  const XcdBarrier xb = xcd_barrier_post(p.bar, st, threadIdx.x == 0);
  do_phase<0>(p, ph_lo, ph_hi, lds, grid, xb);
  do_phase<1>(p, ph_lo, ph_hi, lds, grid, xb);
  do_phase<2>(p, ph_lo, ph_hi, lds, grid, xb);
  do_phase<3>(p, ph_lo, ph_hi, lds, grid, xb);
  do_phase<4>(p, ph_lo, ph_hi, lds, grid, xb);
  do_phase<5>(p, ph_lo, ph_hi, lds, grid, xb);
  do_phase<6>(p, ph_lo, ph_hi, lds, grid, xb);
  do_phase<7>(p, ph_lo, ph_hi, lds, grid, xb);
  do_phase<8>(p, ph_lo, ph_hi, lds, grid, xb);
  do_phase<9>(p, ph_lo, ph_hi, lds, grid, xb);
  do_phase<10>(p, ph_lo, ph_hi, lds, grid, xb);
  do_phase<11>(p, ph_lo, ph_hi, lds, grid, xb);
  do_phase<12>(p, ph_lo, ph_hi, lds, grid, xb);
  do_phase<13>(p, ph_lo, ph_hi, lds, grid, xb);
  do_phase<14>(p, ph_lo, ph_hi, lds, grid, xb);
  do_phase<15>(p, ph_lo, ph_hi, lds, grid, xb);
  do_phase<16>(p, ph_lo, ph_hi, lds, grid, xb);
}

extern "C" void kernel_launch(void* const* d_in, const int* in_sizes, int n_in, void* d_out, int out_size, void* d_ws,
                              size_t ws_size, hipStream_t stream) {
  Params p;
  memset(&p, 0, sizeof(p));
  for (int i = 0; i < 17; ++i) p.in[i] = (const float*)d_in[i];
  p.out = (float*)d_out;
  char* w = (char*)d_ws;
  size_t off = 0;
  auto alloc = [&](size_t bytes) { char* r = w + off; off += (bytes + 255) & ~(size_t)255; return r; };
  p.xb = (u16*)alloc((size_t)T_ALL * DM * 2);
  p.winT = (u16*)alloc((size_t)2 * NPAD * 1024 * 2);
  p.wupT = (u16*)alloc((size_t)2 * NUP * KUP * 2);
  p.woT = (u16*)alloc((size_t)2 * 1024 * 1024 * 2);
  p.wqT = (u16*)alloc((size_t)2 * 2048 * 1024 * 2);
  p.keysb = (u16*)alloc((size_t)2 * 16 * 128 * 128 * 2);
  p.ub = (unsigned char*)alloc((size_t)2 * NEXP * ROWB);
  p.vb = (unsigned char*)alloc((size_t)2 * NEXP * ROWB);
  p.us = (float*)alloc((size_t)2 * NEXP * 4);
  p.vs = (float*)alloc((size_t)2 * NEXP * 4);
  p.cs32 = (float2*)alloc((size_t)SEQ * 16 * 8);
  p.cs64 = (float2*)alloc((size_t)SEQ * 32 * 8);
  p.sumsq = (float*)alloc((size_t)T_ALL * 12 * 4);
  p.stats = (float*)alloc((size_t)T_ALL * 32 * 4);
  p.bar = (unsigned*)alloc((size_t)XCD_BAR_WORDS * 4);
  hipMemsetAsync(p.bar, 0, (size_t)XCD_BAR_WORDS * 4, stream);
  p.cat = (u16*)alloc((size_t)T_ALL * 1024 * 2);
  const size_t r1 = off;
  p.aq = (u16*)alloc((size_t)T_ALL * 256 * 2);
  p.ak = (u16*)alloc((size_t)T_ALL * 256 * 2);
  p.av = (u16*)alloc((size_t)T_ALL * 256 * 2);
  p.bc = (u16*)alloc((size_t)T_ALL * KUP * 2);
  p.bkr = (u16*)alloc((size_t)T_ALL * 32 * 2);
  p.cq = (u16*)alloc((size_t)T_ALL * 384 * 2);
  p.ck = (u16*)alloc((size_t)T_ALL * 384 * 2);
  p.cv = (u16*)alloc((size_t)T_ALL * 384 * 2);
  p.mq = (u16*)alloc((size_t)T_ALL * 576 * 2);
  p.mk = (u16*)alloc((size_t)T_ALL * 384 * 2);
  p.mv = (u16*)alloc((size_t)T_ALL * 384 * 2);
  off = r1;
  p.ybuf = (u16*)alloc((size_t)T_ALL * 1024 * 2);
  p.x1 = (u16*)alloc((size_t)T_ALL * 1024 * 2);
  p.experts = (int*)alloc((size_t)T_ALL * 128 * 4);
  p.gates = (float*)alloc((size_t)T_ALL * 128 * 4);
  p.qbuf = (u16*)d_out;
  p.dilo = (u16*)d_out;
  p.dillse = (float*)((char*)d_out + (size_t)3 * T_ALL * 384 * 2);

#ifdef MULTI_LAUNCH
  hipFuncSetAttribute((const void*)mega, hipFuncAttributeMaxDynamicSharedMemorySize, LDS_BYTES);
  for (int ph = 0; ph < NPHASE; ++ph) {
    hipLaunchKernelGGL(mega, dim3(256), dim3(512), LDS_BYTES, stream, p, ph, ph + 1);
  }
#else
  static int grid_blocks = 0;
  if (!grid_blocks) {
    int dev = 0, cus = 0, per_cu = 0;
    hipGetDevice(&dev);
    hipDeviceGetAttribute(&cus, hipDeviceAttributeMultiprocessorCount, dev);
    hipFuncSetAttribute((const void*)mega, hipFuncAttributeMaxDynamicSharedMemorySize, LDS_BYTES);
    hipOccupancyMaxActiveBlocksPerMultiprocessor(&per_cu, mega, 512, LDS_BYTES);
    if (per_cu > 1) per_cu = 1;
    grid_blocks = cus * per_cu;
  }
  int lo = 0, hi = NPHASE;
  void* args[] = {&p, &lo, &hi};
  hipError_t e = hipLaunchCooperativeKernel((void*)mega, dim3(grid_blocks), dim3(512), args, LDS_BYTES, stream);
  if (e != hipSuccess) fprintf(stderr, "cooperative launch failed: %s (grid %d)\n", hipGetErrorString(e), grid_blocks);
#endif
}
```

```cpp
#include <hip/hip_runtime.h>
#include <hip/hip_cooperative_groups.h>
#include <math.h>
#include <stdio.h>
#include <string.h>
namespace cg = cooperative_groups;

typedef unsigned short u16;
typedef short bf16x8 __attribute__((ext_vector_type(8)));
typedef short s16x4 __attribute__((ext_vector_type(4)));
typedef float f32x16 __attribute__((ext_vector_type(16)));
typedef float f32x2 __attribute__((ext_vector_type(2)));
typedef __bf16 bf16x2_t __attribute__((ext_vector_type(2)));

#define DI __device__ __forceinline__
#define MFMA(a, b, c) __builtin_amdgcn_mfma_f32_32x32x16_bf16((a), (b), (c), 0, 0, 0)

constexpr int T_ALL = 32768, SEQ = 4096, DM = 1024, INW = 2336, NEXP = 16384;
constexpr int NPAD = 2560;
constexpr int NUP = 1536, KUP = 384;
constexpr float LOG2E = 1.4426950408889634f;
constexpr float ALPHA = 1.41421356237309515f;

struct Params {
  const float* in[17];
  float* out;
  u16 *xb, *winT, *wupT, *woT, *wqT, *keysb;
  unsigned char *ub, *vb;
  float *us, *vs;
  float2 *cs32, *cs64;
  u16 *aq, *ak, *av, *bc, *bkr, *cq, *ck, *cv, *mq, *mk, *mv, *cat, *dilo;
  float* dillse;
  u16 *ybuf, *x1, *qbuf;
  int* experts;
  float* gates;
  float *sumsq, *stats;
  unsigned* bar;
  int wave, pad_;
};

DI int otid(int wave) { int lane; asm volatile("v_mbcnt_lo_u32_b32 %0, -1, 0\n\tv_mbcnt_hi_u32_b32 %0, -1, %0" : "=v"(lane)); asm volatile("" : "+s"(wave)); return (wave << 6) | lane; }
DI int obid() { int b = blockIdx.x; asm volatile("" : "+s"(b)); return b; }
DI unsigned pack2(float a, float b) {
  f32x2 v = {a, b};
  return __builtin_bit_cast(unsigned, __builtin_convertvector(v, bf16x2_t));
}
DI float bflo(unsigned w) { return __uint_as_float(w << 16); }
DI float bfhi(unsigned w) { return __uint_as_float(w & 0xffff0000u); }
DI float fexp2(float x) { return __builtin_amdgcn_exp2f(x); }
DI void store8(u16* dst, float a, float b, float c, float d) {
  uint2 v; v.x = pack2(a, b); v.y = pack2(c, d);
  *(uint2*)dst = v;
}
DI void store_tile(u16* dst, const f32x16& v, int hh) {
#pragma unroll
  for (int g = 0; g < 4; ++g) store8(dst + 8 * g + 4 * hh, v[4 * g], v[4 * g + 1], v[4 * g + 2], v[4 * g + 3]);
}
DI void rope32(f32x16& v, const float2* cs, int hh) {
#pragma unroll
  for (int g = 0; g < 2; ++g)
#pragma unroll
    for (int b = 0; b < 4; ++b) {
      float2 c = cs[8 * g + 4 * hh + b];
      float x1 = v[4 * g + b], x2 = v[4 * g + b + 8];
      v[4 * g + b] = x1 * c.x - x2 * c.y;
      v[4 * g + b + 8] = x2 * c.x + x1 * c.y;
    }
}
DI void rope64(f32x16& v0, f32x16& v1, const float2* cs, int hh) {
#pragma unroll
  for (int g = 0; g < 4; ++g)
#pragma unroll
    for (int b = 0; b < 4; ++b) {
      float2 c = cs[8 * g + 4 * hh + b];
      float x1 = v0[4 * g + b], x2 = v1[4 * g + b];
      v0[4 * g + b] = x1 * c.x - x2 * c.y;
      v1[4 * g + b] = x2 * c.x + x1 * c.y;
    }
}
DI float wave_sum(float v) {
#pragma unroll
  for (int o = 32; o; o >>= 1) v += __shfl_xor(v, o);
  return v;
}
DI s16x4 trread(const char* p) {
  return __builtin_amdgcn_ds_read_tr16_b64_v4i16((__attribute__((address_space(3))) s16x4*)(p));
}


constexpr int LDS_BYTES = 131072 + 1024;

namespace pg8 {
#define PG8_LAS __attribute__((address_space(3)))
typedef unsigned short bf16_t;
typedef float f32x4 __attribute__((ext_vector_type(4)));
constexpr int BM = 256, BK = 64, HALF = 128, HTB = HALF * BK * 2, STAGE_BYTES = 8 * HTB, NXCD = 8, WGM = 8;
__host__ __device__ __forceinline__ int lds_byte(int r, int c) { const int st = (r >> 4) * 2 + (c >> 5), rr = r & 15, cc = c & 31, ob = rr * 64 + cc * 2; return st * 1024 + (ob ^ (((ob >> 9) & 1) << 5)); }
__host__ __device__ __forceinline__ void stage_rc(int b, int& R, int& C) { const int st = b / 1024, sb = b % 1024, swz = sb ^ (((sb >> 9) & 1) << 5); R = (st >> 1) * 16 + swz / 64; C = (st & 1) * 32 + (swz % 64) / 2; }
__host__ __device__ __forceinline__ int perm32(int rho) { const int n = rho >> 4, i = rho & 15; return 8 * (i >> 2) + 4 * n + (i & 3); }
struct Unit { int pm, pn; };
struct Gemm { const bf16_t* A; const bf16_t* Bt; int M, N, K; };
struct StaticOrder {
    int nM, nN, nwg, G, c;
    __host__ __device__ void init(int M, int N, int G_, int c_) { nM = M / BM; nN = N / BM; nwg = nM * nN; G = G_; c = c_; }
    __host__ __device__ bool next(int i, Unit& u) const {
        const long L = (long)i * G + c; if (L >= nwg) return false;
        int wgid = (int)L; { const int q = nwg / NXCD, r = nwg % NXCD, xcd = wgid % NXCD, off = wgid / NXCD; wgid = (xcd < r ? xcd * (q + 1) : r * (q + 1) + (xcd - r) * q) + off; }
        const int nig = WGM * nN, gid = wgid / nig, fm = gid * WGM, gsz = (nM - fm) < WGM ? (nM - fm) : WGM;
        u.pm = fm + ((wgid % nig) % gsz); u.pn = (wgid % nig) / gsz; return true;
    }
    __device__ __forceinline__ void a_ready(const Unit&) const {}
    __device__ __forceinline__ void done(const Unit&) const {}
};
template <class Epi, class Sched>
__device__ __forceinline__ void gemm_phase(int wv, PG8_LAS unsigned char* lds, const Gemm g, const Sched& S, const Epi& E) {
    const int tid = otid(wv), wid = __builtin_amdgcn_readfirstlane(tid >> 6), lane = tid & 63, wr = wid >> 2, wc = wid & 3, fr = lane & 15, fq = lane >> 4;
    const int K = g.K, nt = K / BK;
    unsigned voffA[2], voffB[2];
#pragma unroll
    for (int i = 0; i < 2; ++i) { int R, C; stage_rc(tid * 16 + i * 8192, R, C); const int Rb = Epi::PERM ? ((R & ~31) + perm32(R & 31)) : R;
        voffA[i] = (unsigned)(R * K + C) * 2u; voffB[i] = (unsigned)(Rb * K + C) * 2u; }
    const size_t kstep = (size_t)(BK * 2);
    const size_t hstep = (size_t)HALF * K * 2;
    const size_t tstep = 2 * hstep;
    const unsigned ldsw = (unsigned)wid * 1024u;
    const int aoff = lds_byte(wr * 64 + fr, fq * 8), boff = lds_byte(wc * 32 + fr, fq * 8);
#define PG8_SA(b, h) (((b) * 2 + (h)) * HTB)
#define PG8_SB(b, h) ((4 + (b) * 2 + (h)) * HTB)
#define PG8_STAGE(bufoff, gbase, voff) do { _Pragma("unroll") for (int _i = 0; _i < 2; ++_i) \
        __builtin_amdgcn_global_load_lds((const unsigned*)((const char*)(gbase) + (voff)[_i]), (PG8_LAS unsigned*)(lds + (bufoff) + ldsw + _i * 8192), 16, 0, 0); } while (0)
#define PG8_LDA(dst, b, h) do { _Pragma("unroll") for (int m = 0; m < 4; ++m) _Pragma("unroll") for (int k = 0; k < 2; ++k) dst[m][k] = *(const PG8_LAS bf16x8*)(lds + PG8_SA(b, h) + aoff + m * 2048 + k * 1024); } while (0)
#define PG8_LDB(dst, b, h) do { _Pragma("unroll") for (int n = 0; n < 2; ++n) _Pragma("unroll") for (int k = 0; k < 2; ++k) dst[n][k] = *(const PG8_LAS bf16x8*)(lds + PG8_SB(b, h) + boff + n * 2048 + k * 1024); } while (0)
#define PG8_MMA(ai, bj, At, Bt) do { __builtin_amdgcn_s_setprio(1); _Pragma("unroll") for (int m = 0; m < 4; ++m) _Pragma("unroll") for (int n = 0; n < 2; ++n) _Pragma("unroll") for (int k = 0; k < 2; ++k) \
        acc[ai][bj][m][n] = __builtin_amdgcn_mfma_f32_16x16x32_bf16(Bt[n][k], At[m][k], acc[ai][bj][m][n], 0, 0, 0); __builtin_amdgcn_s_setprio(0); } while (0)
#define PG8_WAIT_V(n) asm volatile("s_waitcnt vmcnt(" #n ")" ::: "memory")
#define PG8_WAIT_L(n) asm volatile("s_waitcnt lgkmcnt(" #n ")" ::: "memory")
#define PG8_BAR __builtin_amdgcn_s_barrier()
#define PG8_SCHED __builtin_amdgcn_sched_barrier(0)
    Unit cur, nxt; int ui = 0;
    if (!S.next(0, cur)) return;
    f32x4 acc[2][2][4][2];
#pragma unroll
    for (int a = 0; a < 2; ++a)
#pragma unroll
        for (int b = 0; b < 2; ++b)
#pragma unroll
            for (int m = 0; m < 4; ++m)
#pragma unroll
                for (int n = 0; n < 2; ++n) acc[a][b][m][n] = (f32x4){0.f, 0.f, 0.f, 0.f};
    bf16x8 At[4][2], B0[2][2], B1[2][2];
    const char* cA = (const char*)g.A + (size_t)cur.pm * tstep; const char* cB = (const char*)g.Bt + (size_t)cur.pn * tstep;
    S.a_ready(cur);
    PG8_STAGE(PG8_SB(0, 0), cB, voffB); PG8_STAGE(PG8_SA(0, 0), cA, voffA); PG8_STAGE(PG8_SB(0, 1), cB + hstep, voffB); PG8_STAGE(PG8_SA(0, 1), cA + hstep, voffA);
    if (wr == 1) PG8_BAR;
    PG8_WAIT_V(4); PG8_BAR;
    PG8_STAGE(PG8_SB(1, 0), cB + kstep, voffB); PG8_STAGE(PG8_SA(1, 0), cA + kstep, voffA); PG8_STAGE(PG8_SB(1, 1), cB + hstep + kstep, voffB);
    PG8_WAIT_V(6); PG8_BAR;
    for (;;) {
        const bool has_next = S.next(ui + 1, nxt);
        const char* nA = has_next ? (const char*)g.A + (size_t)nxt.pm * tstep : cA; const char* nB = has_next ? (const char*)g.Bt + (size_t)nxt.pn * tstep : cB;
#pragma unroll 1
        for (int t = 0; t < nt; t += 2) {
            const bool last = (t == nt - 2);
            const char* a1 = cA + (size_t)(t + 1) * kstep;
            const char* a2 = last ? nA : cA + (size_t)(t + 2) * kstep; const char* b2 = last ? nB : cB + (size_t)(t + 2) * kstep;
            const char* a3 = a2 + kstep; const char* b3 = b2 + kstep;
            if (last && has_next) S.a_ready(nxt);
            PG8_LDB(B0, 0, 0); PG8_SCHED; PG8_LDA(At, 0, 0); PG8_STAGE(PG8_SA(1, 1), a1 + hstep, voffA);
            PG8_WAIT_L(8); PG8_BAR; PG8_WAIT_L(0); PG8_MMA(0, 0, At, B0); PG8_BAR; PG8_SCHED;
            PG8_LDB(B1, 0, 1); PG8_STAGE(PG8_SB(0, 0), b2, voffB);
            PG8_BAR; PG8_WAIT_L(0); PG8_MMA(0, 1, At, B1); PG8_BAR;
            PG8_LDA(At, 0, 1); PG8_STAGE(PG8_SA(0, 0), a2, voffA);
            PG8_BAR; PG8_WAIT_L(0); PG8_MMA(1, 0, At, B0); PG8_BAR; PG8_SCHED;
            PG8_STAGE(PG8_SB(0, 1), b2 + hstep, voffB);
            PG8_WAIT_V(6); PG8_BAR; PG8_MMA(1, 1, At, B1); PG8_BAR;
            PG8_LDB(B0, 1, 0); PG8_SCHED; PG8_LDA(At, 1, 0); PG8_STAGE(PG8_SA(0, 1), a2 + hstep, voffA);
            PG8_WAIT_L(8); PG8_BAR; PG8_WAIT_L(0); PG8_MMA(0, 0, At, B0); PG8_BAR; PG8_SCHED;
            PG8_LDB(B1, 1, 1); PG8_STAGE(PG8_SB(1, 0), b3, voffB);
            PG8_BAR; PG8_WAIT_L(0); PG8_MMA(0, 1, At, B1); PG8_BAR;
            PG8_LDA(At, 1, 1); PG8_STAGE(PG8_SA(1, 0), a3, voffA);
            PG8_BAR; PG8_WAIT_L(0); PG8_MMA(1, 0, At, B0); PG8_BAR; PG8_SCHED;
            PG8_STAGE(PG8_SB(1, 1), b3 + hstep, voffB);
            PG8_WAIT_V(6); PG8_BAR; PG8_MMA(1, 1, At, B1); PG8_BAR;
        }
        if constexpr (!Epi::AFTER_DRAIN) { E(acc, cur, wr, wc, fr, fq); S.done(cur); }
        if (!has_next) break;
#pragma unroll
        for (int a = 0; a < 2; ++a)
#pragma unroll
            for (int b = 0; b < 2; ++b)
#pragma unroll
                for (int m = 0; m < 4; ++m)
#pragma unroll
                    for (int n = 0; n < 2; ++n) acc[a][b][m][n] = (f32x4){0.f, 0.f, 0.f, 0.f};
        cur = nxt; cA = nA; cB = nB; ++ui;
    }
    PG8_WAIT_V(0);
    if (wr == 0) PG8_BAR;
    PG8_BAR;
    if constexpr (Epi::AFTER_DRAIN) { E.fused(acc, cur, wr, wc, fr, fq, lds, wid, lane); S.done(cur); }
#undef PG8_SA
#undef PG8_SB
#undef PG8_STAGE
#undef PG8_LDA
#undef PG8_LDB
#undef PG8_MMA
#undef PG8_WAIT_V
#undef PG8_WAIT_L
#undef PG8_BAR
#undef PG8_SCHED
}
}
using pg8::f32x4;
using pg8::Unit;

DI void convert_bf16(int wv, const float* __restrict__ src, u16* __restrict__ dst, size_t n8  ) {
  const size_t i0 = (size_t)obid() * 512 + otid(wv);
  for (size_t i = i0; i < n8; i += (size_t)gridDim.x * 512) {
    float4 a = ((const float4*)src)[2 * i], b = ((const float4*)src)[2 * i + 1];
    uint4 o; o.x = pack2(a.x, a.y); o.y = pack2(a.z, a.w); o.z = pack2(b.x, b.y); o.w = pack2(b.z, b.w);
    ((uint4*)dst)[i] = o;
  }
}
typedef float f32x32 __attribute__((ext_vector_type(32)));
typedef unsigned u32x6 __attribute__((ext_vector_type(6)));
typedef unsigned u32x16 __attribute__((ext_vector_type(16)));
typedef __bf16 bf16x32_t __attribute__((ext_vector_type(32)));
constexpr int ROWB = 768;
DI void convert_rows_fp6(int wv, const float* __restrict__ src, unsigned char* __restrict__ dst, float* __restrict__ inv_scale, int nrows) {
  const int tid = otid(wv), lane = tid & 63, wave = tid >> 6, g = lane & 31;
  for (int row = (obid() * 8 + wave) * 2 + (lane >> 5); row < nrows; row += gridDim.x * 16) {
    const float4* rp = (const float4*)(src + (size_t)row * 1024 + g * 32);
    float4 v[8];
#pragma unroll
    for (int i = 0; i < 8; ++i) v[i] = rp[i];
    float mx = 0.f;
#pragma unroll
    for (int i = 0; i < 8; ++i) mx = fmaxf(mx, fmaxf(fmaxf(fabsf(v[i].x), fabsf(v[i].y)), fmaxf(fabsf(v[i].z), fabsf(v[i].w))));
#pragma unroll
    for (int o = 16; o; o >>= 1) mx = fmaxf(mx, __shfl_xor(mx, o));
    const float sc = (mx > 0.f) ? 7.0f / mx : 1.f;
    unsigned long long lo = 0ull, mid = 0ull, hi = 0ull;
    u32x6 q;
    {
      const float xs[32] = {v[0].x, v[0].y, v[0].z, v[0].w, v[1].x, v[1].y, v[1].z, v[1].w, v[2].x, v[2].y, v[2].z, v[2].w, v[3].x, v[3].y, v[3].z, v[3].w,
                            v[4].x, v[4].y, v[4].z, v[4].w, v[5].x, v[5].y, v[5].z, v[5].w, v[6].x, v[6].y, v[6].z, v[6].w, v[7].x, v[7].y, v[7].z, v[7].w};
      unsigned code[32];
#pragma unroll
      for (int i = 0; i < 32; ++i) {
        const float a = fabsf(xs[i] * sc);
        float c = (a < 2.f) ? rintf(a * 8.f) : (a < 4.f ? 16.f + rintf((a - 2.f) * 4.f) : 24.f + rintf((a - 4.f) * 2.f));
        c = fminf(c, 31.f);
        code[i] = (unsigned)c | ((xs[i] < 0.f) ? 32u : 0u);
      }
#pragma unroll
      for (int h = 0; h < 2; ++h) {
        unsigned long long a0 = 0ull, a1 = 0ull;
#pragma unroll
        for (int i = 0; i < 16; ++i) {
          const int bit = 6 * i;
          const unsigned long long cv = code[16 * h + i];
          if (bit < 64) a0 |= cv << bit;
          if (bit + 6 > 64) a1 |= (bit >= 64) ? (cv << (bit - 64)) : (cv >> (64 - bit));
        }
        q[3 * h + 0] = (unsigned)a0; q[3 * h + 1] = (unsigned)(a0 >> 32); q[3 * h + 2] = (unsigned)a1;
      }
    }
    (void)lo; (void)mid; (void)hi;
    unsigned char* dp = dst + (size_t)row * ROWB + g * 24;
    *(uint2*)dp = make_uint2(q[0], q[1]);
    *(uint2*)(dp + 8) = make_uint2(q[2], q[3]);
    *(uint2*)(dp + 16) = make_uint2(q[4], q[5]);
    if (g == 0) inv_scale[row] = (mx > 0.f) ? mx * (1.f / 7.0f) : 1.f;
  }
}

DI int rope32_d(int pos) { return 4 * (pos >> 3) + (pos & 3) + 16 * ((pos >> 2) & 1); }
DI int map_gemm1(int np) {
  const int G = np >> 5, pos = np & 31;
  if (G < 8) return G * 32 + rope32_d(pos);
  if (G < 16) return 256 + (G - 8) * 32 + rope32_d(pos);
  if (G < 36) return G * 32 + pos;
  if (G == 36) return 1152 + rope32_d(pos);
  if (G == 37) return -1;
  if (G < 62) {
    const int hg = (G < 50) ? (G - 38) : (G - 50);
    const int base = (G < 50) ? 1184 : 1568;
    return base + (hg >> 1) * 64 + 16 * (hg & 1) + 4 * (pos >> 3) + (pos & 3) + 32 * ((pos >> 2) & 1);
  }
  if (G < 74) return 1952 + (G - 62) * 32 + pos;
  return -1;
}
DI int map_up(int np, int& which) {
  const int G = np >> 5, pos = np & 31;
  if (G < 18) { which = 0; const int head = G / 3, part = G % 3; return head * 96 + part * 32 + (part == 2 ? rope32_d(pos) : pos); }
  if (G < 42) { which = 1; return (G - 18) * 32 + pos; }
  which = -1; return -1;
}
DI void transpose_tile(const Params& p, int layer, int mode, u16* __restrict__ dst, int ldd, int nt, int kt, float* tile) {
  const int tid = otid(p.wave);
  const int n0 = nt * 64, k0 = kt * 64;
#pragma unroll
  for (int pass = 0; pass < 2; ++pass) {
    const int kk = (tid >> 4) + pass * 32, nn = (tid & 15) * 4;
    const int np = n0 + nn;
    const float* src = nullptr; int nsrc = 0, col = -1, ksrc = k0 + kk; float sc = 1.f;
    if (mode == 0) {
      col = map_gemm1(np); src = p.in[1] + (size_t)layer * DM * INW; nsrc = INW;
      if (col >= 0 && col < 256) sc = 0.17677669529663687f * LOG2E;
      else if (col >= 1184 && col < 1568) sc = 0.125f * LOG2E;
    } else if (mode == 1) {
      int which; col = map_up(np, which);
      if (which == 0 && k0 < 256) { src = p.in[6] + (size_t)layer * 256 * 576; nsrc = 576; sc = 0.10206207261596575f * LOG2E * p.in[4][layer * 256 + ksrc]; }
      else if (which == 1 && k0 >= 256) { ksrc -= 256; src = p.in[7] + (size_t)layer * 128 * 768; nsrc = 768; sc = p.in[5][layer * 128 + ksrc]; }
      else col = -1;
    } else if (mode == 3) {
      col = np; src = p.in[8] + (size_t)layer * DM * DM; nsrc = DM;
    } else {
      col = np; src = p.in[11] + (size_t)layer * DM * 2048; nsrc = 2048;
    }
    float4 v = make_float4(0.f, 0.f, 0.f, 0.f);
    if (col >= 0) v = *(const float4*)(src + (size_t)ksrc * nsrc + col);
    tile[kk * 65 + nn + 0] = v.x * sc; tile[kk * 65 + nn + 1] = v.y * sc;
    tile[kk * 65 + nn + 2] = v.z * sc; tile[kk * 65 + nn + 3] = v.w * sc;
  }
  __syncthreads();
  {
    const int nn = tid >> 3, k8 = (tid & 7) * 8;
    float f[8];
#pragma unroll
    for (int e = 0; e < 8; ++e) f[e] = tile[(k8 + e) * 65 + nn];
    uint4 o; o.x = pack2(f[0], f[1]); o.y = pack2(f[2], f[3]); o.z = pack2(f[4], f[5]); o.w = pack2(f[6], f[7]);
    *(uint4*)(dst + (size_t)(n0 + nn) * ldd + k0 + k8) = o;
  }
  __syncthreads();
}

DI void phase_prep(const Params& p, char* lds) {
  convert_bf16(p.wave, p.in[0], p.xb, (size_t)T_ALL * DM / 8);
  convert_bf16(p.wave, p.in[12], p.keysb, (size_t)2 * 16 * 128 * 128 / 8);
  convert_rows_fp6(p.wave, p.in[13], p.ub, p.us, 2 * NEXP);
  convert_rows_fp6(p.wave, p.in[14], p.vb, p.vs, 2 * NEXP);
  for (int i = obid() * 512 + otid(p.wave); i < SEQ * 48; i += gridDim.x * 512) {
    int pos = i / 48, r = i % 48;
    if (r < 16) {
      float ang = (float)pos * expf(-logf(10000.0f) * (float)r / 16.f);
      p.cs32[pos * 16 + r] = make_float2(cosf(ang), sinf(ang));
    } else {
      int q = r - 16;
      float ang = (float)pos * expf(-logf(10000.0f) * (float)q / 32.f);
      p.cs64[pos * 32 + q] = make_float2(cosf(ang), sinf(ang));
    }
  }
  float* tile = (float*)lds;
  for (int u = obid(); u < 3104; u += gridDim.x) {
    const int layer = u / 1552, r = u % 1552;
    if (r < 640) transpose_tile(p, layer, 0, p.winT + (size_t)layer * NPAD * 1024, 1024, r / 16, r % 16, tile);
    else if (r < 784) { const int v = r - 640; transpose_tile(p, layer, 1, p.wupT + (size_t)layer * NUP * KUP, KUP, v / 6, v % 6, tile); }
    else if (r < 1040) { const int v = r - 784; transpose_tile(p, layer, 3, p.woT + (size_t)layer * DM * DM, 1024, v / 16, v % 16, tile); }
    else { const int v = r - 1040; transpose_tile(p, layer, 4, p.wqT + (size_t)layer * 2048 * DM, 1024, v / 16, v % 16, tile); }
  }
}

DI void store16(u16* dst, const f32x4& a, const f32x4& b) {
  uint4 w; w.x = pack2(a[0], a[1]); w.y = pack2(a[2], a[3]); w.z = pack2(b[0], b[1]); w.w = pack2(b[2], b[3]);
  *(uint4*)dst = w;
}
DI void rope4(f32x4& v0, f32x4& v1, const float2* cs) {
  const float4 c01 = *(const float4*)cs, c23 = *(const float4*)(cs + 2);
  const float co[4] = {c01.x, c01.z, c23.x, c23.z}, si[4] = {c01.y, c01.w, c23.y, c23.w};
#pragma unroll
  for (int k = 0; k < 4; ++k) {
    const float x1 = v0[k], x2 = v1[k];
    v0[k] = x1 * co[k] - x2 * si[k];
    v1[k] = x2 * co[k] + x1 * si[k];
  }
}
struct EpiGemm1 {
  static constexpr bool PERM = true, AFTER_DRAIN = false;
  u16 *aq, *ak, *av, *bc, *bkr, *cq, *ck, *cv; const float2 *cs32, *cs64; float* sumsq;
  DI void operator()(const f32x4 (&acc)[2][2][4][2], const Unit& u, int wr, int wc, int fr, int fq) const {
#pragma unroll
    for (int bj = 0; bj < 2; ++bj) {
      const int G = u.pn * 8 + bj * 4 + wc;
#pragma unroll
      for (int ai = 0; ai < 2; ++ai)
#pragma unroll
        for (int m = 0; m < 4; ++m) {
          const int t = u.pm * 256 + ai * 128 + wr * 64 + m * 16 + fr;
          const int b = t >> 12, s = t & 4095;
          f32x4 v0 = acc[ai][bj][m][0], v1 = acc[ai][bj][m][1];
          if (G < 16 || G == 36) {
            rope4(v0, v1, cs32 + s * 16 + 4 * fq);
            u16* dst = (G < 8) ? aq + ((size_t)(b * 8 + G) * SEQ + s) * 32
                     : (G < 16) ? ak + ((size_t)(b * 8 + G - 8) * SEQ + s) * 32 : bkr + (size_t)t * 32;
            store8(dst + 4 * fq, v0[0], v0[1], v0[2], v0[3]);
            store8(dst + 16 + 4 * fq, v1[0], v1[1], v1[2], v1[3]);
          } else if (G < 24) {
            store16(av + ((size_t)(b * 4 + ((G - 16) >> 1)) * SEQ + s) * 64 + ((G - 16) & 1) * 32 + 8 * fq, v0, v1);
          } else if (G < 36) {
            store16(bc + (size_t)t * KUP + (G - 24) * 32 + 8 * fq, v0, v1);
            float ps = v0[0] * v0[0] + v0[1] * v0[1] + v0[2] * v0[2] + v0[3] * v0[3] + v1[0] * v1[0] + v1[1] * v1[1] + v1[2] * v1[2] + v1[3] * v1[3];
            ps += __shfl_xor(ps, 16); ps += __shfl_xor(ps, 32);
            if (fq == 0) sumsq[(size_t)t * 12 + (G - 24)] = ps;
          } else if (G == 37) {
          } else if (G < 62) {
            const bool isq = G < 50; const int hg = G - (isq ? 38 : 50), head = hg >> 1, gsel = hg & 1;
            rope4(v0, v1, cs64 + s * 32 + 16 * gsel + 4 * fq);
            u16* dst = (isq ? cq : ck) + ((size_t)(b * 6 + head) * SEQ + s) * 64 + 16 * gsel + 4 * fq;
            store8(dst, v0[0], v0[1], v0[2], v0[3]);
            store8(dst + 32, v1[0], v1[1], v1[2], v1[3]);
          } else if (G < 74) {
            store16(cv + ((size_t)(b * 6 + ((G - 62) >> 1)) * SEQ + s) * 64 + ((G - 62) & 1) * 32 + 8 * fq, v0, v1);
          }
          __builtin_amdgcn_sched_barrier(0);
        }
    }
  }
};
struct EpiUp {
  static constexpr bool PERM = true, AFTER_DRAIN = false;
  u16 *mq, *mk, *mv; const float2* cs32; const float* sumsq;
  DI void operator()(const f32x4 (&acc)[2][2][4][2], const Unit& u, int wr, int wc, int fr, int fq) const {
#pragma unroll
    for (int ai = 0; ai < 2; ++ai)
#pragma unroll
      for (int m = 0; m < 4; ++m) {
        const int t = u.pm * 256 + ai * 128 + wr * 64 + m * 16 + fr;
        const int b = t >> 12, s = t & 4095;
        const float4 sa = *(const float4*)(sumsq + (size_t)t * 12), sb = *(const float4*)(sumsq + (size_t)t * 12 + 4), sc = *(const float4*)(sumsq + (size_t)t * 12 + 8);
        const float rq = rsqrtf((((sa.x + sa.y) + (sa.z + sa.w)) + ((sb.x + sb.y) + (sb.z + sb.w))) * (1.f / 256.f) + 1e-5f);
        const float rkv = rsqrtf(((sc.x + sc.y) + (sc.z + sc.w)) * (1.f / 128.f) + 1e-5f);
#pragma unroll
        for (int bj = 0; bj < 2; ++bj) {
          const int G = u.pn * 8 + bj * 4 + wc;
          f32x4 v0 = acc[ai][bj][m][0], v1 = acc[ai][bj][m][1];
          if (G < 18) {
            const int head = G / 3, part = G % 3;
            v0 *= rq; v1 *= rq;
            u16* dst = mq + ((size_t)(b * 6 + head) * SEQ + s) * 96;
            if (part < 2) store16(dst + part * 32 + 8 * fq, v0, v1);
            else {
              rope4(v0, v1, cs32 + s * 16 + 4 * fq);
              store8(dst + 64 + 4 * fq, v0[0], v0[1], v0[2], v0[3]);
              store8(dst + 80 + 4 * fq, v1[0], v1[1], v1[2], v1[3]);
            }
          } else if (G < 42) {
            const int g = G - 18, head = g >> 2, part = g & 3;
            v0 *= rkv; v1 *= rkv;
            store16((part < 2 ? mk : mv) + ((size_t)(b * 6 + head) * SEQ + s) * 64 + (part & 1) * 32 + 8 * fq, v0, v1);
          }
        }
        __builtin_amdgcn_sched_barrier(0);
      }
  }
};
struct EpiOut {
  static constexpr bool PERM = true, AFTER_DRAIN = false;
  const u16* xb; u16* ybuf; float* stats;
  DI void operator()(const f32x4 (&acc)[2][2][4][2], const Unit& u, int wr, int wc, int fr, int fq) const {
#pragma unroll
    for (int ai = 0; ai < 2; ++ai)
#pragma unroll
      for (int m = 0; m < 4; ++m) {
        const int t = u.pm * 256 + ai * 128 + wr * 64 + m * 16 + fr;
        float s1 = 0.f, s2 = 0.f;
#pragma unroll
        for (int bj = 0; bj < 2; ++bj) {
          const size_t off = (size_t)t * 1024 + u.pn * 256 + bj * 128 + wc * 32 + 8 * fq;
          const uint4 xv = *(const uint4*)(xb + off);
          f32x4 y0, y1;
          y0[0] = ALPHA * bflo(xv.x) + acc[ai][bj][m][0][0]; y0[1] = ALPHA * bfhi(xv.x) + acc[ai][bj][m][0][1];
          y0[2] = ALPHA * bflo(xv.y) + acc[ai][bj][m][0][2]; y0[3] = ALPHA * bfhi(xv.y) + acc[ai][bj][m][0][3];
          y1[0] = ALPHA * bflo(xv.z) + acc[ai][bj][m][1][0]; y1[1] = ALPHA * bfhi(xv.z) + acc[ai][bj][m][1][1];
          y1[2] = ALPHA * bflo(xv.w) + acc[ai][bj][m][1][2]; y1[3] = ALPHA * bfhi(xv.w) + acc[ai][bj][m][1][3];
          s1 += (y0[0] + y0[1]) + (y0[2] + y0[3]) + (y1[0] + y1[1]) + (y1[2] + y1[3]);
          s2 += y0[0] * y0[0] + y0[1] * y0[1] + y0[2] * y0[2] + y0[3] * y0[3] + y1[0] * y1[0] + y1[1] * y1[1] + y1[2] * y1[2] + y1[3] * y1[3];
          store16(ybuf + off, y0, y1);
        }
        s1 += __shfl_xor(s1, 16); s1 += __shfl_xor(s1, 32);
        s2 += __shfl_xor(s2, 16); s2 += __shfl_xor(s2, 32);
        if (fq == 0) { stats[(size_t)t * 32 + u.pn * 4 + wc] = s1; stats[(size_t)t * 32 + 16 + u.pn * 4 + wc] = s2; }
      }
  }
};
struct EpiQ {
  static constexpr bool PERM = true, AFTER_DRAIN = false;
  u16* qbuf;
  DI void operator()(const f32x4 (&acc)[2][2][4][2], const Unit& u, int wr, int wc, int fr, int fq) const {
#pragma unroll
    for (int ai = 0; ai < 2; ++ai)
#pragma unroll
      for (int m = 0; m < 4; ++m) {
        const int t = u.pm * 256 + ai * 128 + wr * 64 + m * 16 + fr;
#pragma unroll
        for (int bj = 0; bj < 2; ++bj)
          store16(qbuf + (size_t)t * 2048 + u.pn * 256 + bj * 128 + wc * 32 + 8 * fq, acc[ai][bj][m][0], acc[ai][bj][m][1]);
      }
  }
};
template <class Epi>
DI void run_gemm(int wv, const u16* A, const u16* Bt, int N, int K, const Epi& E, char* lds) {
  pg8::Gemm g; g.A = A; g.Bt = Bt; g.M = T_ALL; g.N = N; g.K = K;
  pg8::StaticOrder S; S.init(T_ALL, N, gridDim.x, obid());
  pg8::gemm_phase(wv, (PG8_LAS unsigned char*)lds, g, S, E);
  __syncthreads();
}
DI bf16x8 packP(const f32x16& S, int s2) {
  uint4 u;
  u.x = pack2(S[8 * s2 + 0], S[8 * s2 + 1]); u.y = pack2(S[8 * s2 + 2], S[8 * s2 + 3]);
  u.z = pack2(S[8 * s2 + 4], S[8 * s2 + 5]); u.w = pack2(S[8 * s2 + 6], S[8 * s2 + 7]);
  return __builtin_bit_cast(bf16x8, u);
}

DI float fadd_s(float a, float b) { float r; asm("v_add_f32 %0, %1, %2" : "=v"(r) : "v"(a), "v"(b)); return r; }
DI float exp_sum16(f32x16& S) {
#pragma unroll
  for (int e = 0; e < 16; ++e) S[e] = fexp2(S[e]);
  const float a0 = fadd_s(S[0], S[1]), a1 = fadd_s(S[2], S[3]), a2 = fadd_s(S[4], S[5]), a3 = fadd_s(S[6], S[7]);
  const float a4 = fadd_s(S[8], S[9]), a5 = fadd_s(S[10], S[11]), a6 = fadd_s(S[12], S[13]), a7 = fadd_s(S[14], S[15]);
  const float b0 = fadd_s(a0, a1), b1 = fadd_s(a2, a3), b2 = fadd_s(a4, a5), b3 = fadd_s(a6, a7);
  return fadd_s(fadd_s(b0, b1), fadd_s(b2, b3));
}
DI float max3f(float a, float b, float c) { return __builtin_fmaxf(__builtin_fmaxf(a, b), c); }
DI float max16(const f32x16& S) {
  const float a = max3f(S[0], S[1], S[2]), b = max3f(S[3], S[4], S[5]), c = max3f(S[6], S[7], S[8]);
  const float d = max3f(S[9], S[10], S[11]), e = max3f(S[12], S[13], S[14]);
  return max3f(max3f(a, b, c), max3f(d, e, S[15]), a);
}

template <bool MLA, bool SAFE, int NQ  >
DI bool attn_dense_item(const Params& p, int layer, int item, float lam_full, float lam_init, char* lds) {
  constexpr int NKT = MLA ? 1 : 2;
  constexpr int DK = MLA ? 96 : 32;
  constexpr int KSTR = MLA ? 208 : 80;
  constexpr int KB = 64 * KSTR;
  constexpr int STAGE = NKT * KB + 8192;
  constexpr int NKS = DK / 16;
  constexpr float THR = 8.f;
  const int tid = otid(p.wave), lane = tid & 63, wave = tid >> 6, r = lane & 31, hh = lane >> 5;
  const int strm = MLA ? 0 : (wave & 1);
  int b, head, q0;
  if (MLA) { b = item / 96; head = (item / 16) % 6; q0 = (item & 15) * 256 + wave * 32; }
  else if (NQ == 2) { b = item / 64; head = (item / 16) & 3; q0 = (item & 15) * 256 + (wave >> 1) * 64; }
  else { b = item / 128; head = (item / 32) & 3; q0 = (item & 31) * 128 + (wave >> 1) * 32; }
  const u16 *kg0, *kg1, *vg;
  bf16x8 Q[NQ][NKS];
  if (MLA) {
    const u16* qp = p.mq + ((size_t)(b * 6 + head) * SEQ + q0 + r) * 96 + hh * 8;
#pragma unroll
    for (int s = 0; s < NKS; ++s) Q[0][s] = *(const bf16x8*)(qp + s * 16);
    kg0 = p.mk + (size_t)(b * 6 + head) * SEQ * 64;
    kg1 = p.bkr + (size_t)b * SEQ * 32;
    vg = p.mv + (size_t)(b * 6 + head) * SEQ * 64;
  } else {
#pragma unroll
    for (int qi = 0; qi < NQ; ++qi) {
      const u16* qp = p.aq + ((size_t)(b * 8 + head * 2 + strm) * SEQ + q0 + qi * 32 + r) * 32 + hh * 8;
#pragma unroll
      for (int s = 0; s < NKS; ++s) Q[qi][s] = *(const bf16x8*)(qp + s * 16);
    }
    kg0 = p.ak + (size_t)(b * 8 + head * 2) * SEQ * 32;
    kg1 = p.ak + (size_t)(b * 8 + head * 2 + 1) * SEQ * 32;
    vg = p.av + (size_t)(b * 4 + head) * SEQ * 64;
  }
  f32x16 O[NQ][2];
  float mu[NQ], mt[NQ], l[NQ];
#pragma unroll
  for (int qi = 0; qi < NQ; ++qi) {
    l[qi] = 0.f;
#pragma unroll
    for (int e = 0; e < 16; ++e) { O[qi][0][e] = 0.f; O[qi][1][e] = 0.f; }
  }
  const int offk = MLA ? (tid >> 3) * 64 + (tid & 7) * 8 : ((tid & 255) >> 2) * 32 + (tid & 3) * 8;
  const int offp = (tid >> 2) * 32 + (tid & 3) * 8;
  const int offv = (tid >> 3) * 64 + (tid & 7) * 8;
  uint4 gk, gv, gp;
  auto gload = [&](int kt) {
    const int k0 = kt * 64;
    if (MLA) {
      gk = *(const uint4*)(kg0 + (size_t)k0 * 64 + offk);
      if (tid < 256) gp = *(const uint4*)(kg1 + (size_t)k0 * 32 + offp);
    } else {
      const u16* kb = (p.wave < 4) ? kg0 : kg1;
      gk = *(const uint4*)(kb + (size_t)k0 * 32 + offk);
    }
    gv = *(const uint4*)(vg + (size_t)k0 * 64 + offv);
  };
  auto swrite = [&](int sb) {
    char* base = lds + sb * STAGE;
    if (MLA) {
      *(uint4*)(base + (tid >> 3) * KSTR + (tid & 7) * 16) = gk;
      if (tid < 256) *(uint4*)(base + (tid >> 2) * KSTR + 128 + (tid & 3) * 16) = gp;
    } else {
      const int c = tid & 255;
      *(uint4*)(base + (tid >> 8) * KB + (c >> 2) * KSTR + (c & 3) * 16) = gk;
    }
    const int row = tid >> 3;
    *(uint4*)(base + NKT * KB + row * 128 + (((tid & 7) * 16) ^ (((row >> 1) & 1) << 6))) = gv;
  };
  const int tq = (lane & 15) >> 2, tp = lane & 3, tg1 = (lane >> 4) & 1, swz = (tq >> 1) & 1;
  const int voff = NKT * KB + (4 * hh + tq) * 128 + 32 * tg1 + 8 * tp;
  const int koff = strm * KB + r * KSTR + hh * 16;
#define VFRAG(i2, u, s2) ({ const char* a_ = vb + (32 * (u) + 16 * (s2)) * 128 + 64 * ((i2) ^ swz); \
    const s16x4 lo_ = trread(a_), hi_ = trread(a_ + 8 * 128); (bf16x8)__builtin_shufflevector(lo_, hi_, 0, 1, 2, 3, 4, 5, 6, 7); })
#define QXFRAG(m_) __builtin_bit_cast(bf16x8, make_uint4(hh == 0 ? (pack2(-(m_), 0.f) & 0xffffu) : 0u, 0u, 0u, 0u))

  gload(0); swrite(0);
  __syncthreads();
  bf16x8 QX[NQ];
  const bf16x8 KX = __builtin_bit_cast(bf16x8, make_uint4(hh == 0 ? 0x3F80u : 0u, 0u, 0u, 0u));
  {
    const char* kb_ = lds + koff;
#pragma unroll
    for (int qi = 0; qi < NQ; ++qi) {
      f32x16 A0 = (f32x16)(0.f), A1 = (f32x16)(0.f);
#pragma unroll
      for (int s = 0; s < NKS; ++s) { A0 = MFMA(*(const bf16x8*)(kb_ + s * 32), Q[qi][s], A0); A1 = MFMA(*(const bf16x8*)(kb_ + 32 * KSTR + s * 32), Q[qi][s], A1); }
      float mx = fmaxf(max16(A0), max16(A1));
      mx = fmaxf(mx, __shfl_xor(mx, 32));
      mu[qi] = bflo(pack2(mx, 0.f)); mt[qi] = mx;
      QX[qi] = QXFRAG(mu[qi]);
    }
  }
#pragma unroll 1
  for (int kt = 0; kt < 64; ++kt) {
    if (kt + 1 < 64) gload(kt + 1);
    const char* base = lds + (kt & 1) * STAGE;
    const char* vb = base + voff;
    bf16x8 KF[2][NKS];
    const char* kbs_ = base + koff;
    if (!SAFE) {
#pragma unroll
      for (int s = 0; s < NKS; ++s) { KF[0][s] = *(const bf16x8*)(kbs_ + s * 32); KF[1][s] = *(const bf16x8*)(kbs_ + 32 * KSTR + s * 32); }
    }
    if (SAFE) {
      bool need = false;
#pragma unroll
      for (int qi = 0; qi < NQ; ++qi) { mt[qi] = fmaxf(mt[qi], __shfl_xor(mt[qi], 32)); need = need || (mt[qi] > mu[qi] + THR); }
      if (__any(need)) {
#pragma unroll
        for (int qi = 0; qi < NQ; ++qi) {
          const float mn = bflo(pack2(fmaxf(mt[qi], mu[qi]), 0.f));
          const float al = fexp2(mu[qi] - mn);
          mu[qi] = mn; l[qi] *= al;
#pragma unroll
          for (int e = 0; e < 16; ++e) { O[qi][0][e] *= al; O[qi][1][e] *= al; }
          QX[qi] = QXFRAG(mu[qi]);
        }
      }
    }
    __builtin_amdgcn_sched_barrier(0);
#pragma unroll
    for (int qi = 0; qi < NQ; ++qi) {
      f32x16 A0, A1;
      __builtin_amdgcn_s_setprio(1);
      A0 = MFMA(KX, QX[qi], (f32x16)(0.f)); A1 = MFMA(KX, QX[qi], (f32x16)(0.f));
#pragma unroll
      for (int s = 0; s < NKS; ++s) {
        if (!SAFE) { A0 = MFMA(KF[0][s], Q[qi][s], A0); A1 = MFMA(KF[1][s], Q[qi][s], A1); }
        else { A0 = MFMA(*(const bf16x8*)(kbs_ + s * 32), Q[qi][s], A0); A1 = MFMA(*(const bf16x8*)(kbs_ + 32 * KSTR + s * 32), Q[qi][s], A1); }
      }
      __builtin_amdgcn_s_setprio(0);
      bf16x8 V0[2][2];
      if (!SAFE) {
#pragma unroll
        for (int i2 = 0; i2 < 2; ++i2)
#pragma unroll
          for (int s2 = 0; s2 < 2; ++s2) V0[i2][s2] = VFRAG(i2, 0, s2);
      }
      __builtin_amdgcn_sched_barrier(0);
      if (SAFE) mt[qi] = fmaxf(mt[qi], mu[qi] + fmaxf(max16(A0), max16(A1)));
      bf16x8 P0[2], P1[2];
      l[qi] += exp_sum16(A0);
      P0[0] = packP(A0, 0); P0[1] = packP(A0, 1);
      bf16x8 V1[2][2];
      if (!SAFE) {
#pragma unroll
        for (int i2 = 0; i2 < 2; ++i2)
#pragma unroll
          for (int s2 = 0; s2 < 2; ++s2) V1[i2][s2] = VFRAG(i2, 1, s2);
      }
      __builtin_amdgcn_sched_barrier(0);
#pragma unroll
      for (int i2 = 0; i2 < 2; ++i2)
#pragma unroll
        for (int s2 = 0; s2 < 2; ++s2) O[qi][i2] = MFMA(SAFE ? VFRAG(i2, 0, s2) : V0[i2][s2], P0[s2], O[qi][i2]);
      l[qi] += exp_sum16(A1);
      P1[0] = packP(A1, 0); P1[1] = packP(A1, 1);
      __builtin_amdgcn_sched_barrier(0);
#pragma unroll
      for (int i2 = 0; i2 < 2; ++i2)
#pragma unroll
        for (int s2 = 0; s2 < 2; ++s2) O[qi][i2] = MFMA(SAFE ? VFRAG(i2, 1, s2) : V1[i2][s2], P1[s2], O[qi][i2]);
      __builtin_amdgcn_sched_barrier(0);
    }
    if (kt + 1 < 64) swrite((kt + 1) & 1);
    __syncthreads();
  }
#undef VFRAG
#undef QXFRAG
  float lt[NQ];
  bool bad = false;
#pragma unroll
  for (int qi = 0; qi < NQ; ++qi) { lt[qi] = l[qi] + __shfl_xor(l[qi], 32); bad = bad || !(lt[qi] < 1.0e37f); }
  if (!SAFE) {
    if (__syncthreads_or(bad)) return true;
  }
  if (MLA) {
    const int t = b * SEQ + q0 + r;
    const float inv = 1.f / lt[0];
#pragma unroll
    for (int i2 = 0; i2 < 2; ++i2) {
#pragma unroll
      for (int e = 0; e < 16; ++e) O[0][i2][e] *= inv;
      store_tile(p.cat + (size_t)t * 1024 + 256 + head * 64 + i2 * 32, O[0][i2], hh);
    }
  } else {
    float* xch = (float*)lds + (((wave >> 1) * NQ) * 64 + lane) * 33;
    if (strm == 1) {
#pragma unroll
      for (int qi = 0; qi < NQ; ++qi) {
        const float sc = lam_full / lt[qi];
#pragma unroll
        for (int i2 = 0; i2 < 2; ++i2)
#pragma unroll
          for (int e = 0; e < 16; ++e) xch[qi * 64 * 33 + i2 * 16 + e] = O[qi][i2][e] * sc;
      }
    }
    __syncthreads();
    if (strm == 0) {
      const float* g = p.in[3] + layer * 64;
#pragma unroll
      for (int qi = 0; qi < NQ; ++qi) {
        const int t = b * SEQ + q0 + qi * 32 + r;
        const float inv1 = 1.f / lt[qi];
        float ss = 0.f;
#pragma unroll
        for (int i2 = 0; i2 < 2; ++i2)
#pragma unroll
          for (int e = 0; e < 16; ++e) {
            const float o = O[qi][i2][e] * inv1 - xch[qi * 64 * 33 + i2 * 16 + e];
            O[qi][i2][e] = o; ss += o * o;
          }
        ss += __shfl_xor(ss, 32);
        const float rn = rsqrtf(ss * (1.f / 64.f) + 1e-5f) * (1.f - lam_init);
#pragma unroll
        for (int i2 = 0; i2 < 2; ++i2) {
#pragma unroll
          for (int gq = 0; gq < 4; ++gq)
#pragma unroll
            for (int bq = 0; bq < 4; ++bq) O[qi][i2][4 * gq + bq] *= rn * g[i2 * 32 + 8 * gq + 4 * hh + bq];
          store_tile(p.cat + (size_t)t * 1024 + head * 64 + i2 * 32, O[qi][i2], hh);
        }
      }
    }
    __syncthreads();
  }
  return false;
}


DI bool attn_mla_split(const Params& p, int layer, int item, char* lds) {
  constexpr int KSTR = 208, KB = 64 * KSTR;
  const int tid = otid(p.wave), lane = tid & 63, wave = tid >> 6, r = lane & 31, hh = lane >> 5;
  const int qb = p.wave & 3, kh = p.wave >> 2;
  const int b = item / 96, head = (item / 16) % 6, q0 = (item & 15) * 256 + qb * 64;
  bf16x8 Q0[6], Q1[6];
  {
    const u16* qp = p.mq + ((size_t)(b * 6 + head) * SEQ + q0 + r) * 96 + hh * 8;
#pragma unroll
    for (int s = 0; s < 6; ++s) { Q0[s] = *(const bf16x8*)(qp + s * 16); Q1[s] = *(const bf16x8*)(qp + 32 * 96 + s * 16); }
  }
  f32x16 O00 = (f32x16)(0.f), O01 = (f32x16)(0.f), O10 = (f32x16)(0.f), O11 = (f32x16)(0.f);
  float l0 = 0.f, l1 = 0.f;
  const u16* kgp = p.mk + (size_t)(b * 6 + head) * SEQ * 64 + (tid >> 3) * 64 + (tid & 7) * 8;
  const u16* pgp = p.bkr + (size_t)b * SEQ * 32 + (tid >> 3) * 32 + (tid & 7) * 4;
  const u16* vgp = p.mv + (size_t)(b * 6 + head) * SEQ * 64 + (tid >> 3) * 64 + (tid & 7) * 8;
  char* kw = lds + (tid >> 3) * KSTR + (tid & 7) * 16;
  char* vw = lds + 2 * KB + (tid >> 3) * 128 + (((tid & 7) * 16) ^ ((((tid >> 3) >> 1) & 1) << 6));
  uint4 gk0, gv0, gk1, gv1; uint2 gp0, gp1;
#define LD_K(kt, S) { const int kt_ = (kt) < 63 ? (kt) : 63; gk##S = *(const uint4*)(kgp + (size_t)kt_ * 4096); }
#define LD_P(kt, S) { const int kt_ = (kt) < 63 ? (kt) : 63; gp##S = *(const uint2*)(pgp + (size_t)kt_ * 2048); }
#define LD_V(kt, S) { const int kt_ = (kt) < 63 ? (kt) : 63; gv##S = *(const uint4*)(vgp + (size_t)kt_ * 4096); }
#define SW_K(slot, S) *(uint4*)(kw + (slot) * KB) = gk##S;
#define SW_P(slot, S) *(uint2*)(kw + (slot) * KB + 128 - (tid & 7) * 8) = gp##S;
#define SW_V(slot, S) *(uint4*)(vw + (slot) * 8192) = gv##S;
  const int tq = (lane & 15) >> 2, tp = lane & 3, tg1 = (lane >> 4) & 1, swz = (tq >> 1) & 1;
  const char* vb0 = lds + 2 * KB + (32 * kh + 4 * hh + tq) * 128 + 32 * tg1 + 8 * tp + 64 * swz;
  const char* vb1 = lds + 2 * KB + (32 * kh + 4 * hh + tq) * 128 + 32 * tg1 + 8 * tp + 64 * (swz ^ 1);
  const char* kb = lds + (32 * kh + r) * KSTR + hh * 16;
#define VFRX_(VS, i2, s2) ({ const char* a_ = ((i2) ? vb1 : vb0) + (VS) * 8192 + (16 * (s2)) * 128; \
    const s16x4 lo_ = trread(a_), hi_ = trread(a_ + 8 * 128); (bf16x8)__builtin_shufflevector(lo_, hi_, 0, 1, 2, 3, 4, 5, 6, 7); })
#define FEXP_(x) fexp2(x)
  LD_K(0, 0); LD_P(0, 0); LD_V(0, 0); LD_K(1, 1); LD_P(1, 1);
  SW_K(0, 0); SW_P(0, 0); SW_V(0, 0); SW_K(1, 1); SW_P(1, 1);
  LD_K(2, 1); LD_P(2, 1); LD_V(1, 1);
  __syncthreads();
  f32x16 A0 = (f32x16)(0.f), A1 = (f32x16)(0.f), B0, B1;
#pragma unroll
  for (int s = 0; s < 6; ++s) { const bf16x8 ko = *(const bf16x8*)(kb + s * 32); A0 = MFMA(ko, Q0[s], A0); A1 = MFMA(ko, Q1[s], A1); }
#pragma unroll 1
  for (int t = 0; t < 64; t += 2) {
#define KFR_(s) (*(const bf16x8*)(kb + 1 * KB + (s) * 32))
#define VFR_(i2, s2) VFRX_(0, i2, s2)
  const bf16x8 kf0_e = KFR_(0);
  const bf16x8 kf1_e = KFR_(1);
  __builtin_amdgcn_sched_barrier(0);
  B0 = MFMA(kf0_e, Q0[0], (f32x16)(0.f));
  A0[0] = FEXP_(A0[0]);
  A0[1] = FEXP_(A0[1]);
  __builtin_amdgcn_sched_barrier(0);
  B1 = MFMA(kf0_e, Q1[0], (f32x16)(0.f));
  const bf16x8 kf2_e = KFR_(2);
  A0[2] = FEXP_(A0[2]);
  A0[3] = FEXP_(A0[3]);
  const unsigned pw0_0_e = pack2(A0[0], A0[1]);
  const float t0_0_e = fadd_s(A0[0], A0[1]);
  SW_K(0, 1);
  __builtin_amdgcn_sched_barrier(0);
  B0 = MFMA(kf1_e, Q0[1], B0);
  const bf16x8 vf00_e = VFR_(0, 0);
  A0[4] = FEXP_(A0[4]);
  A0[5] = FEXP_(A0[5]);
  const unsigned pw0_1_e = pack2(A0[2], A0[3]);
  const float t0_1_e = fadd_s(A0[2], A0[3]);
  __builtin_amdgcn_sched_barrier(0);
  B1 = MFMA(kf1_e, Q1[1], B1);
  const bf16x8 vf10_e = VFR_(1, 0);
  A0[6] = FEXP_(A0[6]);
  A0[7] = FEXP_(A0[7]);
  const unsigned pw0_2_e = pack2(A0[4], A0[5]);
  const float t0_2_e = fadd_s(A0[4], A0[5]);
  const float s0_0_0_e = fadd_s(t0_0_e, t0_1_e);
  SW_P(0, 1);
  __builtin_amdgcn_sched_barrier(0);
  B0 = MFMA(kf2_e, Q0[2], B0);
  A1[0] = FEXP_(A1[0]);
  A1[1] = FEXP_(A1[1]);
  const unsigned pw0_3_e = pack2(A0[6], A0[7]);
  const bf16x8 P00_e = __builtin_bit_cast(bf16x8, make_uint4(pw0_0_e, pw0_1_e, pw0_2_e, pw0_3_e));
  const float t0_3_e = fadd_s(A0[6], A0[7]);
  __builtin_amdgcn_sched_barrier(0);
  O00 = MFMA(vf00_e, P00_e, O00);
  const bf16x8 kf3_e = KFR_(3);
  A1[2] = FEXP_(A1[2]);
  A1[3] = FEXP_(A1[3]);
  const unsigned pw1_0_e = pack2(A1[0], A1[1]);
  const float s0_0_1_e = fadd_s(t0_2_e, t0_3_e);
  const float t1_0_e = fadd_s(A1[0], A1[1]);
  SW_V(1, 1);
  __builtin_amdgcn_sched_barrier(0);
  O01 = MFMA(vf10_e, P00_e, O01);
  A1[4] = FEXP_(A1[4]);
  A1[5] = FEXP_(A1[5]);
  const unsigned pw1_1_e = pack2(A1[2], A1[3]);
  const float s0_1_0_e = fadd_s(s0_0_0_e, s0_0_1_e);
  const float t1_1_e = fadd_s(A1[2], A1[3]);
  __builtin_amdgcn_sched_barrier(0);
  B1 = MFMA(kf2_e, Q1[2], B1);
  A1[6] = FEXP_(A1[6]);
  A1[7] = FEXP_(A1[7]);
  const unsigned pw1_2_e = pack2(A1[4], A1[5]);
  const float t1_2_e = fadd_s(A1[4], A1[5]);
  const float s1_0_0_e = fadd_s(t1_0_e, t1_1_e);
  __builtin_amdgcn_sched_barrier(0);
  B0 = MFMA(kf3_e, Q0[3], B0);
  A0[8] = FEXP_(A0[8]);
  A0[9] = FEXP_(A0[9]);
  const unsigned pw1_3_e = pack2(A1[6], A1[7]);
  const bf16x8 P10_e = __builtin_bit_cast(bf16x8, make_uint4(pw1_0_e, pw1_1_e, pw1_2_e, pw1_3_e));
  const float t1_3_e = fadd_s(A1[6], A1[7]);
  __builtin_amdgcn_sched_barrier(0);
  O10 = MFMA(vf00_e, P10_e, O10);
  const bf16x8 kf4_e = KFR_(4);
  A0[10] = FEXP_(A0[10]);
  A0[11] = FEXP_(A0[11]);
  const unsigned pw0_4_e = pack2(A0[8], A0[9]);
  const float t0_4_e = fadd_s(A0[8], A0[9]);
  const float s1_0_1_e = fadd_s(t1_2_e, t1_3_e);
  __builtin_amdgcn_sched_barrier(0);
  O11 = MFMA(vf10_e, P10_e, O11);
  const bf16x8 vf01_e = VFR_(0, 1);
  A0[12] = FEXP_(A0[12]);
  A0[13] = FEXP_(A0[13]);
  const unsigned pw0_5_e = pack2(A0[10], A0[11]);
  const float t0_5_e = fadd_s(A0[10], A0[11]);
  const float s1_1_0_e = fadd_s(s1_0_0_e, s1_0_1_e);
  __builtin_amdgcn_sched_barrier(0);
  B1 = MFMA(kf3_e, Q1[3], B1);
  const bf16x8 vf11_e = VFR_(1, 1);
  A0[14] = FEXP_(A0[14]);
  A0[15] = FEXP_(A0[15]);
  const unsigned pw0_6_e = pack2(A0[12], A0[13]);
  const float t0_6_e = fadd_s(A0[12], A0[13]);
  const float s0_0_2_e = fadd_s(t0_4_e, t0_5_e);
  LD_K(t + 3, 0);
  __builtin_amdgcn_sched_barrier(0);
  B0 = MFMA(kf4_e, Q0[4], B0);
  A1[8] = FEXP_(A1[8]);
  A1[9] = FEXP_(A1[9]);
  const unsigned pw0_7_e = pack2(A0[14], A0[15]);
  const bf16x8 P01_e = __builtin_bit_cast(bf16x8, make_uint4(pw0_4_e, pw0_5_e, pw0_6_e, pw0_7_e));
  const float t0_7_e = fadd_s(A0[14], A0[15]);
  __builtin_amdgcn_sched_barrier(0);
  O00 = MFMA(vf01_e, P01_e, O00);
  const bf16x8 kf5_e = KFR_(5);
  A1[10] = FEXP_(A1[10]);
  A1[11] = FEXP_(A1[11]);
  const unsigned pw1_4_e = pack2(A1[8], A1[9]);
  const float s0_0_3_e = fadd_s(t0_6_e, t0_7_e);
  const float t1_4_e = fadd_s(A1[8], A1[9]);
  LD_P(t + 3, 0);
  __builtin_amdgcn_sched_barrier(0);
  O01 = MFMA(vf11_e, P01_e, O01);
  A1[12] = FEXP_(A1[12]);
  A1[13] = FEXP_(A1[13]);
  const unsigned pw1_5_e = pack2(A1[10], A1[11]);
  const float s0_1_1_e = fadd_s(s0_0_2_e, s0_0_3_e);
  const float t1_5_e = fadd_s(A1[10], A1[11]);
  __builtin_amdgcn_sched_barrier(0);
  B1 = MFMA(kf4_e, Q1[4], B1);
  A1[14] = FEXP_(A1[14]);
  A1[15] = FEXP_(A1[15]);
  const unsigned pw1_6_e = pack2(A1[12], A1[13]);
  const float s0_2_0_e = fadd_s(s0_1_0_e, s0_1_1_e);
  const float t1_6_e = fadd_s(A1[12], A1[13]);
  const float s1_0_2_e = fadd_s(t1_4_e, t1_5_e);
  LD_V(t + 2, 0);
  __builtin_amdgcn_sched_barrier(0);
  B0 = MFMA(kf5_e, Q0[5], B0);
  const unsigned pw1_7_e = pack2(A1[14], A1[15]);
  const bf16x8 P11_e = __builtin_bit_cast(bf16x8, make_uint4(pw1_4_e, pw1_5_e, pw1_6_e, pw1_7_e));
  l0 = fadd_s(l0, s0_2_0_e);
  const float t1_7_e = fadd_s(A1[14], A1[15]);
  __builtin_amdgcn_sched_barrier(0);
  O10 = MFMA(vf01_e, P11_e, O10);
  const float s1_0_3_e = fadd_s(t1_6_e, t1_7_e);
  __builtin_amdgcn_sched_barrier(0);
  O11 = MFMA(vf11_e, P11_e, O11);
  const float s1_1_1_e = fadd_s(s1_0_2_e, s1_0_3_e);
  __builtin_amdgcn_sched_barrier(0);
  B1 = MFMA(kf5_e, Q1[5], B1);
  const float s1_2_0_e = fadd_s(s1_1_0_e, s1_1_1_e);
  l1 = fadd_s(l1, s1_2_0_e);
  __builtin_amdgcn_sched_barrier(0);
#undef KFR_
#undef VFR_

    __syncthreads();
#define KFR_(s) (*(const bf16x8*)(kb + 0 * KB + (s) * 32))
#define VFR_(i2, s2) VFRX_(1, i2, s2)
  const bf16x8 kf0_o = KFR_(0);
  const bf16x8 kf1_o = KFR_(1);
  __builtin_amdgcn_sched_barrier(0);
  A0 = MFMA(kf0_o, Q0[0], (f32x16)(0.f));
  B0[0] = FEXP_(B0[0]);
  B0[1] = FEXP_(B0[1]);
  __builtin_amdgcn_sched_barrier(0);
  A1 = MFMA(kf0_o, Q1[0], (f32x16)(0.f));
  const bf16x8 kf2_o = KFR_(2);
  B0[2] = FEXP_(B0[2]);
  B0[3] = FEXP_(B0[3]);
  const unsigned pw0_0_o = pack2(B0[0], B0[1]);
  const float t0_0_o = fadd_s(B0[0], B0[1]);
  SW_K(1, 0);
  __builtin_amdgcn_sched_barrier(0);
  A0 = MFMA(kf1_o, Q0[1], A0);
  const bf16x8 vf00_o = VFR_(0, 0);
  B0[4] = FEXP_(B0[4]);
  B0[5] = FEXP_(B0[5]);
  const unsigned pw0_1_o = pack2(B0[2], B0[3]);
  const float t0_1_o = fadd_s(B0[2], B0[3]);
  __builtin_amdgcn_sched_barrier(0);
  A1 = MFMA(kf1_o, Q1[1], A1);
  const bf16x8 vf10_o = VFR_(1, 0);
  B0[6] = FEXP_(B0[6]);
  B0[7] = FEXP_(B0[7]);
  const unsigned pw0_2_o = pack2(B0[4], B0[5]);
  const float t0_2_o = fadd_s(B0[4], B0[5]);
  const float s0_0_0_o = fadd_s(t0_0_o, t0_1_o);
  SW_P(1, 0);
  __builtin_amdgcn_sched_barrier(0);
  A0 = MFMA(kf2_o, Q0[2], A0);
  B1[0] = FEXP_(B1[0]);
  B1[1] = FEXP_(B1[1]);
  const unsigned pw0_3_o = pack2(B0[6], B0[7]);
  const bf16x8 P00_o = __builtin_bit_cast(bf16x8, make_uint4(pw0_0_o, pw0_1_o, pw0_2_o, pw0_3_o));
  const float t0_3_o = fadd_s(B0[6], B0[7]);
  __builtin_amdgcn_sched_barrier(0);
  O00 = MFMA(vf00_o, P00_o, O00);
  const bf16x8 kf3_o = KFR_(3);
  B1[2] = FEXP_(B1[2]);
  B1[3] = FEXP_(B1[3]);
  const unsigned pw1_0_o = pack2(B1[0], B1[1]);
  const float s0_0_1_o = fadd_s(t0_2_o, t0_3_o);
  const float t1_0_o = fadd_s(B1[0], B1[1]);
  SW_V(0, 0);
  __builtin_amdgcn_sched_barrier(0);
  O01 = MFMA(vf10_o, P00_o, O01);
  B1[4] = FEXP_(B1[4]);
  B1[5] = FEXP_(B1[5]);
  const unsigned pw1_1_o = pack2(B1[2], B1[3]);
  const float s0_1_0_o = fadd_s(s0_0_0_o, s0_0_1_o);
  const float t1_1_o = fadd_s(B1[2], B1[3]);
  __builtin_amdgcn_sched_barrier(0);
  A1 = MFMA(kf2_o, Q1[2], A1);
  B1[6] = FEXP_(B1[6]);
  B1[7] = FEXP_(B1[7]);
  const unsigned pw1_2_o = pack2(B1[4], B1[5]);
  const float t1_2_o = fadd_s(B1[4], B1[5]);
  const float s1_0_0_o = fadd_s(t1_0_o, t1_1_o);
  __builtin_amdgcn_sched_barrier(0);
  A0 = MFMA(kf3_o, Q0[3], A0);
  B0[8] = FEXP_(B0[8]);
  B0[9] = FEXP_(B0[9]);
  const unsigned pw1_3_o = pack2(B1[6], B1[7]);
  const bf16x8 P10_o = __builtin_bit_cast(bf16x8, make_uint4(pw1_0_o, pw1_1_o, pw1_2_o, pw1_3_o));
  const float t1_3_o = fadd_s(B1[6], B1[7]);
  __builtin_amdgcn_sched_barrier(0);
  O10 = MFMA(vf00_o, P10_o, O10);
  const bf16x8 kf4_o = KFR_(4);
  B0[10] = FEXP_(B0[10]);
  B0[11] = FEXP_(B0[11]);
  const unsigned pw0_4_o = pack2(B0[8], B0[9]);
  const float t0_4_o = fadd_s(B0[8], B0[9]);
  const float s1_0_1_o = fadd_s(t1_2_o, t1_3_o);
  __builtin_amdgcn_sched_barrier(0);
  O11 = MFMA(vf10_o, P10_o, O11);
  const bf16x8 vf01_o = VFR_(0, 1);
  B0[12] = FEXP_(B0[12]);
  B0[13] = FEXP_(B0[13]);
  const unsigned pw0_5_o = pack2(B0[10], B0[11]);
  const float t0_5_o = fadd_s(B0[10], B0[11]);
  const float s1_1_0_o = fadd_s(s1_0_0_o, s1_0_1_o);
  __builtin_amdgcn_sched_barrier(0);
  A1 = MFMA(kf3_o, Q1[3], A1);
  const bf16x8 vf11_o = VFR_(1, 1);
  B0[14] = FEXP_(B0[14]);
  B0[15] = FEXP_(B0[15]);
  const unsigned pw0_6_o = pack2(B0[12], B0[13]);
  const float t0_6_o = fadd_s(B0[12], B0[13]);
  const float s0_0_2_o = fadd_s(t0_4_o, t0_5_o);
  LD_K(t + 4, 1);
  __builtin_amdgcn_sched_barrier(0);
  A0 = MFMA(kf4_o, Q0[4], A0);
  B1[8] = FEXP_(B1[8]);
  B1[9] = FEXP_(B1[9]);
  const unsigned pw0_7_o = pack2(B0[14], B0[15]);
  const bf16x8 P01_o = __builtin_bit_cast(bf16x8, make_uint4(pw0_4_o, pw0_5_o, pw0_6_o, pw0_7_o));
  const float t0_7_o = fadd_s(B0[14], B0[15]);
  __builtin_amdgcn_sched_barrier(0);
  O00 = MFMA(vf01_o, P01_o, O00);
  const bf16x8 kf5_o = KFR_(5);
  B1[10] = FEXP_(B1[10]);
  B1[11] = FEXP_(B1[11]);
  const unsigned pw1_4_o = pack2(B1[8], B1[9]);
  const float s0_0_3_o = fadd_s(t0_6_o, t0_7_o);
  const float t1_4_o = fadd_s(B1[8], B1[9]);
  LD_P(t + 4, 1);
  __builtin_amdgcn_sched_barrier(0);
  O01 = MFMA(vf11_o, P01_o, O01);
  B1[12] = FEXP_(B1[12]);
  B1[13] = FEXP_(B1[13]);
  const unsigned pw1_5_o = pack2(B1[10], B1[11]);
  const float s0_1_1_o = fadd_s(s0_0_2_o, s0_0_3_o);
  const float t1_5_o = fadd_s(B1[10], B1[11]);
  __builtin_amdgcn_sched_barrier(0);
  A1 = MFMA(kf4_o, Q1[4], A1);
  B1[14] = FEXP_(B1[14]);
  B1[15] = FEXP_(B1[15]);
  const unsigned pw1_6_o = pack2(B1[12], B1[13]);
  const float s0_2_0_o = fadd_s(s0_1_0_o, s0_1_1_o);
  const float t1_6_o = fadd_s(B1[12], B1[13]);
  const float s1_0_2_o = fadd_s(t1_4_o, t1_5_o);
  LD_V(t + 3, 1);
  __builtin_amdgcn_sched_barrier(0);
  A0 = MFMA(kf5_o, Q0[5], A0);
  const unsigned pw1_7_o = pack2(B1[14], B1[15]);
  const bf16x8 P11_o = __builtin_bit_cast(bf16x8, make_uint4(pw1_4_o, pw1_5_o, pw1_6_o, pw1_7_o));
  l0 = fadd_s(l0, s0_2_0_o);
  const float t1_7_o = fadd_s(B1[14], B1[15]);
  __builtin_amdgcn_sched_barrier(0);
  O10 = MFMA(vf01_o, P11_o, O10);
  const float s1_0_3_o = fadd_s(t1_6_o, t1_7_o);
  __builtin_amdgcn_sched_barrier(0);
  O11 = MFMA(vf11_o, P11_o, O11);
  const float s1_1_1_o = fadd_s(s1_0_2_o, s1_0_3_o);
  __builtin_amdgcn_sched_barrier(0);
  A1 = MFMA(kf5_o, Q1[5], A1);
  const float s1_2_0_o = fadd_s(s1_1_0_o, s1_1_1_o);
  l1 = fadd_s(l1, s1_2_0_o);
  __builtin_amdgcn_sched_barrier(0);
#undef KFR_
#undef VFR_

    __syncthreads();
  }
#undef LD_K
#undef LD_P
#undef LD_V
#undef SW_K
#undef SW_P
#undef SW_V
#undef VFRX_
#undef FEXP_
  float* xs = (float*)lds + (wave * 64 + lane) * 33;
  const float* xr = (const float*)lds + ((wave ^ 4) * 64 + lane) * 33;
  if (kh == 0) {
#pragma unroll
    for (int e = 0; e < 16; ++e) { xs[e] = O10[e]; xs[16 + e] = O11[e]; }
    xs[32] = l1;
  } else {
#pragma unroll
    for (int e = 0; e < 16; ++e) { xs[e] = O00[e]; xs[16 + e] = O01[e]; }
    xs[32] = l0;
  }
  __syncthreads();
  if (kh == 0) {
#pragma unroll
    for (int e = 0; e < 16; ++e) { O00[e] += xr[e]; O01[e] += xr[16 + e]; }
    l0 += xr[32];
  } else {
#pragma unroll
    for (int e = 0; e < 16; ++e) { O10[e] += xr[e]; O11[e] += xr[16 + e]; }
    l1 += xr[32];
  }
  const float lp = kh ? l1 : l0;
  const float lt = lp + __shfl_xor(lp, 32);
  if (__syncthreads_or(!(lt < 1.0e37f) || !(lt > 1.0e-30f))) return true;
  const int tok = b * SEQ + q0 + kh * 32 + r;
  const float inv = 1.f / lt;
  u16* dst = p.cat + (size_t)tok * 1024 + 256 + head * 64;
  if (kh == 0) {
#pragma unroll
    for (int e = 0; e < 16; ++e) { O00[e] *= inv; O01[e] *= inv; }
    store_tile(dst, O00, hh); store_tile(dst + 32, O01, hh);
  } else {
#pragma unroll
    for (int e = 0; e < 16; ++e) { O10[e] *= inv; O11[e] *= inv; }
    store_tile(dst, O10, hh); store_tile(dst + 32, O11, hh);
  }
  return false;
}

struct DilItem { int pair, bh, dil, L, cls, i0; };
DI DilItem dil_decode(int item) {
  DilItem d;
  d.pair = item / 768; const int rem = item % 768; d.bh = rem >> 4; const int sub = rem & 15;
  d.dil = (d.pair == 0) ? 1 : (d.pair == 1 ? 4 : 16);
  d.L = SEQ / d.dil;
  int blk;
  if (d.pair == 0) { d.cls = 0; blk = sub; } else if (d.pair == 1) { d.cls = sub & 3; blk = sub >> 2; } else { d.cls = sub; blk = 0; }
  d.i0 = blk * 256;
  return d;
}
DI void dil_fetch(const Params& p, const DilItem& d, int tid, uint4 (&kr)[6], uint4 (&vr)[6]) {
  const u16* kg = p.ck + (size_t)d.bh * SEQ * 64;
  const u16* vg = p.cv + (size_t)d.bh * SEQ * 64;
#pragma unroll
  for (int e = 0; e < 6; ++e) {
    const int c = tid + e * 512;
    const int row = c >> 3, ch = c & 7;
    const int kk = d.i0 - 64 + row;
    kr[e] = make_uint4(0, 0, 0, 0); vr[e] = make_uint4(0, 0, 0, 0);
    if (kk >= 0 && kk < d.L) {
      const size_t pos = (size_t)(d.cls + d.dil * kk);
      kr[e] = *(const uint4*)(kg + pos * 64 + ch * 8);
      vr[e] = *(const uint4*)(vg + pos * 64 + ch * 8);
    }
  }
}
DI void attn_dilated_items(const Params& p, char* lds) {
  const int tid = otid(p.wave), lane = tid & 63, wave = tid >> 6, r = lane & 31, hh = lane >> 5;
  constexpr int KROW = 144;
  char* Kl = lds;
  char* Vl = lds + 384 * KROW;
  uint4 kr[6], vr[6];
  int item = obid();
  if (item < 2304) { const DilItem d0 = dil_decode(item); dil_fetch(p, d0, tid, kr, vr); }
#pragma unroll 1
  for (; item < 2304; item += gridDim.x) {
  const DilItem d = dil_decode(item);
  const int pair = d.pair, bh = d.bh, dil = d.dil, L = d.L, cls = d.cls, i0 = d.i0;
#pragma unroll
  for (int e = 0; e < 6; ++e) {
    const int c = tid + e * 512;
    const int row = c >> 3, ch = c & 7;
    *(uint4*)(Kl + row * KROW + ch * 16) = kr[e];
    *(uint4*)(Vl + row * 128 + ((ch * 16) ^ (((row >> 1) & 1) << 6))) = vr[e];
  }
  if (item + (int)gridDim.x < 2304) { const DilItem dn = dil_decode(item + gridDim.x); dil_fetch(p, dn, tid, kr, vr); }
  const int qq = i0 + 32 * wave + r;
  const int pq = cls + dil * qq;
  bf16x8 Q[4];
  {
    const u16* qp = p.cq + ((size_t)bh * SEQ + pq) * 64 + hh * 8;
#pragma unroll
    for (int s = 0; s < 4; ++s) Q[s] = *(const bf16x8*)(qp + s * 16);
  }
  __syncthreads();
  f32x16 O[2];
#pragma unroll
  for (int e = 0; e < 16; ++e) { O[0][e] = 0.f; O[1][e] = 0.f; }
  float m = -1e30f, l = 0.f;
  const int tq = (lane & 15) >> 2, tp = lane & 3, tg1 = (lane >> 4) & 1, swz = (tq >> 1) & 1;
  const int voff = (4 * hh + tq) * 128 + 32 * tg1 + 8 * tp;
#pragma unroll
  for (int j = 0; j < 5; ++j) {
    const int rb = 32 * wave + 32 * j;
    f32x16 S;
#pragma unroll
    for (int e = 0; e < 16; ++e) S[e] = 0.f;
    const char* kb = Kl + (rb + r) * KROW + hh * 16;
#pragma unroll
    for (int s = 0; s < 4; ++s) S = MFMA(*(const bf16x8*)(kb + s * 32), Q[s], S);
    unsigned vmask = 0;
#pragma unroll
    for (int e = 0; e < 16; ++e) {
      const int cr = (e & 3) + 8 * (e >> 2) + 4 * hh;
      const int kk = i0 - 64 + rb + cr;
      bool ok = (kk >= 0) && (kk < L);
      if (j == 0) ok = ok && (cr >= r);
      if (j == 4) ok = ok && (cr <= r);
      vmask |= ok ? (1u << e) : 0u;
      S[e] = ok ? S[e] : -1e30f;
    }
    float mx = max16(S);
    mx = fmaxf(mx, __shfl_xor(mx, 32));
    if (__any(mx > m)) {
      const float mn = fmaxf(m, mx);
      const float al = fexp2(m - mn);
      m = mn; l *= al;
#pragma unroll
      for (int e = 0; e < 16; ++e) { O[0][e] *= al; O[1][e] *= al; }
    }
    float ps = 0.f;
#pragma unroll
    for (int e = 0; e < 16; ++e) { S[e] = ((vmask >> e) & 1) ? fexp2(S[e] - m) : 0.f; ps += S[e]; }
    l += ps;
    bf16x8 P0 = packP(S, 0), P1 = packP(S, 1);
    const char* vb = Vl + rb * 128 + voff;
#pragma unroll
    for (int i2 = 0; i2 < 2; ++i2)
#pragma unroll
      for (int s2 = 0; s2 < 2; ++s2) {
        const char* a = vb + (16 * s2) * 128 + 64 * (i2 ^ swz);
        s16x4 lo = trread(a), hi = trread(a + 8 * 128);
        bf16x8 vf = __builtin_shufflevector(lo, hi, 0, 1, 2, 3, 4, 5, 6, 7);
        O[i2] = MFMA(vf, s2 == 0 ? P0 : P1, O[i2]);
      }
  }
  const float lt = l + __shfl_xor(l, 32);
  const float inv = 1.f / lt;
  const int b = bh / 6, head = bh % 6;
  const int t = b * SEQ + pq;
#pragma unroll
  for (int i2 = 0; i2 < 2; ++i2) {
#pragma unroll
    for (int e = 0; e < 16; ++e) O[i2][e] *= inv;
    store_tile(p.dilo + ((size_t)pair * T_ALL + t) * 384 + head * 64 + i2 * 32, O[i2], hh);
  }
  if (hh == 0) p.dillse[((size_t)pair * T_ALL + t) * 6 + head] = m + __log2f(lt);
  __syncthreads();
  }
}


DI void phase_gemm1(const Params& p, int layer, char* lds) {
  EpiGemm1 E; E.aq = p.aq; E.ak = p.ak; E.av = p.av; E.bc = p.bc; E.bkr = p.bkr; E.cq = p.cq; E.ck = p.ck; E.cv = p.cv;
  E.cs32 = p.cs32; E.cs64 = p.cs64; E.sumsq = p.sumsq;
  run_gemm(p.wave, p.xb, p.winT + (size_t)layer * NPAD * 1024, NPAD, 1024, E, lds);
}
DI void phase_up_dil(const Params& p, int layer, char* lds) {
  EpiUp E; E.mq = p.mq; E.mk = p.mk; E.mv = p.mv; E.cs32 = p.cs32; E.sumsq = p.sumsq;
  run_gemm(p.wave, p.bc, p.wupT + (size_t)layer * NUP * KUP, NUP, KUP, E, lds);
  attn_dilated_items(p, lds);
}
DI void phase_attn(const Params& p, int layer, char* lds) {
  const float* lam = p.in[2] + layer * 128;
  float s1 = 0.f, s2 = 0.f;
  for (int i = 0; i < 32; ++i) { s1 += lam[i] * lam[32 + i]; s2 += lam[64 + i] * lam[96 + i]; }
  const float lam_init = 0.8f - 0.6f * expf(-0.3f * (float)(layer + 1));
  const float lam_full = expf(s1) - expf(s2) + lam_init;
  unsigned redo = 0u;
  {
    int k = 0;
    for (int item = obid(); item < 1280; item += gridDim.x, ++k) {
      bool bad;
      if (item < 768) bad = attn_mla_split(p, layer, item, lds);
      else bad = attn_dense_item<false, false, 2>(p, layer, item - 768, lam_full, lam_init, lds);
      redo |= bad ? (1u << k) : 0u;
    }
  }
  redo = __builtin_amdgcn_readfirstlane(redo);
  if (redo) {
    int k = 0;
    for (int item = obid(); item < 1280; item += gridDim.x, ++k) {
      if (!((redo >> k) & 1u)) continue;
      if (item < 768) attn_dense_item<true, true, 1>(p, layer, item, lam_full, lam_init, lds);
      else {
        const int j = item - 768, o = (j / 64) * 128 + ((j / 16) & 3) * 32 + 2 * (j & 15);
        attn_dense_item<false, true, 1>(p, layer, o, lam_full, lam_init, lds);
        attn_dense_item<false, true, 1>(p, layer, o + 1, lam_full, lam_init, lds);
      }
    }
  }
  for (int i = obid() * 512 + otid(p.wave); i < T_ALL * 48; i += gridDim.x * 512) {
    const int t = i / 48, c = i % 48, head = c >> 3;
    const float l0 = p.dillse[((size_t)0 * T_ALL + t) * 6 + head];
    const float l1 = p.dillse[((size_t)1 * T_ALL + t) * 6 + head];
    const float l2 = p.dillse[((size_t)2 * T_ALL + t) * 6 + head];
    const float mx = fmaxf(l0, fmaxf(l1, l2));
    float w0 = fexp2(l0 - mx), w1 = fexp2(l1 - mx), w2 = fexp2(l2 - mx);
    const float inv = 1.f / (w0 + w1 + w2);
    w0 *= inv; w1 *= inv; w2 *= inv;
    const uint4 a = *(const uint4*)(p.dilo + ((size_t)0 * T_ALL + t) * 384 + c * 8);
    const uint4 bq = *(const uint4*)(p.dilo + ((size_t)1 * T_ALL + t) * 384 + c * 8);
    const uint4 cq = *(const uint4*)(p.dilo + ((size_t)2 * T_ALL + t) * 384 + c * 8);
    uint4 o;
    o.x = pack2(w0 * bflo(a.x) + w1 * bflo(bq.x) + w2 * bflo(cq.x), w0 * bfhi(a.x) + w1 * bfhi(bq.x) + w2 * bfhi(cq.x));
    o.y = pack2(w0 * bflo(a.y) + w1 * bflo(bq.y) + w2 * bflo(cq.y), w0 * bfhi(a.y) + w1 * bfhi(bq.y) + w2 * bfhi(cq.y));
    o.z = pack2(w0 * bflo(a.z) + w1 * bflo(bq.z) + w2 * bflo(cq.z), w0 * bfhi(a.z) + w1 * bfhi(bq.z) + w2 * bfhi(cq.z));
    o.w = pack2(w0 * bflo(a.w) + w1 * bflo(bq.w) + w2 * bflo(cq.w), w0 * bfhi(a.w) + w1 * bfhi(bq.w) + w2 * bfhi(cq.w));
    *(uint4*)(p.cat + (size_t)t * 1024 + 640 + c * 8) = o;
  }
}
DI void phase_outproj(const Params& p, int layer, char* lds) {
  EpiOut E; E.xb = p.xb; E.ybuf = p.ybuf; E.stats = p.stats;
  run_gemm(p.wave, p.cat, p.woT + (size_t)layer * DM * DM, DM, DM, E, lds);
}
DI void phase_ln1(const Params& p, int layer, char* lds) {
  const int tid = otid(p.wave), lane = tid & 63, wave = tid >> 6;
  const float* g1 = p.in[9] + layer * 1024 + lane * 16;
  const float* b1 = p.in[10] + layer * 1024 + lane * 16;
  float gg[16], bb[16];
#pragma unroll
  for (int q = 0; q < 4; ++q) {
    const float4 a = *(const float4*)(g1 + 4 * q), b = *(const float4*)(b1 + 4 * q);
    gg[4 * q] = a.x; gg[4 * q + 1] = a.y; gg[4 * q + 2] = a.z; gg[4 * q + 3] = a.w;
    bb[4 * q] = b.x; bb[4 * q + 1] = b.y; bb[4 * q + 2] = b.z; bb[4 * q + 3] = b.w;
  }
  for (int t = obid() * 8 + wave; t < T_ALL; t += gridDim.x * 8) {
    const uint4* yp = (const uint4*)(p.ybuf + (size_t)t * 1024 + lane * 16);
    const uint4 v0 = yp[0], v1 = yp[1];
    float pv = (lane < 32) ? p.stats[(size_t)t * 32 + lane] : 0.f;
    pv += __shfl_xor(pv, 8); pv += __shfl_xor(pv, 4); pv += __shfl_xor(pv, 2); pv += __shfl_xor(pv, 1);
    const float mean = __shfl(pv, 0) * (1.f / 1024.f);
    const float rstd = rsqrtf(fmaxf(__shfl(pv, 16) * (1.f / 1024.f) - mean * mean, 0.f) + 1e-5f);
    const float y[16] = {bflo(v0.x), bfhi(v0.x), bflo(v0.y), bfhi(v0.y), bflo(v0.z), bfhi(v0.z), bflo(v0.w), bfhi(v0.w),
                         bflo(v1.x), bfhi(v1.x), bflo(v1.y), bfhi(v1.y), bflo(v1.z), bfhi(v1.z), bflo(v1.w), bfhi(v1.w)};
    float o[16];
#pragma unroll
    for (int e = 0; e < 16; ++e) o[e] = (y[e] - mean) * rstd * gg[e] + bb[e];
    uint4 w0, w1;
    w0.x = pack2(o[0], o[1]); w0.y = pack2(o[2], o[3]); w0.z = pack2(o[4], o[5]); w0.w = pack2(o[6], o[7]);
    w1.x = pack2(o[8], o[9]); w1.y = pack2(o[10], o[11]); w1.z = pack2(o[12], o[13]); w1.w = pack2(o[14], o[15]);
    uint4* xp = (uint4*)(p.x1 + (size_t)t * 1024 + lane * 16);
    xp[0] = w0; xp[1] = w1;
  }
}
DI void phase_qgemm(const Params& p, int layer, char* lds) {
  EpiQ E; E.qbuf = p.qbuf;
  run_gemm(p.wave, p.x1, p.wqT + (size_t)layer * 2048 * DM, 2048, DM, E, lds);
}

template <int P0>
DI void ins_from(float (&L)[16], float v) {
#pragma unroll
  for (int k = 15; k > P0; --k) L[k] = __builtin_amdgcn_fmed3f(v, L[k - 1], L[k]);
  L[P0] = fmaxf(L[P0], v);
}
template <int I, int J>
DI void cand_row(float (&C)[16], const float (&A)[16], const float (&B)[16]) {
  if constexpr ((I + 1) * (J + 1) <= 16) {
    const float sm = A[I] + B[J];
    const float v = __uint_as_float((__float_as_uint(sm) & ~255u) | (unsigned)(255 - (I * 16 + J)));
    ins_from<(I + 1) * (J + 1) - 1>(C, v);
    cand_row<I, J + 1>(C, A, B);
  }
}
template <int I>
DI void cand_all(float (&C)[16], const float (&A)[16], const float (&B)[16]) {
  if constexpr (I < 16) { cand_row<I, 0>(C, A, B); cand_all<I + 1>(C, A, B); }
}
DI void ins16(float (&L)[16], float v) {
#pragma unroll
  for (int k = 15; k >= 1; --k) L[k] = __builtin_amdgcn_fmed3f(v, L[k - 1], L[k]);
  L[0] = fmaxf(L[0], v);
}
constexpr int QS_STR = 528;

DI void phase_peer_route(const Params& p, int layer, char* lds) {
  const int tid = otid(p.wave), lane = tid & 63, wave = tid >> 6;
  const int r = lane & 31, hh = lane >> 5;
  char* Qs = lds;
  unsigned* Ls = (unsigned*)(lds + 128 * QS_STR);
  for (int item = obid(); item < 2048; item += gridDim.x) {
    const int mt = item >> 3, head = item & 7;
#pragma unroll
    for (int e = 0; e < 8; ++e) {
      const int c = tid + e * 512, row = c >> 5, ch = c & 31;
      *(uint4*)(Qs + row * QS_STR + ch * 16) = *(const uint4*)(p.qbuf + (size_t)(mt * 128 + row) * 2048 + head * 256 + ch * 8);
    }
    __syncthreads();
    {
      const int pp = wave >> 2, tg = wave & 3;
      bf16x8 Bq[8];
      const char* qrow = Qs + (tg * 32 + r) * QS_STR + (pp * 128 + hh * 8) * 2;
#pragma unroll
      for (int s = 0; s < 8; ++s) Bq[s] = *(const bf16x8*)(qrow + s * 32);
      const u16* kbase = p.keysb + ((size_t)(layer * 16 + head * 2 + pp) * 128) * 128;
      float Lst[16];
#pragma unroll
      for (int k = 0; k < 16; ++k) Lst[k] = -3.0e38f;
#pragma unroll
      for (int kt = 0; kt < 4; ++kt) {
        f32x16 S;
#pragma unroll
        for (int e = 0; e < 16; ++e) S[e] = 0.f;
        const u16* krow = kbase + (size_t)(kt * 32 + r) * 128 + hh * 8;
#pragma unroll
        for (int s = 0; s < 8; ++s) S = MFMA(*(const bf16x8*)(krow + s * 16), Bq[s], S);
#pragma unroll
        for (int e = 0; e < 16; ++e) {
          const int kidx = kt * 32 + (e & 3) + 8 * (e >> 2) + 4 * hh;
          const float v = __uint_as_float((__float_as_uint(S[e]) & ~127u) | (unsigned)(127 - kidx));
          ins16(Lst, v);
        }
      }
      float Pl[16];
#pragma unroll
      for (int k = 0; k < 16; ++k) Pl[k] = __shfl_xor(Lst[k], 32);
#pragma unroll
      for (int k = 0; k < 16; ++k) ins16(Lst, Pl[k]);
      if (hh == 0) {
        unsigned* dst = Ls + ((tg * 32 + r) * 2 + pp) * 16;
#pragma unroll
        for (int k = 0; k < 16; ++k) dst[k] = __float_as_uint(Lst[k]);
      }
    }
    __syncthreads();
    if (tid < 128) {
      const unsigned* la = Ls + (tid * 2) * 16;
      float A[16], B[16];
#pragma unroll
      for (int k = 0; k < 16; ++k) { A[k] = __uint_as_float(la[k]); B[k] = __uint_as_float(la[16 + k]); }
      float C[16];
#pragma unroll
      for (int k = 0; k < 16; ++k) C[k] = -3.0e38f;
      cand_all<0>(C, A, B);
      const int t = mt * 128 + tid;
      float e[16], sum = 0.f;
#pragma unroll
      for (int k = 0; k < 16; ++k) { e[k] = __expf(C[k] - C[0]); sum += e[k]; }
      const float inv = 1.f / sum;
      int* ed = p.experts + (size_t)t * 128 + head * 16;
      float* gd = p.gates + (size_t)t * 128 + head * 16;
#pragma unroll
      for (int k = 0; k < 16; ++k) {
        const unsigned code = 255u - (__float_as_uint(C[k]) & 255u);
        const int i1 = 127 - (int)(la[code >> 4] & 127u);
        const int i2 = 127 - (int)(la[16 + (code & 15)] & 127u);
        ed[k] = i1 * 128 + i2;
        gd[k] = e[k] * inv;
      }
    }
    __syncthreads();
  }
}


DI float gelu_exact(float d) { return 0.5f * d * (1.f + erff(d * 0.70710678118654752f)); }

DI float row_allsum(float v) {
  v += __builtin_bit_cast(float, __builtin_amdgcn_update_dpp(0, __builtin_bit_cast(int, v), 0x128, 0xf, 0xf, false));
  v += __builtin_bit_cast(float, __builtin_amdgcn_update_dpp(0, __builtin_bit_cast(int, v), 0x124, 0xf, 0xf, false));
  v += __builtin_bit_cast(float, __builtin_amdgcn_update_dpp(0, __builtin_bit_cast(int, v), 0x122, 0xf, 0xf, false));
  v += __builtin_bit_cast(float, __builtin_amdgcn_update_dpp(0, __builtin_bit_cast(int, v), 0x121, 0xf, 0xf, false));
  return v;
}

DI void phase_peer_ffn(const Params& p, int layer, char* lds) {
  const int tid = otid(p.wave), lane = tid & 63, wave = tid >> 6, grp16 = lane >> 4, l16 = lane & 15;
  uint2* list = (uint2*)(lds + wave * 4096);
  float* dl = (float*)(lds + 32768 + wave * 2048);
  const float* g2 = p.in[15] + layer * 1024;
  const float* b2 = p.in[16] + layer * 1024;
  const unsigned char* ub = p.ub + (size_t)layer * NEXP * ROWB + l16 * 48;
  const unsigned char* vb = p.vb + (size_t)layer * NEXP * ROWB + l16 * 48;
  const float* us = p.us + layer * NEXP;
  const float* vs = p.vs + layer * NEXP;
  const unsigned ltmask16 = (1u << l16) - 1u;
  uint2* mylist = list + grp16 * 128;
  float* mydl = dl + grp16 * 128;
  for (int grp = obid() * 8 + wave; grp < T_ALL / 4; grp += gridDim.x * 8) {
    const int t = grp * 4 + grp16;
    {
      int ev[8]; unsigned gv[8];
      {
        const int4 e0 = *(const int4*)(p.experts + (size_t)t * 128 + l16 * 8);
        const int4 e1 = *(const int4*)(p.experts + (size_t)t * 128 + l16 * 8 + 4);
        const uint4 g0 = *(const uint4*)(p.gates + (size_t)t * 128 + l16 * 8);
        const uint4 g1 = *(const uint4*)(p.gates + (size_t)t * 128 + l16 * 8 + 4);
        ev[0] = e0.x; ev[1] = e0.y; ev[2] = e0.z; ev[3] = e0.w; ev[4] = e1.x; ev[5] = e1.y; ev[6] = e1.z; ev[7] = e1.w;
        gv[0] = g0.x; gv[1] = g0.y; gv[2] = g0.z; gv[3] = g0.w; gv[4] = g1.x; gv[5] = g1.y; gv[6] = g1.z; gv[7] = g1.w;
      }
      int pos[8];
#pragma unroll
      for (int s2 = 0; s2 < 8; ++s2) pos[s2] = 0;
      int running = 0;
#pragma unroll 1
      for (int b = 0; b < 16; ++b) {
#pragma unroll
        for (int s2 = 0; s2 < 8; ++s2) {
          const bool mt = (ev[s2] >> 10) == b;
          const unsigned m = (unsigned)(__ballot(mt) >> (grp16 * 16)) & 0xffffu;
          if (mt) pos[s2] = running + __popc(m & ltmask16);
          running += __popc(m);
        }
      }
#pragma unroll
      for (int s2 = 0; s2 < 8; ++s2) mylist[pos[s2]] = make_uint2((unsigned)ev[s2], gv[s2]);
    }
    __builtin_amdgcn_sched_barrier(0);
#define LD_ROW(buf, tab, i)                                                                     \
  {                                                                                             \
    const unsigned char* r_ = (tab) + (size_t)mylist[(i)].x * ROWB;                             \
    buf[0] = *(const uint4*)r_; buf[1] = *(const uint4*)(r_ + 16); buf[2] = *(const uint4*)(r_ + 32); \
  }
#define ROW_Q0(buf) ((u32x6){buf[0].x, buf[0].y, buf[0].z, buf[0].w, buf[1].x, buf[1].y})
#define ROW_Q1(buf) ((u32x6){buf[1].z, buf[1].w, buf[2].x, buf[2].y, buf[2].z, buf[2].w})
    {
      unsigned xw[32];
#pragma unroll
      for (int n = 0; n < 8; ++n) {
        const uint4 xa = *(const uint4*)(p.x1 + (size_t)t * 1024 + l16 * 64 + n * 8);
        xw[4 * n] = xa.x; xw[4 * n + 1] = xa.y; xw[4 * n + 2] = xa.z; xw[4 * n + 3] = xa.w;
      }
      uint4 r0[3], r1[3], r2[3], r3[3], r4[3], r5[3];
#define PASS1(buf, i)                                                                           \
  {                                                                                             \
    u32x16 u0_ = __builtin_bit_cast(u32x16, __builtin_amdgcn_cvt_scalef32_pk32_bf16_fp6(ROW_Q0(buf), 1.0f)); \
    u32x16 u1_ = __builtin_bit_cast(u32x16, __builtin_amdgcn_cvt_scalef32_pk32_bf16_fp6(ROW_Q1(buf), 1.0f)); \
    float da_ = 0.f, db_ = 0.f;                                                                 \
    _Pragma("unroll") for (int e = 0; e < 16; ++e) {                                            \
      unsigned wa_ = u0_[e], wb_ = u1_[e];                                                      \
      asm volatile("" : "+v"(wa_), "+v"(wb_));     \
      da_ = __builtin_amdgcn_fdot2_f32_bf16(__builtin_bit_cast(bf16x2_t, wa_), __builtin_bit_cast(bf16x2_t, xw[e]), da_, false); \
      db_ = __builtin_amdgcn_fdot2_f32_bf16(__builtin_bit_cast(bf16x2_t, wb_), __builtin_bit_cast(bf16x2_t, xw[16 + e]), db_, false); \
    }                                                                                           \
    const float d_ = row_allsum(da_ + db_);                                                     \
    if (l16 == 0) mydl[(i)] = d_;                                                               \
  }
      LD_ROW(r0, ub, 0) LD_ROW(r1, ub, 1) LD_ROW(r2, ub, 2) LD_ROW(r3, ub, 3) LD_ROW(r4, ub, 4)
#pragma unroll 1
      for (int i = 0; i < 126; i += 6) {
        LD_ROW(r5, ub, i + 5)
        PASS1(r0, i)
        LD_ROW(r0, ub, i + 6)
        PASS1(r1, i + 1)
        LD_ROW(r1, ub, i + 7)
        PASS1(r2, i + 2)
        LD_ROW(r2, ub, min(i + 8, 127))
        PASS1(r3, i + 3)
        LD_ROW(r3, ub, min(i + 9, 127))
        PASS1(r4, i + 4)
        LD_ROW(r4, ub, min(i + 10, 127))
        PASS1(r5, i + 5)
      }
      PASS1(r0, 126)
      PASS1(r1, 127)
    }
    __builtin_amdgcn_sched_barrier(0);
#pragma unroll 2
    for (int k = 0; k < 8; ++k) {
      const int idx = l16 + 16 * k;
      const uint2 en = mylist[idx];
      const float d = mydl[idx] * us[en.x];
      mylist[idx].y = __float_as_uint(__uint_as_float(en.y) * gelu_exact(d) * vs[en.x]);
    }
    __builtin_amdgcn_sched_barrier(0);
    {
      f32x2 acc[32];
#pragma unroll
      for (int e = 0; e < 32; ++e) { acc[e][0] = 0.f; acc[e][1] = 0.f; }
      uint4 r0[3], r1[3], r2[3], r3[3], r4[3], r5[3];
#define PASS2(buf, i)                                                                           \
  {                                                                                             \
    const float c_ = __uint_as_float(mylist[(i)].y);                                            \
    {                                                                                           \
      f32x32 v0_ = __builtin_amdgcn_cvt_scalef32_pk32_f32_fp6(ROW_Q0(buf), 1.0f);               \
      asm volatile("" : "+v"(v0_));                                                             \
      _Pragma("unroll") for (int e = 0; e < 16; ++e) acc[e] = (f32x2){v0_[2 * e], v0_[2 * e + 1]} * c_ + acc[e]; \
    }                                                                                           \
    __builtin_amdgcn_sched_barrier(0);                                                          \
    {                                                                                           \
      f32x32 v1_ = __builtin_amdgcn_cvt_scalef32_pk32_f32_fp6(ROW_Q1(buf), 1.0f);               \
      asm volatile("" : "+v"(v1_));                                                             \
      _Pragma("unroll") for (int e = 0; e < 16; ++e) acc[16 + e] = (f32x2){v1_[2 * e], v1_[2 * e + 1]} * c_ + acc[16 + e]; \
    }                                                                                           \
    __builtin_amdgcn_sched_barrier(0);                                                          \
  }
      LD_ROW(r0, vb, 0) LD_ROW(r1, vb, 1) LD_ROW(r2, vb, 2) LD_ROW(r3, vb, 3) LD_ROW(r4, vb, 4)
#pragma unroll 1
      for (int i = 0; i < 126; i += 6) {
        LD_ROW(r5, vb, i + 5)
        PASS2(r0, i)
        LD_ROW(r0, vb, i + 6)
        PASS2(r1, i + 1)
        LD_ROW(r1, vb, i + 7)
        PASS2(r2, i + 2)
        LD_ROW(r2, vb, min(i + 8, 127))
        PASS2(r3, i + 3)
        LD_ROW(r3, vb, min(i + 9, 127))
        PASS2(r4, i + 4)
        LD_ROW(r4, vb, min(i + 10, 127))
        PASS2(r5, i + 5)
      }
      PASS2(r0, 126)
      PASS2(r1, 127)
      float sm = 0.f;
#pragma unroll
      for (int n = 0; n < 8; ++n) {
        const uint4 xa = *(const uint4*)(p.x1 + (size_t)t * 1024 + l16 * 64 + n * 8);
        const unsigned xq[4] = {xa.x, xa.y, xa.z, xa.w};
#pragma unroll
        for (int e = 0; e < 4; ++e) {
          acc[4 * n + e][0] = ALPHA * bflo(xq[e]) + acc[4 * n + e][0];
          acc[4 * n + e][1] = ALPHA * bfhi(xq[e]) + acc[4 * n + e][1];
          sm += acc[4 * n + e][0] + acc[4 * n + e][1];
        }
      }
      const float mean = row_allsum(sm) * (1.f / 1024.f);
      float vsum = 0.f;
#pragma unroll
      for (int e = 0; e < 32; ++e) {
        acc[e][0] -= mean; acc[e][1] -= mean;
        vsum += acc[e][0] * acc[e][0] + acc[e][1] * acc[e][1];
      }
      const float rstd = rsqrtf(row_allsum(vsum) * (1.f / 1024.f) + 1e-5f);
#pragma unroll
      for (int n = 0; n < 4; ++n) {
        const int d0 = l16 * 64 + n * 16;
        float o[16];
#pragma unroll
        for (int q = 0; q < 4; ++q) {
          const float4 gg = *(const float4*)(g2 + d0 + 4 * q);
          const float4 bb = *(const float4*)(b2 + d0 + 4 * q);
          o[4 * q + 0] = acc[8 * n + 2 * q][0] * rstd * gg.x + bb.x;
          o[4 * q + 1] = acc[8 * n + 2 * q][1] * rstd * gg.y + bb.y;
          o[4 * q + 2] = acc[8 * n + 2 * q + 1][0] * rstd * gg.z + bb.z;
          o[4 * q + 3] = acc[8 * n + 2 * q + 1][1] * rstd * gg.w + bb.w;
        }
        if (layer == 1) {
          float4* oa = (float4*)(p.out + (size_t)t * 1024 + d0);
          oa[0] = make_float4(o[0], o[1], o[2], o[3]); oa[1] = make_float4(o[4], o[5], o[6], o[7]);
          oa[2] = make_float4(o[8], o[9], o[10], o[11]); oa[3] = make_float4(o[12], o[13], o[14], o[15]);
        } else {
          uint4 w0, w1;
          w0.x = pack2(o[0], o[1]); w0.y = pack2(o[2], o[3]); w0.z = pack2(o[4], o[5]); w0.w = pack2(o[6], o[7]);
          w1.x = pack2(o[8], o[9]); w1.y = pack2(o[10], o[11]); w1.z = pack2(o[12], o[13]); w1.w = pack2(o[14], o[15]);
          *(uint4*)(p.xb + (size_t)t * 1024 + d0) = w0;
          *(uint4*)(p.xb + (size_t)t * 1024 + d0 + 8) = w1;
        }
        __builtin_amdgcn_sched_barrier(0);
      }
    }
  }
}

#define XB_TMO      128
#define XB_XCNT(j)  (256  + 64 * (j))
#define XB_XSUB(j)  (1280 + 64 * (j))
#define XB_XGEN(j)  (2304 + 64 * (j))
#define XB_TOP      3328
#define XB_TOPGEN   3392
#define XCD_BAR_WORDS 3456
#define XB_SPIN_CAP (1u << 22)
#define LAS __attribute__((address_space(3)))
DI unsigned xb_ld(unsigned* p) { return __hip_atomic_load(p, __ATOMIC_RELAXED, __HIP_MEMORY_SCOPE_AGENT); }
DI unsigned xb_add(unsigned* p, unsigned v) { return __hip_atomic_fetch_add(p, v, __ATOMIC_RELAXED, __HIP_MEMORY_SCOPE_AGENT); }
DI unsigned xb_xcc_id() { return (unsigned)__builtin_amdgcn_s_getreg((3 << 11) | 20) & 0xFu; }
#define XB_SPIN(cond, bar) do { unsigned _sp = 0; while (cond) { __builtin_amdgcn_s_sleep(1); \
    if ((++_sp & 255u) == 0u) { if (xb_ld(&(bar)[XB_TMO])) break; if (_sp > XB_SPIN_CAP) { atomicAdd(&(bar)[XB_TMO], 1u); break; } } } } while (0)
struct XcdBarrier { unsigned* bar; unsigned x; volatile LAS unsigned* st; };
DI XcdBarrier xcd_barrier_post(unsigned* bar, volatile LAS unsigned* st, bool leader) {
  XcdBarrier b; b.bar = bar; b.x = xb_xcc_id(); b.st = st;
  if (leader) (void)xb_add(&bar[XB_XCNT(b.x)], 1u);
  return b;
}
DI void xcd_barrier_complete(unsigned* bar, unsigned x, unsigned& nloc, unsigned& nx) {
  const unsigned G = gridDim.x;
  unsigned sum, cnt, mine, sp = 0u;
  for (;;) {
    sum = 0u; cnt = 0u; mine = 0u;
#pragma unroll
    for (unsigned j = 0; j < 16; ++j) { const unsigned c = xb_ld(&bar[XB_XCNT(j)]); sum += c; cnt += (c > 0u) ? 1u : 0u; mine = (j == x) ? c : mine; }
    if (sum == G) break;
    __builtin_amdgcn_s_sleep(1);
    if ((++sp & 255u) == 0u) { if (xb_ld(&bar[XB_TMO])) break; if (sp > XB_SPIN_CAP) { atomicAdd(&bar[XB_TMO], 1u); break; } }
  }
  nloc = mine > 0u ? mine : 1u; nx = cnt > 0u ? cnt : 1u;
}
DI void xcd_barrier(const XcdBarrier& b, bool leader) {
  asm volatile("s_waitcnt vmcnt(0)" ::: "memory");
  __syncthreads();
  if (leader) {
    unsigned* bar = b.bar;
    __builtin_amdgcn_s_waitcnt(0);
    unsigned nloc = b.st[0], nx = b.st[1];
    if (nloc == 0u) { xcd_barrier_complete(bar, b.x, nloc, nx); b.st[0] = nloc; b.st[1] = nx; }
    const unsigned old = xb_add(&bar[XB_XSUB(b.x)], 1u);
    const unsigned gen = old / nloc;
    if (old + 1u == (gen + 1u) * nloc) {
      __builtin_amdgcn_fence(__ATOMIC_RELEASE, "agent");
      asm volatile("s_waitcnt vmcnt(0)" ::: "memory");
      const unsigned og = xb_add(&bar[XB_TOP], 1u);
      const unsigned tg = og / nx;
      if (og + 1u == (tg + 1u) * nx) xb_add(&bar[XB_TOPGEN], 1u);
      else XB_SPIN(xb_ld(&bar[XB_TOPGEN]) == tg, bar);
      __builtin_amdgcn_fence(__ATOMIC_ACQUIRE, "agent");
      xb_add(&bar[XB_XGEN(b.x)], 1u);
      asm volatile("s_waitcnt vmcnt(0)" ::: "memory");
    } else {
      XB_SPIN(xb_ld(&bar[XB_XGEN(b.x)]) == gen, bar);
      __builtin_amdgcn_fence(__ATOMIC_ACQUIRE, "agent");
      asm volatile("s_waitcnt vmcnt(0)" ::: "memory");
    }
  }
  __syncthreads();
}

#ifndef REP_SUB
#define REP_SUB -1
#endif
#ifndef REP_N
#define REP_N 0
#endif
constexpr int NSUB = 8;
constexpr int NPHASE = 1 + 2 * NSUB;
template <int PH>
DI void run_phase(const Params& p, char* lds) {
  if (PH == 0) {
    phase_prep(p, lds);
  } else {
    constexpr int layer = (PH - 1) / NSUB, sub = (PH - 1) % NSUB;
    if (sub == 0) phase_gemm1(p, layer, lds);
    else if (sub == 1) phase_up_dil(p, layer, lds);
    else if (sub == 2) phase_attn(p, layer, lds);
    else if (sub == 3) phase_outproj(p, layer, lds);
    else if (sub == 4) phase_ln1(p, layer, lds);
    else if (sub == 5) phase_qgemm(p, layer, lds);
    else if (sub == 6) phase_peer_route(p, layer, lds);
    else phase_peer_ffn(p, layer, lds);
  }
}
template <int PH>
DI void do_phase(const Params& p, int ph_lo, int ph_hi, char* lds, cg::grid_group& grid, const XcdBarrier& xb) {
  if (ph_lo <= PH && PH < ph_hi) {
    constexpr int extra = (REP_SUB == 8) ? (PH == 0 ? REP_N : 0) : ((REP_SUB >= 0 && PH > 0 && (PH - 1) % NSUB == REP_SUB) ? REP_N : 0);
#pragma unroll
    for (int rp = 0; rp < 1 + extra; ++rp) {
      run_phase<PH>(p, lds);
      if (rp < extra) xcd_barrier(xb, otid(p.wave) == 0);
    }
    if (PH + 1 < ph_hi) {
      if (PH == 0) grid.sync();
      else xcd_barrier(xb, otid(p.wave) == 0);
    }
  }
}
__global__ __launch_bounds__(512) void mega(Params p, int ph_lo, int ph_hi) {
  extern __shared__ __attribute__((aligned(16))) char lds[];
  cg::grid_group grid = cg::this_grid();
  p.wave = __builtin_amdgcn_readfirstlane(threadIdx.x >> 6);
  volatile LAS unsigned* st = (volatile LAS unsigned*)(LAS char*)(lds + 131072 + 1008);
  if (threadIdx.x == 0) { st[0] = 0u; st[1] = 0u; }
  __syncthreads();
  const XcdBarrier xb = xcd_barrier_post(p.bar, st, threadIdx.x == 0);
  do_phase<0>(p, ph_lo, ph_hi, lds, grid, xb);
  do_phase<1>(p, ph_lo, ph_hi, lds, grid, xb);
  do_phase<2>(p, ph_lo, ph_hi, lds, grid, xb);
  do_phase<3>(p, ph_lo, ph_hi, lds, grid, xb);
  do_phase<4>(p, ph_lo, ph_hi, lds, grid, xb);
  do_phase<5>(p, ph_lo, ph_hi, lds, grid, xb);
  do_phase<6>(p, ph_lo, ph_hi, lds, grid, xb);
  do_phase<7>(p, ph_lo, ph_hi, lds, grid, xb);
  do_phase<8>(p, ph_lo, ph_hi, lds, grid, xb);
  do_phase<9>(p, ph_lo, ph_hi, lds, grid, xb);
  do_phase<10>(p, ph_lo, ph_hi, lds, grid, xb);
  do_phase<11>(p, ph_lo, ph_hi, lds, grid, xb);
  do_phase<12>(p, ph_lo, ph_hi, lds, grid, xb);
  do_phase<13>(p, ph_lo, ph_hi, lds, grid, xb);
  do_phase<14>(p, ph_lo, ph_hi, lds, grid, xb);
  do_phase<15>(p, ph_lo, ph_hi, lds, grid, xb);
  do_phase<16>(p, ph_lo, ph_hi, lds, grid, xb);
}

extern "C" void kernel_launch(void* const* d_in, const int* in_sizes, int n_in, void* d_out, int out_size, void* d_ws,
                              size_t ws_size, hipStream_t stream) {
  Params p;
  memset(&p, 0, sizeof(p));
  for (int i = 0; i < 17; ++i) p.in[i] = (const float*)d_in[i];
  p.out = (float*)d_out;
  char* w = (char*)d_ws;
  size_t off = 0;
  auto alloc = [&](size_t bytes) { char* r = w + off; off += (bytes + 255) & ~(size_t)255; return r; };
  p.xb = (u16*)alloc((size_t)T_ALL * DM * 2);
  p.winT = (u16*)alloc((size_t)2 * NPAD * 1024 * 2);
  p.wupT = (u16*)alloc((size_t)2 * NUP * KUP * 2);
  p.woT = (u16*)alloc((size_t)2 * 1024 * 1024 * 2);
  p.wqT = (u16*)alloc((size_t)2 * 2048 * 1024 * 2);
  p.keysb = (u16*)alloc((size_t)2 * 16 * 128 * 128 * 2);
  p.ub = (unsigned char*)alloc((size_t)2 * NEXP * ROWB);
  p.vb = (unsigned char*)alloc((size_t)2 * NEXP * ROWB);
  p.us = (float*)alloc((size_t)2 * NEXP * 4);
  p.vs = (float*)alloc((size_t)2 * NEXP * 4);
  p.cs32 = (float2*)alloc((size_t)SEQ * 16 * 8);
  p.cs64 = (float2*)alloc((size_t)SEQ * 32 * 8);
  p.sumsq = (float*)alloc((size_t)T_ALL * 12 * 4);
  p.stats = (float*)alloc((size_t)T_ALL * 32 * 4);
  p.bar = (unsigned*)alloc((size_t)XCD_BAR_WORDS * 4);
  hipMemsetAsync(p.bar, 0, (size_t)XCD_BAR_WORDS * 4, stream);
  p.cat = (u16*)alloc((size_t)T_ALL * 1024 * 2);
  const size_t r1 = off;
  p.aq = (u16*)alloc((size_t)T_ALL * 256 * 2);
  p.ak = (u16*)alloc((size_t)T_ALL * 256 * 2);
  p.av = (u16*)alloc((size_t)T_ALL * 256 * 2);
  p.bc = (u16*)alloc((size_t)T_ALL * KUP * 2);
  p.bkr = (u16*)alloc((size_t)T_ALL * 32 * 2);
  p.cq = (u16*)alloc((size_t)T_ALL * 384 * 2);
  p.ck = (u16*)alloc((size_t)T_ALL * 384 * 2);
  p.cv = (u16*)alloc((size_t)T_ALL * 384 * 2);
  p.mq = (u16*)alloc((size_t)T_ALL * 576 * 2);
  p.mk = (u16*)alloc((size_t)T_ALL * 384 * 2);
  p.mv = (u16*)alloc((size_t)T_ALL * 384 * 2);
  off = r1;
  p.ybuf = (u16*)alloc((size_t)T_ALL * 1024 * 2);
  p.x1 = (u16*)alloc((size_t)T_ALL * 1024 * 2);
  p.experts = (int*)alloc((size_t)T_ALL * 128 * 4);
  p.gates = (float*)alloc((size_t)T_ALL * 128 * 4);
  p.qbuf = (u16*)d_out;
  p.dilo = (u16*)d_out;
  p.dillse = (float*)((char*)d_out + (size_t)3 * T_ALL * 384 * 2);

#ifdef MULTI_LAUNCH
  hipFuncSetAttribute((const void*)mega, hipFuncAttributeMaxDynamicSharedMemorySize, LDS_BYTES);
  for (int ph = 0; ph < NPHASE; ++ph) {
    hipLaunchKernelGGL(mega, dim3(256), dim3(512), LDS_BYTES, stream, p, ph, ph + 1);
  }
#else
  static int grid_blocks = 0;
  if (!grid_blocks) {
    int dev = 0, cus = 0, per_cu = 0;
    hipGetDevice(&dev);
    hipDeviceGetAttribute(&cus, hipDeviceAttributeMultiprocessorCount, dev);
    hipFuncSetAttribute((const void*)mega, hipFuncAttributeMaxDynamicSharedMemorySize, LDS_BYTES);
    hipOccupancyMaxActiveBlocksPerMultiprocessor(&per_cu, mega, 512, LDS_BYTES);
    if (per_cu > 1) per_cu = 1;
    grid_blocks = cus * per_cu;
  }
  int lo = 0, hi = NPHASE;
  void* args[] = {&p, &lo, &hi};
  hipError_t e = hipLaunchCooperativeKernel((void*)mega, dim3(grid_blocks), dim3(512), args, LDS_BYTES, stream);
  if (e != hipSuccess) fprintf(stderr, "cooperative launch failed: %s (grid %d)\n", hipGetErrorString(e), grid_blocks);
#endif
}
```

```cpp
#include <hip/hip_runtime.h>
#include <hip/hip_cooperative_groups.h>
#include <math.h>
#include <stdio.h>
#include <string.h>
namespace cg = cooperative_groups;

typedef unsigned short u16;
typedef short bf16x8 __attribute__((ext_vector_type(8)));
typedef short s16x4 __attribute__((ext_vector_type(4)));
typedef float f32x16 __attribute__((ext_vector_type(16)));
typedef float f32x2 __attribute__((ext_vector_type(2)));
typedef __bf16 bf16x2_t __attribute__((ext_vector_type(2)));

#define DI __device__ __forceinline__
#define MFMA(a, b, c) __builtin_amdgcn_mfma_f32_32x32x16_bf16((a), (b), (c), 0, 0, 0)

constexpr int T_ALL = 32768, SEQ = 4096, DM = 1024, INW = 2336, NEXP = 16384;
constexpr int NPAD = 2560;
constexpr int NUP = 1536, KUP = 384;
constexpr float LOG2E = 1.4426950408889634f;
constexpr float ALPHA = 1.41421356237309515f;

struct Params {
  const float* in[17];
  float* out;
  u16 *xb, *winT, *wupT, *woT, *wqT, *keysb;
  unsigned char *ub, *vb;
  float *us, *vs;
  float2 *cs32, *cs64;
  u16 *aq, *ak, *av, *bc, *bkr, *cq, *ck, *cv, *mq, *mk, *mv, *cat, *dilo;
  float* dillse;
  u16 *ybuf, *x1, *qbuf;
  int* experts;
  float* gates;
  float *sumsq, *stats;
  unsigned* bar;
  int wave, pad_;
};

DI int otid(int wave) { int lane; asm volatile("v_mbcnt_lo_u32_b32 %0, -1, 0\n\tv_mbcnt_hi_u32_b32 %0, -1, %0" : "=v"(lane)); asm volatile("" : "+s"(wave)); return (wave << 6) | lane; }
DI int obid() { int b = blockIdx.x; asm volatile("" : "+s"(b)); return b; }
DI unsigned pack2(float a, float b) {
  f32x2 v = {a, b};
  return __builtin_bit_cast(unsigned, __builtin_convertvector(v, bf16x2_t));
}
DI float bflo(unsigned w) { return __uint_as_float(w << 16); }
DI float bfhi(unsigned w) { return __uint_as_float(w & 0xffff0000u); }
DI float fexp2(float x) { return __builtin_amdgcn_exp2f(x); }
DI void store8(u16* dst, float a, float b, float c, float d) {
  uint2 v; v.x = pack2(a, b); v.y = pack2(c, d);
  *(uint2*)dst = v;
}
DI void store_tile(u16* dst, const f32x16& v, int hh) {
#pragma unroll
  for (int g = 0; g < 4; ++g) store8(dst + 8 * g + 4 * hh, v[4 * g], v[4 * g + 1], v[4 * g + 2], v[4 * g + 3]);
}
DI void rope32(f32x16& v, const float2* cs, int hh) {
#pragma unroll
  for (int g = 0; g < 2; ++g)
#pragma unroll
    for (int b = 0; b < 4; ++b) {
      float2 c = cs[8 * g + 4 * hh + b];
      float x1 = v[4 * g + b], x2 = v[4 * g + b + 8];
      v[4 * g + b] = x1 * c.x - x2 * c.y;
      v[4 * g + b + 8] = x2 * c.x + x1 * c.y;
    }
}
DI void rope64(f32x16& v0, f32x16& v1, const float2* cs, int hh) {
#pragma unroll
  for (int g = 0; g < 4; ++g)
#pragma unroll
    for (int b = 0; b < 4; ++b) {
      float2 c = cs[8 * g + 4 * hh + b];
      float x1 = v0[4 * g + b], x2 = v1[4 * g + b];
      v0[4 * g + b] = x1 * c.x - x2 * c.y;
      v1[4 * g + b] = x2 * c.x + x1 * c.y;
    }
}
DI float wave_sum(float v) {
#pragma unroll
  for (int o = 32; o; o >>= 1) v += __shfl_xor(v, o);
  return v;
}
DI s16x4 trread(const char* p) {
  return __builtin_amdgcn_ds_read_tr16_b64_v4i16((__attribute__((address_space(3))) s16x4*)(p));
}


constexpr int LDS_BYTES = 131072 + 1024;

namespace pg8 {
#define PG8_LAS __attribute__((address_space(3)))
typedef unsigned short bf16_t;
typedef float f32x4 __attribute__((ext_vector_type(4)));
constexpr int BM = 256, BK = 64, HALF = 128, HTB = HALF * BK * 2, STAGE_BYTES = 8 * HTB, NXCD = 8, WGM = 8;
__host__ __device__ __forceinline__ int lds_byte(int r, int c) { const int st = (r >> 4) * 2 + (c >> 5), rr = r & 15, cc = c & 31, ob = rr * 64 + cc * 2; return st * 1024 + (ob ^ (((ob >> 9) & 1) << 5)); }
__host__ __device__ __forceinline__ void stage_rc(int b, int& R, int& C) { const int st = b / 1024, sb = b % 1024, swz = sb ^ (((sb >> 9) & 1) << 5); R = (st >> 1) * 16 + swz / 64; C = (st & 1) * 32 + (swz % 64) / 2; }
__host__ __device__ __forceinline__ int perm32(int rho) { const int n = rho >> 4, i = rho & 15; return 8 * (i >> 2) + 4 * n + (i & 3); }
struct Unit { int pm, pn; };
struct Gemm { const bf16_t* A; const bf16_t* Bt; int M, N, K; };
struct StaticOrder {
    int nM, nN, nwg, G, c;
    __host__ __device__ void init(int M, int N, int G_, int c_) { nM = M / BM; nN = N / BM; nwg = nM * nN; G = G_; c = c_; }
    __host__ __device__ bool next(int i, Unit& u) const {
        const long L = (long)i * G + c; if (L >= nwg) return false;
        int wgid = (int)L; { const int q = nwg / NXCD, r = nwg % NXCD, xcd = wgid % NXCD, off = wgid / NXCD; wgid = (xcd < r ? xcd * (q + 1) : r * (q + 1) + (xcd - r) * q) + off; }
        const int nig = WGM * nN, gid = wgid / nig, fm = gid * WGM, gsz = (nM - fm) < WGM ? (nM - fm) : WGM;
        u.pm = fm + ((wgid % nig) % gsz); u.pn = (wgid % nig) / gsz; return true;
    }
    __device__ __forceinline__ void a_ready(const Unit&) const {}
    __device__ __forceinline__ void done(const Unit&) const {}
};
template <class Epi, class Sched>
__device__ __forceinline__ void gemm_phase(int wv, PG8_LAS unsigned char* lds, const Gemm g, const Sched& S, const Epi& E) {
    const int tid = otid(wv), wid = __builtin_amdgcn_readfirstlane(tid >> 6), lane = tid & 63, wr = wid >> 2, wc = wid & 3, fr = lane & 15, fq = lane >> 4;
    const int K = g.K, nt = K / BK;
    unsigned voffA[2], voffB[2];
#pragma unroll
    for (int i = 0; i < 2; ++i) { int R, C; stage_rc(tid * 16 + i * 8192, R, C); const int Rb = Epi::PERM ? ((R & ~31) + perm32(R & 31)) : R;
        voffA[i] = (unsigned)(R * K + C) * 2u; voffB[i] = (unsigned)(Rb * K + C) * 2u; }
    const size_t kstep = (size_t)(BK * 2);
    const size_t hstep = (size_t)HALF * K * 2;
    const size_t tstep = 2 * hstep;
    const unsigned ldsw = (unsigned)wid * 1024u;
    const int aoff = lds_byte(wr * 64 + fr, fq * 8), boff = lds_byte(wc * 32 + fr, fq * 8);
#define PG8_SA(b, h) (((b) * 2 + (h)) * HTB)
#define PG8_SB(b, h) ((4 + (b) * 2 + (h)) * HTB)
#define PG8_STAGE(bufoff, gbase, voff) do { _Pragma("unroll") for (int _i = 0; _i < 2; ++_i) \
        __builtin_amdgcn_global_load_lds((const unsigned*)((const char*)(gbase) + (voff)[_i]), (PG8_LAS unsigned*)(lds + (bufoff) + ldsw + _i * 8192), 16, 0, 0); } while (0)
#define PG8_LDA(dst, b, h) do { _Pragma("unroll") for (int m = 0; m < 4; ++m) _Pragma("unroll") for (int k = 0; k < 2; ++k) dst[m][k] = *(const PG8_LAS bf16x8*)(lds + PG8_SA(b, h) + aoff + m * 2048 + k * 1024); } while (0)
#define PG8_LDB(dst, b, h) do { _Pragma("unroll") for (int n = 0; n < 2; ++n) _Pragma("unroll") for (int k = 0; k < 2; ++k) dst[n][k] = *(const PG8_LAS bf16x8*)(lds + PG8_SB(b, h) + boff + n * 2048 + k * 1024); } while (0)
#define PG8_MMA(ai, bj, At, Bt) do { __builtin_amdgcn_s_setprio(1); _Pragma("unroll") for (int m = 0; m < 4; ++m) _Pragma("unroll") for (int n = 0; n < 2; ++n) _Pragma("unroll") for (int k = 0; k < 2; ++k) \
        acc[ai][bj][m][n] = __builtin_amdgcn_mfma_f32_16x16x32_bf16(Bt[n][k], At[m][k], acc[ai][bj][m][n], 0, 0, 0); __builtin_amdgcn_s_setprio(0); } while (0)
#define PG8_WAIT_V(n) asm volatile("s_waitcnt vmcnt(" #n ")" ::: "memory")
#define PG8_WAIT_L(n) asm volatile("s_waitcnt lgkmcnt(" #n ")" ::: "memory")
#define PG8_BAR __builtin_amdgcn_s_barrier()
#define PG8_SCHED __builtin_amdgcn_sched_barrier(0)
    Unit cur, nxt; int ui = 0;
    if (!S.next(0, cur)) return;
    f32x4 acc[2][2][4][2];
#pragma unroll
    for (int a = 0; a < 2; ++a)
#pragma unroll
        for (int b = 0; b < 2; ++b)
#pragma unroll
            for (int m = 0; m < 4; ++m)
#pragma unroll
                for (int n = 0; n < 2; ++n) acc[a][b][m][n] = (f32x4){0.f, 0.f, 0.f, 0.f};
    bf16x8 At[4][2], B0[2][2], B1[2][2];
    const char* cA = (const char*)g.A + (size_t)cur.pm * tstep; const char* cB = (const char*)g.Bt + (size_t)cur.pn * tstep;
    S.a_ready(cur);
    PG8_STAGE(PG8_SB(0, 0), cB, voffB); PG8_STAGE(PG8_SA(0, 0), cA, voffA); PG8_STAGE(PG8_SB(0, 1), cB + hstep, voffB); PG8_STAGE(PG8_SA(0, 1), cA + hstep, voffA);
    if (wr == 1) PG8_BAR;
    PG8_WAIT_V(4); PG8_BAR;
    PG8_STAGE(PG8_SB(1, 0), cB + kstep, voffB); PG8_STAGE(PG8_SA(1, 0), cA + kstep, voffA); PG8_STAGE(PG8_SB(1, 1), cB + hstep + kstep, voffB);
    PG8_WAIT_V(6); PG8_BAR;
    for (;;) {
        const bool has_next = S.next(ui + 1, nxt);
        const char* nA = has_next ? (const char*)g.A + (size_t)nxt.pm * tstep : cA; const char* nB = has_next ? (const char*)g.Bt + (size_t)nxt.pn * tstep : cB;
#pragma unroll 1
        for (int t = 0; t < nt; t += 2) {
            const bool last = (t == nt - 2);
            const char* a1 = cA + (size_t)(t + 1) * kstep;
            const char* a2 = last ? nA : cA + (size_t)(t + 2) * kstep; const char* b2 = last ? nB : cB + (size_t)(t + 2) * kstep;
            const char* a3 = a2 + kstep; const char* b3 = b2 + kstep;
            if (last && has_next) S.a_ready(nxt);
            PG8_LDB(B0, 0, 0); PG8_SCHED; PG8_LDA(At, 0, 0); PG8_STAGE(PG8_SA(1, 1), a1 + hstep, voffA);
            PG8_WAIT_L(8); PG8_BAR; PG8_WAIT_L(0); PG8_MMA(0, 0, At, B0); PG8_BAR; PG8_SCHED;
            PG8_LDB(B1, 0, 1); PG8_STAGE(PG8_SB(0, 0), b2, voffB);
            PG8_BAR; PG8_WAIT_L(0); PG8_MMA(0, 1, At, B1); PG8_BAR;
            PG8_LDA(At, 0, 1); PG8_STAGE(PG8_SA(0, 0), a2, voffA);
            PG8_BAR; PG8_WAIT_L(0); PG8_MMA(1, 0, At, B0); PG8_BAR; PG8_SCHED;
            PG8_STAGE(PG8_SB(0, 1), b2 + hstep, voffB);
            PG8_WAIT_V(6); PG8_BAR; PG8_MMA(1, 1, At, B1); PG8_BAR;
            PG8_LDB(B0, 1, 0); PG8_SCHED; PG8_LDA(At, 1, 0); PG8_STAGE(PG8_SA(0, 1), a2 + hstep, voffA);
            PG8_WAIT_L(8); PG8_BAR; PG8_WAIT_L(0); PG8_MMA(0, 0, At, B0); PG8_BAR; PG8_SCHED;
            PG8_LDB(B1, 1, 1); PG8_STAGE(PG8_SB(1, 0), b3, voffB);
            PG8_BAR; PG8_WAIT_L(0); PG8_MMA(0, 1, At, B1); PG8_BAR;
            PG8_LDA(At, 1, 1); PG8_STAGE(PG8_SA(1, 0), a3, voffA);
            PG8_BAR; PG8_WAIT_L(0); PG8_MMA(1, 0, At, B0); PG8_BAR; PG8_SCHED;
            PG8_STAGE(PG8_SB(1, 1), b3 + hstep, voffB);
            PG8_WAIT_V(6); PG8_BAR; PG8_MMA(1, 1, At, B1); PG8_BAR;
        }
        if constexpr (!Epi::AFTER_DRAIN) { E(acc, cur, wr, wc, fr, fq); S.done(cur); }
        if (!has_next) break;
#pragma unroll
        for (int a = 0; a < 2; ++a)
#pragma unroll
            for (int b = 0; b < 2; ++b)
#pragma unroll
                for (int m = 0; m < 4; ++m)
#pragma unroll
                    for (int n = 0; n < 2; ++n) acc[a][b][m][n] = (f32x4){0.f, 0.f, 0.f, 0.f};
        cur = nxt; cA = nA; cB = nB; ++ui;
    }
    PG8_WAIT_V(0);
    if (wr == 0) PG8_BAR;
    PG8_BAR;
    if constexpr (Epi::AFTER_DRAIN) { E.fused(acc, cur, wr, wc, fr, fq, lds, wid, lane); S.done(cur); }
#undef PG8_SA
#undef PG8_SB
#undef PG8_STAGE
#undef PG8_LDA
#undef PG8_LDB
#undef PG8_MMA
#undef PG8_WAIT_V
#undef PG8_WAIT_L
#undef PG8_BAR
#undef PG8_SCHED
}
}
using pg8::f32x4;
using pg8::Unit;

DI void convert_bf16(int wv, const float* __restrict__ src, u16* __restrict__ dst, size_t n8  ) {
  const size_t i0 = (size_t)obid() * 512 + otid(wv);
  for (size_t i = i0; i < n8; i += (size_t)gridDim.x * 512) {
    float4 a = ((const float4*)src)[2 * i], b = ((const float4*)src)[2 * i + 1];
    uint4 o; o.x = pack2(a.x, a.y); o.y = pack2(a.z, a.w); o.z = pack2(b.x, b.y); o.w = pack2(b.z, b.w);
    ((uint4*)dst)[i] = o;
  }
}
typedef float f32x32 __attribute__((ext_vector_type(32)));
typedef unsigned u32x6 __attribute__((ext_vector_type(6)));
typedef unsigned u32x16 __attribute__((ext_vector_type(16)));
typedef __bf16 bf16x32_t __attribute__((ext_vector_type(32)));
constexpr int ROWB = 768;
DI void convert_rows_fp6(int wv, const float* __restrict__ src, unsigned char* __restrict__ dst, float* __restrict__ inv_scale, int nrows) {
  const int tid = otid(wv), lane = tid & 63, wave = tid >> 6, g = lane & 31;
  for (int row = (obid() * 8 + wave) * 2 + (lane >> 5); row < nrows; row += gridDim.x * 16) {
    const float4* rp = (const float4*)(src + (size_t)row * 1024 + g * 32);
    float4 v[8];
#pragma unroll
    for (int i = 0; i < 8; ++i) v[i] = rp[i];
    float mx = 0.f;
#pragma unroll
    for (int i = 0; i < 8; ++i) mx = fmaxf(mx, fmaxf(fmaxf(fabsf(v[i].x), fabsf(v[i].y)), fmaxf(fabsf(v[i].z), fabsf(v[i].w))));
#pragma unroll
    for (int o = 16; o; o >>= 1) mx = fmaxf(mx, __shfl_xor(mx, o));
    const float sc = (mx > 0.f) ? 7.0f / mx : 1.f;
    unsigned long long lo = 0ull, mid = 0ull, hi = 0ull;
    u32x6 q;
    {
      const float xs[32] = {v[0].x, v[0].y, v[0].z, v[0].w, v[1].x, v[1].y, v[1].z, v[1].w, v[2].x, v[2].y, v[2].z, v[2].w, v[3].x, v[3].y, v[3].z, v[3].w,
                            v[4].x, v[4].y, v[4].z, v[4].w, v[5].x, v[5].y, v[5].z, v[5].w, v[6].x, v[6].y, v[6].z, v[6].w, v[7].x, v[7].y, v[7].z, v[7].w};
      unsigned code[32];
#pragma unroll
      for (int i = 0; i < 32; ++i) {
        const float a = fabsf(xs[i] * sc);
        float c = (a < 2.f) ? rintf(a * 8.f) : (a < 4.f ? 16.f + rintf((a - 2.f) * 4.f) : 24.f + rintf((a - 4.f) * 2.f));
        c = fminf(c, 31.f);
        code[i] = (unsigned)c | ((xs[i] < 0.f) ? 32u : 0u);
      }
#pragma unroll
      for (int h = 0; h < 2; ++h) {
        unsigned long long a0 = 0ull, a1 = 0ull;
#pragma unroll
        for (int i = 0; i < 16; ++i) {
          const int bit = 6 * i;
          const unsigned long long cv = code[16 * h + i];
          if (bit < 64) a0 |= cv << bit;
          if (bit + 6 > 64) a1 |= (bit >= 64) ? (cv << (bit - 64)) : (cv >> (64 - bit));
        }
        q[3 * h + 0] = (unsigned)a0; q[3 * h + 1] = (unsigned)(a0 >> 32); q[3 * h + 2] = (unsigned)a1;
      }
    }
    (void)lo; (void)mid; (void)hi;
    unsigned char* dp = dst + (size_t)row * ROWB + g * 24;
    *(uint2*)dp = make_uint2(q[0], q[1]);
    *(uint2*)(dp + 8) = make_uint2(q[2], q[3]);
    *(uint2*)(dp + 16) = make_uint2(q[4], q[5]);
    if (g == 0) inv_scale[row] = (mx > 0.f) ? mx * (1.f / 7.0f) : 1.f;
  }
}

DI int rope32_d(int pos) { return 4 * (pos >> 3) + (pos & 3) + 16 * ((pos >> 2) & 1); }
DI int map_gemm1(int np) {
  const int G = np >> 5, pos = np & 31;
  if (G < 8) return G * 32 + rope32_d(pos);
  if (G < 16) return 256 + (G - 8) * 32 + rope32_d(pos);
  if (G < 36) return G * 32 + pos;
  if (G == 36) return 1152 + rope32_d(pos);
  if (G == 37) return -1;
  if (G < 62) {
    const int hg = (G < 50) ? (G - 38) : (G - 50);
    const int base = (G < 50) ? 1184 : 1568;
    return base + (hg >> 1) * 64 + 16 * (hg & 1) + 4 * (pos >> 3) + (pos & 3) + 32 * ((pos >> 2) & 1);
  }
  if (G < 74) return 1952 + (G - 62) * 32 + pos;
  return -1;
}
DI int map_up(int np, int& which) {
  const int G = np >> 5, pos = np & 31;
  if (G < 18) { which = 0; const int head = G / 3, part = G % 3; return head * 96 + part * 32 + (part == 2 ? rope32_d(pos) : pos); }
  if (G < 42) { which = 1; return (G - 18) * 32 + pos; }
  which = -1; return -1;
}
DI void transpose_tile(const Params& p, int layer, int mode, u16* __restrict__ dst, int ldd, int nt, int kt, float* tile) {
  const int tid = otid(p.wave);
  const int n0 = nt * 64, k0 = kt * 64;
#pragma unroll
  for (int pass = 0; pass < 2; ++pass) {
    const int kk = (tid >> 4) + pass * 32, nn = (tid & 15) * 4;
    const int np = n0 + nn;
    const float* src = nullptr; int nsrc = 0, col = -1, ksrc = k0 + kk; float sc = 1.f;
    if (mode == 0) {
      col = map_gemm1(np); src = p.in[1] + (size_t)layer * DM * INW; nsrc = INW;
      if (col >= 0 && col < 256) sc = 0.17677669529663687f * LOG2E;
      else if (col >= 1184 && col < 1568) sc = 0.125f * LOG2E;
    } else if (mode == 1) {
      int which; col = map_up(np, which);
      if (which == 0 && k0 < 256) { src = p.in[6] + (size_t)layer * 256 * 576; nsrc = 576; sc = 0.10206207261596575f * LOG2E * p.in[4][layer * 256 + ksrc]; }
      else if (which == 1 && k0 >= 256) { ksrc -= 256; src = p.in[7] + (size_t)layer * 128 * 768; nsrc = 768; sc = p.in[5][layer * 128 + ksrc]; }
      else col = -1;
    } else if (mode == 3) {
      col = np; src = p.in[8] + (size_t)layer * DM * DM; nsrc = DM;
    } else {
      col = np; src = p.in[11] + (size_t)layer * DM * 2048; nsrc = 2048;
    }
    float4 v = make_float4(0.f, 0.f, 0.f, 0.f);
    if (col >= 0) v = *(const float4*)(src + (size_t)ksrc * nsrc + col);
    tile[kk * 65 + nn + 0] = v.x * sc; tile[kk * 65 + nn + 1] = v.y * sc;
    tile[kk * 65 + nn + 2] = v.z * sc; tile[kk * 65 + nn + 3] = v.w * sc;
  }
  __syncthreads();
  {
    const int nn = tid >> 3, k8 = (tid & 7) * 8;
    float f[8];
#pragma unroll
    for (int e = 0; e < 8; ++e) f[e] = tile[(k8 + e) * 65 + nn];
    uint4 o; o.x = pack2(f[0], f[1]); o.y = pack2(f[2], f[3]); o.z = pack2(f[4], f[5]); o.w = pack2(f[6], f[7]);
    *(uint4*)(dst + (size_t)(n0 + nn) * ldd + k0 + k8) = o;
  }
  __syncthreads();
}

DI void phase_prep(const Params& p, char* lds) {
  convert_bf16(p.wave, p.in[0], p.xb, (size_t)T_ALL * DM / 8);
  convert_bf16(p.wave, p.in[12], p.keysb, (size_t)2 * 16 * 128 * 128 / 8);
  convert_rows_fp6(p.wave, p.in[13], p.ub, p.us, 2 * NEXP);
  convert_rows_fp6(p.wave, p.in[14], p.vb, p.vs, 2 * NEXP);
  for (int i = obid() * 512 + otid(p.wave); i < SEQ * 48; i += gridDim.x * 512) {
    int pos = i / 48, r = i % 48;
    if (r < 16) {
      float ang = (float)pos * expf(-logf(10000.0f) * (float)r / 16.f);
      p.cs32[pos * 16 + r] = make_float2(cosf(ang), sinf(ang));
    } else {
      int q = r - 16;
      float ang = (float)pos * expf(-logf(10000.0f) * (float)q / 32.f);
      p.cs64[pos * 32 + q] = make_float2(cosf(ang), sinf(ang));
    }
  }
  float* tile = (float*)lds;
  for (int u = obid(); u < 3104; u += gridDim.x) {
    const int layer = u / 1552, r = u % 1552;
    if (r < 640) transpose_tile(p, layer, 0, p.winT + (size_t)layer * NPAD * 1024, 1024, r / 16, r % 16, tile);
    else if (r < 784) { const int v = r - 640; transpose_tile(p, layer, 1, p.wupT + (size_t)layer * NUP * KUP, KUP, v / 6, v % 6, tile); }
    else if (r < 1040) { const int v = r - 784; transpose_tile(p, layer, 3, p.woT + (size_t)layer * DM * DM, 1024, v / 16, v % 16, tile); }
    else { const int v = r - 1040; transpose_tile(p, layer, 4, p.wqT + (size_t)layer * 2048 * DM, 1024, v / 16, v % 16, tile); }
  }
}

DI void store16(u16* dst, const f32x4& a, const f32x4& b) {
  uint4 w; w.x = pack2(a[0], a[1]); w.y = pack2(a[2], a[3]); w.z = pack2(b[0], b[1]); w.w = pack2(b[2], b[3]);
  *(uint4*)dst = w;
}
DI void rope4(f32x4& v0, f32x4& v1, const float2* cs) {
  const float4 c01 = *(const float4*)cs, c23 = *(const float4*)(cs + 2);
  const float co[4] = {c01.x, c01.z, c23.x, c23.z}, si[4] = {c01.y, c01.w, c23.y, c23.w};
#pragma unroll
  for (int k = 0; k < 4; ++k) {
    const float x1 = v0[k], x2 = v1[k];
    v0[k] = x1 * co[k] - x2 * si[k];
    v1[k] = x2 * co[k] + x1 * si[k];
  }
}
struct EpiGemm1 {
  static constexpr bool PERM = true, AFTER_DRAIN = false;
  u16 *aq, *ak, *av, *bc, *bkr, *cq, *ck, *cv; const float2 *cs32, *cs64; float* sumsq;
  DI void operator()(const f32x4 (&acc)[2][2][4][2], const Unit& u, int wr, int wc, int fr, int fq) const {
#pragma unroll
    for (int bj = 0; bj < 2; ++bj) {
      const int G = u.pn * 8 + bj * 4 + wc;
#pragma unroll
      for (int ai = 0; ai < 2; ++ai)
#pragma unroll
        for (int m = 0; m < 4; ++m) {
          const int t = u.pm * 256 + ai * 128 + wr * 64 + m * 16 + fr;
          const int b = t >> 12, s = t & 4095;
          f32x4 v0 = acc[ai][bj][m][0], v1 = acc[ai][bj][m][1];
          if (G < 16 || G == 36) {
            rope4(v0, v1, cs32 + s * 16 + 4 * fq);
            u16* dst = (G < 8) ? aq + ((size_t)(b * 8 + G) * SEQ + s) * 32
                     : (G < 16) ? ak + ((size_t)(b * 8 + G - 8) * SEQ + s) * 32 : bkr + (size_t)t * 32;
            store8(dst + 4 * fq, v0[0], v0[1], v0[2], v0[3]);
            store8(dst + 16 + 4 * fq, v1[0], v1[1], v1[2], v1[3]);
          } else if (G < 24) {
            store16(av + ((size_t)(b * 4 + ((G - 16) >> 1)) * SEQ + s) * 64 + ((G - 16) & 1) * 32 + 8 * fq, v0, v1);
          } else if (G < 36) {
            store16(bc + (size_t)t * KUP + (G - 24) * 32 + 8 * fq, v0, v1);
            float ps = v0[0] * v0[0] + v0[1] * v0[1] + v0[2] * v0[2] + v0[3] * v0[3] + v1[0] * v1[0] + v1[1] * v1[1] + v1[2] * v1[2] + v1[3] * v1[3];
            ps += __shfl_xor(ps, 16); ps += __shfl_xor(ps, 32);
            if (fq == 0) sumsq[(size_t)t * 12 + (G - 24)] = ps;
          } else if (G == 37) {
          } else if (G < 62) {
            const bool isq = G < 50; const int hg = G - (isq ? 38 : 50), head = hg >> 1, gsel = hg & 1;
            rope4(v0, v1, cs64 + s * 32 + 16 * gsel + 4 * fq);
            u16* dst = (isq ? cq : ck) + ((size_t)(b * 6 + head) * SEQ + s) * 64 + 16 * gsel + 4 * fq;
            store8(dst, v0[0], v0[1], v0[2], v0[3]);
            store8(dst + 32, v1[0], v1[1], v1[2], v1[3]);
          } else if (G < 74) {
            store16(cv + ((size_t)(b * 6 + ((G - 62) >> 1)) * SEQ + s) * 64 + ((G - 62) & 1) * 32 + 8 * fq, v0, v1);
          }
          __builtin_amdgcn_sched_barrier(0);
        }
    }
  }
};
struct EpiUp {
  static constexpr bool PERM = true, AFTER_DRAIN = false;
  u16 *mq, *mk, *mv; const float2* cs32; const float* sumsq;
  DI void operator()(const f32x4 (&acc)[2][2][4][2], const Unit& u, int wr, int wc, int fr, int fq) const {
#pragma unroll
    for (int ai = 0; ai < 2; ++ai)
#pragma unroll
      for (int m = 0; m < 4; ++m) {
        const int t = u.pm * 256 + ai * 128 + wr * 64 + m * 16 + fr;
        const int b = t >> 12, s = t & 4095;
        const float4 sa = *(const float4*)(sumsq + (size_t)t * 12), sb = *(const float4*)(sumsq + (size_t)t * 12 + 4), sc = *(const float4*)(sumsq + (size_t)t * 12 + 8);
        const float rq = rsqrtf((((sa.x + sa.y) + (sa.z + sa.w)) + ((sb.x + sb.y) + (sb.z + sb.w))) * (1.f / 256.f) + 1e-5f);
        const float rkv = rsqrtf(((sc.x + sc.y) + (sc.z + sc.w)) * (1.f / 128.f) + 1e-5f);
#pragma unroll
        for (int bj = 0; bj < 2; ++bj) {
          const int G = u.pn * 8 + bj * 4 + wc;
          f32x4 v0 = acc[ai][bj][m][0], v1 = acc[ai][bj][m][1];
          if (G < 18) {
            const int head = G / 3, part = G % 3;
            v0 *= rq; v1 *= rq;
            u16* dst = mq + ((size_t)(b * 6 + head) * SEQ + s) * 96;
            if (part < 2) store16(dst + part * 32 + 8 * fq, v0, v1);
            else {
              rope4(v0, v1, cs32 + s * 16 + 4 * fq);
              store8(dst + 64 + 4 * fq, v0[0], v0[1], v0[2], v0[3]);
              store8(dst + 80 + 4 * fq, v1[0], v1[1], v1[2], v1[3]);
            }
          } else if (G < 42) {
            const int g = G - 18, head = g >> 2, part = g & 3;
            v0 *= rkv; v1 *= rkv;
            store16((part < 2 ? mk : mv) + ((size_t)(b * 6 + head) * SEQ + s) * 64 + (part & 1) * 32 + 8 * fq, v0, v1);
          }
        }
        __builtin_amdgcn_sched_barrier(0);
      }
  }
};
struct EpiOut {
  static constexpr bool PERM = true, AFTER_DRAIN = false;
  const u16* xb; u16* ybuf; float* stats;
  DI void operator()(const f32x4 (&acc)[2][2][4][2], const Unit& u, int wr, int wc, int fr, int fq) const {
#pragma unroll
    for (int ai = 0; ai < 2; ++ai)
#pragma unroll
      for (int m = 0; m < 4; ++m) {
        const int t = u.pm * 256 + ai * 128 + wr * 64 + m * 16 + fr;
        float s1 = 0.f, s2 = 0.f;
#pragma unroll
        for (int bj = 0; bj < 2; ++bj) {
          const size_t off = (size_t)t * 1024 + u.pn * 256 + bj * 128 + wc * 32 + 8 * fq;
          const uint4 xv = *(const uint4*)(xb + off);
          f32x4 y0, y1;
          y0[0] = ALPHA * bflo(xv.x) + acc[ai][bj][m][0][0]; y0[1] = ALPHA * bfhi(xv.x) + acc[ai][bj][m][0][1];
          y0[2] = ALPHA * bflo(xv.y) + acc[ai][bj][m][0][2]; y0[3] = ALPHA * bfhi(xv.y) + acc[ai][bj][m][0][3];
          y1[0] = ALPHA * bflo(xv.z) + acc[ai][bj][m][1][0]; y1[1] = ALPHA * bfhi(xv.z) + acc[ai][bj][m][1][1];
          y1[2] = ALPHA * bflo(xv.w) + acc[ai][bj][m][1][2]; y1[3] = ALPHA * bfhi(xv.w) + acc[ai][bj][m][1][3];
          s1 += (y0[0] + y0[1]) + (y0[2] + y0[3]) + (y1[0] + y1[1]) + (y1[2] + y1[3]);
          s2 += y0[0] * y0[0] + y0[1] * y0[1] + y0[2] * y0[2] + y0[3] * y0[3] + y1[0] * y1[0] + y1[1] * y1[1] + y1[2] * y1[2] + y1[3] * y1[3];
          store16(ybuf + off, y0, y1);
        }
        s1 += __shfl_xor(s1, 16); s1 += __shfl_xor(s1, 32);
        s2 += __shfl_xor(s2, 16); s2 += __shfl_xor(s2, 32);
        if (fq == 0) { stats[(size_t)t * 32 + u.pn * 4 + wc] = s1; stats[(size_t)t * 32 + 16 + u.pn * 4 + wc] = s2; }
      }
  }
};
struct EpiQ {
  static constexpr bool PERM = true, AFTER_DRAIN = false;
  u16* qbuf;
  DI void operator()(const f32x4 (&acc)[2][2][4][2], const Unit& u, int wr, int wc, int fr, int fq) const {
#pragma unroll
    for (int ai = 0; ai < 2; ++ai)
#pragma unroll
      for (int m = 0; m < 4; ++m) {
        const int t = u.pm * 256 + ai * 128 + wr * 64 + m * 16 + fr;
#pragma unroll
        for (int bj = 0; bj < 2; ++bj)
          store16(qbuf + (size_t)t * 2048 + u.pn * 256 + bj * 128 + wc * 32 + 8 * fq, acc[ai][bj][m][0], acc[ai][bj][m][1]);
      }
  }
};
template <class Epi>
DI void run_gemm(int wv, const u16* A, const u16* Bt, int N, int K, const Epi& E, char* lds) {
  pg8::Gemm g; g.A = A; g.Bt = Bt; g.M = T_ALL; g.N = N; g.K = K;
  pg8::StaticOrder S; S.init(T_ALL, N, gridDim.x, obid());
  pg8::gemm_phase(wv, (PG8_LAS unsigned char*)lds, g, S, E);
  __syncthreads();
}
DI bf16x8 packP(const f32x16& S, int s2) {
  uint4 u;
  u.x = pack2(S[8 * s2 + 0], S[8 * s2 + 1]); u.y = pack2(S[8 * s2 + 2], S[8 * s2 + 3]);
  u.z = pack2(S[8 * s2 + 4], S[8 * s2 + 5]); u.w = pack2(S[8 * s2 + 6], S[8 * s2 + 7]);
  return __builtin_bit_cast(bf16x8, u);
}

DI float fadd_s(float a, float b) { float r; asm("v_add_f32 %0, %1, %2" : "=v"(r) : "v"(a), "v"(b)); return r; }
DI float exp_sum16(f32x16& S) {
#pragma unroll
  for (int e = 0; e < 16; ++e) S[e] = fexp2(S[e]);
  const float a0 = fadd_s(S[0], S[1]), a1 = fadd_s(S[2], S[3]), a2 = fadd_s(S[4], S[5]), a3 = fadd_s(S[6], S[7]);
  const float a4 = fadd_s(S[8], S[9]), a5 = fadd_s(S[10], S[11]), a6 = fadd_s(S[12], S[13]), a7 = fadd_s(S[14], S[15]);
  const float b0 = fadd_s(a0, a1), b1 = fadd_s(a2, a3), b2 = fadd_s(a4, a5), b3 = fadd_s(a6, a7);
  return fadd_s(fadd_s(b0, b1), fadd_s(b2, b3));
}
DI float max3f(float a, float b, float c) { return __builtin_fmaxf(__builtin_fmaxf(a, b), c); }
DI float max16(const f32x16& S) {
  const float a = max3f(S[0], S[1], S[2]), b = max3f(S[3], S[4], S[5]), c = max3f(S[6], S[7], S[8]);
  const float d = max3f(S[9], S[10], S[11]), e = max3f(S[12], S[13], S[14]);
  return max3f(max3f(a, b, c), max3f(d, e, S[15]), a);
}

template <bool MLA, bool SAFE, int NQ  >
DI bool attn_dense_item(const Params& p, int layer, int item, float lam_full, float lam_init, char* lds) {
  constexpr int NKT = MLA ? 1 : 2;
  constexpr int DK = MLA ? 96 : 32;
  constexpr int KSTR = MLA ? 208 : 80;
  constexpr int KB = 64 * KSTR;
  constexpr int STAGE = NKT * KB + 8192;
  constexpr int NKS = DK / 16;
  constexpr float THR = 8.f;
  const int tid = otid(p.wave), lane = tid & 63, wave = tid >> 6, r = lane & 31, hh = lane >> 5;
  const int strm = MLA ? 0 : (wave & 1);
  int b, head, q0;
  if (MLA) { b = item / 96; head = (item / 16) % 6; q0 = (item & 15) * 256 + wave * 32; }
  else if (NQ == 2) { b = item / 64; head = (item / 16) & 3; q0 = (item & 15) * 256 + (wave >> 1) * 64; }
  else { b = item / 128; head = (item / 32) & 3; q0 = (item & 31) * 128 + (wave >> 1) * 32; }
  const u16 *kg0, *kg1, *vg;
  bf16x8 Q[NQ][NKS];
  if (MLA) {
    const u16* qp = p.mq + ((size_t)(b * 6 + head) * SEQ + q0 + r) * 96 + hh * 8;
#pragma unroll
    for (int s = 0; s < NKS; ++s) Q[0][s] = *(const bf16x8*)(qp + s * 16);
    kg0 = p.mk + (size_t)(b * 6 + head) * SEQ * 64;
    kg1 = p.bkr + (size_t)b * SEQ * 32;
    vg = p.mv + (size_t)(b * 6 + head) * SEQ * 64;
  } else {
#pragma unroll
    for (int qi = 0; qi < NQ; ++qi) {
      const u16* qp = p.aq + ((size_t)(b * 8 + head * 2 + strm) * SEQ + q0 + qi * 32 + r) * 32 + hh * 8;
#pragma unroll
      for (int s = 0; s < NKS; ++s) Q[qi][s] = *(const bf16x8*)(qp + s * 16);
    }
    kg0 = p.ak + (size_t)(b * 8 + head * 2) * SEQ * 32;
    kg1 = p.ak + (size_t)(b * 8 + head * 2 + 1) * SEQ * 32;
    vg = p.av + (size_t)(b * 4 + head) * SEQ * 64;
  }
  f32x16 O[NQ][2];
  float mu[NQ], mt[NQ], l[NQ];
#pragma unroll
  for (int qi = 0; qi < NQ; ++qi) {
    l[qi] = 0.f;
#pragma unroll
    for (int e = 0; e < 16; ++e) { O[qi][0][e] = 0.f; O[qi][1][e] = 0.f; }
  }
  const int offk = MLA ? (tid >> 3) * 64 + (tid & 7) * 8 : ((tid & 255) >> 2) * 32 + (tid & 3) * 8;
  const int offp = (tid >> 2) * 32 + (tid & 3) * 8;
  const int offv = (tid >> 3) * 64 + (tid & 7) * 8;
  uint4 gk, gv, gp;
  auto gload = [&](int kt) {
    const int k0 = kt * 64;
    if (MLA) {
      gk = *(const uint4*)(kg0 + (size_t)k0 * 64 + offk);
      if (tid < 256) gp = *(const uint4*)(kg1 + (size_t)k0 * 32 + offp);
    } else {
      const u16* kb = (p.wave < 4) ? kg0 : kg1;
      gk = *(const uint4*)(kb + (size_t)k0 * 32 + offk);
    }
    gv = *(const uint4*)(vg + (size_t)k0 * 64 + offv);
  };
  auto swrite = [&](int sb) {
    char* base = lds + sb * STAGE;
    if (MLA) {
      *(uint4*)(base + (tid >> 3) * KSTR + (tid & 7) * 16) = gk;
      if (tid < 256) *(uint4*)(base + (tid >> 2) * KSTR + 128 + (tid & 3) * 16) = gp;
    } else {
      const int c = tid & 255;
      *(uint4*)(base + (tid >> 8) * KB + (c >> 2) * KSTR + (c & 3) * 16) = gk;
    }
    const int row = tid >> 3;
    *(uint4*)(base + NKT * KB + row * 128 + (((tid & 7) * 16) ^ (((row >> 1) & 1) << 6))) = gv;
  };
  const int tq = (lane & 15) >> 2, tp = lane & 3, tg1 = (lane >> 4) & 1, swz = (tq >> 1) & 1;
  const int voff = NKT * KB + (4 * hh + tq) * 128 + 32 * tg1 + 8 * tp;
  const int koff = strm * KB + r * KSTR + hh * 16;
#define VFRAG(i2, u, s2) ({ const char* a_ = vb + (32 * (u) + 16 * (s2)) * 128 + 64 * ((i2) ^ swz); \
    const s16x4 lo_ = trread(a_), hi_ = trread(a_ + 8 * 128); (bf16x8)__builtin_shufflevector(lo_, hi_, 0, 1, 2, 3, 4, 5, 6, 7); })
#define QXFRAG(m_) __builtin_bit_cast(bf16x8, make_uint4(hh == 0 ? (pack2(-(m_), 0.f) & 0xffffu) : 0u, 0u, 0u, 0u))

  gload(0); swrite(0);
  __syncthreads();
  bf16x8 QX[NQ];
  const bf16x8 KX = __builtin_bit_cast(bf16x8, make_uint4(hh == 0 ? 0x3F80u : 0u, 0u, 0u, 0u));
  {
    const char* kb_ = lds + koff;
#pragma unroll
    for (int qi = 0; qi < NQ; ++qi) {
      f32x16 A0 = (f32x16)(0.f), A1 = (f32x16)(0.f);
#pragma unroll
      for (int s = 0; s < NKS; ++s) { A0 = MFMA(*(const bf16x8*)(kb_ + s * 32), Q[qi][s], A0); A1 = MFMA(*(const bf16x8*)(kb_ + 32 * KSTR + s * 32), Q[qi][s], A1); }
      float mx = fmaxf(max16(A0), max16(A1));
      mx = fmaxf(mx, __shfl_xor(mx, 32));
      mu[qi] = bflo(pack2(mx, 0.f)); mt[qi] = mx;
      QX[qi] = QXFRAG(mu[qi]);
    }
  }
#pragma unroll 1
  for (int kt = 0; kt < 64; ++kt) {
    if (kt + 1 < 64) gload(kt + 1);
    const char* base = lds + (kt & 1) * STAGE;
    const char* vb = base + voff;
    bf16x8 KF[2][NKS];
    const char* kbs_ = base + koff;
    if (!SAFE) {
#pragma unroll
      for (int s = 0; s < NKS; ++s) { KF[0][s] = *(const bf16x8*)(kbs_ + s * 32); KF[1][s] = *(const bf16x8*)(kbs_ + 32 * KSTR + s * 32); }
    }
    if (SAFE) {
      bool need = false;
#pragma unroll
      for (int qi = 0; qi < NQ; ++qi) { mt[qi] = fmaxf(mt[qi], __shfl_xor(mt[qi], 32)); need = need || (mt[qi] > mu[qi] + THR); }
      if (__any(need)) {
#pragma unroll
        for (int qi = 0; qi < NQ; ++qi) {
          const float mn = bflo(pack2(fmaxf(mt[qi], mu[qi]), 0.f));
          const float al = fexp2(mu[qi] - mn);
          mu[qi] = mn; l[qi] *= al;
#pragma unroll
          for (int e = 0; e < 16; ++e) { O[qi][0][e] *= al; O[qi][1][e] *= al; }
          QX[qi] = QXFRAG(mu[qi]);
        }
      }
    }
    __builtin_amdgcn_sched_barrier(0);
#pragma unroll
    for (int qi = 0; qi < NQ; ++qi) {
      f32x16 A0, A1;
      __builtin_amdgcn_s_setprio(1);
      A0 = MFMA(KX, QX[qi], (f32x16)(0.f)); A1 = MFMA(KX, QX[qi], (f32x16)(0.f));
#pragma unroll
      for (int s = 0; s < NKS; ++s) {
        if (!SAFE) { A0 = MFMA(KF[0][s], Q[qi][s], A0); A1 = MFMA(KF[1][s], Q[qi][s], A1); }
        else { A0 = MFMA(*(const bf16x8*)(kbs_ + s * 32), Q[qi][s], A0); A1 = MFMA(*(const bf16x8*)(kbs_ + 32 * KSTR + s * 32), Q[qi][s], A1); }
      }
      __builtin_amdgcn_s_setprio(0);
      bf16x8 V0[2][2];
      if (!SAFE) {
#pragma unroll
        for (int i2 = 0; i2 < 2; ++i2)
#pragma unroll
          for (int s2 = 0; s2 < 2; ++s2) V0[i2][s2] = VFRAG(i2, 0, s2);
      }
      __builtin_amdgcn_sched_barrier(0);
      if (SAFE) mt[qi] = fmaxf(mt[qi], mu[qi] + fmaxf(max16(A0), max16(A1)));
      bf16x8 P0[2], P1[2];
      l[qi] += exp_sum16(A0);
      P0[0] = packP(A0, 0); P0[1] = packP(A0, 1);
      bf16x8 V1[2][2];
      if (!SAFE) {
#pragma unroll
        for (int i2 = 0; i2 < 2; ++i2)
#pragma unroll
          for (int s2 = 0; s2 < 2; ++s2) V1[i2][s2] = VFRAG(i2, 1, s2);
      }
      __builtin_amdgcn_sched_barrier(0);
#pragma unroll
      for (int i2 = 0; i2 < 2; ++i2)
#pragma unroll
        for (int s2 = 0; s2 < 2; ++s2) O[qi][i2] = MFMA(SAFE ? VFRAG(i2, 0, s2) : V0[i2][s2], P0[s2], O[qi][i2]);
      l[qi] += exp_sum16(A1);
      P1[0] = packP(A1, 0); P1[1] = packP(A1, 1);
      __builtin_amdgcn_sched_barrier(0);
#pragma unroll
      for (int i2 = 0; i2 < 2; ++i2)
#pragma unroll
        for (int s2 = 0; s2 < 2; ++s2) O[qi][i2] = MFMA(SAFE ? VFRAG(i2, 1, s2) : V1[i2][s2], P1[s2], O[qi][i2]);
      __builtin_amdgcn_sched_barrier(0);
    }
    if (kt + 1 < 64) swrite((kt + 1) & 1);
    __syncthreads();
  }
#undef VFRAG
#undef QXFRAG
  float lt[NQ];
  bool bad = false;
#pragma unroll
  for (int qi = 0; qi < NQ; ++qi) { lt[qi] = l[qi] + __shfl_xor(l[qi], 32); bad = bad || !(lt[qi] < 1.0e37f); }
  if (!SAFE) {
    if (__syncthreads_or(bad)) return true;
  }
  if (MLA) {
    const int t = b * SEQ + q0 + r;
    const float inv = 1.f / lt[0];
#pragma unroll
    for (int i2 = 0; i2 < 2; ++i2) {
#pragma unroll
      for (int e = 0; e < 16; ++e) O[0][i2][e] *= inv;
      store_tile(p.cat + (size_t)t * 1024 + 256 + head * 64 + i2 * 32, O[0][i2], hh);
    }
  } else {
    float* xch = (float*)lds + (((wave >> 1) * NQ) * 64 + lane) * 33;
    if (strm == 1) {
#pragma unroll
      for (int qi = 0; qi < NQ; ++qi) {
        const float sc = lam_full / lt[qi];
#pragma unroll
        for (int i2 = 0; i2 < 2; ++i2)
#pragma unroll
          for (int e = 0; e < 16; ++e) xch[qi * 64 * 33 + i2 * 16 + e] = O[qi][i2][e] * sc;
      }
    }
    __syncthreads();
    if (strm == 0) {
      const float* g = p.in[3] + layer * 64;
#pragma unroll
      for (int qi = 0; qi < NQ; ++qi) {
        const int t = b * SEQ + q0 + qi * 32 + r;
        const float inv1 = 1.f / lt[qi];
        float ss = 0.f;
#pragma unroll
        for (int i2 = 0; i2 < 2; ++i2)
#pragma unroll
          for (int e = 0; e < 16; ++e) {
            const float o = O[qi][i2][e] * inv1 - xch[qi * 64 * 33 + i2 * 16 + e];
            O[qi][i2][e] = o; ss += o * o;
          }
        ss += __shfl_xor(ss, 32);
        const float rn = rsqrtf(ss * (1.f / 64.f) + 1e-5f) * (1.f - lam_init);
#pragma unroll
        for (int i2 = 0; i2 < 2; ++i2) {
#pragma unroll
          for (int gq = 0; gq < 4; ++gq)
#pragma unroll
            for (int bq = 0; bq < 4; ++bq) O[qi][i2][4 * gq + bq] *= rn * g[i2 * 32 + 8 * gq + 4 * hh + bq];
          store_tile(p.cat + (size_t)t * 1024 + head * 64 + i2 * 32, O[qi][i2], hh);
        }
      }
    }
    __syncthreads();
  }
  return false;
}


DI bool attn_mla_split(const Params& p, int layer, int item, char* lds) {
  constexpr int KSTR = 208, KB = 64 * KSTR;
  const int tid = otid(p.wave), lane = tid & 63, wave = tid >> 6, r = lane & 31, hh = lane >> 5;
  const int qb = p.wave & 3, kh = p.wave >> 2;
  const int b = item / 96, head = (item / 16) % 6, q0 = (item & 15) * 256 + qb * 64;
  bf16x8 Q0[6], Q1[6];
  {
    const u16* qp = p.mq + ((size_t)(b * 6 + head) * SEQ + q0 + r) * 96 + hh * 8;
#pragma unroll
    for (int s = 0; s < 6; ++s) { Q0[s] = *(const bf16x8*)(qp + s * 16); Q1[s] = *(const bf16x8*)(qp + 32 * 96 + s * 16); }
  }
  f32x16 O00 = (f32x16)(0.f), O01 = (f32x16)(0.f), O10 = (f32x16)(0.f), O11 = (f32x16)(0.f);
  float l0 = 0.f, l1 = 0.f;
  const u16* kgp = p.mk + (size_t)(b * 6 + head) * SEQ * 64 + (tid >> 3) * 64 + (tid & 7) * 8;
  const u16* pgp = p.bkr + (size_t)b * SEQ * 32 + (tid >> 3) * 32 + (tid & 7) * 4;
  const u16* vgp = p.mv + (size_t)(b * 6 + head) * SEQ * 64 + (tid >> 3) * 64 + (tid & 7) * 8;
  char* kw = lds + (tid >> 3) * KSTR + (tid & 7) * 16;
  char* vw = lds + 2 * KB + (tid >> 3) * 128 + (((tid & 7) * 16) ^ ((((tid >> 3) >> 1) & 1) << 6));
  uint4 gk0, gv0, gk1, gv1; uint2 gp0, gp1;
#define LD_K(kt, S) { const int kt_ = (kt) < 63 ? (kt) : 63; gk##S = *(const uint4*)(kgp + (size_t)kt_ * 4096); }
#define LD_P(kt, S) { const int kt_ = (kt) < 63 ? (kt) : 63; gp##S = *(const uint2*)(pgp + (size_t)kt_ * 2048); }
#define LD_V(kt, S) { const int kt_ = (kt) < 63 ? (kt) : 63; gv##S = *(const uint4*)(vgp + (size_t)kt_ * 4096); }
#define SW_K(slot, S) *(uint4*)(kw + (slot) * KB) = gk##S;
#define SW_P(slot, S) *(uint2*)(kw + (slot) * KB + 128 - (tid & 7) * 8) = gp##S;
#define SW_V(slot, S) *(uint4*)(vw + (slot) * 8192) = gv##S;
  const int tq = (lane & 15) >> 2, tp = lane & 3, tg1 = (lane >> 4) & 1, swz = (tq >> 1) & 1;
  const char* vb0 = lds + 2 * KB + (32 * kh + 4 * hh + tq) * 128 + 32 * tg1 + 8 * tp + 64 * swz;
  const char* vb1 = lds + 2 * KB + (32 * kh + 4 * hh + tq) * 128 + 32 * tg1 + 8 * tp + 64 * (swz ^ 1);
  const char* kb = lds + (32 * kh + r) * KSTR + hh * 16;
#define VFRX_(VS, i2, s2) ({ const char* a_ = ((i2) ? vb1 : vb0) + (VS) * 8192 + (16 * (s2)) * 128; \
    const s16x4 lo_ = trread(a_), hi_ = trread(a_ + 8 * 128); (bf16x8)__builtin_shufflevector(lo_, hi_, 0, 1, 2, 3, 4, 5, 6, 7); })
#define FEXP_(x) fexp2(x)
  LD_K(0, 0); LD_P(0, 0); LD_V(0, 0); LD_K(1, 1); LD_P(1, 1);
  SW_K(0, 0); SW_P(0, 0); SW_V(0, 0); SW_K(1, 1); SW_P(1, 1);
  LD_K(2, 1); LD_P(2, 1); LD_V(1, 1);
  __syncthreads();
  f32x16 A0 = (f32x16)(0.f), A1 = (f32x16)(0.f), B0, B1;
#pragma unroll
  for (int s = 0; s < 6; ++s) { const bf16x8 ko = *(const bf16x8*)(kb + s * 32); A0 = MFMA(ko, Q0[s], A0); A1 = MFMA(ko, Q1[s], A1); }
#pragma unroll 1
  for (int t = 0; t < 64; t += 2) {
#define KFR_(s) (*(const bf16x8*)(kb + 1 * KB + (s) * 32))
#define VFR_(i2, s2) VFRX_(0, i2, s2)
  const bf16x8 kf0_e = KFR_(0);
  const bf16x8 kf1_e = KFR_(1);
  __builtin_amdgcn_sched_barrier(0);
  B0 = MFMA(kf0_e, Q0[0], (f32x16)(0.f));
  A0[0] = FEXP_(A0[0]);
  A0[1] = FEXP_(A0[1]);
  __builtin_amdgcn_sched_barrier(0);
  B1 = MFMA(kf0_e, Q1[0], (f32x16)(0.f));
  const bf16x8 kf2_e = KFR_(2);
  A0[2] = FEXP_(A0[2]);
  A0[3] = FEXP_(A0[3]);
  const unsigned pw0_0_e = pack2(A0[0], A0[1]);
  const float t0_0_e = fadd_s(A0[0], A0[1]);
  SW_K(0, 1);
  __builtin_amdgcn_sched_barrier(0);
  B0 = MFMA(kf1_e, Q0[1], B0);
  const bf16x8 vf00_e = VFR_(0, 0);
  A0[4] = FEXP_(A0[4]);
  A0[5] = FEXP_(A0[5]);
  const unsigned pw0_1_e = pack2(A0[2], A0[3]);
  const float t0_1_e = fadd_s(A0[2], A0[3]);
  __builtin_amdgcn_sched_barrier(0);
  B1 = MFMA(kf1_e, Q1[1], B1);
  const bf16x8 vf10_e = VFR_(1, 0);
  A0[6] = FEXP_(A0[6]);
  A0[7] = FEXP_(A0[7]);
  const unsigned pw0_2_e = pack2(A0[4], A0[5]);
  const float t0_2_e = fadd_s(A0[4], A0[5]);
  const float s0_0_0_e = fadd_s(t0_0_e, t0_1_e);
  SW_P(0, 1);
  __builtin_amdgcn_sched_barrier(0);
  B0 = MFMA(kf2_e, Q0[2], B0);
  A1[0] = FEXP_(A1[0]);
  A1[1] = FEXP_(A1[1]);
  const unsigned pw0_3_e = pack2(A0[6], A0[7]);
  const bf16x8 P00_e = __builtin_bit_cast(bf16x8, make_uint4(pw0_0_e, pw0_1_e, pw0_2_e, pw0_3_e));
  const float t0_3_e = fadd_s(A0[6], A0[7]);
  __builtin_amdgcn_sched_barrier(0);
  O00 = MFMA(vf00_e, P00_e, O00);
  const bf16x8 kf3_e = KFR_(3);
  A1[2] = FEXP_(A1[2]);
  A1[3] = FEXP_(A1[3]);
  const unsigned pw1_0_e = pack2(A1[0], A1[1]);
  const float s0_0_1_e = fadd_s(t0_2_e, t0_3_e);
  const float t1_0_e = fadd_s(A1[0], A1[1]);
  SW_V(1, 1);
  __builtin_amdgcn_sched_barrier(0);
  O01 = MFMA(vf10_e, P00_e, O01);
  A1[4] = FEXP_(A1[4]);
  A1[5] = FEXP_(A1[5]);
  const unsigned pw1_1_e = pack2(A1[2], A1[3]);
  const float s0_1_0_e = fadd_s(s0_0_0_e, s0_0_1_e);
  const float t1_1_e = fadd_s(A1[2], A1[3]);
  __builtin_amdgcn_sched_barrier(0);
  B1 = MFMA(kf2_e, Q1[2], B1);
  A1[6] = FEXP_(A1[6]);
  A1[7] = FEXP_(A1[7]);
  const unsigned pw1_2_e = pack2(A1[4], A1[5]);
  const float t1_2_e = fadd_s(A1[4], A1[5]);
  const float s1_0_0_e = fadd_s(t1_0_e, t1_1_e);
  __builtin_amdgcn_sched_barrier(0);
  B0 = MFMA(kf3_e, Q0[3], B0);
  A0[8] = FEXP_(A0[8]);
  A0[9] = FEXP_(A0[9]);
  const unsigned pw1_3_e = pack2(A1[6], A1[7]);
  const bf16x8 P10_e = __builtin_bit_cast(bf16x8, make_uint4(pw1_0_e, pw1_1_e, pw1_2_e, pw1_3_e));
  const float t1_3_e = fadd_s(A1[6], A1[7]);
  __builtin_amdgcn_sched_barrier(0);
  O10 = MFMA(vf00_e, P10_e, O10);
  const bf16x8 kf4_e = KFR_(4);
  A0[10] = FEXP_(A0[10]);
  A0[11] = FEXP_(A0[11]);
  const unsigned pw0_4_e = pack2(A0[8], A0[9]);
  const float t0_4_e = fadd_s(A0[8], A0[9]);
  const float s1_0_1_e = fadd_s(t1_2_e, t1_3_e);
  __builtin_amdgcn_sched_barrier(0);
  O11 = MFMA(vf10_e, P10_e, O11);
  const bf16x8 vf01_e = VFR_(0, 1);
  A0[12] = FEXP_(A0[12]);
  A0[13] = FEXP_(A0[13]);
  const unsigned pw0_5_e = pack2(A0[10], A0[11]);
  const float t0_5_e = fadd_s(A0[10], A0[11]);
  const float s1_1_0_e = fadd_s(s1_0_0_e, s1_0_1_e);
  __builtin_amdgcn_sched_barrier(0);
  B1 = MFMA(kf3_e, Q1[3], B1);
  const bf16x8 vf11_e = VFR_(1, 1);
  A0[14] = FEXP_(A0[14]);
  A0[15] = FEXP_(A0[15]);
  const unsigned pw0_6_e = pack2(A0[12], A0[13]);
  const float t0_6_e = fadd_s(A0[12], A0[13]);
  const float s0_0_2_e = fadd_s(t0_4_e, t0_5_e);
  LD_K(t + 3, 0);
  __builtin_amdgcn_sched_barrier(0);
  B0 = MFMA(kf4_e, Q0[4], B0);
  A1[8] = FEXP_(A1[8]);
  A1[9] = FEXP_(A1[9]);
  const unsigned pw0_7_e = pack2(A0[14], A0[15]);
  const bf16x8 P01_e = __builtin_bit_cast(bf16x8, make_uint4(pw0_4_e, pw0_5_e, pw0_6_e, pw0_7_e));
  const float t0_7_e = fadd_s(A0[14], A0[15]);
  __builtin_amdgcn_sched_barrier(0);
  O00 = MFMA(vf01_e, P01_e, O00);
  const bf16x8 kf5_e = KFR_(5);
  A1[10] = FEXP_(A1[10]);
  A1[11] = FEXP_(A1[11]);
  const unsigned pw1_4_e = pack2(A1[8], A1[9]);
  const float s0_0_3_e = fadd_s(t0_6_e, t0_7_e);
  const float t1_4_e = fadd_s(A1[8], A1[9]);
  LD_P(t + 3, 0);
  __builtin_amdgcn_sched_barrier(0);
  O01 = MFMA(vf11_e, P01_e, O01);
  A1[12] = FEXP_(A1[12]);
  A1[13] = FEXP_(A1[13]);
  const unsigned pw1_5_e = pack2(A1[10], A1[11]);
  const float s0_1_1_e = fadd_s(s0_0_2_e, s0_0_3_e);
  const float t1_5_e = fadd_s(A1[10], A1[11]);
  __builtin_amdgcn_sched_barrier(0);
  B1 = MFMA(kf4_e, Q1[4], B1);
  A1[14] = FEXP_(A1[14]);
  A1[15] = FEXP_(A1[15]);
  const unsigned pw1_6_e = pack2(A1[12], A1[13]);
  const float s0_2_0_e = fadd_s(s0_1_0_e, s0_1_1_e);
  const float t1_6_e = fadd_s(A1[12], A1[13]);
  const float s1_0_2_e = fadd_s(t1_4_e, t1_5_e);
  LD_V(t + 2, 0);
  __builtin_amdgcn_sched_barrier(0);
  B0 = MFMA(kf5_e, Q0[5], B0);
  const unsigned pw1_7_e = pack2(A1[14], A1[15]);
  const bf16x8 P11_e = __builtin_bit_cast(bf16x8, make_uint4(pw1_4_e, pw1_5_e, pw1_6_e, pw1_7_e));
  l0 = fadd_s(l0, s0_2_0_e);
  const float t1_7_e = fadd_s(A1[14], A1[15]);
  __builtin_amdgcn_sched_barrier(0);
  O10 = MFMA(vf01_e, P11_e, O10);
  const float s1_0_3_e = fadd_s(t1_6_e, t1_7_e);
  __builtin_amdgcn_sched_barrier(0);
  O11 = MFMA(vf11_e, P11_e, O11);
  const float s1_1_1_e = fadd_s(s1_0_2_e, s1_0_3_e);
  __builtin_amdgcn_sched_barrier(0);
  B1 = MFMA(kf5_e, Q1[5], B1);
  const float s1_2_0_e = fadd_s(s1_1_0_e, s1_1_1_e);
  l1 = fadd_s(l1, s1_2_0_e);
  __builtin_amdgcn_sched_barrier(0);
#undef KFR_
#undef VFR_

    __syncthreads();
#define KFR_(s) (*(const bf16x8*)(kb + 0 * KB + (s) * 32))
#define VFR_(i2, s2) VFRX_(1, i2, s2)
  const bf16x8 kf0_o = KFR_(0);
  const bf16x8 kf1_o = KFR_(1);
  __builtin_amdgcn_sched_barrier(0);
  A0 = MFMA(kf0_o, Q0[0], (f32x16)(0.f));
  B0[0] = FEXP_(B0[0]);
  B0[1] = FEXP_(B0[1]);
  __builtin_amdgcn_sched_barrier(0);
  A1 = MFMA(kf0_o, Q1[0], (f32x16)(0.f));
  const bf16x8 kf2_o = KFR_(2);
  B0[2] = FEXP_(B0[2]);
  B0[3] = FEXP_(B0[3]);
  const unsigned pw0_0_o = pack2(B0[0], B0[1]);
  const float t0_0_o = fadd_s(B0[0], B0[1]);
  SW_K(1, 0);
  __builtin_amdgcn_sched_barrier(0);
  A0 = MFMA(kf1_o, Q0[1], A0);
  const bf16x8 vf00_o = VFR_(0, 0);
  B0[4] = FEXP_(B0[4]);
  B0[5] = FEXP_(B0[5]);
  const unsigned pw0_1_o = pack2(B0[2], B0[3]);
  const float t0_1_o = fadd_s(B0[2], B0[3]);
  __builtin_amdgcn_sched_barrier(0);
  A1 = MFMA(kf1_o, Q1[1], A1);
  const bf16x8 vf10_o = VFR_(1, 0);
  B0[6] = FEXP_(B0[6]);
  B0[7] = FEXP_(B0[7]);
  const unsigned pw0_2_o = pack2(B0[4], B0[5]);
  const float t0_2_o = fadd_s(B0[4], B0[5]);
  const float s0_0_0_o = fadd_s(t0_0_o, t0_1_o);
  SW_P(1, 0);
  __builtin_amdgcn_sched_barrier(0);
  A0 = MFMA(kf2_o, Q0[2], A0);
  B1[0] = FEXP_(B1[0]);
  B1[1] = FEXP_(B1[1]);
  const unsigned pw0_3_o = pack2(B0[6], B0[7]);
  const bf16x8 P00_o = __builtin_bit_cast(bf16x8, make_uint4(pw0_0_o, pw0_1_o, pw0_2_o, pw0_3_o));
  const float t0_3_o = fadd_s(B0[6], B0[7]);
  __builtin_amdgcn_sched_barrier(0);
  O00 = MFMA(vf00_o, P00_o, O00);
  const bf16x8 kf3_o = KFR_(3);
  B1[2] = FEXP_(B1[2]);
  B1[3] = FEXP_(B1[3]);
  const unsigned pw1_0_o = pack2(B1[0], B1[1]);
  const float s0_0_1_o = fadd_s(t0_2_o, t0_3_o);
  const float t1_0_o = fadd_s(B1[0], B1[1]);
  SW_V(0, 0);
  __builtin_amdgcn_sched_barrier(0);
  O01 = MFMA(vf10_o, P00_o, O01);
  B1[4] = FEXP_(B1[4]);
  B1[5] = FEXP_(B1[5]);
  const unsigned pw1_1_o = pack2(B1[2], B1[3]);
  const float s0_1_0_o = fadd_s(s0_0_0_o, s0_0_1_o);
  const float t1_1_o = fadd_s(B1[2], B1[3]);
  __builtin_amdgcn_sched_barrier(0);
  A1 = MFMA(kf2_o, Q1[2], A1);
  B1[6] = FEXP_(B1[6]);
  B1[7] = FEXP_(B1[7]);
  const unsigned pw1_2_o = pack2(B1[4], B1[5]);
  const float t1_2_o = fadd_s(B1[4], B1[5]);
  const float s1_0_0_o = fadd_s(t1_0_o, t1_1_o);
  __builtin_amdgcn_sched_barrier(0);
  A0 = MFMA(kf3_o, Q0[3], A0);
  B0[8] = FEXP_(B0[8]);
  B0[9] = FEXP_(B0[9]);
  const unsigned pw1_3_o = pack2(B1[6], B1[7]);
  const bf16x8 P10_o = __builtin_bit_cast(bf16x8, make_uint4(pw1_0_o, pw1_1_o, pw1_2_o, pw1_3_o));
  const float t1_3_o = fadd_s(B1[6], B1[7]);
  __builtin_amdgcn_sched_barrier(0);
  O10 = MFMA(vf00_o, P10_o, O10);
  const bf16x8 kf4_o = KFR_(4);
  B0[10] = FEXP_(B0[10]);
  B0[11] = FEXP_(B0[11]);
  const unsigned pw0_4_o = pack2(B0[8], B0[9]);
  const float t0_4_o = fadd_s(B0[8], B0[9]);
  const float s1_0_1_o = fadd_s(t1_2_o, t1_3_o);
  __builtin_amdgcn_sched_barrier(0);
  O11 = MFMA(vf10_o, P10_o, O11);
  const bf16x8 vf01_o = VFR_(0, 1);
  B0[12] = FEXP_(B0[12]);
  B0[13] = FEXP_(B0[13]);
  const unsigned pw0_5_o = pack2(B0[10], B0[11]);
  const float t0_5_o = fadd_s(B0[10], B0[11]);
  const float s1_1_0_o = fadd_s(s1_0_0_o, s1_0_1_o);
  __builtin_amdgcn_sched_barrier(0);
  A1 = MFMA(kf3_o, Q1[3], A1);
  const bf16x8 vf11_o = VFR_(1, 1);
  B0[14] = FEXP_(B0[14]);
  B0[15] = FEXP_(B0[15]);
  const unsigned pw0_6_o = pack2(B0[12], B0[13]);
  const float t0_6_o = fadd_s(B0[12], B0[13]);
  const float s0_0_2_o = fadd_s(t0_4_o, t0_5_o);
  LD_K(t + 4, 1);
  __builtin_amdgcn_sched_barrier(0);
  A0 = MFMA(kf4_o, Q0[4], A0);
  B1[8] = FEXP_(B1[8]);
  B1[9] = FEXP_(B1[9]);
  const unsigned pw0_7_o = pack2(B0[14], B0[15]);
  const bf16x8 P01_o = __builtin_bit_cast(bf16x8, make_uint4(pw0_4_o, pw0_5_o, pw0_6_o, pw0_7_o));
  const float t0_7_o = fadd_s(B0[14], B0[15]);
  __builtin_amdgcn_sched_barrier(0);
  O00 = MFMA(vf01_o, P01_o, O00);
  const bf16x8 kf5_o = KFR_(5);
  B1[10] = FEXP_(B1[10]);
  B1[11] = FEXP_(B1[11]);
  const unsigned pw1_4_o = pack2(B1[8], B1[9]);
  const float s0_0_3_o = fadd_s(t0_6_o, t0_7_o);
  const float t1_4_o = fadd_s(B1[8], B1[9]);
  LD_P(t + 4, 1);
  __builtin_amdgcn_sched_barrier(0);
  O01 = MFMA(vf11_o, P01_o, O01);
  B1[12] = FEXP_(B1[12]);
  B1[13] = FEXP_(B1[13]);
  const unsigned pw1_5_o = pack2(B1[10], B1[11]);
  const float s0_1_1_o = fadd_s(s0_0_2_o, s0_0_3_o);
  const float t1_5_o = fadd_s(B1[10], B1[11]);
  __builtin_amdgcn_sched_barrier(0);
  A1 = MFMA(kf4_o, Q1[4], A1);
  B1[14] = FEXP_(B1[14]);
  B1[15] = FEXP_(B1[15]);
  const unsigned pw1_6_o = pack2(B1[12], B1[13]);
  const float s0_2_0_o = fadd_s(s0_1_0_o, s0_1_1_o);
  const float t1_6_o = fadd_s(B1[12], B1[13]);
  const float s1_0_2_o = fadd_s(t1_4_o, t1_5_o);
  LD_V(t + 3, 1);
  __builtin_amdgcn_sched_barrier(0);
  A0 = MFMA(kf5_o, Q0[5], A0);
  const unsigned pw1_7_o = pack2(B1[14], B1[15]);
  const bf16x8 P11_o = __builtin_bit_cast(bf16x8, make_uint4(pw1_4_o, pw1_5_o, pw1_6_o, pw1_7_o));
  l0 = fadd_s(l0, s0_2_0_o);
  const float t1_7_o = fadd_s(B1[14], B1[15]);
  __builtin_amdgcn_sched_barrier(0);
  O10 = MFMA(vf01_o, P11_o, O10);
  const float s1_0_3_o = fadd_s(t1_6_o, t1_7_o);
  __builtin_amdgcn_sched_barrier(0);
  O11 = MFMA(vf11_o, P11_o, O11);
  const float s1_1_1_o = fadd_s(s1_0_2_o, s1_0_3_o);
  __builtin_amdgcn_sched_barrier(0);
  A1 = MFMA(kf5_o, Q1[5], A1);
  const float s1_2_0_o = fadd_s(s1_1_0_o, s1_1_1_o);
  l1 = fadd_s(l1, s1_2_0_o);
  __builtin_amdgcn_sched_barrier(0);
#undef KFR_
#undef VFR_

    __syncthreads();
  }
#undef LD_K
#undef LD_P
#undef LD_V
#undef SW_K
#undef SW_P
#undef SW_V
#undef VFRX_
#undef FEXP_
  float* xs = (float*)lds + (wave * 64 + lane) * 33;
  const float* xr = (const float*)lds + ((wave ^ 4) * 64 + lane) * 33;
  if (kh == 0) {
#pragma unroll
    for (int e = 0; e < 16; ++e) { xs[e] = O10[e]; xs[16 + e] = O11[e]; }
    xs[32] = l1;
  } else {
#pragma unroll
    for (int e = 0; e < 16; ++e) { xs[e] = O00[e]; xs[16 + e] = O01[e]; }
    xs[32] = l0;
  }
  __syncthreads();
  if (kh == 0) {
#pragma unroll
    for (int e = 0; e < 16; ++e) { O00[e] += xr[e]; O01[e] += xr[16 + e]; }
    l0 += xr[32];
  } else {
#pragma unroll
    for (int e = 0; e < 16; ++e) { O10[e] += xr[e]; O11[e] += xr[16 + e]; }
    l1 += xr[32];
  }
  const float lp = kh ? l1 : l0;
  const float lt = lp + __shfl_xor(lp, 32);
  if (__syncthreads_or(!(lt < 1.0e37f) || !(lt > 1.0e-30f))) return true;
  const int tok = b * SEQ + q0 + kh * 32 + r;
  const float inv = 1.f / lt;
  u16* dst = p.cat + (size_t)tok * 1024 + 256 + head * 64;
  if (kh == 0) {
#pragma unroll
    for (int e = 0; e < 16; ++e) { O00[e] *= inv; O01[e] *= inv; }
    store_tile(dst, O00, hh); store_tile(dst + 32, O01, hh);
  } else {
#pragma unroll
    for (int e = 0; e < 16; ++e) { O10[e] *= inv; O11[e] *= inv; }
    store_tile(dst, O10, hh); store_tile(dst + 32, O11, hh);
  }
  return false;
}


DI bool attn_diff_pipe(const Params& p, int layer, int item, float lam_full, float lam_init, char* lds) {
  constexpr int KSTR = 80, KB = 64 * KSTR, KRING = 2 * KB, VOFF = 3 * KRING;
  const int tid = otid(p.wave), lane = tid & 63, wave = tid >> 6, r = lane & 31, hh = lane >> 5;
  const int strm = wave & 1;
  const int b = item / 64, head = (item / 16) & 3, q0 = (item & 15) * 256 + (wave >> 1) * 64;
  bf16x8 Q0[2], Q1[2];
  {
    const u16* qp = p.aq + ((size_t)(b * 8 + head * 2 + strm) * SEQ + q0 + r) * 32 + hh * 8;
    Q0[0] = *(const bf16x8*)(qp); Q0[1] = *(const bf16x8*)(qp + 16);
    Q1[0] = *(const bf16x8*)(qp + 32 * 32); Q1[1] = *(const bf16x8*)(qp + 32 * 32 + 16);
  }
  f32x16 O00 = (f32x16)(0.f), O01 = (f32x16)(0.f), O10 = (f32x16)(0.f), O11 = (f32x16)(0.f);
  float l0 = 0.f, l1 = 0.f;
  const u16* kgp = p.ak + (size_t)(b * 8 + head * 2 + (tid >> 8)) * SEQ * 32 + ((tid & 255) >> 2) * 32 + (tid & 3) * 8;
  const u16* vgp = p.av + (size_t)(b * 4 + head) * SEQ * 64 + (tid >> 3) * 64 + (tid & 7) * 8;
  char* kw0 = lds + (tid >> 8) * KB + ((tid & 255) >> 2) * KSTR + (tid & 3) * 16;
  char* vw = lds + VOFF + (tid >> 3) * 128 + (((tid & 7) * 16) ^ ((((tid >> 3) >> 1) & 1) << 6));
  uint4 gk0, gv0, gk1, gv1;
#define LD_K(kt, S) { const int kt_ = (kt) < 63 ? (kt) : 63; gk##S = *(const uint4*)(kgp + (size_t)kt_ * 2048); }
#define LD_V(kt, S) { const int kt_ = (kt) < 63 ? (kt) : 63; gv##S = *(const uint4*)(vgp + (size_t)kt_ * 4096); }
#define SW_K(S) *(uint4*)(kw0 + kwr) = gk##S;
#define SW_V(slot, S) *(uint4*)(vw + (slot) * 8192) = gv##S;
  const int tq = (lane & 15) >> 2, tp = lane & 3, tg1 = (lane >> 4) & 1, swz = (tq >> 1) & 1;
  const char* vb0 = lds + VOFF + (4 * hh + tq) * 128 + 32 * tg1 + 8 * tp + 64 * swz;
  const char* vb1 = lds + VOFF + (4 * hh + tq) * 128 + 32 * tg1 + 8 * tp + 64 * (swz ^ 1);
  const char* kb = lds + strm * KB + r * KSTR + hh * 16;
#define VFRX_(VS, i2, u, s2) ({ const char* a_ = ((i2) ? vb1 : vb0) + (VS) * 8192 + (32 * (u) + 16 * (s2)) * 128; \
    const s16x4 lo_ = trread(a_), hi_ = trread(a_ + 8 * 128); (bf16x8)__builtin_shufflevector(lo_, hi_, 0, 1, 2, 3, 4, 5, 6, 7); })
#define KFR_(base, u, s) (*(const bf16x8*)((base) + (u) * 32 * KSTR + (s) * 32))
#define FEXP_(x) fexp2(x)
  int kcu = 0, knx = KRING, kwr = 2 * KRING;
  LD_K(0, 0); LD_V(0, 0); LD_K(1, 1);
  { kwr = 0; SW_K(0); SW_V(0, 0); kwr = KRING; SW_K(1); kwr = 2 * KRING; }
  LD_K(2, 1); LD_V(1, 1);
  __syncthreads();
  f32x16 SA, SB = (f32x16)(0.f);
  SA = MFMA(*(const bf16x8*)(kb), Q0[0], (f32x16)(0.f)); SA = MFMA(*(const bf16x8*)(kb + 32), Q0[1], SA);
  bf16x8 P3c0 = (bf16x8)(0), P3c1 = (bf16x8)(0), vfc00 = (bf16x8)(0), vfc10 = (bf16x8)(0), vfc01 = (bf16x8)(0), vfc11 = (bf16x8)(0);
#pragma unroll 1
  for (int t = 0; t < 64; t += 2) {
    {
      const char* KC = kb + kcu; const char* KN = kb + knx;
#define VFR_(i2, u, s2) VFRX_(0, i2, u, s2)
  const bf16x8 kfA0_e = KFR_(KC, 0, 0);
  __builtin_amdgcn_sched_barrier(0);
  O10 = MFMA(vfc00, P3c0, O10);
  SA[0] = FEXP_(SA[0]);
  SA[1] = FEXP_(SA[1]);
  SA[2] = FEXP_(SA[2]);
  __builtin_amdgcn_sched_barrier(0);
  O11 = MFMA(vfc10, P3c0, O11);
  const bf16x8 kfA1_e = KFR_(KC, 0, 1);
  SA[3] = FEXP_(SA[3]);
  SA[4] = FEXP_(SA[4]);
  SA[5] = FEXP_(SA[5]);
  const unsigned pw0_0_e = pack2(SA[0], SA[1]);
  const float t0_0_e = fadd_s(SA[0], SA[1]);
  __builtin_amdgcn_sched_barrier(0);
  SB = MFMA(kfA0_e, Q1[0], (f32x16)(0.f));
  const bf16x8 vf000_e = VFR_(0, 0, 0);
  SA[6] = FEXP_(SA[6]);
  SA[7] = FEXP_(SA[7]);
  SA[8] = FEXP_(SA[8]);
  const unsigned pw0_1_e = pack2(SA[2], SA[3]);
  const float t0_1_e = fadd_s(SA[2], SA[3]);
  const unsigned pw0_2_e = pack2(SA[4], SA[5]);
  const float t0_2_e = fadd_s(SA[4], SA[5]);
  __builtin_amdgcn_sched_barrier(0);
  O10 = MFMA(vfc01, P3c1, O10);
  const bf16x8 vf010_e = VFR_(1, 0, 0);
  SA[9] = FEXP_(SA[9]);
  SA[10] = FEXP_(SA[10]);
  SA[11] = FEXP_(SA[11]);
  const unsigned pw0_3_e = pack2(SA[6], SA[7]);
  const float t0_3_e = fadd_s(SA[6], SA[7]);
  const bf16x8 P00_e = __builtin_bit_cast(bf16x8, make_uint4(pw0_0_e, pw0_1_e, pw0_2_e, pw0_3_e));
  const float s0_0_0_e = fadd_s(t0_0_e, t0_1_e);
  SW_K(1);
  __builtin_amdgcn_sched_barrier(0);
  SB = MFMA(kfA1_e, Q1[1], SB);
  SA[12] = FEXP_(SA[12]);
  SA[13] = FEXP_(SA[13]);
  const unsigned pw0_4_e = pack2(SA[8], SA[9]);
  const float t0_4_e = fadd_s(SA[8], SA[9]);
  const unsigned pw0_5_e = pack2(SA[10], SA[11]);
  const float t0_5_e = fadd_s(SA[10], SA[11]);
  const float s0_0_1_e = fadd_s(t0_2_e, t0_3_e);
  __builtin_amdgcn_sched_barrier(0);
  O11 = MFMA(vfc11, P3c1, O11);
  const bf16x8 kfB0_e = KFR_(KC, 1, 0);
  const bf16x8 vf001_e = VFR_(0, 0, 1);
  SA[14] = FEXP_(SA[14]);
  SA[15] = FEXP_(SA[15]);
  const unsigned pw0_6_e = pack2(SA[12], SA[13]);
  const float t0_6_e = fadd_s(SA[12], SA[13]);
  const float s0_0_2_e = fadd_s(t0_4_e, t0_5_e);
  const float s0_1_0_e = fadd_s(s0_0_0_e, s0_0_1_e);
  __builtin_amdgcn_sched_barrier(0);
  O00 = MFMA(vf000_e, P00_e, O00);
  const unsigned pw0_7_e = pack2(SA[14], SA[15]);
  const float t0_7_e = fadd_s(SA[14], SA[15]);
  const bf16x8 P01_e = __builtin_bit_cast(bf16x8, make_uint4(pw0_4_e, pw0_5_e, pw0_6_e, pw0_7_e));
  SB[0] = FEXP_(SB[0]);
  SB[1] = FEXP_(SB[1]);
  SB[2] = FEXP_(SB[2]);
  __builtin_amdgcn_sched_barrier(0);
  O01 = MFMA(vf010_e, P00_e, O01);
  const bf16x8 kfB1_e = KFR_(KC, 1, 1);
  const bf16x8 vf011_e = VFR_(1, 0, 1);
  const float s0_0_3_e = fadd_s(t0_6_e, t0_7_e);
  SB[3] = FEXP_(SB[3]);
  SB[4] = FEXP_(SB[4]);
  SB[5] = FEXP_(SB[5]);
  const unsigned pw1_0_e = pack2(SB[0], SB[1]);
  const float t1_0_e = fadd_s(SB[0], SB[1]);
  __builtin_amdgcn_sched_barrier(0);
  SA = MFMA(kfB0_e, Q0[0], (f32x16)(0.f));
  const float s0_1_1_e = fadd_s(s0_0_2_e, s0_0_3_e);
  SB[6] = FEXP_(SB[6]);
  SB[7] = FEXP_(SB[7]);
  SB[8] = FEXP_(SB[8]);
  const unsigned pw1_1_e = pack2(SB[2], SB[3]);
  const float t1_1_e = fadd_s(SB[2], SB[3]);
  const unsigned pw1_2_e = pack2(SB[4], SB[5]);
  const float t1_2_e = fadd_s(SB[4], SB[5]);
  __builtin_amdgcn_sched_barrier(0);
  O00 = MFMA(vf001_e, P01_e, O00);
  const float s0_2_0_e = fadd_s(s0_1_0_e, s0_1_1_e);
  SB[9] = FEXP_(SB[9]);
  SB[10] = FEXP_(SB[10]);
  SB[11] = FEXP_(SB[11]);
  const unsigned pw1_3_e = pack2(SB[6], SB[7]);
  const float t1_3_e = fadd_s(SB[6], SB[7]);
  const bf16x8 P10_e = __builtin_bit_cast(bf16x8, make_uint4(pw1_0_e, pw1_1_e, pw1_2_e, pw1_3_e));
  const float s1_0_0_e = fadd_s(t1_0_e, t1_1_e);
  SW_V(1, 1);
  __builtin_amdgcn_sched_barrier(0);
  SA = MFMA(kfB1_e, Q0[1], SA);
  l0 = fadd_s(l0, s0_2_0_e);
  SB[12] = FEXP_(SB[12]);
  SB[13] = FEXP_(SB[13]);
  const unsigned pw1_4_e = pack2(SB[8], SB[9]);
  const float t1_4_e = fadd_s(SB[8], SB[9]);
  const unsigned pw1_5_e = pack2(SB[10], SB[11]);
  const float t1_5_e = fadd_s(SB[10], SB[11]);
  const float s1_0_1_e = fadd_s(t1_2_e, t1_3_e);
  __builtin_amdgcn_sched_barrier(0);
  O01 = MFMA(vf011_e, P01_e, O01);
  SB[14] = FEXP_(SB[14]);
  SB[15] = FEXP_(SB[15]);
  const unsigned pw1_6_e = pack2(SB[12], SB[13]);
  const float t1_6_e = fadd_s(SB[12], SB[13]);
  const float s1_0_2_e = fadd_s(t1_4_e, t1_5_e);
  const float s1_1_0_e = fadd_s(s1_0_0_e, s1_0_1_e);
  __builtin_amdgcn_sched_barrier(0);
  O10 = MFMA(vf000_e, P10_e, O10);
  const unsigned pw1_7_e = pack2(SB[14], SB[15]);
  const float t1_7_e = fadd_s(SB[14], SB[15]);
  const bf16x8 P11_e = __builtin_bit_cast(bf16x8, make_uint4(pw1_4_e, pw1_5_e, pw1_6_e, pw1_7_e));
  SA[0] = FEXP_(SA[0]);
  SA[1] = FEXP_(SA[1]);
  SA[2] = FEXP_(SA[2]);
  __builtin_amdgcn_sched_barrier(0);
  O11 = MFMA(vf010_e, P10_e, O11);
  const float s1_0_3_e = fadd_s(t1_6_e, t1_7_e);
  SA[3] = FEXP_(SA[3]);
  SA[4] = FEXP_(SA[4]);
  SA[5] = FEXP_(SA[5]);
  const unsigned pw2_0_e = pack2(SA[0], SA[1]);
  const float t2_0_e = fadd_s(SA[0], SA[1]);
  LD_K(t + 3, 0);
  __builtin_amdgcn_sched_barrier(0);
  SB = MFMA(kfB0_e, Q1[0], (f32x16)(0.f));
  const bf16x8 vf100_e = VFR_(0, 1, 0);
  const float s1_1_1_e = fadd_s(s1_0_2_e, s1_0_3_e);
  SA[6] = FEXP_(SA[6]);
  SA[7] = FEXP_(SA[7]);
  SA[8] = FEXP_(SA[8]);
  const unsigned pw2_1_e = pack2(SA[2], SA[3]);
  const float t2_1_e = fadd_s(SA[2], SA[3]);
  const unsigned pw2_2_e = pack2(SA[4], SA[5]);
  const float t2_2_e = fadd_s(SA[4], SA[5]);
  __builtin_amdgcn_sched_barrier(0);
  O10 = MFMA(vf001_e, P11_e, O10);
  const bf16x8 vf110_e = VFR_(1, 1, 0);
  const float s1_2_0_e = fadd_s(s1_1_0_e, s1_1_1_e);
  SA[9] = FEXP_(SA[9]);
  SA[10] = FEXP_(SA[10]);
  SA[11] = FEXP_(SA[11]);
  const unsigned pw2_3_e = pack2(SA[6], SA[7]);
  const float t2_3_e = fadd_s(SA[6], SA[7]);
  const bf16x8 P20_e = __builtin_bit_cast(bf16x8, make_uint4(pw2_0_e, pw2_1_e, pw2_2_e, pw2_3_e));
  const float s2_0_0_e = fadd_s(t2_0_e, t2_1_e);
  __builtin_amdgcn_sched_barrier(0);
  SB = MFMA(kfB1_e, Q1[1], SB);
  l1 = fadd_s(l1, s1_2_0_e);
  SA[12] = FEXP_(SA[12]);
  SA[13] = FEXP_(SA[13]);
  const unsigned pw2_4_e = pack2(SA[8], SA[9]);
  const float t2_4_e = fadd_s(SA[8], SA[9]);
  const unsigned pw2_5_e = pack2(SA[10], SA[11]);
  const float t2_5_e = fadd_s(SA[10], SA[11]);
  const float s2_0_1_e = fadd_s(t2_2_e, t2_3_e);
  __builtin_amdgcn_sched_barrier(0);
  O11 = MFMA(vf011_e, P11_e, O11);
  const bf16x8 kfN0_e = KFR_(KN, 0, 0);
  const bf16x8 vf101_e = VFR_(0, 1, 1);
  SA[14] = FEXP_(SA[14]);
  SA[15] = FEXP_(SA[15]);
  const unsigned pw2_6_e = pack2(SA[12], SA[13]);
  const float t2_6_e = fadd_s(SA[12], SA[13]);
  const float s2_0_2_e = fadd_s(t2_4_e, t2_5_e);
  const float s2_1_0_e = fadd_s(s2_0_0_e, s2_0_1_e);
  __builtin_amdgcn_sched_barrier(0);
  O00 = MFMA(vf100_e, P20_e, O00);
  const unsigned pw2_7_e = pack2(SA[14], SA[15]);
  const float t2_7_e = fadd_s(SA[14], SA[15]);
  const bf16x8 P21_e = __builtin_bit_cast(bf16x8, make_uint4(pw2_4_e, pw2_5_e, pw2_6_e, pw2_7_e));
  SB[0] = FEXP_(SB[0]);
  SB[1] = FEXP_(SB[1]);
  SB[2] = FEXP_(SB[2]);
  __builtin_amdgcn_sched_barrier(0);
  O01 = MFMA(vf110_e, P20_e, O01);
  const bf16x8 kfN1_e = KFR_(KN, 0, 1);
  const bf16x8 vf111_e = VFR_(1, 1, 1);
  const float s2_0_3_e = fadd_s(t2_6_e, t2_7_e);
  SB[3] = FEXP_(SB[3]);
  SB[4] = FEXP_(SB[4]);
  SB[5] = FEXP_(SB[5]);
  const unsigned pw3_0_e = pack2(SB[0], SB[1]);
  const float t3_0_e = fadd_s(SB[0], SB[1]);
  LD_V(t + 2, 0);
  __builtin_amdgcn_sched_barrier(0);
  SA = MFMA(kfN0_e, Q0[0], (f32x16)(0.f));
  const float s2_1_1_e = fadd_s(s2_0_2_e, s2_0_3_e);
  SB[6] = FEXP_(SB[6]);
  SB[7] = FEXP_(SB[7]);
  SB[8] = FEXP_(SB[8]);
  const unsigned pw3_1_e = pack2(SB[2], SB[3]);
  const float t3_1_e = fadd_s(SB[2], SB[3]);
  const unsigned pw3_2_e = pack2(SB[4], SB[5]);
  const float t3_2_e = fadd_s(SB[4], SB[5]);
  __builtin_amdgcn_sched_barrier(0);
  O00 = MFMA(vf101_e, P21_e, O00);
  const float s2_2_0_e = fadd_s(s2_1_0_e, s2_1_1_e);
  SB[9] = FEXP_(SB[9]);
  SB[10] = FEXP_(SB[10]);
  SB[11] = FEXP_(SB[11]);
  const unsigned pw3_3_e = pack2(SB[6], SB[7]);
  const float t3_3_e = fadd_s(SB[6], SB[7]);
  const bf16x8 P30_e = __builtin_bit_cast(bf16x8, make_uint4(pw3_0_e, pw3_1_e, pw3_2_e, pw3_3_e));
  const float s3_0_0_e = fadd_s(t3_0_e, t3_1_e);
  __builtin_amdgcn_sched_barrier(0);
  SA = MFMA(kfN1_e, Q0[1], SA);
  l0 = fadd_s(l0, s2_2_0_e);
  SB[12] = FEXP_(SB[12]);
  SB[13] = FEXP_(SB[13]);
  const unsigned pw3_4_e = pack2(SB[8], SB[9]);
  const float t3_4_e = fadd_s(SB[8], SB[9]);
  const unsigned pw3_5_e = pack2(SB[10], SB[11]);
  const float t3_5_e = fadd_s(SB[10], SB[11]);
  const float s3_0_1_e = fadd_s(t3_2_e, t3_3_e);
  __builtin_amdgcn_sched_barrier(0);
  O01 = MFMA(vf111_e, P21_e, O01);
  SB[14] = FEXP_(SB[14]);
  SB[15] = FEXP_(SB[15]);
  const unsigned pw3_6_e = pack2(SB[12], SB[13]);
  const float t3_6_e = fadd_s(SB[12], SB[13]);
  const float s3_0_2_e = fadd_s(t3_4_e, t3_5_e);
  const float s3_1_0_e = fadd_s(s3_0_0_e, s3_0_1_e);
  __builtin_amdgcn_sched_barrier(0);
  const unsigned pw3_7_e = pack2(SB[14], SB[15]);
  const float t3_7_e = fadd_s(SB[14], SB[15]);
  const bf16x8 P31_e = __builtin_bit_cast(bf16x8, make_uint4(pw3_4_e, pw3_5_e, pw3_6_e, pw3_7_e));
  const float s3_0_3_e = fadd_s(t3_6_e, t3_7_e);
  const float s3_1_1_e = fadd_s(s3_0_2_e, s3_0_3_e);
  const float s3_2_0_e = fadd_s(s3_1_0_e, s3_1_1_e);
  l1 = fadd_s(l1, s3_2_0_e);
  P3c0 = P30_e; P3c1 = P31_e; vfc00 = vf100_e; vfc10 = vf110_e; vfc01 = vf101_e; vfc11 = vf111_e;
  __builtin_amdgcn_sched_barrier(0);
#undef VFR_

    }
    { const int tmp_ = kcu; kcu = knx; knx = kwr; kwr = tmp_; }
    __syncthreads();
    {
      const char* KC = kb + kcu; const char* KN = kb + knx;
#define VFR_(i2, u, s2) VFRX_(1, i2, u, s2)
  const bf16x8 kfA0_o = KFR_(KC, 0, 0);
  __builtin_amdgcn_sched_barrier(0);
  O10 = MFMA(vfc00, P3c0, O10);
  SA[0] = FEXP_(SA[0]);
  SA[1] = FEXP_(SA[1]);
  SA[2] = FEXP_(SA[2]);
  __builtin_amdgcn_sched_barrier(0);
  O11 = MFMA(vfc10, P3c0, O11);
  const bf16x8 kfA1_o = KFR_(KC, 0, 1);
  SA[3] = FEXP_(SA[3]);
  SA[4] = FEXP_(SA[4]);
  SA[5] = FEXP_(SA[5]);
  const unsigned pw0_0_o = pack2(SA[0], SA[1]);
  const float t0_0_o = fadd_s(SA[0], SA[1]);
  __builtin_amdgcn_sched_barrier(0);
  SB = MFMA(kfA0_o, Q1[0], (f32x16)(0.f));
  const bf16x8 vf000_o = VFR_(0, 0, 0);
  SA[6] = FEXP_(SA[6]);
  SA[7] = FEXP_(SA[7]);
  SA[8] = FEXP_(SA[8]);
  const unsigned pw0_1_o = pack2(SA[2], SA[3]);
  const float t0_1_o = fadd_s(SA[2], SA[3]);
  const unsigned pw0_2_o = pack2(SA[4], SA[5]);
  const float t0_2_o = fadd_s(SA[4], SA[5]);
  __builtin_amdgcn_sched_barrier(0);
  O10 = MFMA(vfc01, P3c1, O10);
  const bf16x8 vf010_o = VFR_(1, 0, 0);
  SA[9] = FEXP_(SA[9]);
  SA[10] = FEXP_(SA[10]);
  SA[11] = FEXP_(SA[11]);
  const unsigned pw0_3_o = pack2(SA[6], SA[7]);
  const float t0_3_o = fadd_s(SA[6], SA[7]);
  const bf16x8 P00_o = __builtin_bit_cast(bf16x8, make_uint4(pw0_0_o, pw0_1_o, pw0_2_o, pw0_3_o));
  const float s0_0_0_o = fadd_s(t0_0_o, t0_1_o);
  SW_K(0);
  __builtin_amdgcn_sched_barrier(0);
  SB = MFMA(kfA1_o, Q1[1], SB);
  SA[12] = FEXP_(SA[12]);
  SA[13] = FEXP_(SA[13]);
  const unsigned pw0_4_o = pack2(SA[8], SA[9]);
  const float t0_4_o = fadd_s(SA[8], SA[9]);
  const unsigned pw0_5_o = pack2(SA[10], SA[11]);
  const float t0_5_o = fadd_s(SA[10], SA[11]);
  const float s0_0_1_o = fadd_s(t0_2_o, t0_3_o);
  __builtin_amdgcn_sched_barrier(0);
  O11 = MFMA(vfc11, P3c1, O11);
  const bf16x8 kfB0_o = KFR_(KC, 1, 0);
  const bf16x8 vf001_o = VFR_(0, 0, 1);
  SA[14] = FEXP_(SA[14]);
  SA[15] = FEXP_(SA[15]);
  const unsigned pw0_6_o = pack2(SA[12], SA[13]);
  const float t0_6_o = fadd_s(SA[12], SA[13]);
  const float s0_0_2_o = fadd_s(t0_4_o, t0_5_o);
  const float s0_1_0_o = fadd_s(s0_0_0_o, s0_0_1_o);
  __builtin_amdgcn_sched_barrier(0);
  O00 = MFMA(vf000_o, P00_o, O00);
  const unsigned pw0_7_o = pack2(SA[14], SA[15]);
  const float t0_7_o = fadd_s(SA[14], SA[15]);
  const bf16x8 P01_o = __builtin_bit_cast(bf16x8, make_uint4(pw0_4_o, pw0_5_o, pw0_6_o, pw0_7_o));
  SB[0] = FEXP_(SB[0]);
  SB[1] = FEXP_(SB[1]);
  SB[2] = FEXP_(SB[2]);
  __builtin_amdgcn_sched_barrier(0);
  O01 = MFMA(vf010_o, P00_o, O01);
  const bf16x8 kfB1_o = KFR_(KC, 1, 1);
  const bf16x8 vf011_o = VFR_(1, 0, 1);
  const float s0_0_3_o = fadd_s(t0_6_o, t0_7_o);
  SB[3] = FEXP_(SB[3]);
  SB[4] = FEXP_(SB[4]);
  SB[5] = FEXP_(SB[5]);
  const unsigned pw1_0_o = pack2(SB[0], SB[1]);
  const float t1_0_o = fadd_s(SB[0], SB[1]);
  __builtin_amdgcn_sched_barrier(0);
  SA = MFMA(kfB0_o, Q0[0], (f32x16)(0.f));
  const float s0_1_1_o = fadd_s(s0_0_2_o, s0_0_3_o);
  SB[6] = FEXP_(SB[6]);
  SB[7] = FEXP_(SB[7]);
  SB[8] = FEXP_(SB[8]);
  const unsigned pw1_1_o = pack2(SB[2], SB[3]);
  const float t1_1_o = fadd_s(SB[2], SB[3]);
  const unsigned pw1_2_o = pack2(SB[4], SB[5]);
  const float t1_2_o = fadd_s(SB[4], SB[5]);
  __builtin_amdgcn_sched_barrier(0);
  O00 = MFMA(vf001_o, P01_o, O00);
  const float s0_2_0_o = fadd_s(s0_1_0_o, s0_1_1_o);
  SB[9] = FEXP_(SB[9]);
  SB[10] = FEXP_(SB[10]);
  SB[11] = FEXP_(SB[11]);
  const unsigned pw1_3_o = pack2(SB[6], SB[7]);
  const float t1_3_o = fadd_s(SB[6], SB[7]);
  const bf16x8 P10_o = __builtin_bit_cast(bf16x8, make_uint4(pw1_0_o, pw1_1_o, pw1_2_o, pw1_3_o));
  const float s1_0_0_o = fadd_s(t1_0_o, t1_1_o);
  SW_V(0, 0);
  __builtin_amdgcn_sched_barrier(0);
  SA = MFMA(kfB1_o, Q0[1], SA);
  l0 = fadd_s(l0, s0_2_0_o);
  SB[12] = FEXP_(SB[12]);
  SB[13] = FEXP_(SB[13]);
  const unsigned pw1_4_o = pack2(SB[8], SB[9]);
  const float t1_4_o = fadd_s(SB[8], SB[9]);
  const unsigned pw1_5_o = pack2(SB[10], SB[11]);
  const float t1_5_o = fadd_s(SB[10], SB[11]);
  const float s1_0_1_o = fadd_s(t1_2_o, t1_3_o);
  __builtin_amdgcn_sched_barrier(0);
  O01 = MFMA(vf011_o, P01_o, O01);
  SB[14] = FEXP_(SB[14]);
  SB[15] = FEXP_(SB[15]);
  const unsigned pw1_6_o = pack2(SB[12], SB[13]);
  const float t1_6_o = fadd_s(SB[12], SB[13]);
  const float s1_0_2_o = fadd_s(t1_4_o, t1_5_o);
  const float s1_1_0_o = fadd_s(s1_0_0_o, s1_0_1_o);
  __builtin_amdgcn_sched_barrier(0);
  O10 = MFMA(vf000_o, P10_o, O10);
  const unsigned pw1_7_o = pack2(SB[14], SB[15]);
  const float t1_7_o = fadd_s(SB[14], SB[15]);
  const bf16x8 P11_o = __builtin_bit_cast(bf16x8, make_uint4(pw1_4_o, pw1_5_o, pw1_6_o, pw1_7_o));
  SA[0] = FEXP_(SA[0]);
  SA[1] = FEXP_(SA[1]);
  SA[2] = FEXP_(SA[2]);
  __builtin_amdgcn_sched_barrier(0);
  O11 = MFMA(vf010_o, P10_o, O11);
  const float s1_0_3_o = fadd_s(t1_6_o, t1_7_o);
  SA[3] = FEXP_(SA[3]);
  SA[4] = FEXP_(SA[4]);
  SA[5] = FEXP_(SA[5]);
  const unsigned pw2_0_o = pack2(SA[0], SA[1]);
  const float t2_0_o = fadd_s(SA[0], SA[1]);
  LD_K(t + 4, 1);
  __builtin_amdgcn_sched_barrier(0);
  SB = MFMA(kfB0_o, Q1[0], (f32x16)(0.f));
  const bf16x8 vf100_o = VFR_(0, 1, 0);
  const float s1_1_1_o = fadd_s(s1_0_2_o, s1_0_3_o);
  SA[6] = FEXP_(SA[6]);
  SA[7] = FEXP_(SA[7]);
  SA[8] = FEXP_(SA[8]);
  const unsigned pw2_1_o = pack2(SA[2], SA[3]);
  const float t2_1_o = fadd_s(SA[2], SA[3]);
  const unsigned pw2_2_o = pack2(SA[4], SA[5]);
  const float t2_2_o = fadd_s(SA[4], SA[5]);
  __builtin_amdgcn_sched_barrier(0);
  O10 = MFMA(vf001_o, P11_o, O10);
  const bf16x8 vf110_o = VFR_(1, 1, 0);
  const float s1_2_0_o = fadd_s(s1_1_0_o, s1_1_1_o);
  SA[9] = FEXP_(SA[9]);
  SA[10] = FEXP_(SA[10]);
  SA[11] = FEXP_(SA[11]);
  const unsigned pw2_3_o = pack2(SA[6], SA[7]);
  const float t2_3_o = fadd_s(SA[6], SA[7]);
  const bf16x8 P20_o = __builtin_bit_cast(bf16x8, make_uint4(pw2_0_o, pw2_1_o, pw2_2_o, pw2_3_o));
  const float s2_0_0_o = fadd_s(t2_0_o, t2_1_o);
  __builtin_amdgcn_sched_barrier(0);
  SB = MFMA(kfB1_o, Q1[1], SB);
  l1 = fadd_s(l1, s1_2_0_o);
  SA[12] = FEXP_(SA[12]);
  SA[13] = FEXP_(SA[13]);
  const unsigned pw2_4_o = pack2(SA[8], SA[9]);
  const float t2_4_o = fadd_s(SA[8], SA[9]);
  const unsigned pw2_5_o = pack2(SA[10], SA[11]);
  const float t2_5_o = fadd_s(SA[10], SA[11]);
  const float s2_0_1_o = fadd_s(t2_2_o, t2_3_o);
  __builtin_amdgcn_sched_barrier(0);
  O11 = MFMA(vf011_o, P11_o, O11);
  const bf16x8 kfN0_o = KFR_(KN, 0, 0);
  const bf16x8 vf101_o = VFR_(0, 1, 1);
  SA[14] = FEXP_(SA[14]);
  SA[15] = FEXP_(SA[15]);
  const unsigned pw2_6_o = pack2(SA[12], SA[13]);
  const float t2_6_o = fadd_s(SA[12], SA[13]);
  const float s2_0_2_o = fadd_s(t2_4_o, t2_5_o);
  const float s2_1_0_o = fadd_s(s2_0_0_o, s2_0_1_o);
  __builtin_amdgcn_sched_barrier(0);
  O00 = MFMA(vf100_o, P20_o, O00);
  const unsigned pw2_7_o = pack2(SA[14], SA[15]);
  const float t2_7_o = fadd_s(SA[14], SA[15]);
  const bf16x8 P21_o = __builtin_bit_cast(bf16x8, make_uint4(pw2_4_o, pw2_5_o, pw2_6_o, pw2_7_o));
  SB[0] = FEXP_(SB[0]);
  SB[1] = FEXP_(SB[1]);
  SB[2] = FEXP_(SB[2]);
  __builtin_amdgcn_sched_barrier(0);
  O01 = MFMA(vf110_o, P20_o, O01);
  const bf16x8 kfN1_o = KFR_(KN, 0, 1);
  const bf16x8 vf111_o = VFR_(1, 1, 1);
  const float s2_0_3_o = fadd_s(t2_6_o, t2_7_o);
  SB[3] = FEXP_(SB[3]);
  SB[4] = FEXP_(SB[4]);
  SB[5] = FEXP_(SB[5]);
  const unsigned pw3_0_o = pack2(SB[0], SB[1]);
  const float t3_0_o = fadd_s(SB[0], SB[1]);
  LD_V(t + 3, 1);
  __builtin_amdgcn_sched_barrier(0);
  SA = MFMA(kfN0_o, Q0[0], (f32x16)(0.f));
  const float s2_1_1_o = fadd_s(s2_0_2_o, s2_0_3_o);
  SB[6] = FEXP_(SB[6]);
  SB[7] = FEXP_(SB[7]);
  SB[8] = FEXP_(SB[8]);
  const unsigned pw3_1_o = pack2(SB[2], SB[3]);
  const float t3_1_o = fadd_s(SB[2], SB[3]);
  const unsigned pw3_2_o = pack2(SB[4], SB[5]);
  const float t3_2_o = fadd_s(SB[4], SB[5]);
  __builtin_amdgcn_sched_barrier(0);
  O00 = MFMA(vf101_o, P21_o, O00);
  const float s2_2_0_o = fadd_s(s2_1_0_o, s2_1_1_o);
  SB[9] = FEXP_(SB[9]);
  SB[10] = FEXP_(SB[10]);
  SB[11] = FEXP_(SB[11]);
  const unsigned pw3_3_o = pack2(SB[6], SB[7]);
  const float t3_3_o = fadd_s(SB[6], SB[7]);
  const bf16x8 P30_o = __builtin_bit_cast(bf16x8, make_uint4(pw3_0_o, pw3_1_o, pw3_2_o, pw3_3_o));
  const float s3_0_0_o = fadd_s(t3_0_o, t3_1_o);
  __builtin_amdgcn_sched_barrier(0);
  SA = MFMA(kfN1_o, Q0[1], SA);
  l0 = fadd_s(l0, s2_2_0_o);
  SB[12] = FEXP_(SB[12]);
  SB[13] = FEXP_(SB[13]);
  const unsigned pw3_4_o = pack2(SB[8], SB[9]);
  const float t3_4_o = fadd_s(SB[8], SB[9]);
  const unsigned pw3_5_o = pack2(SB[10], SB[11]);
  const float t3_5_o = fadd_s(SB[10], SB[11]);
  const float s3_0_1_o = fadd_s(t3_2_o, t3_3_o);
  __builtin_amdgcn_sched_barrier(0);
  O01 = MFMA(vf111_o, P21_o, O01);
  SB[14] = FEXP_(SB[14]);
  SB[15] = FEXP_(SB[15]);
  const unsigned pw3_6_o = pack2(SB[12], SB[13]);
  const float t3_6_o = fadd_s(SB[12], SB[13]);
  const float s3_0_2_o = fadd_s(t3_4_o, t3_5_o);
  const float s3_1_0_o = fadd_s(s3_0_0_o, s3_0_1_o);
  __builtin_amdgcn_sched_barrier(0);
  const unsigned pw3_7_o = pack2(SB[14], SB[15]);
  const float t3_7_o = fadd_s(SB[14], SB[15]);
  const bf16x8 P31_o = __builtin_bit_cast(bf16x8, make_uint4(pw3_4_o, pw3_5_o, pw3_6_o, pw3_7_o));
  const float s3_0_3_o = fadd_s(t3_6_o, t3_7_o);
  const float s3_1_1_o = fadd_s(s3_0_2_o, s3_0_3_o);
  const float s3_2_0_o = fadd_s(s3_1_0_o, s3_1_1_o);
  l1 = fadd_s(l1, s3_2_0_o);
  P3c0 = P30_o; P3c1 = P31_o; vfc00 = vf100_o; vfc10 = vf110_o; vfc01 = vf101_o; vfc11 = vf111_o;
  __builtin_amdgcn_sched_barrier(0);
#undef VFR_

    }
    { const int tmp_ = kcu; kcu = knx; knx = kwr; kwr = tmp_; }
    __syncthreads();
  }
  O10 = MFMA(vfc00, P3c0, O10); O11 = MFMA(vfc10, P3c0, O11); O10 = MFMA(vfc01, P3c1, O10); O11 = MFMA(vfc11, P3c1, O11);
#undef LD_K
#undef LD_V
#undef SW_K
#undef SW_V
#undef VFRX_
#undef KFR_
#undef FEXP_
  const float lt0 = l0 + __shfl_xor(l0, 32), lt1 = l1 + __shfl_xor(l1, 32);
  if (__syncthreads_or(!(lt0 < 1.0e37f) || !(lt0 > 1.0e-30f) || !(lt1 < 1.0e37f) || !(lt1 > 1.0e-30f))) return true;
  float* xch = (float*)lds + (((wave >> 1) * 2) * 64 + lane) * 33;
  if (strm == 1) {
    const float sc0 = lam_full / lt0, sc1 = lam_full / lt1;
#pragma unroll
    for (int e = 0; e < 16; ++e) {
      xch[e] = O00[e] * sc0; xch[16 + e] = O01[e] * sc0;
      xch[64 * 33 + e] = O10[e] * sc1; xch[64 * 33 + 16 + e] = O11[e] * sc1;
    }
  }
  __syncthreads();
  if (strm == 0) {
    const float* g = p.in[3] + layer * 64;
#define DIFF_FIN_(QI, OA, OB, LT) { \
      const int t_ = b * SEQ + q0 + (QI) * 32 + r; \
      const float inv1 = 1.f / (LT); \
      float ss = 0.f; \
      _Pragma("unroll") for (int e = 0; e < 16; ++e) { \
        const float oa = OA[e] * inv1 - xch[(QI) * 64 * 33 + e]; OA[e] = oa; ss += oa * oa; \
        const float ob = OB[e] * inv1 - xch[(QI) * 64 * 33 + 16 + e]; OB[e] = ob; ss += ob * ob; } \
      ss += __shfl_xor(ss, 32); \
      const float rn = rsqrtf(ss * (1.f / 64.f) + 1e-5f) * (1.f - lam_init); \
      _Pragma("unroll") for (int gq = 0; gq < 4; ++gq) \
        _Pragma("unroll") for (int bq = 0; bq < 4; ++bq) { OA[4 * gq + bq] *= rn * g[8 * gq + 4 * hh + bq]; OB[4 * gq + bq] *= rn * g[32 + 8 * gq + 4 * hh + bq]; } \
      store_tile(p.cat + (size_t)t_ * 1024 + head * 64, OA, hh); \
      store_tile(p.cat + (size_t)t_ * 1024 + head * 64 + 32, OB, hh); }
    DIFF_FIN_(0, O00, O01, lt0)
    DIFF_FIN_(1, O10, O11, lt1)
#undef DIFF_FIN_
  }
  __syncthreads();
  return false;
}

struct DilItem { int pair, bh, dil, L, cls, i0; };
DI DilItem dil_decode(int item) {
  DilItem d;
  d.pair = item / 768; const int rem = item % 768; d.bh = rem >> 4; const int sub = rem & 15;
  d.dil = (d.pair == 0) ? 1 : (d.pair == 1 ? 4 : 16);
  d.L = SEQ / d.dil;
  int blk;
  if (d.pair == 0) { d.cls = 0; blk = sub; } else if (d.pair == 1) { d.cls = sub & 3; blk = sub >> 2; } else { d.cls = sub; blk = 0; }
  d.i0 = blk * 256;
  return d;
}
DI void dil_fetch(const Params& p, const DilItem& d, int tid, uint4 (&kr)[6], uint4 (&vr)[6]) {
  const u16* kg = p.ck + (size_t)d.bh * SEQ * 64;
  const u16* vg = p.cv + (size_t)d.bh * SEQ * 64;
#pragma unroll
  for (int e = 0; e < 6; ++e) {
    const int c = tid + e * 512;
    const int row = c >> 3, ch = c & 7;
    const int kk = d.i0 - 64 + row;
    kr[e] = make_uint4(0, 0, 0, 0); vr[e] = make_uint4(0, 0, 0, 0);
    if (kk >= 0 && kk < d.L) {
      const size_t pos = (size_t)(d.cls + d.dil * kk);
      kr[e] = *(const uint4*)(kg + pos * 64 + ch * 8);
      vr[e] = *(const uint4*)(vg + pos * 64 + ch * 8);
    }
  }
}
DI void attn_dilated_items(const Params& p, char* lds) {
  const int tid = otid(p.wave), lane = tid & 63, wave = tid >> 6, r = lane & 31, hh = lane >> 5;
  constexpr int KROW = 144;
  char* Kl = lds;
  char* Vl = lds + 384 * KROW;
  uint4 kr[6], vr[6];
  int item = obid();
  if (item < 2304) { const DilItem d0 = dil_decode(item); dil_fetch(p, d0, tid, kr, vr); }
#pragma unroll 1
  for (; item < 2304; item += gridDim.x) {
  const DilItem d = dil_decode(item);
  const int pair = d.pair, bh = d.bh, dil = d.dil, L = d.L, cls = d.cls, i0 = d.i0;
#pragma unroll
  for (int e = 0; e < 6; ++e) {
    const int c = tid + e * 512;
    const int row = c >> 3, ch = c & 7;
    *(uint4*)(Kl + row * KROW + ch * 16) = kr[e];
    *(uint4*)(Vl + row * 128 + ((ch * 16) ^ (((row >> 1) & 1) << 6))) = vr[e];
  }
  if (item + (int)gridDim.x < 2304) { const DilItem dn = dil_decode(item + gridDim.x); dil_fetch(p, dn, tid, kr, vr); }
  const int qq = i0 + 32 * wave + r;
  const int pq = cls + dil * qq;
  bf16x8 Q[4];
  {
    const u16* qp = p.cq + ((size_t)bh * SEQ + pq) * 64 + hh * 8;
#pragma unroll
    for (int s = 0; s < 4; ++s) Q[s] = *(const bf16x8*)(qp + s * 16);
  }
  __syncthreads();
  f32x16 O[2];
#pragma unroll
  for (int e = 0; e < 16; ++e) { O[0][e] = 0.f; O[1][e] = 0.f; }
  float m = -1e30f, l = 0.f;
  const int tq = (lane & 15) >> 2, tp = lane & 3, tg1 = (lane >> 4) & 1, swz = (tq >> 1) & 1;
  const int voff = (4 * hh + tq) * 128 + 32 * tg1 + 8 * tp;
#pragma unroll
  for (int j = 0; j < 5; ++j) {
    const int rb = 32 * wave + 32 * j;
    f32x16 S;
#pragma unroll
    for (int e = 0; e < 16; ++e) S[e] = 0.f;
    const char* kb = Kl + (rb + r) * KROW + hh * 16;
#pragma unroll
    for (int s = 0; s < 4; ++s) S = MFMA(*(const bf16x8*)(kb + s * 32), Q[s], S);
    unsigned vmask = 0;
#pragma unroll
    for (int e = 0; e < 16; ++e) {
      const int cr = (e & 3) + 8 * (e >> 2) + 4 * hh;
      const int kk = i0 - 64 + rb + cr;
      bool ok = (kk >= 0) && (kk < L);
      if (j == 0) ok = ok && (cr >= r);
      if (j == 4) ok = ok && (cr <= r);
      vmask |= ok ? (1u << e) : 0u;
      S[e] = ok ? S[e] : -1e30f;
    }
    float mx = max16(S);
    mx = fmaxf(mx, __shfl_xor(mx, 32));
    if (__any(mx > m)) {
      const float mn = fmaxf(m, mx);
      const float al = fexp2(m - mn);
      m = mn; l *= al;
#pragma unroll
      for (int e = 0; e < 16; ++e) { O[0][e] *= al; O[1][e] *= al; }
    }
    float ps = 0.f;
#pragma unroll
    for (int e = 0; e < 16; ++e) { S[e] = ((vmask >> e) & 1) ? fexp2(S[e] - m) : 0.f; ps += S[e]; }
    l += ps;
    bf16x8 P0 = packP(S, 0), P1 = packP(S, 1);
    const char* vb = Vl + rb * 128 + voff;
#pragma unroll
    for (int i2 = 0; i2 < 2; ++i2)
#pragma unroll
      for (int s2 = 0; s2 < 2; ++s2) {
        const char* a = vb + (16 * s2) * 128 + 64 * (i2 ^ swz);
        s16x4 lo = trread(a), hi = trread(a + 8 * 128);
        bf16x8 vf = __builtin_shufflevector(lo, hi, 0, 1, 2, 3, 4, 5, 6, 7);
        O[i2] = MFMA(vf, s2 == 0 ? P0 : P1, O[i2]);
      }
  }
  const float lt = l + __shfl_xor(l, 32);
  const float inv = 1.f / lt;
  const int b = bh / 6, head = bh % 6;
  const int t = b * SEQ + pq;
#pragma unroll
  for (int i2 = 0; i2 < 2; ++i2) {
#pragma unroll
    for (int e = 0; e < 16; ++e) O[i2][e] *= inv;
    store_tile(p.dilo + ((size_t)pair * T_ALL + t) * 384 + head * 64 + i2 * 32, O[i2], hh);
  }
  if (hh == 0) p.dillse[((size_t)pair * T_ALL + t) * 6 + head] = m + __log2f(lt);
  __syncthreads();
  }
}


DI void phase_gemm1(const Params& p, int layer, char* lds) {
  EpiGemm1 E; E.aq = p.aq; E.ak = p.ak; E.av = p.av; E.bc = p.bc; E.bkr = p.bkr; E.cq = p.cq; E.ck = p.ck; E.cv = p.cv;
  E.cs32 = p.cs32; E.cs64 = p.cs64; E.sumsq = p.sumsq;
  run_gemm(p.wave, p.xb, p.winT + (size_t)layer * NPAD * 1024, NPAD, 1024, E, lds);
}
DI void phase_up_dil(const Params& p, int layer, char* lds) {
  EpiUp E; E.mq = p.mq; E.mk = p.mk; E.mv = p.mv; E.cs32 = p.cs32; E.sumsq = p.sumsq;
  run_gemm(p.wave, p.bc, p.wupT + (size_t)layer * NUP * KUP, NUP, KUP, E, lds);
  attn_dilated_items(p, lds);
}
DI void phase_attn(const Params& p, int layer, char* lds) {
  const float* lam = p.in[2] + layer * 128;
  float s1 = 0.f, s2 = 0.f;
  for (int i = 0; i < 32; ++i) { s1 += lam[i] * lam[32 + i]; s2 += lam[64 + i] * lam[96 + i]; }
  const float lam_init = 0.8f - 0.6f * expf(-0.3f * (float)(layer + 1));
  const float lam_full = expf(s1) - expf(s2) + lam_init;
  unsigned redo = 0u;
  {
    int k = 0;
    for (int item = obid(); item < 1280; item += gridDim.x, ++k) {
      bool bad;
      if (item < 768) bad = attn_mla_split(p, layer, item, lds);
      else bad = attn_diff_pipe(p, layer, item - 768, lam_full, lam_init, lds);
      redo |= bad ? (1u << k) : 0u;
    }
  }
  redo = __builtin_amdgcn_readfirstlane(redo);
  if (redo) {
    int k = 0;
    for (int item = obid(); item < 1280; item += gridDim.x, ++k) {
      if (!((redo >> k) & 1u)) continue;
      if (item < 768) attn_dense_item<true, true, 1>(p, layer, item, lam_full, lam_init, lds);
      else {
        const int j = item - 768, o = (j / 64) * 128 + ((j / 16) & 3) * 32 + 2 * (j & 15);
        attn_dense_item<false, true, 1>(p, layer, o, lam_full, lam_init, lds);
        attn_dense_item<false, true, 1>(p, layer, o + 1, lam_full, lam_init, lds);
      }
    }
  }
  for (int i = obid() * 512 + otid(p.wave); i < T_ALL * 48; i += gridDim.x * 512) {
    const int t = i / 48, c = i % 48, head = c >> 3;
    const float l0 = p.dillse[((size_t)0 * T_ALL + t) * 6 + head];
    const float l1 = p.dillse[((size_t)1 * T_ALL + t) * 6 + head];
    const float l2 = p.dillse[((size_t)2 * T_ALL + t) * 6 + head];
    const float mx = fmaxf(l0, fmaxf(l1, l2));
    float w0 = fexp2(l0 - mx), w1 = fexp2(l1 - mx), w2 = fexp2(l2 - mx);
    const float inv = 1.f / (w0 + w1 + w2);
    w0 *= inv; w1 *= inv; w2 *= inv;
    const uint4 a = *(const uint4*)(p.dilo + ((size_t)0 * T_ALL + t) * 384 + c * 8);
    const uint4 bq = *(const uint4*)(p.dilo + ((size_t)1 * T_ALL + t) * 384 + c * 8);
    const uint4 cq = *(const uint4*)(p.dilo + ((size_t)2 * T_ALL + t) * 384 + c * 8);
    uint4 o;
    o.x = pack2(w0 * bflo(a.x) + w1 * bflo(bq.x) + w2 * bflo(cq.x), w0 * bfhi(a.x) + w1 * bfhi(bq.x) + w2 * bfhi(cq.x));
    o.y = pack2(w0 * bflo(a.y) + w1 * bflo(bq.y) + w2 * bflo(cq.y), w0 * bfhi(a.y) + w1 * bfhi(bq.y) + w2 * bfhi(cq.y));
    o.z = pack2(w0 * bflo(a.z) + w1 * bflo(bq.z) + w2 * bflo(cq.z), w0 * bfhi(a.z) + w1 * bfhi(bq.z) + w2 * bfhi(cq.z));
    o.w = pack2(w0 * bflo(a.w) + w1 * bflo(bq.w) + w2 * bflo(cq.w), w0 * bfhi(a.w) + w1 * bfhi(bq.w) + w2 * bfhi(cq.w));
    *(uint4*)(p.cat + (size_t)t * 1024 + 640 + c * 8) = o;
  }
}
DI void phase_outproj(const Params& p, int layer, char* lds) {
  EpiOut E; E.xb = p.xb; E.ybuf = p.ybuf; E.stats = p.stats;
  run_gemm(p.wave, p.cat, p.woT + (size_t)layer * DM * DM, DM, DM, E, lds);
}
DI void phase_ln1(const Params& p, int layer, char* lds) {
  const int tid = otid(p.wave), lane = tid & 63, wave = tid >> 6;
  const float* g1 = p.in[9] + layer * 1024 + lane * 16;
  const float* b1 = p.in[10] + layer * 1024 + lane * 16;
  float gg[16], bb[16];
#pragma unroll
  for (int q = 0; q < 4; ++q) {
    const float4 a = *(const float4*)(g1 + 4 * q), b = *(const float4*)(b1 + 4 * q);
    gg[4 * q] = a.x; gg[4 * q + 1] = a.y; gg[4 * q + 2] = a.z; gg[4 * q + 3] = a.w;
    bb[4 * q] = b.x; bb[4 * q + 1] = b.y; bb[4 * q + 2] = b.z; bb[4 * q + 3] = b.w;
  }
  for (int t = obid() * 8 + wave; t < T_ALL; t += gridDim.x * 8) {
    const uint4* yp = (const uint4*)(p.ybuf + (size_t)t * 1024 + lane * 16);
    const uint4 v0 = yp[0], v1 = yp[1];
    float pv = (lane < 32) ? p.stats[(size_t)t * 32 + lane] : 0.f;
    pv += __shfl_xor(pv, 8); pv += __shfl_xor(pv, 4); pv += __shfl_xor(pv, 2); pv += __shfl_xor(pv, 1);
    const float mean = __shfl(pv, 0) * (1.f / 1024.f);
    const float rstd = rsqrtf(fmaxf(__shfl(pv, 16) * (1.f / 1024.f) - mean * mean, 0.f) + 1e-5f);
    const float y[16] = {bflo(v0.x), bfhi(v0.x), bflo(v0.y), bfhi(v0.y), bflo(v0.z), bfhi(v0.z), bflo(v0.w), bfhi(v0.w),
                         bflo(v1.x), bfhi(v1.x), bflo(v1.y), bfhi(v1.y), bflo(v1.z), bfhi(v1.z), bflo(v1.w), bfhi(v1.w)};
    float o[16];
#pragma unroll
    for (int e = 0; e < 16; ++e) o[e] = (y[e] - mean) * rstd * gg[e] + bb[e];
    uint4 w0, w1;
    w0.x = pack2(o[0], o[1]); w0.y = pack2(o[2], o[3]); w0.z = pack2(o[4], o[5]); w0.w = pack2(o[6], o[7]);
    w1.x = pack2(o[8], o[9]); w1.y = pack2(o[10], o[11]); w1.z = pack2(o[12], o[13]); w1.w = pack2(o[14], o[15]);
    uint4* xp = (uint4*)(p.x1 + (size_t)t * 1024 + lane * 16);
    xp[0] = w0; xp[1] = w1;
  }
}
DI void phase_qgemm(const Params& p, int layer, char* lds) {
  EpiQ E; E.qbuf = p.qbuf;
  run_gemm(p.wave, p.x1, p.wqT + (size_t)layer * 2048 * DM, 2048, DM, E, lds);
}

template <int P0>
DI void ins_from(float (&L)[16], float v) {
#pragma unroll
  for (int k = 15; k > P0; --k) L[k] = __builtin_amdgcn_fmed3f(v, L[k - 1], L[k]);
  L[P0] = fmaxf(L[P0], v);
}
template <int I, int J>
DI void cand_row(float (&C)[16], const float (&A)[16], const float (&B)[16]) {
  if constexpr ((I + 1) * (J + 1) <= 16) {
    const float sm = A[I] + B[J];
    const float v = __uint_as_float((__float_as_uint(sm) & ~255u) | (unsigned)(255 - (I * 16 + J)));
    ins_from<(I + 1) * (J + 1) - 1>(C, v);
    cand_row<I, J + 1>(C, A, B);
  }
}
template <int I>
DI void cand_all(float (&C)[16], const float (&A)[16], const float (&B)[16]) {
  if constexpr (I < 16) { cand_row<I, 0>(C, A, B); cand_all<I + 1>(C, A, B); }
}
DI void ins16(float (&L)[16], float v) {
#pragma unroll
  for (int k = 15; k >= 1; --k) L[k] = __builtin_amdgcn_fmed3f(v, L[k - 1], L[k]);
  L[0] = fmaxf(L[0], v);
}
constexpr int QS_STR = 528;

DI void phase_peer_route(const Params& p, int layer, char* lds) {
  const int tid = otid(p.wave), lane = tid & 63, wave = tid >> 6;
  const int r = lane & 31, hh = lane >> 5;
  char* Qs = lds;
  unsigned* Ls = (unsigned*)(lds + 128 * QS_STR);
  for (int item = obid(); item < 2048; item += gridDim.x) {
    const int mt = item >> 3, head = item & 7;
#pragma unroll
    for (int e = 0; e < 8; ++e) {
      const int c = tid + e * 512, row = c >> 5, ch = c & 31;
      *(uint4*)(Qs + row * QS_STR + ch * 16) = *(const uint4*)(p.qbuf + (size_t)(mt * 128 + row) * 2048 + head * 256 + ch * 8);
    }
    __syncthreads();
    {
      const int pp = wave >> 2, tg = wave & 3;
      bf16x8 Bq[8];
      const char* qrow = Qs + (tg * 32 + r) * QS_STR + (pp * 128 + hh * 8) * 2;
#pragma unroll
      for (int s = 0; s < 8; ++s) Bq[s] = *(const bf16x8*)(qrow + s * 32);
      const u16* kbase = p.keysb + ((size_t)(layer * 16 + head * 2 + pp) * 128) * 128;
      float Lst[16];
#pragma unroll
      for (int k = 0; k < 16; ++k) Lst[k] = -3.0e38f;
#pragma unroll
      for (int kt = 0; kt < 4; ++kt) {
        f32x16 S;
#pragma unroll
        for (int e = 0; e < 16; ++e) S[e] = 0.f;
        const u16* krow = kbase + (size_t)(kt * 32 + r) * 128 + hh * 8;
#pragma unroll
        for (int s = 0; s < 8; ++s) S = MFMA(*(const bf16x8*)(krow + s * 16), Bq[s], S);
#pragma unroll
        for (int e = 0; e < 16; ++e) {
          const int kidx = kt * 32 + (e & 3) + 8 * (e >> 2) + 4 * hh;
          const float v = __uint_as_float((__float_as_uint(S[e]) & ~127u) | (unsigned)(127 - kidx));
          ins16(Lst, v);
        }
      }
      float Pl[16];
#pragma unroll
      for (int k = 0; k < 16; ++k) Pl[k] = __shfl_xor(Lst[k], 32);
#pragma unroll
      for (int k = 0; k < 16; ++k) ins16(Lst, Pl[k]);
      if (hh == 0) {
        unsigned* dst = Ls + ((tg * 32 + r) * 2 + pp) * 16;
#pragma unroll
        for (int k = 0; k < 16; ++k) dst[k] = __float_as_uint(Lst[k]);
      }
    }
    __syncthreads();
    if (tid < 128) {
      const unsigned* la = Ls + (tid * 2) * 16;
      float A[16], B[16];
#pragma unroll
      for (int k = 0; k < 16; ++k) { A[k] = __uint_as_float(la[k]); B[k] = __uint_as_float(la[16 + k]); }
      float C[16];
#pragma unroll
      for (int k = 0; k < 16; ++k) C[k] = -3.0e38f;
      cand_all<0>(C, A, B);
      const int t = mt * 128 + tid;
      float e[16], sum = 0.f;
#pragma unroll
      for (int k = 0; k < 16; ++k) { e[k] = __expf(C[k] - C[0]); sum += e[k]; }
      const float inv = 1.f / sum;
      int* ed = p.experts + (size_t)t * 128 + head * 16;
      float* gd = p.gates + (size_t)t * 128 + head * 16;
#pragma unroll
      for (int k = 0; k < 16; ++k) {
        const unsigned code = 255u - (__float_as_uint(C[k]) & 255u);
        const int i1 = 127 - (int)(la[code >> 4] & 127u);
        const int i2 = 127 - (int)(la[16 + (code & 15)] & 127u);
        ed[k] = i1 * 128 + i2;
        gd[k] = e[k] * inv;
      }
    }
    __syncthreads();
  }
}


DI float gelu_exact(float d) { return 0.5f * d * (1.f + erff(d * 0.70710678118654752f)); }

DI float row_allsum(float v) {
  v += __builtin_bit_cast(float, __builtin_amdgcn_update_dpp(0, __builtin_bit_cast(int, v), 0x128, 0xf, 0xf, false));
  v += __builtin_bit_cast(float, __builtin_amdgcn_update_dpp(0, __builtin_bit_cast(int, v), 0x124, 0xf, 0xf, false));
  v += __builtin_bit_cast(float, __builtin_amdgcn_update_dpp(0, __builtin_bit_cast(int, v), 0x122, 0xf, 0xf, false));
  v += __builtin_bit_cast(float, __builtin_amdgcn_update_dpp(0, __builtin_bit_cast(int, v), 0x121, 0xf, 0xf, false));
  return v;
}

DI void phase_peer_ffn(const Params& p, int layer, char* lds) {
  const int tid = otid(p.wave), lane = tid & 63, wave = tid >> 6, grp16 = lane >> 4, l16 = lane & 15;
  uint2* list = (uint2*)(lds + wave * 4096);
  float* dl = (float*)(lds + 32768 + wave * 2048);
  const float* g2 = p.in[15] + layer * 1024;
  const float* b2 = p.in[16] + layer * 1024;
  const unsigned char* ub = p.ub + (size_t)layer * NEXP * ROWB + l16 * 48;
  const unsigned char* vb = p.vb + (size_t)layer * NEXP * ROWB + l16 * 48;
  const float* us = p.us + layer * NEXP;
  const float* vs = p.vs + layer * NEXP;
  const unsigned ltmask16 = (1u << l16) - 1u;
  uint2* mylist = list + grp16 * 128;
  float* mydl = dl + grp16 * 128;
  for (int grp = obid() * 8 + wave; grp < T_ALL / 4; grp += gridDim.x * 8) {
    const int t = grp * 4 + grp16;
    {
      int ev[8]; unsigned gv[8];
      {
        const int4 e0 = *(const int4*)(p.experts + (size_t)t * 128 + l16 * 8);
        const int4 e1 = *(const int4*)(p.experts + (size_t)t * 128 + l16 * 8 + 4);
        const uint4 g0 = *(const uint4*)(p.gates + (size_t)t * 128 + l16 * 8);
        const uint4 g1 = *(const uint4*)(p.gates + (size_t)t * 128 + l16 * 8 + 4);
        ev[0] = e0.x; ev[1] = e0.y; ev[2] = e0.z; ev[3] = e0.w; ev[4] = e1.x; ev[5] = e1.y; ev[6] = e1.z; ev[7] = e1.w;
        gv[0] = g0.x; gv[1] = g0.y; gv[2] = g0.z; gv[3] = g0.w; gv[4] = g1.x; gv[5] = g1.y; gv[6] = g1.z; gv[7] = g1.w;
      }
      int pos[8];
#pragma unroll
      for (int s2 = 0; s2 < 8; ++s2) pos[s2] = 0;
      int running = 0;
#pragma unroll 1
      for (int b = 0; b < 16; ++b) {
#pragma unroll
        for (int s2 = 0; s2 < 8; ++s2) {
          const bool mt = (ev[s2] >> 10) == b;
          const unsigned m = (unsigned)(__ballot(mt) >> (grp16 * 16)) & 0xffffu;
          if (mt) pos[s2] = running + __popc(m & ltmask16);
          running += __popc(m);
        }
      }
#pragma unroll
      for (int s2 = 0; s2 < 8; ++s2) mylist[pos[s2]] = make_uint2((unsigned)ev[s2], gv[s2]);
    }
    __builtin_amdgcn_sched_barrier(0);
#define LD_ROW(buf, tab, i)                                                                     \
  {                                                                                             \
    const unsigned char* r_ = (tab) + (size_t)mylist[(i)].x * ROWB;                             \
    buf[0] = *(const uint4*)r_; buf[1] = *(const uint4*)(r_ + 16); buf[2] = *(const uint4*)(r_ + 32); \
  }
#define ROW_Q0(buf) ((u32x6){buf[0].x, buf[0].y, buf[0].z, buf[0].w, buf[1].x, buf[1].y})
#define ROW_Q1(buf) ((u32x6){buf[1].z, buf[1].w, buf[2].x, buf[2].y, buf[2].z, buf[2].w})
    {
      unsigned xw[32];
#pragma unroll
      for (int n = 0; n < 8; ++n) {
        const uint4 xa = *(const uint4*)(p.x1 + (size_t)t * 1024 + l16 * 64 + n * 8);
        xw[4 * n] = xa.x; xw[4 * n + 1] = xa.y; xw[4 * n + 2] = xa.z; xw[4 * n + 3] = xa.w;
      }
      uint4 r0[3], r1[3], r2[3], r3[3], r4[3], r5[3];
#define PASS1(buf, i)                                                                           \
  {                                                                                             \
    u32x16 u0_ = __builtin_bit_cast(u32x16, __builtin_amdgcn_cvt_scalef32_pk32_bf16_fp6(ROW_Q0(buf), 1.0f)); \
    u32x16 u1_ = __builtin_bit_cast(u32x16, __builtin_amdgcn_cvt_scalef32_pk32_bf16_fp6(ROW_Q1(buf), 1.0f)); \
    float da_ = 0.f, db_ = 0.f;                                                                 \
    _Pragma("unroll") for (int e = 0; e < 16; ++e) {                                            \
      unsigned wa_ = u0_[e], wb_ = u1_[e];                                                      \
      asm volatile("" : "+v"(wa_), "+v"(wb_));     \
      da_ = __builtin_amdgcn_fdot2_f32_bf16(__builtin_bit_cast(bf16x2_t, wa_), __builtin_bit_cast(bf16x2_t, xw[e]), da_, false); \
      db_ = __builtin_amdgcn_fdot2_f32_bf16(__builtin_bit_cast(bf16x2_t, wb_), __builtin_bit_cast(bf16x2_t, xw[16 + e]), db_, false); \
    }                                                                                           \
    const float d_ = row_allsum(da_ + db_);                                                     \
    if (l16 == 0) mydl[(i)] = d_;                                                               \
  }
      LD_ROW(r0, ub, 0) LD_ROW(r1, ub, 1) LD_ROW(r2, ub, 2) LD_ROW(r3, ub, 3) LD_ROW(r4, ub, 4)
#pragma unroll 1
      for (int i = 0; i < 126; i += 6) {
        LD_ROW(r5, ub, i + 5)
        PASS1(r0, i)
        LD_ROW(r0, ub, i + 6)
        PASS1(r1, i + 1)
        LD_ROW(r1, ub, i + 7)
        PASS1(r2, i + 2)
        LD_ROW(r2, ub, min(i + 8, 127))
        PASS1(r3, i + 3)
        LD_ROW(r3, ub, min(i + 9, 127))
        PASS1(r4, i + 4)
        LD_ROW(r4, ub, min(i + 10, 127))
        PASS1(r5, i + 5)
      }
      PASS1(r0, 126)
      PASS1(r1, 127)
    }
    __builtin_amdgcn_sched_barrier(0);
#pragma unroll 2
    for (int k = 0; k < 8; ++k) {
      const int idx = l16 + 16 * k;
      const uint2 en = mylist[idx];
      const float d = mydl[idx] * us[en.x];
      mylist[idx].y = __float_as_uint(__uint_as_float(en.y) * gelu_exact(d) * vs[en.x]);
    }
    __builtin_amdgcn_sched_barrier(0);
    {
      f32x2 acc[32];
#pragma unroll
      for (int e = 0; e < 32; ++e) { acc[e][0] = 0.f; acc[e][1] = 0.f; }
      uint4 r0[3], r1[3], r2[3], r3[3], r4[3], r5[3];
#define PASS2(buf, i)                                                                           \
  {                                                                                             \
    const float c_ = __uint_as_float(mylist[(i)].y);                                            \
    {                                                                                           \
      f32x32 v0_ = __builtin_amdgcn_cvt_scalef32_pk32_f32_fp6(ROW_Q0(buf), 1.0f);               \
      asm volatile("" : "+v"(v0_));                                                             \
      _Pragma("unroll") for (int e = 0; e < 16; ++e) acc[e] = (f32x2){v0_[2 * e], v0_[2 * e + 1]} * c_ + acc[e]; \
    }                                                                                           \
    __builtin_amdgcn_sched_barrier(0);                                                          \
    {                                                                                           \
      f32x32 v1_ = __builtin_amdgcn_cvt_scalef32_pk32_f32_fp6(ROW_Q1(buf), 1.0f);               \
      asm volatile("" : "+v"(v1_));                                                             \
      _Pragma("unroll") for (int e = 0; e < 16; ++e) acc[16 + e] = (f32x2){v1_[2 * e], v1_[2 * e + 1]} * c_ + acc[16 + e]; \
    }                                                                                           \
    __builtin_amdgcn_sched_barrier(0);                                                          \
  }
      LD_ROW(r0, vb, 0) LD_ROW(r1, vb, 1) LD_ROW(r2, vb, 2) LD_ROW(r3, vb, 3) LD_ROW(r4, vb, 4)
#pragma unroll 1
      for (int i = 0; i < 126; i += 6) {
        LD_ROW(r5, vb, i + 5)
        PASS2(r0, i)
        LD_ROW(r0, vb, i + 6)
        PASS2(r1, i + 1)
        LD_ROW(r1, vb, i + 7)
        PASS2(r2, i + 2)
        LD_ROW(r2, vb, min(i + 8, 127))
        PASS2(r3, i + 3)
        LD_ROW(r3, vb, min(i + 9, 127))
        PASS2(r4, i + 4)
        LD_ROW(r4, vb, min(i + 10, 127))
        PASS2(r5, i + 5)
      }
      PASS2(r0, 126)
      PASS2(r1, 127)
      float sm = 0.f;
#pragma unroll
      for (int n = 0; n < 8; ++n) {
        const uint4 xa = *(const uint4*)(p.x1 + (size_t)t * 1024 + l16 * 64 + n * 8);
        const unsigned xq[4] = {xa.x, xa.y, xa.z, xa.w};
#pragma unroll
        for (int e = 0; e < 4; ++e) {
          acc[4 * n + e][0] = ALPHA * bflo(xq[e]) + acc[4 * n + e][0];
          acc[4 * n + e][1] = ALPHA * bfhi(xq[e]) + acc[4 * n + e][1];
          sm += acc[4 * n + e][0] + acc[4 * n + e][1];
        }
      }
      const float mean = row_allsum(sm) * (1.f / 1024.f);
      float vsum = 0.f;
#pragma unroll
      for (int e = 0; e < 32; ++e) {
        acc[e][0] -= mean; acc[e][1] -= mean;
        vsum += acc[e][0] * acc[e][0] + acc[e][1] * acc[e][1];
      }
      const float rstd = rsqrtf(row_allsum(vsum) * (1.f / 1024.f) + 1e-5f);
#pragma unroll
      for (int n = 0; n < 4; ++n) {
        const int d0 = l16 * 64 + n * 16;
        float o[16];
#pragma unroll
        for (int q = 0; q < 4; ++q) {
          const float4 gg = *(const float4*)(g2 + d0 + 4 * q);
          const float4 bb = *(const float4*)(b2 + d0 + 4 * q);
          o[4 * q + 0] = acc[8 * n + 2 * q][0] * rstd * gg.x + bb.x;
          o[4 * q + 1] = acc[8 * n + 2 * q][1] * rstd * gg.y + bb.y;
          o[4 * q + 2] = acc[8 * n + 2 * q + 1][0] * rstd * gg.z + bb.z;
          o[4 * q + 3] = acc[8 * n + 2 * q + 1][1] * rstd * gg.w + bb.w;
        }
        if (layer == 1) {
          float4* oa = (float4*)(p.out + (size_t)t * 1024 + d0);
          oa[0] = make_float4(o[0], o[1], o[2], o[3]); oa[1] = make_float4(o[4], o[5], o[6], o[7]);
          oa[2] = make_float4(o[8], o[9], o[10], o[11]); oa[3] = make_float4(o[12], o[13], o[14], o[15]);
        } else {
          uint4 w0, w1;
          w0.x = pack2(o[0], o[1]); w0.y = pack2(o[2], o[3]); w0.z = pack2(o[4], o[5]); w0.w = pack2(o[6], o[7]);
          w1.x = pack2(o[8], o[9]); w1.y = pack2(o[10], o[11]); w1.z = pack2(o[12], o[13]); w1.w = pack2(o[14], o[15]);
          *(uint4*)(p.xb + (size_t)t * 1024 + d0) = w0;
          *(uint4*)(p.xb + (size_t)t * 1024 + d0 + 8) = w1;
        }
        __builtin_amdgcn_sched_barrier(0);
      }
    }
  }
}

#define XB_TMO      128
#define XB_XCNT(j)  (256  + 64 * (j))
#define XB_XSUB(j)  (1280 + 64 * (j))
#define XB_XGEN(j)  (2304 + 64 * (j))
#define XB_TOP      3328
#define XB_TOPGEN   3392
#define XCD_BAR_WORDS 3456
#define XB_SPIN_CAP (1u << 22)
#define LAS __attribute__((address_space(3)))
DI unsigned xb_ld(unsigned* p) { return __hip_atomic_load(p, __ATOMIC_RELAXED, __HIP_MEMORY_SCOPE_AGENT); }
DI unsigned xb_add(unsigned* p, unsigned v) { return __hip_atomic_fetch_add(p, v, __ATOMIC_RELAXED, __HIP_MEMORY_SCOPE_AGENT); }
DI unsigned xb_xcc_id() { return (unsigned)__builtin_amdgcn_s_getreg((3 << 11) | 20) & 0xFu; }
#define XB_SPIN(cond, bar) do { unsigned _sp = 0; while (cond) { __builtin_amdgcn_s_sleep(1); \
    if ((++_sp & 255u) == 0u) { if (xb_ld(&(bar)[XB_TMO])) break; if (_sp > XB_SPIN_CAP) { atomicAdd(&(bar)[XB_TMO], 1u); break; } } } } while (0)
struct XcdBarrier { unsigned* bar; unsigned x; volatile LAS unsigned* st; };
DI XcdBarrier xcd_barrier_post(unsigned* bar, volatile LAS unsigned* st, bool leader) {
  XcdBarrier b; b.bar = bar; b.x = xb_xcc_id(); b.st = st;
  if (leader) (void)xb_add(&bar[XB_XCNT(b.x)], 1u);
  return b;
}
DI void xcd_barrier_complete(unsigned* bar, unsigned x, unsigned& nloc, unsigned& nx) {
  const unsigned G = gridDim.x;
  unsigned sum, cnt, mine, sp = 0u;
  for (;;) {
    sum = 0u; cnt = 0u; mine = 0u;
#pragma unroll
    for (unsigned j = 0; j < 16; ++j) { const unsigned c = xb_ld(&bar[XB_XCNT(j)]); sum += c; cnt += (c > 0u) ? 1u : 0u; mine = (j == x) ? c : mine; }
    if (sum == G) break;
    __builtin_amdgcn_s_sleep(1);
    if ((++sp & 255u) == 0u) { if (xb_ld(&bar[XB_TMO])) break; if (sp > XB_SPIN_CAP) { atomicAdd(&bar[XB_TMO], 1u); break; } }
  }
  nloc = mine > 0u ? mine : 1u; nx = cnt > 0u ? cnt : 1u;
}
DI void xcd_barrier(const XcdBarrier& b, bool leader) {
  asm volatile("s_waitcnt vmcnt(0)" ::: "memory");
  __syncthreads();
  if (leader) {
    unsigned* bar = b.bar;
    __builtin_amdgcn_s_waitcnt(0);
    unsigned nloc = b.st[0], nx = b.st[1];
    if (nloc == 0u) { xcd_barrier_complete(bar, b.x, nloc, nx); b.st[0] = nloc; b.st[1] = nx; }
    const unsigned old = xb_add(&bar[XB_XSUB(b.x)], 1u);
    const unsigned gen = old / nloc;
    if (old + 1u == (gen + 1u) * nloc) {
      __builtin_amdgcn_fence(__ATOMIC_RELEASE, "agent");
      asm volatile("s_waitcnt vmcnt(0)" ::: "memory");
      const unsigned og = xb_add(&bar[XB_TOP], 1u);
      const unsigned tg = og / nx;
      if (og + 1u == (tg + 1u) * nx) xb_add(&bar[XB_TOPGEN], 1u);
      else XB_SPIN(xb_ld(&bar[XB_TOPGEN]) == tg, bar);
      __builtin_amdgcn_fence(__ATOMIC_ACQUIRE, "agent");
      xb_add(&bar[XB_XGEN(b.x)], 1u);
      asm volatile("s_waitcnt vmcnt(0)" ::: "memory");
    } else {
      XB_SPIN(xb_ld(&bar[XB_XGEN(b.x)]) == gen, bar);
      __builtin_amdgcn_fence(__ATOMIC_ACQUIRE, "agent");
      asm volatile("s_waitcnt vmcnt(0)" ::: "memory");
    }
  }
  __syncthreads();
}

#ifndef REP_SUB
#define REP_SUB -1
#endif
#ifndef REP_N
#define REP_N 0
#endif
constexpr int NSUB = 8;
constexpr int NPHASE = 1 + 2 * NSUB;
template <int PH>
DI void run_phase(const Params& p, char* lds) {
  if (PH == 0) {
    phase_prep(p, lds);
  } else {
    constexpr int layer = (PH - 1) / NSUB, sub = (PH - 1) % NSUB;
    if (sub == 0) phase_gemm1(p, layer, lds);
    else if (sub == 1) phase_up_dil(p, layer, lds);
    else if (sub == 2) phase_attn(p, layer, lds);
    else if (sub == 3) phase_outproj(p, layer, lds);
    else if (sub == 4) phase_ln1(p, layer, lds);
    else if (sub == 5) phase_qgemm(p, layer, lds);
    else if (sub == 6) phase_peer_route(p, layer, lds);
    else phase_peer_ffn(p, layer, lds);
  }
}
template <int PH>
DI void do_phase(const Params& p, int ph_lo, int ph_hi, char* lds, cg::grid_group& grid, const XcdBarrier& xb) {
  if (ph_lo <= PH && PH < ph_hi) {
    constexpr int extra = (REP_SUB == 8) ? (PH == 0 ? REP_N : 0) : ((REP_SUB >= 0 && PH > 0 && (PH - 1) % NSUB == REP_SUB) ? REP_N : 0);
#pragma unroll
    for (int rp = 0; rp < 1 + extra; ++rp) {
      run_phase<PH>(p, lds);
      if (rp < extra) xcd_barrier(xb, otid(p.wave) == 0);
    }
    if (PH + 1 < ph_hi) {
      if (PH == 0) grid.sync();
      else xcd_barrier(xb, otid(p.wave) == 0);
    }
  }
}
__global__ __launch_bounds__(512) void mega(Params p, int ph_lo, int ph_hi) {
  extern __shared__ __attribute__((aligned(16))) char lds[];
  cg::grid_group grid = cg::this_grid();
  p.wave = __builtin_amdgcn_readfirstlane(threadIdx.x >> 6);
  volatile LAS unsigned* st = (volatile LAS unsigned*)(LAS char*)(lds + 131072 + 1008);
  if (threadIdx.x == 0) { st[0] = 0u; st[1] = 0u; }
  __syncthreads();
  const XcdBarrier xb = xcd_barrier_post(p.bar, st, threadIdx.x == 0);
  do_phase<0>(p, ph_lo, ph_hi, lds, grid, xb);
  do_phase<1>(p, ph_lo, ph_hi, lds, grid, xb);
  do_phase<2>(p, ph_lo, ph_hi, lds, grid, xb);
  do_phase<3>(p, ph_lo, ph_hi, lds, grid, xb);
  do_phase<4>(p, ph_lo, ph_hi, lds, grid, xb);
  do_phase<5>(p, ph_lo, ph_hi, lds, grid, xb);
  do_phase<6>(p, ph_lo, ph_hi, lds, grid, xb);
  do_phase<7>(p, ph_lo, ph_hi, lds, grid, xb);
  do_phase<8>(p, ph_lo, ph_hi, lds, grid, xb);
  do_phase<9>(p, ph_lo, ph_hi, lds, grid, xb);
  do_phase<10>(p, ph_lo, ph_hi, lds, grid, xb);
  do_phase<11>(p, ph_lo, ph_hi, lds, grid, xb);
  do_phase<12>(p, ph_lo, ph_hi, lds, grid, xb);
  do_phase<13>(p, ph_lo, ph_hi, lds, grid, xb);
  do_phase<14>(p, ph_lo, ph_hi, lds, grid, xb);
  do_phase<15>(p, ph_lo, ph_hi, lds, grid, xb);
  do_phase<16>(p, ph_lo, ph_hi, lds, grid, xb);
}

extern "C" void kernel_launch(void* const* d_in, const int* in_sizes, int n_in, void* d_out, int out_size, void* d_ws,
                              size_t ws_size, hipStream_t stream) {
  Params p;
  memset(&p, 0, sizeof(p));
  for (int i = 0; i < 17; ++i) p.in[i] = (const float*)d_in[i];
  p.out = (float*)d_out;
  char* w = (char*)d_ws;
  size_t off = 0;
  auto alloc = [&](size_t bytes) { char* r = w + off; off += (bytes + 255) & ~(size_t)255; return r; };
  p.xb = (u16*)alloc((size_t)T_ALL * DM * 2);
  p.winT = (u16*)alloc((size_t)2 * NPAD * 1024 * 2);
  p.wupT = (u16*)alloc((size_t)2 * NUP * KUP * 2);
  p.woT = (u16*)alloc((size_t)2 * 1024 * 1024 * 2);
  p.wqT = (u16*)alloc((size_t)2 * 2048 * 1024 * 2);
  p.keysb = (u16*)alloc((size_t)2 * 16 * 128 * 128 * 2);
  p.ub = (unsigned char*)alloc((size_t)2 * NEXP * ROWB);
  p.vb = (unsigned char*)alloc((size_t)2 * NEXP * ROWB);
  p.us = (float*)alloc((size_t)2 * NEXP * 4);
  p.vs = (float*)alloc((size_t)2 * NEXP * 4);
  p.cs32 = (float2*)alloc((size_t)SEQ * 16 * 8);
  p.cs64 = (float2*)alloc((size_t)SEQ * 32 * 8);
  p.sumsq = (float*)alloc((size_t)T_ALL * 12 * 4);
  p.stats = (float*)alloc((size_t)T_ALL * 32 * 4);
  p.bar = (unsigned*)alloc((size_t)XCD_BAR_WORDS * 4);
  hipMemsetAsync(p.bar, 0, (size_t)XCD_BAR_WORDS * 4, stream);
  p.cat = (u16*)alloc((size_t)T_ALL * 1024 * 2);
  const size_t r1 = off;
  p.aq = (u16*)alloc((size_t)T_ALL * 256 * 2);
  p.ak = (u16*)alloc((size_t)T_ALL * 256 * 2);
  p.av = (u16*)alloc((size_t)T_ALL * 256 * 2);
  p.bc = (u16*)alloc((size_t)T_ALL * KUP * 2);
  p.bkr = (u16*)alloc((size_t)T_ALL * 32 * 2);
  p.cq = (u16*)alloc((size_t)T_ALL * 384 * 2);
  p.ck = (u16*)alloc((size_t)T_ALL * 384 * 2);
  p.cv = (u16*)alloc((size_t)T_ALL * 384 * 2);
  p.mq = (u16*)alloc((size_t)T_ALL * 576 * 2);
  p.mk = (u16*)alloc((size_t)T_ALL * 384 * 2);
  p.mv = (u16*)alloc((size_t)T_ALL * 384 * 2);
  off = r1;
  p.ybuf = (u16*)alloc((size_t)T_ALL * 1024 * 2);
  p.x1 = (u16*)alloc((size_t)T_ALL * 1024 * 2);
  p.experts = (int*)alloc((size_t)T_ALL * 128 * 4);
  p.gates = (float*)alloc((size_t)T_ALL * 128 * 4);
  p.qbuf = (u16*)d_out;
  p.dilo = (u16*)d_out;
  p.dillse = (float*)((char*)d_out + (size_t)3 * T_ALL * 384 * 2);

#ifdef MULTI_LAUNCH
  hipFuncSetAttribute((const void*)mega, hipFuncAttributeMaxDynamicSharedMemorySize, LDS_BYTES);
  for (int ph = 0; ph < NPHASE; ++ph) {
    hipLaunchKernelGGL(mega, dim3(256), dim3(512), LDS_BYTES, stream, p, ph, ph + 1);
  }
#else
  static int grid_blocks = 0;
  if (!grid_blocks) {
    int dev = 0, cus = 0, per_cu = 0;
    hipGetDevice(&dev);
    hipDeviceGetAttribute(&cus, hipDeviceAttributeMultiprocessorCount, dev);
    hipFuncSetAttribute((const void*)mega, hipFuncAttributeMaxDynamicSharedMemorySize, LDS_BYTES);
    hipOccupancyMaxActiveBlocksPerMultiprocessor(&per_cu, mega, 512, LDS_BYTES);
    if (per_cu > 1) per_cu = 1;
    grid_blocks = cus * per_cu;
  }
  int lo = 0, hi = NPHASE;
  void* args[] = {&p, &lo, &hi};
  hipError_t e = hipLaunchCooperativeKernel((void*)mega, dim3(grid_blocks), dim3(512), args, LDS_BYTES, stream);
  if (e != hipSuccess) fprintf(stderr, "cooperative launch failed: %s (grid %d)\n", hipGetErrorString(e), grid_blocks);
#endif
}
```

```cpp
#include <hip/hip_runtime.h>
#include <hip/hip_cooperative_groups.h>
#include <math.h>
#include <stdio.h>
#include <string.h>
namespace cg = cooperative_groups;

typedef unsigned short u16;
typedef short bf16x8 __attribute__((ext_vector_type(8)));
typedef short s16x4 __attribute__((ext_vector_type(4)));
typedef float f32x16 __attribute__((ext_vector_type(16)));
typedef float f32x2 __attribute__((ext_vector_type(2)));
typedef __bf16 bf16x2_t __attribute__((ext_vector_type(2)));

#define DI __device__ __forceinline__
#define MFMA(a, b, c) __builtin_amdgcn_mfma_f32_32x32x16_bf16((a), (b), (c), 0, 0, 0)

constexpr int T_ALL = 32768, SEQ = 4096, DM = 1024, INW = 2336, NEXP = 16384;
constexpr int NPAD = 2560;
constexpr int NUP = 1536, KUP = 384;
constexpr float LOG2E = 1.4426950408889634f;
constexpr float ALPHA = 1.41421356237309515f;

struct Params {
  const float* in[17];
  float* out;
  u16 *xb, *winT, *wupT, *woT, *wqT, *keysb;
  unsigned char *ub, *vb;
  float *us, *vs;
  float2 *cs32, *cs64;
  u16 *aq, *ak, *av, *bc, *bkr, *cq, *ck, *cv, *mq, *mk, *mv, *cat, *dilo;
  float* dillse;
  u16 *ybuf, *x1, *qbuf;
  int* experts;
  float* gates;
  float *sumsq, *stats;
  unsigned* bar;
  int wave, pad_;
};

DI int otid(int wave) { int lane; asm volatile("v_mbcnt_lo_u32_b32 %0, -1, 0\n\tv_mbcnt_hi_u32_b32 %0, -1, %0" : "=v"(lane)); asm volatile("" : "+s"(wave)); return (wave << 6) | lane; }
DI int obid() { int b = blockIdx.x; asm volatile("" : "+s"(b)); return b; }
DI unsigned pack2(float a, float b) {
  f32x2 v = {a, b};
  return __builtin_bit_cast(unsigned, __builtin_convertvector(v, bf16x2_t));
}
DI float bflo(unsigned w) { return __uint_as_float(w << 16); }
DI float bfhi(unsigned w) { return __uint_as_float(w & 0xffff0000u); }
DI float fexp2(float x) { return __builtin_amdgcn_exp2f(x); }
DI void store8(u16* dst, float a, float b, float c, float d) {
  uint2 v; v.x = pack2(a, b); v.y = pack2(c, d);
  *(uint2*)dst = v;
}
DI void store_tile(u16* dst, const f32x16& v, int hh) {
#pragma unroll
  for (int g = 0; g < 4; ++g) store8(dst + 8 * g + 4 * hh, v[4 * g], v[4 * g + 1], v[4 * g + 2], v[4 * g + 3]);
}
DI void rope32(f32x16& v, const float2* cs, int hh) {
#pragma unroll
  for (int g = 0; g < 2; ++g)
#pragma unroll
    for (int b = 0; b < 4; ++b) {
      float2 c = cs[8 * g + 4 * hh + b];
      float x1 = v[4 * g + b], x2 = v[4 * g + b + 8];
      v[4 * g + b] = x1 * c.x - x2 * c.y;
      v[4 * g + b + 8] = x2 * c.x + x1 * c.y;
    }
}
DI void rope64(f32x16& v0, f32x16& v1, const float2* cs, int hh) {
#pragma unroll
  for (int g = 0; g < 4; ++g)
#pragma unroll
    for (int b = 0; b < 4; ++b) {
      float2 c = cs[8 * g + 4 * hh + b];
      float x1 = v0[4 * g + b], x2 = v1[4 * g + b];
      v0[4 * g + b] = x1 * c.x - x2 * c.y;
      v1[4 * g + b] = x2 * c.x + x1 * c.y;
    }
}
DI float wave_sum(float v) {
#pragma unroll
  for (int o = 32; o; o >>= 1) v += __shfl_xor(v, o);
  return v;
}
DI s16x4 trread(const char* p) {
  return __builtin_amdgcn_ds_read_tr16_b64_v4i16((__attribute__((address_space(3))) s16x4*)(p));
}


constexpr int LDS_BYTES = 131072 + 1024;

namespace pg8 {
#define PG8_LAS __attribute__((address_space(3)))
typedef unsigned short bf16_t;
typedef float f32x4 __attribute__((ext_vector_type(4)));
constexpr int BM = 256, BK = 64, HALF = 128, HTB = HALF * BK * 2, STAGE_BYTES = 8 * HTB, NXCD = 8, WGM = 8;
__host__ __device__ __forceinline__ int lds_byte(int r, int c) { const int st = (r >> 4) * 2 + (c >> 5), rr = r & 15, cc = c & 31, ob = rr * 64 + cc * 2; return st * 1024 + (ob ^ (((ob >> 9) & 1) << 5)); }
__host__ __device__ __forceinline__ void stage_rc(int b, int& R, int& C) { const int st = b / 1024, sb = b % 1024, swz = sb ^ (((sb >> 9) & 1) << 5); R = (st >> 1) * 16 + swz / 64; C = (st & 1) * 32 + (swz % 64) / 2; }
__host__ __device__ __forceinline__ int perm32(int rho) { const int n = rho >> 4, i = rho & 15; return 8 * (i >> 2) + 4 * n + (i & 3); }
struct Unit { int pm, pn; };
struct Gemm { const bf16_t* A; const bf16_t* Bt; int M, N, K; };
struct StaticOrder {
    int nM, nN, nwg, G, c;
    __host__ __device__ void init(int M, int N, int G_, int c_) { nM = M / BM; nN = N / BM; nwg = nM * nN; G = G_; c = c_; }
    __host__ __device__ bool next(int i, Unit& u) const {
        const long L = (long)i * G + c; if (L >= nwg) return false;
        int wgid = (int)L; { const int q = nwg / NXCD, r = nwg % NXCD, xcd = wgid % NXCD, off = wgid / NXCD; wgid = (xcd < r ? xcd * (q + 1) : r * (q + 1) + (xcd - r) * q) + off; }
        const int nig = WGM * nN, gid = wgid / nig, fm = gid * WGM, gsz = (nM - fm) < WGM ? (nM - fm) : WGM;
        u.pm = fm + ((wgid % nig) % gsz); u.pn = (wgid % nig) / gsz; return true;
    }
    __device__ __forceinline__ void a_ready(const Unit&) const {}
    __device__ __forceinline__ void done(const Unit&) const {}
};
template <class Epi, class Sched>
__device__ __forceinline__ void gemm_phase(int wv, PG8_LAS unsigned char* lds, const Gemm g, const Sched& S, const Epi& E) {
    const int tid = otid(wv), wid = __builtin_amdgcn_readfirstlane(tid >> 6), lane = tid & 63, wr = wid >> 2, wc = wid & 3, fr = lane & 15, fq = lane >> 4;
    const int K = g.K, nt = K / BK;
    unsigned voffA[2], voffB[2];
#pragma unroll
    for (int i = 0; i < 2; ++i) { int R, C; stage_rc(tid * 16 + i * 8192, R, C); const int Rb = Epi::PERM ? ((R & ~31) + perm32(R & 31)) : R;
        voffA[i] = (unsigned)(R * K + C) * 2u; voffB[i] = (unsigned)(Rb * K + C) * 2u; }
    const size_t kstep = (size_t)(BK * 2);
    const size_t hstep = (size_t)HALF * K * 2;
    const size_t tstep = 2 * hstep;
    const unsigned ldsw = (unsigned)wid * 1024u;
    const int aoff = lds_byte(wr * 64 + fr, fq * 8), boff = lds_byte(wc * 32 + fr, fq * 8);
#define PG8_SA(b, h) (((b) * 2 + (h)) * HTB)
#define PG8_SB(b, h) ((4 + (b) * 2 + (h)) * HTB)
#define PG8_STAGE(bufoff, gbase, voff) do { _Pragma("unroll") for (int _i = 0; _i < 2; ++_i) \
        __builtin_amdgcn_global_load_lds((const unsigned*)((const char*)(gbase) + (voff)[_i]), (PG8_LAS unsigned*)(lds + (bufoff) + ldsw + _i * 8192), 16, 0, 0); } while (0)
#define PG8_LDA(dst, b, h) do { _Pragma("unroll") for (int m = 0; m < 4; ++m) _Pragma("unroll") for (int k = 0; k < 2; ++k) dst[m][k] = *(const PG8_LAS bf16x8*)(lds + PG8_SA(b, h) + aoff + m * 2048 + k * 1024); } while (0)
#define PG8_LDB(dst, b, h) do { _Pragma("unroll") for (int n = 0; n < 2; ++n) _Pragma("unroll") for (int k = 0; k < 2; ++k) dst[n][k] = *(const PG8_LAS bf16x8*)(lds + PG8_SB(b, h) + boff + n * 2048 + k * 1024); } while (0)
#define PG8_MMA(ai, bj, At, Bt) do { __builtin_amdgcn_s_setprio(1); _Pragma("unroll") for (int m = 0; m < 4; ++m) _Pragma("unroll") for (int n = 0; n < 2; ++n) _Pragma("unroll") for (int k = 0; k < 2; ++k) \
        acc[ai][bj][m][n] = __builtin_amdgcn_mfma_f32_16x16x32_bf16(Bt[n][k], At[m][k], acc[ai][bj][m][n], 0, 0, 0); __builtin_amdgcn_s_setprio(0); } while (0)
#define PG8_WAIT_V(n) asm volatile("s_waitcnt vmcnt(" #n ")" ::: "memory")
#define PG8_WAIT_L(n) asm volatile("s_waitcnt lgkmcnt(" #n ")" ::: "memory")
#define PG8_BAR __builtin_amdgcn_s_barrier()
#define PG8_SCHED __builtin_amdgcn_sched_barrier(0)
    Unit cur, nxt; int ui = 0;
    if (!S.next(0, cur)) return;
    f32x4 acc[2][2][4][2];
#pragma unroll
    for (int a = 0; a < 2; ++a)
#pragma unroll
        for (int b = 0; b < 2; ++b)
#pragma unroll
            for (int m = 0; m < 4; ++m)
#pragma unroll
                for (int n = 0; n < 2; ++n) acc[a][b][m][n] = (f32x4){0.f, 0.f, 0.f, 0.f};
    bf16x8 At[4][2], B0[2][2], B1[2][2];
    const char* cA = (const char*)g.A + (size_t)cur.pm * tstep; const char* cB = (const char*)g.Bt + (size_t)cur.pn * tstep;
    S.a_ready(cur);
    PG8_STAGE(PG8_SB(0, 0), cB, voffB); PG8_STAGE(PG8_SA(0, 0), cA, voffA); PG8_STAGE(PG8_SB(0, 1), cB + hstep, voffB); PG8_STAGE(PG8_SA(0, 1), cA + hstep, voffA);
    if (wr == 1) PG8_BAR;
    PG8_WAIT_V(4); PG8_BAR;
    PG8_STAGE(PG8_SB(1, 0), cB + kstep, voffB); PG8_STAGE(PG8_SA(1, 0), cA + kstep, voffA); PG8_STAGE(PG8_SB(1, 1), cB + hstep + kstep, voffB);
    PG8_WAIT_V(6); PG8_BAR;
    for (;;) {
        const bool has_next = S.next(ui + 1, nxt);
        const char* nA = has_next ? (const char*)g.A + (size_t)nxt.pm * tstep : cA; const char* nB = has_next ? (const char*)g.Bt + (size_t)nxt.pn * tstep : cB;
#pragma unroll 1
        for (int t = 0; t < nt; t += 2) {
            const bool last = (t == nt - 2);
            const char* a1 = cA + (size_t)(t + 1) * kstep;
            const char* a2 = last ? nA : cA + (size_t)(t + 2) * kstep; const char* b2 = last ? nB : cB + (size_t)(t + 2) * kstep;
            const char* a3 = a2 + kstep; const char* b3 = b2 + kstep;
            if (last && has_next) S.a_ready(nxt);
            PG8_LDB(B0, 0, 0); PG8_SCHED; PG8_LDA(At, 0, 0); PG8_STAGE(PG8_SA(1, 1), a1 + hstep, voffA);
            PG8_WAIT_L(8); PG8_BAR; PG8_WAIT_L(0); PG8_MMA(0, 0, At, B0); PG8_BAR; PG8_SCHED;
            PG8_LDB(B1, 0, 1); PG8_STAGE(PG8_SB(0, 0), b2, voffB);
            PG8_BAR; PG8_WAIT_L(0); PG8_MMA(0, 1, At, B1); PG8_BAR;
            PG8_LDA(At, 0, 1); PG8_STAGE(PG8_SA(0, 0), a2, voffA);
            PG8_BAR; PG8_WAIT_L(0); PG8_MMA(1, 0, At, B0); PG8_BAR; PG8_SCHED;
            PG8_STAGE(PG8_SB(0, 1), b2 + hstep, voffB);
            PG8_WAIT_V(6); PG8_BAR; PG8_MMA(1, 1, At, B1); PG8_BAR;
            PG8_LDB(B0, 1, 0); PG8_SCHED; PG8_LDA(At, 1, 0); PG8_STAGE(PG8_SA(0, 1), a2 + hstep, voffA);
            PG8_WAIT_L(8); PG8_BAR; PG8_WAIT_L(0); PG8_MMA(0, 0, At, B0); PG8_BAR; PG8_SCHED;
            PG8_LDB(B1, 1, 1); PG8_STAGE(PG8_SB(1, 0), b3, voffB);
            PG8_BAR; PG8_WAIT_L(0); PG8_MMA(0, 1, At, B1); PG8_BAR;
            PG8_LDA(At, 1, 1); PG8_STAGE(PG8_SA(1, 0), a3, voffA);
            PG8_BAR; PG8_WAIT_L(0); PG8_MMA(1, 0, At, B0); PG8_BAR; PG8_SCHED;
            PG8_STAGE(PG8_SB(1, 1), b3 + hstep, voffB);
            PG8_WAIT_V(6); PG8_BAR; PG8_MMA(1, 1, At, B1); PG8_BAR;
        }
        if constexpr (!Epi::AFTER_DRAIN) { E(acc, cur, wr, wc, fr, fq); S.done(cur); }
        if (!has_next) break;
#pragma unroll
        for (int a = 0; a < 2; ++a)
#pragma unroll
            for (int b = 0; b < 2; ++b)
#pragma unroll
                for (int m = 0; m < 4; ++m)
#pragma unroll
                    for (int n = 0; n < 2; ++n) acc[a][b][m][n] = (f32x4){0.f, 0.f, 0.f, 0.f};
        cur = nxt; cA = nA; cB = nB; ++ui;
    }
    PG8_WAIT_V(0);
    if (wr == 0) PG8_BAR;
    PG8_BAR;
    if constexpr (Epi::AFTER_DRAIN) { E.fused(acc, cur, wr, wc, fr, fq, lds, wid, lane); S.done(cur); }
#undef PG8_SA
#undef PG8_SB
#undef PG8_STAGE
#undef PG8_LDA
#undef PG8_LDB
#undef PG8_MMA
#undef PG8_WAIT_V
#undef PG8_WAIT_L
#undef PG8_BAR
#undef PG8_SCHED
}
}
using pg8::f32x4;
using pg8::Unit;

DI void convert_bf16(int wv, const float* __restrict__ src, u16* __restrict__ dst, size_t n8  ) {
  const size_t i0 = (size_t)obid() * 512 + otid(wv);
  for (size_t i = i0; i < n8; i += (size_t)gridDim.x * 512) {
    float4 a = ((const float4*)src)[2 * i], b = ((const float4*)src)[2 * i + 1];
    uint4 o; o.x = pack2(a.x, a.y); o.y = pack2(a.z, a.w); o.z = pack2(b.x, b.y); o.w = pack2(b.z, b.w);
    ((uint4*)dst)[i] = o;
  }
}
typedef float f32x32 __attribute__((ext_vector_type(32)));
typedef unsigned u32x6 __attribute__((ext_vector_type(6)));
typedef unsigned u32x16 __attribute__((ext_vector_type(16)));
typedef __bf16 bf16x32_t __attribute__((ext_vector_type(32)));
constexpr int ROWB = 768;
DI void convert_rows_fp6(int wv, const float* __restrict__ src, unsigned char* __restrict__ dst, float* __restrict__ inv_scale, int nrows) {
  const int tid = otid(wv), lane = tid & 63, wave = tid >> 6, g = lane & 31;
  for (int row = (obid() * 8 + wave) * 2 + (lane >> 5); row < nrows; row += gridDim.x * 16) {
    const float4* rp = (const float4*)(src + (size_t)row * 1024 + g * 32);
    float4 v[8];
#pragma unroll
    for (int i = 0; i < 8; ++i) v[i] = rp[i];
    float mx = 0.f;
#pragma unroll
    for (int i = 0; i < 8; ++i) mx = fmaxf(mx, fmaxf(fmaxf(fabsf(v[i].x), fabsf(v[i].y)), fmaxf(fabsf(v[i].z), fabsf(v[i].w))));
#pragma unroll
    for (int o = 16; o; o >>= 1) mx = fmaxf(mx, __shfl_xor(mx, o));
    const float sc = (mx > 0.f) ? 7.0f / mx : 1.f;
    unsigned long long lo = 0ull, mid = 0ull, hi = 0ull;
    u32x6 q;
    {
      const float xs[32] = {v[0].x, v[0].y, v[0].z, v[0].w, v[1].x, v[1].y, v[1].z, v[1].w, v[2].x, v[2].y, v[2].z, v[2].w, v[3].x, v[3].y, v[3].z, v[3].w,
                            v[4].x, v[4].y, v[4].z, v[4].w, v[5].x, v[5].y, v[5].z, v[5].w, v[6].x, v[6].y, v[6].z, v[6].w, v[7].x, v[7].y, v[7].z, v[7].w};
      unsigned code[32];
#pragma unroll
      for (int i = 0; i < 32; ++i) {
        const float a = fabsf(xs[i] * sc);
        float c = (a < 2.f) ? rintf(a * 8.f) : (a < 4.f ? 16.f + rintf((a - 2.f) * 4.f) : 24.f + rintf((a - 4.f) * 2.f));
        c = fminf(c, 31.f);
        code[i] = (unsigned)c | ((xs[i] < 0.f) ? 32u : 0u);
      }
#pragma unroll
      for (int h = 0; h < 2; ++h) {
        unsigned long long a0 = 0ull, a1 = 0ull;
#pragma unroll
        for (int i = 0; i < 16; ++i) {
          const int bit = 6 * i;
          const unsigned long long cv = code[16 * h + i];
          if (bit < 64) a0 |= cv << bit;
          if (bit + 6 > 64) a1 |= (bit >= 64) ? (cv << (bit - 64)) : (cv >> (64 - bit));
        }
        q[3 * h + 0] = (unsigned)a0; q[3 * h + 1] = (unsigned)(a0 >> 32); q[3 * h + 2] = (unsigned)a1;
      }
    }
    (void)lo; (void)mid; (void)hi;
    unsigned char* dp = dst + (size_t)row * ROWB + g * 24;
    *(uint2*)dp = make_uint2(q[0], q[1]);
    *(uint2*)(dp + 8) = make_uint2(q[2], q[3]);
    *(uint2*)(dp + 16) = make_uint2(q[4], q[5]);
    if (g == 0) inv_scale[row] = (mx > 0.f) ? mx * (1.f / 7.0f) : 1.f;
  }
}

DI int rope32_d(int pos) { return 4 * (pos >> 3) + (pos & 3) + 16 * ((pos >> 2) & 1); }
DI int map_gemm1(int np) {
  const int G = np >> 5, pos = np & 31;
  if (G < 8) return G * 32 + rope32_d(pos);
  if (G < 16) return 256 + (G - 8) * 32 + rope32_d(pos);
  if (G < 36) return G * 32 + pos;
  if (G == 36) return 1152 + rope32_d(pos);
  if (G == 37) return -1;
  if (G < 62) {
    const int hg = (G < 50) ? (G - 38) : (G - 50);
    const int base = (G < 50) ? 1184 : 1568;
    return base + (hg >> 1) * 64 + 16 * (hg & 1) + 4 * (pos >> 3) + (pos & 3) + 32 * ((pos >> 2) & 1);
  }
  if (G < 74) return 1952 + (G - 62) * 32 + pos;
  return -1;
}
DI int map_up(int np, int& which) {
  const int G = np >> 5, pos = np & 31;
  if (G < 18) { which = 0; const int head = G / 3, part = G % 3; return head * 96 + part * 32 + (part == 2 ? rope32_d(pos) : pos); }
  if (G < 42) { which = 1; return (G - 18) * 32 + pos; }
  which = -1; return -1;
}
DI void transpose_tile(const Params& p, int layer, int mode, u16* __restrict__ dst, int ldd, int nt, int kt, float* tile) {
  const int tid = otid(p.wave);
  const int n0 = nt * 64, k0 = kt * 64;
#pragma unroll
  for (int pass = 0; pass < 2; ++pass) {
    const int kk = (tid >> 4) + pass * 32, nn = (tid & 15) * 4;
    const int np = n0 + nn;
    const float* src = nullptr; int nsrc = 0, col = -1, ksrc = k0 + kk; float sc = 1.f;
    if (mode == 0) {
      col = map_gemm1(np); src = p.in[1] + (size_t)layer * DM * INW; nsrc = INW;
      if (col >= 0 && col < 256) sc = 0.17677669529663687f * LOG2E;
      else if (col >= 1184 && col < 1568) sc = 0.125f * LOG2E;
    } else if (mode == 1) {
      int which; col = map_up(np, which);
      if (which == 0 && k0 < 256) { src = p.in[6] + (size_t)layer * 256 * 576; nsrc = 576; sc = 0.10206207261596575f * LOG2E * p.in[4][layer * 256 + ksrc]; }
      else if (which == 1 && k0 >= 256) { ksrc -= 256; src = p.in[7] + (size_t)layer * 128 * 768; nsrc = 768; sc = p.in[5][layer * 128 + ksrc]; }
      else col = -1;
    } else if (mode == 3) {
      col = np; src = p.in[8] + (size_t)layer * DM * DM; nsrc = DM;
    } else {
      col = np; src = p.in[11] + (size_t)layer * DM * 2048; nsrc = 2048;
    }
    float4 v = make_float4(0.f, 0.f, 0.f, 0.f);
    if (col >= 0) v = *(const float4*)(src + (size_t)ksrc * nsrc + col);
    tile[kk * 65 + nn + 0] = v.x * sc; tile[kk * 65 + nn + 1] = v.y * sc;
    tile[kk * 65 + nn + 2] = v.z * sc; tile[kk * 65 + nn + 3] = v.w * sc;
  }
  __syncthreads();
  {
    const int nn = tid >> 3, k8 = (tid & 7) * 8;
    float f[8];
#pragma unroll
    for (int e = 0; e < 8; ++e) f[e] = tile[(k8 + e) * 65 + nn];
    uint4 o; o.x = pack2(f[0], f[1]); o.y = pack2(f[2], f[3]); o.z = pack2(f[4], f[5]); o.w = pack2(f[6], f[7]);
    *(uint4*)(dst + (size_t)(n0 + nn) * ldd + k0 + k8) = o;
  }
  __syncthreads();
}

DI void phase_prep(const Params& p, char* lds) {
  convert_bf16(p.wave, p.in[0], p.xb, (size_t)T_ALL * DM / 8);
  convert_bf16(p.wave, p.in[12], p.keysb, (size_t)2 * 16 * 128 * 128 / 8);
  convert_rows_fp6(p.wave, p.in[13], p.ub, p.us, 2 * NEXP);
  convert_rows_fp6(p.wave, p.in[14], p.vb, p.vs, 2 * NEXP);
  for (int i = obid() * 512 + otid(p.wave); i < SEQ * 48; i += gridDim.x * 512) {
    int pos = i / 48, r = i % 48;
    if (r < 16) {
      float ang = (float)pos * expf(-logf(10000.0f) * (float)r / 16.f);
      p.cs32[pos * 16 + r] = make_float2(cosf(ang), sinf(ang));
    } else {
      int q = r - 16;
      float ang = (float)pos * expf(-logf(10000.0f) * (float)q / 32.f);
      p.cs64[pos * 32 + q] = make_float2(cosf(ang), sinf(ang));
    }
  }
  float* tile = (float*)lds;
  for (int u = obid(); u < 3104; u += gridDim.x) {
    const int layer = u / 1552, r = u % 1552;
    if (r < 640) transpose_tile(p, layer, 0, p.winT + (size_t)layer * NPAD * 1024, 1024, r / 16, r % 16, tile);
    else if (r < 784) { const int v = r - 640; transpose_tile(p, layer, 1, p.wupT + (size_t)layer * NUP * KUP, KUP, v / 6, v % 6, tile); }
    else if (r < 1040) { const int v = r - 784; transpose_tile(p, layer, 3, p.woT + (size_t)layer * DM * DM, 1024, v / 16, v % 16, tile); }
    else { const int v = r - 1040; transpose_tile(p, layer, 4, p.wqT + (size_t)layer * 2048 * DM, 1024, v / 16, v % 16, tile); }
  }
}

DI void store16(u16* dst, const f32x4& a, const f32x4& b) {
  uint4 w; w.x = pack2(a[0], a[1]); w.y = pack2(a[2], a[3]); w.z = pack2(b[0], b[1]); w.w = pack2(b[2], b[3]);
  *(uint4*)dst = w;
}
DI void rope4(f32x4& v0, f32x4& v1, const float2* cs) {
  const float4 c01 = *(const float4*)cs, c23 = *(const float4*)(cs + 2);
  const float co[4] = {c01.x, c01.z, c23.x, c23.z}, si[4] = {c01.y, c01.w, c23.y, c23.w};
#pragma unroll
  for (int k = 0; k < 4; ++k) {
    const float x1 = v0[k], x2 = v1[k];
    v0[k] = x1 * co[k] - x2 * si[k];
    v1[k] = x2 * co[k] + x1 * si[k];
  }
}
struct EpiGemm1 {
  static constexpr bool PERM = true, AFTER_DRAIN = false;
  u16 *aq, *ak, *av, *bc, *bkr, *cq, *ck, *cv; const float2 *cs32, *cs64; float* sumsq;
  DI void operator()(const f32x4 (&acc)[2][2][4][2], const Unit& u, int wr, int wc, int fr, int fq) const {
#pragma unroll
    for (int bj = 0; bj < 2; ++bj) {
      const int G = u.pn * 8 + bj * 4 + wc;
#pragma unroll
      for (int ai = 0; ai < 2; ++ai)
#pragma unroll
        for (int m = 0; m < 4; ++m) {
          const int t = u.pm * 256 + ai * 128 + wr * 64 + m * 16 + fr;
          const int b = t >> 12, s = t & 4095;
          f32x4 v0 = acc[ai][bj][m][0], v1 = acc[ai][bj][m][1];
          if (G < 16 || G == 36) {
            rope4(v0, v1, cs32 + s * 16 + 4 * fq);
            u16* dst = (G < 8) ? aq + ((size_t)(b * 8 + G) * SEQ + s) * 32
                     : (G < 16) ? ak + ((size_t)(b * 8 + G - 8) * SEQ + s) * 32 : bkr + (size_t)t * 32;
            store8(dst + 4 * fq, v0[0], v0[1], v0[2], v0[3]);
            store8(dst + 16 + 4 * fq, v1[0], v1[1], v1[2], v1[3]);
          } else if (G < 24) {
            store16(av + ((size_t)(b * 4 + ((G - 16) >> 1)) * SEQ + s) * 64 + ((G - 16) & 1) * 32 + 8 * fq, v0, v1);
          } else if (G < 36) {
            store16(bc + (size_t)t * KUP + (G - 24) * 32 + 8 * fq, v0, v1);
            float ps = v0[0] * v0[0] + v0[1] * v0[1] + v0[2] * v0[2] + v0[3] * v0[3] + v1[0] * v1[0] + v1[1] * v1[1] + v1[2] * v1[2] + v1[3] * v1[3];
            ps += __shfl_xor(ps, 16); ps += __shfl_xor(ps, 32);
            if (fq == 0) sumsq[(size_t)t * 12 + (G - 24)] = ps;
          } else if (G == 37) {
          } else if (G < 62) {
            const bool isq = G < 50; const int hg = G - (isq ? 38 : 50), head = hg >> 1, gsel = hg & 1;
            rope4(v0, v1, cs64 + s * 32 + 16 * gsel + 4 * fq);
            u16* dst = (isq ? cq : ck) + ((size_t)(b * 6 + head) * SEQ + s) * 64 + 16 * gsel + 4 * fq;
            store8(dst, v0[0], v0[1], v0[2], v0[3]);
            store8(dst + 32, v1[0], v1[1], v1[2], v1[3]);
          } else if (G < 74) {
            store16(cv + ((size_t)(b * 6 + ((G - 62) >> 1)) * SEQ + s) * 64 + ((G - 62) & 1) * 32 + 8 * fq, v0, v1);
          }
          __builtin_amdgcn_sched_barrier(0);
        }
    }
  }
};
struct EpiUp {
  static constexpr bool PERM = true, AFTER_DRAIN = false;
  u16 *mq, *mk, *mv; const float2* cs32; const float* sumsq;
  DI void operator()(const f32x4 (&acc)[2][2][4][2], const Unit& u, int wr, int wc, int fr, int fq) const {
#pragma unroll
    for (int ai = 0; ai < 2; ++ai)
#pragma unroll
      for (int m = 0; m < 4; ++m) {
        const int t = u.pm * 256 + ai * 128 + wr * 64 + m * 16 + fr;
        const int b = t >> 12, s = t & 4095;
        const float4 sa = *(const float4*)(sumsq + (size_t)t * 12), sb = *(const float4*)(sumsq + (size_t)t * 12 + 4), sc = *(const float4*)(sumsq + (size_t)t * 12 + 8);
        const float rq = rsqrtf((((sa.x + sa.y) + (sa.z + sa.w)) + ((sb.x + sb.y) + (sb.z + sb.w))) * (1.f / 256.f) + 1e-5f);
        const float rkv = rsqrtf(((sc.x + sc.y) + (sc.z + sc.w)) * (1.f / 128.f) + 1e-5f);
#pragma unroll
        for (int bj = 0; bj < 2; ++bj) {
          const int G = u.pn * 8 + bj * 4 + wc;
          f32x4 v0 = acc[ai][bj][m][0], v1 = acc[ai][bj][m][1];
          if (G < 18) {
            const int head = G / 3, part = G % 3;
            v0 *= rq; v1 *= rq;
            u16* dst = mq + ((size_t)(b * 6 + head) * SEQ + s) * 96;
            if (part < 2) store16(dst + part * 32 + 8 * fq, v0, v1);
            else {
              rope4(v0, v1, cs32 + s * 16 + 4 * fq);
              store8(dst + 64 + 4 * fq, v0[0], v0[1], v0[2], v0[3]);
              store8(dst + 80 + 4 * fq, v1[0], v1[1], v1[2], v1[3]);
            }
          } else if (G < 42) {
            const int g = G - 18, head = g >> 2, part = g & 3;
            v0 *= rkv; v1 *= rkv;
            store16((part < 2 ? mk : mv) + ((size_t)(b * 6 + head) * SEQ + s) * 64 + (part & 1) * 32 + 8 * fq, v0, v1);
          }
        }
        __builtin_amdgcn_sched_barrier(0);
      }
  }
};
struct EpiOut {
  static constexpr bool PERM = true, AFTER_DRAIN = false;
  const u16* xb; u16* ybuf; float* stats;
  DI void operator()(const f32x4 (&acc)[2][2][4][2], const Unit& u, int wr, int wc, int fr, int fq) const {
#pragma unroll
    for (int ai = 0; ai < 2; ++ai)
#pragma unroll
      for (int m = 0; m < 4; ++m) {
        const int t = u.pm * 256 + ai * 128 + wr * 64 + m * 16 + fr;
        float s1 = 0.f, s2 = 0.f;
#pragma unroll
        for (int bj = 0; bj < 2; ++bj) {
          const size_t off = (size_t)t * 1024 + u.pn * 256 + bj * 128 + wc * 32 + 8 * fq;
          const uint4 xv = *(const uint4*)(xb + off);
          f32x4 y0, y1;
          y0[0] = ALPHA * bflo(xv.x) + acc[ai][bj][m][0][0]; y0[1] = ALPHA * bfhi(xv.x) + acc[ai][bj][m][0][1];
          y0[2] = ALPHA * bflo(xv.y) + acc[ai][bj][m][0][2]; y0[3] = ALPHA * bfhi(xv.y) + acc[ai][bj][m][0][3];
          y1[0] = ALPHA * bflo(xv.z) + acc[ai][bj][m][1][0]; y1[1] = ALPHA * bfhi(xv.z) + acc[ai][bj][m][1][1];
          y1[2] = ALPHA * bflo(xv.w) + acc[ai][bj][m][1][2]; y1[3] = ALPHA * bfhi(xv.w) + acc[ai][bj][m][1][3];
          s1 += (y0[0] + y0[1]) + (y0[2] + y0[3]) + (y1[0] + y1[1]) + (y1[2] + y1[3]);
          s2 += y0[0] * y0[0] + y0[1] * y0[1] + y0[2] * y0[2] + y0[3] * y0[3] + y1[0] * y1[0] + y1[1] * y1[1] + y1[2] * y1[2] + y1[3] * y1[3];
          store16(ybuf + off, y0, y1);
        }
        s1 += __shfl_xor(s1, 16); s1 += __shfl_xor(s1, 32);
        s2 += __shfl_xor(s2, 16); s2 += __shfl_xor(s2, 32);
        if (fq == 0) { stats[(size_t)t * 32 + u.pn * 4 + wc] = s1; stats[(size_t)t * 32 + 16 + u.pn * 4 + wc] = s2; }
      }
  }
};
struct EpiQ {
  static constexpr bool PERM = true, AFTER_DRAIN = false;
  u16* qbuf;
  DI void operator()(const f32x4 (&acc)[2][2][4][2], const Unit& u, int wr, int wc, int fr, int fq) const {
#pragma unroll
    for (int ai = 0; ai < 2; ++ai)
#pragma unroll
      for (int m = 0; m < 4; ++m) {
        const int t = u.pm * 256 + ai * 128 + wr * 64 + m * 16 + fr;
#pragma unroll
        for (int bj = 0; bj < 2; ++bj)
          store16(qbuf + (size_t)t * 2048 + u.pn * 256 + bj * 128 + wc * 32 + 8 * fq, acc[ai][bj][m][0], acc[ai][bj][m][1]);
      }
  }
};
template <class Epi>
DI void run_gemm(int wv, const u16* A, const u16* Bt, int N, int K, const Epi& E, char* lds) {
  pg8::Gemm g; g.A = A; g.Bt = Bt; g.M = T_ALL; g.N = N; g.K = K;
  pg8::StaticOrder S; S.init(T_ALL, N, gridDim.x, obid());
  pg8::gemm_phase(wv, (PG8_LAS unsigned char*)lds, g, S, E);
  __syncthreads();
}
DI bf16x8 packP(const f32x16& S, int s2) {
  uint4 u;
  u.x = pack2(S[8 * s2 + 0], S[8 * s2 + 1]); u.y = pack2(S[8 * s2 + 2], S[8 * s2 + 3]);
  u.z = pack2(S[8 * s2 + 4], S[8 * s2 + 5]); u.w = pack2(S[8 * s2 + 6], S[8 * s2 + 7]);
  return __builtin_bit_cast(bf16x8, u);
}

DI float fadd_s(float a, float b) { float r; asm("v_add_f32 %0, %1, %2" : "=v"(r) : "v"(a), "v"(b)); return r; }
DI float exp_sum16(f32x16& S) {
#pragma unroll
  for (int e = 0; e < 16; ++e) S[e] = fexp2(S[e]);
  const float a0 = fadd_s(S[0], S[1]), a1 = fadd_s(S[2], S[3]), a2 = fadd_s(S[4], S[5]), a3 = fadd_s(S[6], S[7]);
  const float a4 = fadd_s(S[8], S[9]), a5 = fadd_s(S[10], S[11]), a6 = fadd_s(S[12], S[13]), a7 = fadd_s(S[14], S[15]);
  const float b0 = fadd_s(a0, a1), b1 = fadd_s(a2, a3), b2 = fadd_s(a4, a5), b3 = fadd_s(a6, a7);
  return fadd_s(fadd_s(b0, b1), fadd_s(b2, b3));
}
DI float max3f(float a, float b, float c) { return __builtin_fmaxf(__builtin_fmaxf(a, b), c); }
DI float max16(const f32x16& S) {
  const float a = max3f(S[0], S[1], S[2]), b = max3f(S[3], S[4], S[5]), c = max3f(S[6], S[7], S[8]);
  const float d = max3f(S[9], S[10], S[11]), e = max3f(S[12], S[13], S[14]);
  return max3f(max3f(a, b, c), max3f(d, e, S[15]), a);
}

template <bool MLA, bool SAFE, int NQ  >
DI bool attn_dense_item(const Params& p, int layer, int item, float lam_full, float lam_init, char* lds) {
  constexpr int NKT = MLA ? 1 : 2;
  constexpr int DK = MLA ? 96 : 32;
  constexpr int KSTR = MLA ? 208 : 80;
  constexpr int KB = 64 * KSTR;
  constexpr int STAGE = NKT * KB + 8192;
  constexpr int NKS = DK / 16;
  constexpr float THR = 8.f;
  const int tid = otid(p.wave), lane = tid & 63, wave = tid >> 6, r = lane & 31, hh = lane >> 5;
  const int strm = MLA ? 0 : (wave & 1);
  int b, head, q0;
  if (MLA) { b = item / 96; head = (item / 16) % 6; q0 = (item & 15) * 256 + wave * 32; }
  else if (NQ == 2) { b = item / 64; head = (item / 16) & 3; q0 = (item & 15) * 256 + (wave >> 1) * 64; }
  else { b = item / 128; head = (item / 32) & 3; q0 = (item & 31) * 128 + (wave >> 1) * 32; }
  const u16 *kg0, *kg1, *vg;
  bf16x8 Q[NQ][NKS];
  if (MLA) {
    const u16* qp = p.mq + ((size_t)(b * 6 + head) * SEQ + q0 + r) * 96 + hh * 8;
#pragma unroll
    for (int s = 0; s < NKS; ++s) Q[0][s] = *(const bf16x8*)(qp + s * 16);
    kg0 = p.mk + (size_t)(b * 6 + head) * SEQ * 64;
    kg1 = p.bkr + (size_t)b * SEQ * 32;
    vg = p.mv + (size_t)(b * 6 + head) * SEQ * 64;
  } else {
#pragma unroll
    for (int qi = 0; qi < NQ; ++qi) {
      const u16* qp = p.aq + ((size_t)(b * 8 + head * 2 + strm) * SEQ + q0 + qi * 32 + r) * 32 + hh * 8;
#pragma unroll
      for (int s = 0; s < NKS; ++s) Q[qi][s] = *(const bf16x8*)(qp + s * 16);
    }
    kg0 = p.ak + (size_t)(b * 8 + head * 2) * SEQ * 32;
    kg1 = p.ak + (size_t)(b * 8 + head * 2 + 1) * SEQ * 32;
    vg = p.av + (size_t)(b * 4 + head) * SEQ * 64;
  }
  f32x16 O[NQ][2];
  float mu[NQ], mt[NQ], l[NQ];
#pragma unroll
  for (int qi = 0; qi < NQ; ++qi) {
    l[qi] = 0.f;
#pragma unroll
    for (int e = 0; e < 16; ++e) { O[qi][0][e] = 0.f; O[qi][1][e] = 0.f; }
  }
  const int offk = MLA ? (tid >> 3) * 64 + (tid & 7) * 8 : ((tid & 255) >> 2) * 32 + (tid & 3) * 8;
  const int offp = (tid >> 2) * 32 + (tid & 3) * 8;
  const int offv = (tid >> 3) * 64 + (tid & 7) * 8;
  uint4 gk, gv, gp;
  auto gload = [&](int kt) {
    const int k0 = kt * 64;
    if (MLA) {
      gk = *(const uint4*)(kg0 + (size_t)k0 * 64 + offk);
      if (tid < 256) gp = *(const uint4*)(kg1 + (size_t)k0 * 32 + offp);
    } else {
      const u16* kb = (p.wave < 4) ? kg0 : kg1;
      gk = *(const uint4*)(kb + (size_t)k0 * 32 + offk);
    }
    gv = *(const uint4*)(vg + (size_t)k0 * 64 + offv);
  };
  auto swrite = [&](int sb) {
    char* base = lds + sb * STAGE;
    if (MLA) {
      *(uint4*)(base + (tid >> 3) * KSTR + (tid & 7) * 16) = gk;
      if (tid < 256) *(uint4*)(base + (tid >> 2) * KSTR + 128 + (tid & 3) * 16) = gp;
    } else {
      const int c = tid & 255;
      *(uint4*)(base + (tid >> 8) * KB + (c >> 2) * KSTR + (c & 3) * 16) = gk;
    }
    const int row = tid >> 3;
    *(uint4*)(base + NKT * KB + row * 128 + (((tid & 7) * 16) ^ (((row >> 1) & 1) << 6))) = gv;
  };
  const int tq = (lane & 15) >> 2, tp = lane & 3, tg1 = (lane >> 4) & 1, swz = (tq >> 1) & 1;
  const int voff = NKT * KB + (4 * hh + tq) * 128 + 32 * tg1 + 8 * tp;
  const int koff = strm * KB + r * KSTR + hh * 16;
#define VFRAG(i2, u, s2) ({ const char* a_ = vb + (32 * (u) + 16 * (s2)) * 128 + 64 * ((i2) ^ swz); \
    const s16x4 lo_ = trread(a_), hi_ = trread(a_ + 8 * 128); (bf16x8)__builtin_shufflevector(lo_, hi_, 0, 1, 2, 3, 4, 5, 6, 7); })
#define QXFRAG(m_) __builtin_bit_cast(bf16x8, make_uint4(hh == 0 ? (pack2(-(m_), 0.f) & 0xffffu) : 0u, 0u, 0u, 0u))

  gload(0); swrite(0);
  __syncthreads();
  bf16x8 QX[NQ];
  const bf16x8 KX = __builtin_bit_cast(bf16x8, make_uint4(hh == 0 ? 0x3F80u : 0u, 0u, 0u, 0u));
  {
    const char* kb_ = lds + koff;
#pragma unroll
    for (int qi = 0; qi < NQ; ++qi) {
      f32x16 A0 = (f32x16)(0.f), A1 = (f32x16)(0.f);
#pragma unroll
      for (int s = 0; s < NKS; ++s) { A0 = MFMA(*(const bf16x8*)(kb_ + s * 32), Q[qi][s], A0); A1 = MFMA(*(const bf16x8*)(kb_ + 32 * KSTR + s * 32), Q[qi][s], A1); }
      float mx = fmaxf(max16(A0), max16(A1));
      mx = fmaxf(mx, __shfl_xor(mx, 32));
      mu[qi] = bflo(pack2(mx, 0.f)); mt[qi] = mx;
      QX[qi] = QXFRAG(mu[qi]);
    }
  }
#pragma unroll 1
  for (int kt = 0; kt < 64; ++kt) {
    if (kt + 1 < 64) gload(kt + 1);
    const char* base = lds + (kt & 1) * STAGE;
    const char* vb = base + voff;
    bf16x8 KF[2][NKS];
    const char* kbs_ = base + koff;
    if (!SAFE) {
#pragma unroll
      for (int s = 0; s < NKS; ++s) { KF[0][s] = *(const bf16x8*)(kbs_ + s * 32); KF[1][s] = *(const bf16x8*)(kbs_ + 32 * KSTR + s * 32); }
    }
    if (SAFE) {
      bool need = false;
#pragma unroll
      for (int qi = 0; qi < NQ; ++qi) { mt[qi] = fmaxf(mt[qi], __shfl_xor(mt[qi], 32)); need = need || (mt[qi] > mu[qi] + THR); }
      if (__any(need)) {
#pragma unroll
        for (int qi = 0; qi < NQ; ++qi) {
          const float mn = bflo(pack2(fmaxf(mt[qi], mu[qi]), 0.f));
          const float al = fexp2(mu[qi] - mn);
          mu[qi] = mn; l[qi] *= al;
#pragma unroll
          for (int e = 0; e < 16; ++e) { O[qi][0][e] *= al; O[qi][1][e] *= al; }
          QX[qi] = QXFRAG(mu[qi]);
        }
      }
    }
    __builtin_amdgcn_sched_barrier(0);
#pragma unroll
    for (int qi = 0; qi < NQ; ++qi) {
      f32x16 A0, A1;
      __builtin_amdgcn_s_setprio(1);
      A0 = MFMA(KX, QX[qi], (f32x16)(0.f)); A1 = MFMA(KX, QX[qi], (f32x16)(0.f));
#pragma unroll
      for (int s = 0; s < NKS; ++s) {
        if (!SAFE) { A0 = MFMA(KF[0][s], Q[qi][s], A0); A1 = MFMA(KF[1][s], Q[qi][s], A1); }
        else { A0 = MFMA(*(const bf16x8*)(kbs_ + s * 32), Q[qi][s], A0); A1 = MFMA(*(const bf16x8*)(kbs_ + 32 * KSTR + s * 32), Q[qi][s], A1); }
      }
      __builtin_amdgcn_s_setprio(0);
      bf16x8 V0[2][2];
      if (!SAFE) {
#pragma unroll
        for (int i2 = 0; i2 < 2; ++i2)
#pragma unroll
          for (int s2 = 0; s2 < 2; ++s2) V0[i2][s2] = VFRAG(i2, 0, s2);
      }
      __builtin_amdgcn_sched_barrier(0);
      if (SAFE) mt[qi] = fmaxf(mt[qi], mu[qi] + fmaxf(max16(A0), max16(A1)));
      bf16x8 P0[2], P1[2];
      l[qi] += exp_sum16(A0);
      P0[0] = packP(A0, 0); P0[1] = packP(A0, 1);
      bf16x8 V1[2][2];
      if (!SAFE) {
#pragma unroll
        for (int i2 = 0; i2 < 2; ++i2)
#pragma unroll
          for (int s2 = 0; s2 < 2; ++s2) V1[i2][s2] = VFRAG(i2, 1, s2);
      }
      __builtin_amdgcn_sched_barrier(0);
#pragma unroll
      for (int i2 = 0; i2 < 2; ++i2)
#pragma unroll
        for (int s2 = 0; s2 < 2; ++s2) O[qi][i2] = MFMA(SAFE ? VFRAG(i2, 0, s2) : V0[i2][s2], P0[s2], O[qi][i2]);
      l[qi] += exp_sum16(A1);
      P1[0] = packP(A1, 0); P1[1] = packP(A1, 1);
      __builtin_amdgcn_sched_barrier(0);
#pragma unroll
      for (int i2 = 0; i2 < 2; ++i2)
#pragma unroll
        for (int s2 = 0; s2 < 2; ++s2) O[qi][i2] = MFMA(SAFE ? VFRAG(i2, 1, s2) : V1[i2][s2], P1[s2], O[qi][i2]);
      __builtin_amdgcn_sched_barrier(0);
    }
    if (kt + 1 < 64) swrite((kt + 1) & 1);
    __syncthreads();
  }
#undef VFRAG
#undef QXFRAG
  float lt[NQ];
  bool bad = false;
#pragma unroll
  for (int qi = 0; qi < NQ; ++qi) { lt[qi] = l[qi] + __shfl_xor(l[qi], 32); bad = bad || !(lt[qi] < 1.0e37f); }
  if (!SAFE) {
    if (__syncthreads_or(bad)) return true;
  }
  if (MLA) {
    const int t = b * SEQ + q0 + r;
    const float inv = 1.f / lt[0];
#pragma unroll
    for (int i2 = 0; i2 < 2; ++i2) {
#pragma unroll
      for (int e = 0; e < 16; ++e) O[0][i2][e] *= inv;
      store_tile(p.cat + (size_t)t * 1024 + 256 + head * 64 + i2 * 32, O[0][i2], hh);
    }
  } else {
    float* xch = (float*)lds + (((wave >> 1) * NQ) * 64 + lane) * 33;
    if (strm == 1) {
#pragma unroll
      for (int qi = 0; qi < NQ; ++qi) {
        const float sc = lam_full / lt[qi];
#pragma unroll
        for (int i2 = 0; i2 < 2; ++i2)
#pragma unroll
          for (int e = 0; e < 16; ++e) xch[qi * 64 * 33 + i2 * 16 + e] = O[qi][i2][e] * sc;
      }
    }
    __syncthreads();
    if (strm == 0) {
      const float* g = p.in[3] + layer * 64;
#pragma unroll
      for (int qi = 0; qi < NQ; ++qi) {
        const int t = b * SEQ + q0 + qi * 32 + r;
        const float inv1 = 1.f / lt[qi];
        float ss = 0.f;
#pragma unroll
        for (int i2 = 0; i2 < 2; ++i2)
#pragma unroll
          for (int e = 0; e < 16; ++e) {
            const float o = O[qi][i2][e] * inv1 - xch[qi * 64 * 33 + i2 * 16 + e];
            O[qi][i2][e] = o; ss += o * o;
          }
        ss += __shfl_xor(ss, 32);
        const float rn = rsqrtf(ss * (1.f / 64.f) + 1e-5f) * (1.f - lam_init);
#pragma unroll
        for (int i2 = 0; i2 < 2; ++i2) {
#pragma unroll
          for (int gq = 0; gq < 4; ++gq)
#pragma unroll
            for (int bq = 0; bq < 4; ++bq) O[qi][i2][4 * gq + bq] *= rn * g[i2 * 32 + 8 * gq + 4 * hh + bq];
          store_tile(p.cat + (size_t)t * 1024 + head * 64 + i2 * 32, O[qi][i2], hh);
        }
      }
    }
    __syncthreads();
  }
  return false;
}


DI bool attn_mla_split(const Params& p, int layer, int item, char* lds) {
  constexpr int KSTR = 208, KB = 64 * KSTR;
  const int tid = otid(p.wave), lane = tid & 63, wave = tid >> 6, r = lane & 31, hh = lane >> 5;
  const int qb = p.wave & 3, kh = p.wave >> 2;
  const int b = item / 96, head = (item / 16) % 6, q0 = (item & 15) * 256 + qb * 64;
  bf16x8 Q0[6], Q1[6];
  {
    const u16* qp = p.mq + ((size_t)(b * 6 + head) * SEQ + q0 + r) * 96 + hh * 8;
#pragma unroll
    for (int s = 0; s < 6; ++s) { Q0[s] = *(const bf16x8*)(qp + s * 16); Q1[s] = *(const bf16x8*)(qp + 32 * 96 + s * 16); }
  }
  f32x16 O00 = (f32x16)(0.f), O01 = (f32x16)(0.f), O10 = (f32x16)(0.f), O11 = (f32x16)(0.f);
  float l0 = 0.f, l1 = 0.f;
  const u16* kgp = p.mk + (size_t)(b * 6 + head) * SEQ * 64 + (tid >> 3) * 64 + (tid & 7) * 8;
  const u16* pgp = p.bkr + (size_t)b * SEQ * 32 + (tid >> 3) * 32 + (tid & 7) * 4;
  const u16* vgp = p.mv + (size_t)(b * 6 + head) * SEQ * 64 + (tid >> 3) * 64 + (tid & 7) * 8;
  char* kw = lds + (tid >> 3) * KSTR + (tid & 7) * 16;
  char* vw = lds + 2 * KB + (tid >> 3) * 128 + (((tid & 7) * 16) ^ ((((tid >> 3) >> 1) & 1) << 6));
  uint4 gk0, gv0, gk1, gv1; uint2 gp0, gp1;
#define LD_K(kt, S) { const int kt_ = (kt) < 63 ? (kt) : 63; gk##S = *(const uint4*)(kgp + (size_t)kt_ * 4096); }
#define LD_P(kt, S) { const int kt_ = (kt) < 63 ? (kt) : 63; gp##S = *(const uint2*)(pgp + (size_t)kt_ * 2048); }
#define LD_V(kt, S) { const int kt_ = (kt) < 63 ? (kt) : 63; gv##S = *(const uint4*)(vgp + (size_t)kt_ * 4096); }
#define SW_K(slot, S) *(uint4*)(kw + (slot) * KB) = gk##S;
#define SW_P(slot, S) *(uint2*)(kw + (slot) * KB + 128 - (tid & 7) * 8) = gp##S;
#define SW_V(slot, S) *(uint4*)(vw + (slot) * 8192) = gv##S;
  const int tq = (lane & 15) >> 2, tp = lane & 3, tg1 = (lane >> 4) & 1, swz = (tq >> 1) & 1;
  const char* vb0 = lds + 2 * KB + (32 * kh + 4 * hh + tq) * 128 + 32 * tg1 + 8 * tp + 64 * swz;
  const char* vb1 = lds + 2 * KB + (32 * kh + 4 * hh + tq) * 128 + 32 * tg1 + 8 * tp + 64 * (swz ^ 1);
  const char* kb = lds + (32 * kh + r) * KSTR + hh * 16;
#define VFRX_(VS, i2, s2) ({ const char* a_ = ((i2) ? vb1 : vb0) + (VS) * 8192 + (16 * (s2)) * 128; \
    const s16x4 lo_ = trread(a_), hi_ = trread(a_ + 8 * 128); (bf16x8)__builtin_shufflevector(lo_, hi_, 0, 1, 2, 3, 4, 5, 6, 7); })
#define FEXP_(x) fexp2(x)
  LD_K(0, 0); LD_P(0, 0); LD_V(0, 0); LD_K(1, 1); LD_P(1, 1);
  SW_K(0, 0); SW_P(0, 0); SW_V(0, 0); SW_K(1, 1); SW_P(1, 1);
  LD_K(2, 1); LD_P(2, 1); LD_V(1, 1);
  __syncthreads();
  f32x16 A0 = (f32x16)(0.f), A1 = (f32x16)(0.f), B0, B1;
#pragma unroll
  for (int s = 0; s < 6; ++s) { const bf16x8 ko = *(const bf16x8*)(kb + s * 32); A0 = MFMA(ko, Q0[s], A0); A1 = MFMA(ko, Q1[s], A1); }
#pragma unroll 1
  for (int t = 0; t < 64; t += 2) {
#define KFR_(s) (*(const bf16x8*)(kb + 1 * KB + (s) * 32))
#define VFR_(i2, s2) VFRX_(0, i2, s2)
  const bf16x8 kf0_e = KFR_(0);
  const bf16x8 kf1_e = KFR_(1);
  __builtin_amdgcn_sched_barrier(0);
  B0 = MFMA(kf0_e, Q0[0], (f32x16)(0.f));
  A0[0] = FEXP_(A0[0]);
  A0[1] = FEXP_(A0[1]);
  __builtin_amdgcn_sched_barrier(0);
  B1 = MFMA(kf0_e, Q1[0], (f32x16)(0.f));
  const bf16x8 kf2_e = KFR_(2);
  A0[2] = FEXP_(A0[2]);
  A0[3] = FEXP_(A0[3]);
  const unsigned pw0_0_e = pack2(A0[0], A0[1]);
  const float t0_0_e = fadd_s(A0[0], A0[1]);
  SW_K(0, 1);
  __builtin_amdgcn_sched_barrier(0);
  B0 = MFMA(kf1_e, Q0[1], B0);
  const bf16x8 vf00_e = VFR_(0, 0);
  A0[4] = FEXP_(A0[4]);
  A0[5] = FEXP_(A0[5]);
  const unsigned pw0_1_e = pack2(A0[2], A0[3]);
  const float t0_1_e = fadd_s(A0[2], A0[3]);
  __builtin_amdgcn_sched_barrier(0);
  B1 = MFMA(kf1_e, Q1[1], B1);
  const bf16x8 vf10_e = VFR_(1, 0);
  A0[6] = FEXP_(A0[6]);
  A0[7] = FEXP_(A0[7]);
  const unsigned pw0_2_e = pack2(A0[4], A0[5]);
  const float t0_2_e = fadd_s(A0[4], A0[5]);
  const float s0_0_0_e = fadd_s(t0_0_e, t0_1_e);
  SW_P(0, 1);
  __builtin_amdgcn_sched_barrier(0);
  B0 = MFMA(kf2_e, Q0[2], B0);
  A1[0] = FEXP_(A1[0]);
  A1[1] = FEXP_(A1[1]);
  const unsigned pw0_3_e = pack2(A0[6], A0[7]);
  const bf16x8 P00_e = __builtin_bit_cast(bf16x8, make_uint4(pw0_0_e, pw0_1_e, pw0_2_e, pw0_3_e));
  const float t0_3_e = fadd_s(A0[6], A0[7]);
  __builtin_amdgcn_sched_barrier(0);
  O00 = MFMA(vf00_e, P00_e, O00);
  const bf16x8 kf3_e = KFR_(3);
  A1[2] = FEXP_(A1[2]);
  A1[3] = FEXP_(A1[3]);
  const unsigned pw1_0_e = pack2(A1[0], A1[1]);
  const float s0_0_1_e = fadd_s(t0_2_e, t0_3_e);
  const float t1_0_e = fadd_s(A1[0], A1[1]);
  SW_V(1, 1);
  __builtin_amdgcn_sched_barrier(0);
  O01 = MFMA(vf10_e, P00_e, O01);
  A1[4] = FEXP_(A1[4]);
  A1[5] = FEXP_(A1[5]);
  const unsigned pw1_1_e = pack2(A1[2], A1[3]);
  const float s0_1_0_e = fadd_s(s0_0_0_e, s0_0_1_e);
  const float t1_1_e = fadd_s(A1[2], A1[3]);
  __builtin_amdgcn_sched_barrier(0);
  B1 = MFMA(kf2_e, Q1[2], B1);
  A1[6] = FEXP_(A1[6]);
  A1[7] = FEXP_(A1[7]);
  const unsigned pw1_2_e = pack2(A1[4], A1[5]);
  const float t1_2_e = fadd_s(A1[4], A1[5]);
  const float s1_0_0_e = fadd_s(t1_0_e, t1_1_e);
  __builtin_amdgcn_sched_barrier(0);
  B0 = MFMA(kf3_e, Q0[3], B0);
  A0[8] = FEXP_(A0[8]);
  A0[9] = FEXP_(A0[9]);
  const unsigned pw1_3_e = pack2(A1[6], A1[7]);
  const bf16x8 P10_e = __builtin_bit_cast(bf16x8, make_uint4(pw1_0_e, pw1_1_e, pw1_2_e, pw1_3_e));
  const float t1_3_e = fadd_s(A1[6], A1[7]);
  __builtin_amdgcn_sched_barrier(0);
  O10 = MFMA(vf00_e, P10_e, O10);
  const bf16x8 kf4_e = KFR_(4);
  A0[10] = FEXP_(A0[10]);
  A0[11] = FEXP_(A0[11]);
  const unsigned pw0_4_e = pack2(A0[8], A0[9]);
  const float t0_4_e = fadd_s(A0[8], A0[9]);
  const float s1_0_1_e = fadd_s(t1_2_e, t1_3_e);
  __builtin_amdgcn_sched_barrier(0);
  O11 = MFMA(vf10_e, P10_e, O11);
  const bf16x8 vf01_e = VFR_(0, 1);
  A0[12] = FEXP_(A0[12]);
  A0[13] = FEXP_(A0[13]);
  const unsigned pw0_5_e = pack2(A0[10], A0[11]);
  const float t0_5_e = fadd_s(A0[10], A0[11]);
  const float s1_1_0_e = fadd_s(s1_0_0_e, s1_0_1_e);
  __builtin_amdgcn_sched_barrier(0);
  B1 = MFMA(kf3_e, Q1[3], B1);
  const bf16x8 vf11_e = VFR_(1, 1);
  A0[14] = FEXP_(A0[14]);
  A0[15] = FEXP_(A0[15]);
  const unsigned pw0_6_e = pack2(A0[12], A0[13]);
  const float t0_6_e = fadd_s(A0[12], A0[13]);
  const float s0_0_2_e = fadd_s(t0_4_e, t0_5_e);
  LD_K(t + 3, 0);
  __builtin_amdgcn_sched_barrier(0);
  B0 = MFMA(kf4_e, Q0[4], B0);
  A1[8] = FEXP_(A1[8]);
  A1[9] = FEXP_(A1[9]);
  const unsigned pw0_7_e = pack2(A0[14], A0[15]);
  const bf16x8 P01_e = __builtin_bit_cast(bf16x8, make_uint4(pw0_4_e, pw0_5_e, pw0_6_e, pw0_7_e));
  const float t0_7_e = fadd_s(A0[14], A0[15]);
  __builtin_amdgcn_sched_barrier(0);
  O00 = MFMA(vf01_e, P01_e, O00);
  const bf16x8 kf5_e = KFR_(5);
  A1[10] = FEXP_(A1[10]);
  A1[11] = FEXP_(A1[11]);
  const unsigned pw1_4_e = pack2(A1[8], A1[9]);
  const float s0_0_3_e = fadd_s(t0_6_e, t0_7_e);
  const float t1_4_e = fadd_s(A1[8], A1[9]);
  LD_P(t + 3, 0);
  __builtin_amdgcn_sched_barrier(0);
  O01 = MFMA(vf11_e, P01_e, O01);
  A1[12] = FEXP_(A1[12]);
  A1[13] = FEXP_(A1[13]);
  const unsigned pw1_5_e = pack2(A1[10], A1[11]);
  const float s0_1_1_e = fadd_s(s0_0_2_e, s0_0_3_e);
  const float t1_5_e = fadd_s(A1[10], A1[11]);
  __builtin_amdgcn_sched_barrier(0);
  B1 = MFMA(kf4_e, Q1[4], B1);
  A1[14] = FEXP_(A1[14]);
  A1[15] = FEXP_(A1[15]);
  const unsigned pw1_6_e = pack2(A1[12], A1[13]);
  const float s0_2_0_e = fadd_s(s0_1_0_e, s0_1_1_e);
  const float t1_6_e = fadd_s(A1[12], A1[13]);
  const float s1_0_2_e = fadd_s(t1_4_e, t1_5_e);
  LD_V(t + 2, 0);
  __builtin_amdgcn_sched_barrier(0);
  B0 = MFMA(kf5_e, Q0[5], B0);
  const unsigned pw1_7_e = pack2(A1[14], A1[15]);
  const bf16x8 P11_e = __builtin_bit_cast(bf16x8, make_uint4(pw1_4_e, pw1_5_e, pw1_6_e, pw1_7_e));
  l0 = fadd_s(l0, s0_2_0_e);
  const float t1_7_e = fadd_s(A1[14], A1[15]);
  __builtin_amdgcn_sched_barrier(0);
  O10 = MFMA(vf01_e, P11_e, O10);
  const float s1_0_3_e = fadd_s(t1_6_e, t1_7_e);
  __builtin_amdgcn_sched_barrier(0);
  O11 = MFMA(vf11_e, P11_e, O11);
  const float s1_1_1_e = fadd_s(s1_0_2_e, s1_0_3_e);
  __builtin_amdgcn_sched_barrier(0);
  B1 = MFMA(kf5_e, Q1[5], B1);
  const float s1_2_0_e = fadd_s(s1_1_0_e, s1_1_1_e);
  l1 = fadd_s(l1, s1_2_0_e);
  __builtin_amdgcn_sched_barrier(0);
#undef KFR_
#undef VFR_

    __syncthreads();
#define KFR_(s) (*(const bf16x8*)(kb + 0 * KB + (s) * 32))
#define VFR_(i2, s2) VFRX_(1, i2, s2)
  const bf16x8 kf0_o = KFR_(0);
  const bf16x8 kf1_o = KFR_(1);
  __builtin_amdgcn_sched_barrier(0);
  A0 = MFMA(kf0_o, Q0[0], (f32x16)(0.f));
  B0[0] = FEXP_(B0[0]);
  B0[1] = FEXP_(B0[1]);
  __builtin_amdgcn_sched_barrier(0);
  A1 = MFMA(kf0_o, Q1[0], (f32x16)(0.f));
  const bf16x8 kf2_o = KFR_(2);
  B0[2] = FEXP_(B0[2]);
  B0[3] = FEXP_(B0[3]);
  const unsigned pw0_0_o = pack2(B0[0], B0[1]);
  const float t0_0_o = fadd_s(B0[0], B0[1]);
  SW_K(1, 0);
  __builtin_amdgcn_sched_barrier(0);
  A0 = MFMA(kf1_o, Q0[1], A0);
  const bf16x8 vf00_o = VFR_(0, 0);
  B0[4] = FEXP_(B0[4]);
  B0[5] = FEXP_(B0[5]);
  const unsigned pw0_1_o = pack2(B0[2], B0[3]);
  const float t0_1_o = fadd_s(B0[2], B0[3]);
  __builtin_amdgcn_sched_barrier(0);
  A1 = MFMA(kf1_o, Q1[1], A1);
  const bf16x8 vf10_o = VFR_(1, 0);
  B0[6] = FEXP_(B0[6]);
  B0[7] = FEXP_(B0[7]);
  const unsigned pw0_2_o = pack2(B0[4], B0[5]);
  const float t0_2_o = fadd_s(B0[4], B0[5]);
  const float s0_0_0_o = fadd_s(t0_0_o, t0_1_o);
  SW_P(1, 0);
  __builtin_amdgcn_sched_barrier(0);
  A0 = MFMA(kf2_o, Q0[2], A0);
  B1[0] = FEXP_(B1[0]);
  B1[1] = FEXP_(B1[1]);
  const unsigned pw0_3_o = pack2(B0[6], B0[7]);
  const bf16x8 P00_o = __builtin_bit_cast(bf16x8, make_uint4(pw0_0_o, pw0_1_o, pw0_2_o, pw0_3_o));
  const float t0_3_o = fadd_s(B0[6], B0[7]);
  __builtin_amdgcn_sched_barrier(0);
  O00 = MFMA(vf00_o, P00_o, O00);
  const bf16x8 kf3_o = KFR_(3);
  B1[2] = FEXP_(B1[2]);
  B1[3] = FEXP_(B1[3]);
  const unsigned pw1_0_o = pack2(B1[0], B1[1]);
  const float s0_0_1_o = fadd_s(t0_2_o, t0_3_o);
  const float t1_0_o = fadd_s(B1[0], B1[1]);
  SW_V(0, 0);
  __builtin_amdgcn_sched_barrier(0);
  O01 = MFMA(vf10_o, P00_o, O01);
  B1[4] = FEXP_(B1[4]);
  B1[5] = FEXP_(B1[5]);
  const unsigned pw1_1_o = pack2(B1[2], B1[3]);
  const float s0_1_0_o = fadd_s(s0_0_0_o, s0_0_1_o);
  const float t1_1_o = fadd_s(B1[2], B1[3]);
  __builtin_amdgcn_sched_barrier(0);
  A1 = MFMA(kf2_o, Q1[2], A1);
  B1[6] = FEXP_(B1[6]);
  B1[7] = FEXP_(B1[7]);
  const unsigned pw1_2_o = pack2(B1[4], B1[5]);
  const float t1_2_o = fadd_s(B1[4], B1[5]);
  const float s1_0_0_o = fadd_s(t1_0_o, t1_1_o);
  __builtin_amdgcn_sched_barrier(0);
  A0 = MFMA(kf3_o, Q0[3], A0);
  B0[8] = FEXP_(B0[8]);
  B0[9] = FEXP_(B0[9]);
  const unsigned pw1_3_o = pack2(B1[6], B1[7]);
  const bf16x8 P10_o = __builtin_bit_cast(bf16x8, make_uint4(pw1_0_o, pw1_1_o, pw1_2_o, pw1_3_o));
  const float t1_3_o = fadd_s(B1[6], B1[7]);
  __builtin_amdgcn_sched_barrier(0);
  O10 = MFMA(vf00_o, P10_o, O10);
  const bf16x8 kf4_o = KFR_(4);
  B0[10] = FEXP_(B0[10]);
  B0[11] = FEXP_(B0[11]);
  const unsigned pw0_4_o = pack2(B0[8], B0[9]);
  const float t0_4_o = fadd_s(B0[8], B0[9]);
  const float s1_0_1_o = fadd_s(t1_2_o, t1_3_o);
  __builtin_amdgcn_sched_barrier(0);
  O11 = MFMA(vf10_o, P10_o, O11);
  const bf16x8 vf01_o = VFR_(0, 1);
  B0[12] = FEXP_(B0[12]);
  B0[13] = FEXP_(B0[13]);
  const unsigned pw0_5_o = pack2(B0[10], B0[11]);
  const float t0_5_o = fadd_s(B0[10], B0[11]);
  const float s1_1_0_o = fadd_s(s1_0_0_o, s1_0_1_o);
  __builtin_amdgcn_sched_barrier(0);
  A1 = MFMA(kf3_o, Q1[3], A1);
  const bf16x8 vf11_o = VFR_(1, 1);
  B0[14] = FEXP_(B0[14]);
  B0[15] = FEXP_(B0[15]);
  const unsigned pw0_6_o = pack2(B0[12], B0[13]);
  const float t0_6_o = fadd_s(B0[12], B0[13]);
  const float s0_0_2_o = fadd_s(t0_4_o, t0_5_o);
  LD_K(t + 4, 1);
  __builtin_amdgcn_sched_barrier(0);
  A0 = MFMA(kf4_o, Q0[4], A0);
  B1[8] = FEXP_(B1[8]);
  B1[9] = FEXP_(B1[9]);
  const unsigned pw0_7_o = pack2(B0[14], B0[15]);
  const bf16x8 P01_o = __builtin_bit_cast(bf16x8, make_uint4(pw0_4_o, pw0_5_o, pw0_6_o, pw0_7_o));
  const float t0_7_o = fadd_s(B0[14], B0[15]);
  __builtin_amdgcn_sched_barrier(0);
  O00 = MFMA(vf01_o, P01_o, O00);
  const bf16x8 kf5_o = KFR_(5);
  B1[10] = FEXP_(B1[10]);
  B1[11] = FEXP_(B1[11]);
  const unsigned pw1_4_o = pack2(B1[8], B1[9]);
  const float s0_0_3_o = fadd_s(t0_6_o, t0_7_o);
  const float t1_4_o = fadd_s(B1[8], B1[9]);
  LD_P(t + 4, 1);
  __builtin_amdgcn_sched_barrier(0);
  O01 = MFMA(vf11_o, P01_o, O01);
  B1[12] = FEXP_(B1[12]);
  B1[13] = FEXP_(B1[13]);
  const unsigned pw1_5_o = pack2(B1[10], B1[11]);
  const float s0_1_1_o = fadd_s(s0_0_2_o, s0_0_3_o);
  const float t1_5_o = fadd_s(B1[10], B1[11]);
  __builtin_amdgcn_sched_barrier(0);
  A1 = MFMA(kf4_o, Q1[4], A1);
  B1[14] = FEXP_(B1[14]);
  B1[15] = FEXP_(B1[15]);
  const unsigned pw1_6_o = pack2(B1[12], B1[13]);
  const float s0_2_0_o = fadd_s(s0_1_0_o, s0_1_1_o);
  const float t1_6_o = fadd_s(B1[12], B1[13]);
  const float s1_0_2_o = fadd_s(t1_4_o, t1_5_o);
  LD_V(t + 3, 1);
  __builtin_amdgcn_sched_barrier(0);
  A0 = MFMA(kf5_o, Q0[5], A0);
  const unsigned pw1_7_o = pack2(B1[14], B1[15]);
  const bf16x8 P11_o = __builtin_bit_cast(bf16x8, make_uint4(pw1_4_o, pw1_5_o, pw1_6_o, pw1_7_o));
  l0 = fadd_s(l0, s0_2_0_o);
  const float t1_7_o = fadd_s(B1[14], B1[15]);
  __builtin_amdgcn_sched_barrier(0);
  O10 = MFMA(vf01_o, P11_o, O10);
  const float s1_0_3_o = fadd_s(t1_6_o, t1_7_o);
  __builtin_amdgcn_sched_barrier(0);
  O11 = MFMA(vf11_o, P11_o, O11);
  const float s1_1_1_o = fadd_s(s1_0_2_o, s1_0_3_o);
  __builtin_amdgcn_sched_barrier(0);
  A1 = MFMA(kf5_o, Q1[5], A1);
  const float s1_2_0_o = fadd_s(s1_1_0_o, s1_1_1_o);
  l1 = fadd_s(l1, s1_2_0_o);
  __builtin_amdgcn_sched_barrier(0);
#undef KFR_
#undef VFR_

    __syncthreads();
  }
#undef LD_K
#undef LD_P
#undef LD_V
#undef SW_K
#undef SW_P
#undef SW_V
#undef VFRX_
#undef FEXP_
  float* xs = (float*)lds + (wave * 64 + lane) * 33;
  const float* xr = (const float*)lds + ((wave ^ 4) * 64 + lane) * 33;
  if (kh == 0) {
#pragma unroll
    for (int e = 0; e < 16; ++e) { xs[e] = O10[e]; xs[16 + e] = O11[e]; }
    xs[32] = l1;
  } else {
#pragma unroll
    for (int e = 0; e < 16; ++e) { xs[e] = O00[e]; xs[16 + e] = O01[e]; }
    xs[32] = l0;
  }
  __syncthreads();
  if (kh == 0) {
#pragma unroll
    for (int e = 0; e < 16; ++e) { O00[e] += xr[e]; O01[e] += xr[16 + e]; }
    l0 += xr[32];
  } else {
#pragma unroll
    for (int e = 0; e < 16; ++e) { O10[e] += xr[e]; O11[e] += xr[16 + e]; }
    l1 += xr[32];
  }
  const float lp = kh ? l1 : l0;
  const float lt = lp + __shfl_xor(lp, 32);
  if (__syncthreads_or(!(lt < 1.0e37f) || !(lt > 1.0e-30f))) return true;
  const int tok = b * SEQ + q0 + kh * 32 + r;
  const float inv = 1.f / lt;
  u16* dst = p.cat + (size_t)tok * 1024 + 256 + head * 64;
  if (kh == 0) {
#pragma unroll
    for (int e = 0; e < 16; ++e) { O00[e] *= inv; O01[e] *= inv; }
    store_tile(dst, O00, hh); store_tile(dst + 32, O01, hh);
  } else {
#pragma unroll
    for (int e = 0; e < 16; ++e) { O10[e] *= inv; O11[e] *= inv; }
    store_tile(dst, O10, hh); store_tile(dst + 32, O11, hh);
  }
  return false;
}


DI bool attn_diff_pipe(const Params& p, int layer, int item, float lam_full, float lam_init, char* lds) {
  constexpr int KSTR = 80, KB = 64 * KSTR, KRING = 2 * KB, VOFF = 3 * KRING;
  const int tid = otid(p.wave), lane = tid & 63, wave = tid >> 6, r = lane & 31, hh = lane >> 5;
  const int strm = wave & 1;
  const int b = item / 64, head = (item / 16) & 3, q0 = (item & 15) * 256 + (wave >> 1) * 64;
  bf16x8 Q0[2], Q1[2];
  {
    const u16* qp = p.aq + ((size_t)(b * 8 + head * 2 + strm) * SEQ + q0 + r) * 32 + hh * 8;
    Q0[0] = *(const bf16x8*)(qp); Q0[1] = *(const bf16x8*)(qp + 16);
    Q1[0] = *(const bf16x8*)(qp + 32 * 32); Q1[1] = *(const bf16x8*)(qp + 32 * 32 + 16);
  }
  f32x16 O00 = (f32x16)(0.f), O01 = (f32x16)(0.f), O10 = (f32x16)(0.f), O11 = (f32x16)(0.f);
  float l0 = 0.f, l1 = 0.f;
  const u16* kgp = p.ak + (size_t)(b * 8 + head * 2 + (tid >> 8)) * SEQ * 32 + ((tid & 255) >> 2) * 32 + (tid & 3) * 8;
  const u16* vgp = p.av + (size_t)(b * 4 + head) * SEQ * 64 + (tid >> 3) * 64 + (tid & 7) * 8;
  char* kw0 = lds + (tid >> 8) * KB + ((tid & 255) >> 2) * KSTR + (tid & 3) * 16;
  char* vw = lds + VOFF + (tid >> 3) * 128 + (((tid & 7) * 16) ^ ((((tid >> 3) >> 1) & 1) << 6));
  uint4 gk0, gv0, gk1, gv1;
#define LD_K(kt, S) { const int kt_ = (kt) < 63 ? (kt) : 63; gk##S = *(const uint4*)(kgp + (size_t)kt_ * 2048); }
#define LD_V(kt, S) { const int kt_ = (kt) < 63 ? (kt) : 63; gv##S = *(const uint4*)(vgp + (size_t)kt_ * 4096); }
#define SW_K(S) { *(uint4*)(kw0 + kwr) = gk##S; }
#define SW_V(slot, S) { *(uint4*)(vw + (slot) * 8192) = gv##S; }
  const int tq = (lane & 15) >> 2, tp = lane & 3, tg1 = (lane >> 4) & 1, swz = (tq >> 1) & 1;
  const char* vb0 = lds + VOFF + (4 * hh + tq) * 128 + 32 * tg1 + 8 * tp + 64 * swz;
  const char* vb1 = lds + VOFF + (4 * hh + tq) * 128 + 32 * tg1 + 8 * tp + 64 * (swz ^ 1);
  const char* kb = lds + strm * KB + r * KSTR + hh * 16;
#define VFRX_(VS, i2, u, s2) ({ const char* a_ = ((i2) ? vb1 : vb0) + (VS) * 8192 + (32 * (u) + 16 * (s2)) * 128; \
    const s16x4 lo_ = trread(a_), hi_ = trread(a_ + 8 * 128); (bf16x8)__builtin_shufflevector(lo_, hi_, 0, 1, 2, 3, 4, 5, 6, 7); })
#define KFR_(base, u, s) (*(const bf16x8*)((base) + (u) * 32 * KSTR + (s) * 32))
#define FEXP_(x) fexp2(x)
  int kcu = 0, knx = KRING, kwr = 2 * KRING;
  LD_K(0, 0); LD_V(0, 0); LD_K(1, 1);
  { kwr = 0; SW_K(0); SW_V(0, 0); kwr = KRING; SW_K(1); kwr = 2 * KRING; }
  LD_K(2, 1); LD_V(1, 1);
  __syncthreads();
  f32x16 SA, SB = (f32x16)(0.f);
  SA = MFMA(*(const bf16x8*)(kb), Q0[0], (f32x16)(0.f)); SA = MFMA(*(const bf16x8*)(kb + 32), Q0[1], SA);
  bf16x8 kfc0 = *(const bf16x8*)(kb), kfc1 = *(const bf16x8*)(kb + 32);
  bf16x8 P3c0 = (bf16x8)(0), P3c1 = (bf16x8)(0), vfc00 = (bf16x8)(0), vfc10 = (bf16x8)(0), vfc01 = (bf16x8)(0), vfc11 = (bf16x8)(0);
#pragma unroll 1
  for (int t = 0; t < 64; t += 2) {
    {
      const char* KC = kb + kcu; const char* KN = kb + knx;
#define VFR_(i2, u, s2) VFRX_(0, i2, u, s2)
  __builtin_amdgcn_sched_barrier(0);
  O10 = MFMA(vfc00, P3c0, O10);
  const bf16x8 kfB0_b0 = KFR_(KC, 1, 0);
  SA[0] = FEXP_(SA[0]);
  SA[1] = FEXP_(SA[1]);
  SA[2] = FEXP_(SA[2]);
  __builtin_amdgcn_sched_barrier(0);
  O11 = MFMA(vfc10, P3c0, O11);
  SA[3] = FEXP_(SA[3]);
  SA[4] = FEXP_(SA[4]);
  SA[5] = FEXP_(SA[5]);
  const unsigned pw0_0_b0 = pack2(SA[0], SA[1]);
  const float t0_0_b0 = fadd_s(SA[0], SA[1]);
  __builtin_amdgcn_sched_barrier(0);
  SB = MFMA(kfc0, Q1[0], (f32x16)(0.f));
  const bf16x8 kfB1_b0 = KFR_(KC, 1, 1);
  const bf16x8 vf000_b0 = VFR_(0, 0, 0);
  SA[6] = FEXP_(SA[6]);
  SA[7] = FEXP_(SA[7]);
  SA[8] = FEXP_(SA[8]);
  const unsigned pw0_1_b0 = pack2(SA[2], SA[3]);
  const float t0_1_b0 = fadd_s(SA[2], SA[3]);
  const unsigned pw0_2_b0 = pack2(SA[4], SA[5]);
  const float t0_2_b0 = fadd_s(SA[4], SA[5]);
  __builtin_amdgcn_sched_barrier(0);
  O10 = MFMA(vfc01, P3c1, O10);
  const bf16x8 vf010_b0 = VFR_(1, 0, 0);
  SA[9] = FEXP_(SA[9]);
  SA[10] = FEXP_(SA[10]);
  SA[11] = FEXP_(SA[11]);
  const unsigned pw0_3_b0 = pack2(SA[6], SA[7]);
  const float t0_3_b0 = fadd_s(SA[6], SA[7]);
  const bf16x8 P00_b0 = __builtin_bit_cast(bf16x8, make_uint4(pw0_0_b0, pw0_1_b0, pw0_2_b0, pw0_3_b0));
  const float s0_0_0_b0 = fadd_s(t0_0_b0, t0_1_b0);
  SW_K(1);
  __builtin_amdgcn_sched_barrier(0);
  SB = MFMA(kfc1, Q1[1], SB);
  SA[12] = FEXP_(SA[12]);
  SA[13] = FEXP_(SA[13]);
  const unsigned pw0_4_b0 = pack2(SA[8], SA[9]);
  const float t0_4_b0 = fadd_s(SA[8], SA[9]);
  const unsigned pw0_5_b0 = pack2(SA[10], SA[11]);
  const float t0_5_b0 = fadd_s(SA[10], SA[11]);
  const float s0_0_1_b0 = fadd_s(t0_2_b0, t0_3_b0);
  __builtin_amdgcn_sched_barrier(0);
  O11 = MFMA(vfc11, P3c1, O11);
  const bf16x8 vf001_b0 = VFR_(0, 0, 1);
  SA[14] = FEXP_(SA[14]);
  SA[15] = FEXP_(SA[15]);
  const unsigned pw0_6_b0 = pack2(SA[12], SA[13]);
  const float t0_6_b0 = fadd_s(SA[12], SA[13]);
  const float s0_0_2_b0 = fadd_s(t0_4_b0, t0_5_b0);
  const float s0_1_0_b0 = fadd_s(s0_0_0_b0, s0_0_1_b0);
  __builtin_amdgcn_sched_barrier(0);
  O00 = MFMA(vf000_b0, P00_b0, O00);
  const unsigned pw0_7_b0 = pack2(SA[14], SA[15]);
  const float t0_7_b0 = fadd_s(SA[14], SA[15]);
  const bf16x8 P01_b0 = __builtin_bit_cast(bf16x8, make_uint4(pw0_4_b0, pw0_5_b0, pw0_6_b0, pw0_7_b0));
  SB[0] = FEXP_(SB[0]);
  SB[1] = FEXP_(SB[1]);
  SB[2] = FEXP_(SB[2]);
  __builtin_amdgcn_sched_barrier(0);
  O01 = MFMA(vf010_b0, P00_b0, O01);
  const bf16x8 vf011_b0 = VFR_(1, 0, 1);
  const float s0_0_3_b0 = fadd_s(t0_6_b0, t0_7_b0);
  SB[3] = FEXP_(SB[3]);
  SB[4] = FEXP_(SB[4]);
  SB[5] = FEXP_(SB[5]);
  const unsigned pw1_0_b0 = pack2(SB[0], SB[1]);
  const float t1_0_b0 = fadd_s(SB[0], SB[1]);
  __builtin_amdgcn_sched_barrier(0);
  SA = MFMA(kfB0_b0, Q0[0], (f32x16)(0.f));
  const float s0_1_1_b0 = fadd_s(s0_0_2_b0, s0_0_3_b0);
  SB[6] = FEXP_(SB[6]);
  SB[7] = FEXP_(SB[7]);
  SB[8] = FEXP_(SB[8]);
  const unsigned pw1_1_b0 = pack2(SB[2], SB[3]);
  const float t1_1_b0 = fadd_s(SB[2], SB[3]);
  const unsigned pw1_2_b0 = pack2(SB[4], SB[5]);
  const float t1_2_b0 = fadd_s(SB[4], SB[5]);
  __builtin_amdgcn_sched_barrier(0);
  O00 = MFMA(vf001_b0, P01_b0, O00);
  const float s0_2_0_b0 = fadd_s(s0_1_0_b0, s0_1_1_b0);
  SB[9] = FEXP_(SB[9]);
  SB[10] = FEXP_(SB[10]);
  SB[11] = FEXP_(SB[11]);
  const unsigned pw1_3_b0 = pack2(SB[6], SB[7]);
  const float t1_3_b0 = fadd_s(SB[6], SB[7]);
  const bf16x8 P10_b0 = __builtin_bit_cast(bf16x8, make_uint4(pw1_0_b0, pw1_1_b0, pw1_2_b0, pw1_3_b0));
  const float s1_0_0_b0 = fadd_s(t1_0_b0, t1_1_b0);
  SW_V(1, 1);
  __builtin_amdgcn_sched_barrier(0);
  SA = MFMA(kfB1_b0, Q0[1], SA);
  l0 = fadd_s(l0, s0_2_0_b0);
  SB[12] = FEXP_(SB[12]);
  SB[13] = FEXP_(SB[13]);
  const unsigned pw1_4_b0 = pack2(SB[8], SB[9]);
  const float t1_4_b0 = fadd_s(SB[8], SB[9]);
  const unsigned pw1_5_b0 = pack2(SB[10], SB[11]);
  const float t1_5_b0 = fadd_s(SB[10], SB[11]);
  const float s1_0_1_b0 = fadd_s(t1_2_b0, t1_3_b0);
  __builtin_amdgcn_sched_barrier(0);
  O01 = MFMA(vf011_b0, P01_b0, O01);
  SB[14] = FEXP_(SB[14]);
  SB[15] = FEXP_(SB[15]);
  const unsigned pw1_6_b0 = pack2(SB[12], SB[13]);
  const float t1_6_b0 = fadd_s(SB[12], SB[13]);
  const float s1_0_2_b0 = fadd_s(t1_4_b0, t1_5_b0);
  const float s1_1_0_b0 = fadd_s(s1_0_0_b0, s1_0_1_b0);
  __builtin_amdgcn_sched_barrier(0);
  O10 = MFMA(vf000_b0, P10_b0, O10);
  const bf16x8 kfN0_b0 = KFR_(KN, 0, 0);
  const unsigned pw1_7_b0 = pack2(SB[14], SB[15]);
  const float t1_7_b0 = fadd_s(SB[14], SB[15]);
  const bf16x8 P11_b0 = __builtin_bit_cast(bf16x8, make_uint4(pw1_4_b0, pw1_5_b0, pw1_6_b0, pw1_7_b0));
  SA[0] = FEXP_(SA[0]);
  SA[1] = FEXP_(SA[1]);
  SA[2] = FEXP_(SA[2]);
  __builtin_amdgcn_sched_barrier(0);
  O11 = MFMA(vf010_b0, P10_b0, O11);
  const float s1_0_3_b0 = fadd_s(t1_6_b0, t1_7_b0);
  SA[3] = FEXP_(SA[3]);
  SA[4] = FEXP_(SA[4]);
  SA[5] = FEXP_(SA[5]);
  const unsigned pw2_0_b0 = pack2(SA[0], SA[1]);
  const float t2_0_b0 = fadd_s(SA[0], SA[1]);
  LD_K(t + 3, 0);
  __builtin_amdgcn_sched_barrier(0);
  SB = MFMA(kfB0_b0, Q1[0], (f32x16)(0.f));
  const bf16x8 kfN1_b0 = KFR_(KN, 0, 1);
  const bf16x8 vf100_b0 = VFR_(0, 1, 0);
  const float s1_1_1_b0 = fadd_s(s1_0_2_b0, s1_0_3_b0);
  SA[6] = FEXP_(SA[6]);
  SA[7] = FEXP_(SA[7]);
  SA[8] = FEXP_(SA[8]);
  const unsigned pw2_1_b0 = pack2(SA[2], SA[3]);
  const float t2_1_b0 = fadd_s(SA[2], SA[3]);
  const unsigned pw2_2_b0 = pack2(SA[4], SA[5]);
  const float t2_2_b0 = fadd_s(SA[4], SA[5]);
  __builtin_amdgcn_sched_barrier(0);
  O10 = MFMA(vf001_b0, P11_b0, O10);
  const bf16x8 vf110_b0 = VFR_(1, 1, 0);
  const float s1_2_0_b0 = fadd_s(s1_1_0_b0, s1_1_1_b0);
  SA[9] = FEXP_(SA[9]);
  SA[10] = FEXP_(SA[10]);
  SA[11] = FEXP_(SA[11]);
  const unsigned pw2_3_b0 = pack2(SA[6], SA[7]);
  const float t2_3_b0 = fadd_s(SA[6], SA[7]);
  const bf16x8 P20_b0 = __builtin_bit_cast(bf16x8, make_uint4(pw2_0_b0, pw2_1_b0, pw2_2_b0, pw2_3_b0));
  const float s2_0_0_b0 = fadd_s(t2_0_b0, t2_1_b0);
  __builtin_amdgcn_sched_barrier(0);
  SB = MFMA(kfB1_b0, Q1[1], SB);
  l1 = fadd_s(l1, s1_2_0_b0);
  SA[12] = FEXP_(SA[12]);
  SA[13] = FEXP_(SA[13]);
  const unsigned pw2_4_b0 = pack2(SA[8], SA[9]);
  const float t2_4_b0 = fadd_s(SA[8], SA[9]);
  const unsigned pw2_5_b0 = pack2(SA[10], SA[11]);
  const float t2_5_b0 = fadd_s(SA[10], SA[11]);
  const float s2_0_1_b0 = fadd_s(t2_2_b0, t2_3_b0);
  __builtin_amdgcn_sched_barrier(0);
  O11 = MFMA(vf011_b0, P11_b0, O11);
  const bf16x8 vf101_b0 = VFR_(0, 1, 1);
  SA[14] = FEXP_(SA[14]);
  SA[15] = FEXP_(SA[15]);
  const unsigned pw2_6_b0 = pack2(SA[12], SA[13]);
  const float t2_6_b0 = fadd_s(SA[12], SA[13]);
  const float s2_0_2_b0 = fadd_s(t2_4_b0, t2_5_b0);
  const float s2_1_0_b0 = fadd_s(s2_0_0_b0, s2_0_1_b0);
  __builtin_amdgcn_sched_barrier(0);
  O00 = MFMA(vf100_b0, P20_b0, O00);
  const unsigned pw2_7_b0 = pack2(SA[14], SA[15]);
  const float t2_7_b0 = fadd_s(SA[14], SA[15]);
  const bf16x8 P21_b0 = __builtin_bit_cast(bf16x8, make_uint4(pw2_4_b0, pw2_5_b0, pw2_6_b0, pw2_7_b0));
  SB[0] = FEXP_(SB[0]);
  SB[1] = FEXP_(SB[1]);
  SB[2] = FEXP_(SB[2]);
  __builtin_amdgcn_sched_barrier(0);
  O01 = MFMA(vf110_b0, P20_b0, O01);
  const bf16x8 vf111_b0 = VFR_(1, 1, 1);
  const float s2_0_3_b0 = fadd_s(t2_6_b0, t2_7_b0);
  SB[3] = FEXP_(SB[3]);
  SB[4] = FEXP_(SB[4]);
  SB[5] = FEXP_(SB[5]);
  const unsigned pw3_0_b0 = pack2(SB[0], SB[1]);
  const float t3_0_b0 = fadd_s(SB[0], SB[1]);
  LD_V(t + 2, 0);
  __builtin_amdgcn_sched_barrier(0);
  SA = MFMA(kfN0_b0, Q0[0], (f32x16)(0.f));
  const float s2_1_1_b0 = fadd_s(s2_0_2_b0, s2_0_3_b0);
  SB[6] = FEXP_(SB[6]);
  SB[7] = FEXP_(SB[7]);
  SB[8] = FEXP_(SB[8]);
  const unsigned pw3_1_b0 = pack2(SB[2], SB[3]);
  const float t3_1_b0 = fadd_s(SB[2], SB[3]);
  const unsigned pw3_2_b0 = pack2(SB[4], SB[5]);
  const float t3_2_b0 = fadd_s(SB[4], SB[5]);
  __builtin_amdgcn_sched_barrier(0);
  O00 = MFMA(vf101_b0, P21_b0, O00);
  const float s2_2_0_b0 = fadd_s(s2_1_0_b0, s2_1_1_b0);
  SB[9] = FEXP_(SB[9]);
  SB[10] = FEXP_(SB[10]);
  SB[11] = FEXP_(SB[11]);
  const unsigned pw3_3_b0 = pack2(SB[6], SB[7]);
  const float t3_3_b0 = fadd_s(SB[6], SB[7]);
  const bf16x8 P30_b0 = __builtin_bit_cast(bf16x8, make_uint4(pw3_0_b0, pw3_1_b0, pw3_2_b0, pw3_3_b0));
  const float s3_0_0_b0 = fadd_s(t3_0_b0, t3_1_b0);
  __builtin_amdgcn_sched_barrier(0);
  SA = MFMA(kfN1_b0, Q0[1], SA);
  l0 = fadd_s(l0, s2_2_0_b0);
  SB[12] = FEXP_(SB[12]);
  SB[13] = FEXP_(SB[13]);
  const unsigned pw3_4_b0 = pack2(SB[8], SB[9]);
  const float t3_4_b0 = fadd_s(SB[8], SB[9]);
  const unsigned pw3_5_b0 = pack2(SB[10], SB[11]);
  const float t3_5_b0 = fadd_s(SB[10], SB[11]);
  const float s3_0_1_b0 = fadd_s(t3_2_b0, t3_3_b0);
  __builtin_amdgcn_sched_barrier(0);
  O01 = MFMA(vf111_b0, P21_b0, O01);
  SB[14] = FEXP_(SB[14]);
  SB[15] = FEXP_(SB[15]);
  const unsigned pw3_6_b0 = pack2(SB[12], SB[13]);
  const float t3_6_b0 = fadd_s(SB[12], SB[13]);
  const float s3_0_2_b0 = fadd_s(t3_4_b0, t3_5_b0);
  const float s3_1_0_b0 = fadd_s(s3_0_0_b0, s3_0_1_b0);
  __builtin_amdgcn_sched_barrier(0);
  const unsigned pw3_7_b0 = pack2(SB[14], SB[15]);
  const float t3_7_b0 = fadd_s(SB[14], SB[15]);
  const bf16x8 P31_b0 = __builtin_bit_cast(bf16x8, make_uint4(pw3_4_b0, pw3_5_b0, pw3_6_b0, pw3_7_b0));
  const float s3_0_3_b0 = fadd_s(t3_6_b0, t3_7_b0);
  const float s3_1_1_b0 = fadd_s(s3_0_2_b0, s3_0_3_b0);
  const float s3_2_0_b0 = fadd_s(s3_1_0_b0, s3_1_1_b0);
  l1 = fadd_s(l1, s3_2_0_b0);
  P3c0 = P30_b0; P3c1 = P31_b0; vfc00 = vf100_b0; vfc10 = vf110_b0; vfc01 = vf101_b0; vfc11 = vf111_b0; kfc0 = kfN0_b0; kfc1 = kfN1_b0;
  __builtin_amdgcn_sched_barrier(0);
#undef VFR_
    }
    { const int tmp_ = kcu; kcu = knx; knx = kwr; kwr = tmp_; }
    __syncthreads();
    {
      const char* KC = kb + kcu; const char* KN = kb + knx;
#define VFR_(i2, u, s2) VFRX_(1, i2, u, s2)
  __builtin_amdgcn_sched_barrier(0);
  O10 = MFMA(vfc00, P3c0, O10);
  const bf16x8 kfB0_b1 = KFR_(KC, 1, 0);
  SA[0] = FEXP_(SA[0]);
  SA[1] = FEXP_(SA[1]);
  SA[2] = FEXP_(SA[2]);
  __builtin_amdgcn_sched_barrier(0);
  O11 = MFMA(vfc10, P3c0, O11);
  SA[3] = FEXP_(SA[3]);
  SA[4] = FEXP_(SA[4]);
  SA[5] = FEXP_(SA[5]);
  const unsigned pw0_0_b1 = pack2(SA[0], SA[1]);
  const float t0_0_b1 = fadd_s(SA[0], SA[1]);
  __builtin_amdgcn_sched_barrier(0);
  SB = MFMA(kfc0, Q1[0], (f32x16)(0.f));
  const bf16x8 kfB1_b1 = KFR_(KC, 1, 1);
  const bf16x8 vf000_b1 = VFR_(0, 0, 0);
  SA[6] = FEXP_(SA[6]);
  SA[7] = FEXP_(SA[7]);
  SA[8] = FEXP_(SA[8]);
  const unsigned pw0_1_b1 = pack2(SA[2], SA[3]);
  const float t0_1_b1 = fadd_s(SA[2], SA[3]);
  const unsigned pw0_2_b1 = pack2(SA[4], SA[5]);
  const float t0_2_b1 = fadd_s(SA[4], SA[5]);
  __builtin_amdgcn_sched_barrier(0);
  O10 = MFMA(vfc01, P3c1, O10);
  const bf16x8 vf010_b1 = VFR_(1, 0, 0);
  SA[9] = FEXP_(SA[9]);
  SA[10] = FEXP_(SA[10]);
  SA[11] = FEXP_(SA[11]);
  const unsigned pw0_3_b1 = pack2(SA[6], SA[7]);
  const float t0_3_b1 = fadd_s(SA[6], SA[7]);
  const bf16x8 P00_b1 = __builtin_bit_cast(bf16x8, make_uint4(pw0_0_b1, pw0_1_b1, pw0_2_b1, pw0_3_b1));
  const float s0_0_0_b1 = fadd_s(t0_0_b1, t0_1_b1);
  SW_K(0);
  __builtin_amdgcn_sched_barrier(0);
  SB = MFMA(kfc1, Q1[1], SB);
  SA[12] = FEXP_(SA[12]);
  SA[13] = FEXP_(SA[13]);
  const unsigned pw0_4_b1 = pack2(SA[8], SA[9]);
  const float t0_4_b1 = fadd_s(SA[8], SA[9]);
  const unsigned pw0_5_b1 = pack2(SA[10], SA[11]);
  const float t0_5_b1 = fadd_s(SA[10], SA[11]);
  const float s0_0_1_b1 = fadd_s(t0_2_b1, t0_3_b1);
  __builtin_amdgcn_sched_barrier(0);
  O11 = MFMA(vfc11, P3c1, O11);
  const bf16x8 vf001_b1 = VFR_(0, 0, 1);
  SA[14] = FEXP_(SA[14]);
  SA[15] = FEXP_(SA[15]);
  const unsigned pw0_6_b1 = pack2(SA[12], SA[13]);
  const float t0_6_b1 = fadd_s(SA[12], SA[13]);
  const float s0_0_2_b1 = fadd_s(t0_4_b1, t0_5_b1);
  const float s0_1_0_b1 = fadd_s(s0_0_0_b1, s0_0_1_b1);
  __builtin_amdgcn_sched_barrier(0);
  O00 = MFMA(vf000_b1, P00_b1, O00);
  const unsigned pw0_7_b1 = pack2(SA[14], SA[15]);
  const float t0_7_b1 = fadd_s(SA[14], SA[15]);
  const bf16x8 P01_b1 = __builtin_bit_cast(bf16x8, make_uint4(pw0_4_b1, pw0_5_b1, pw0_6_b1, pw0_7_b1));
  SB[0] = FEXP_(SB[0]);
  SB[1] = FEXP_(SB[1]);
  SB[2] = FEXP_(SB[2]);
  __builtin_amdgcn_sched_barrier(0);
  O01 = MFMA(vf010_b1, P00_b1, O01);
  const bf16x8 vf011_b1 = VFR_(1, 0, 1);
  const float s0_0_3_b1 = fadd_s(t0_6_b1, t0_7_b1);
  SB[3] = FEXP_(SB[3]);
  SB[4] = FEXP_(SB[4]);
  SB[5] = FEXP_(SB[5]);
  const unsigned pw1_0_b1 = pack2(SB[0], SB[1]);
  const float t1_0_b1 = fadd_s(SB[0], SB[1]);
  __builtin_amdgcn_sched_barrier(0);
  SA = MFMA(kfB0_b1, Q0[0], (f32x16)(0.f));
  const float s0_1_1_b1 = fadd_s(s0_0_2_b1, s0_0_3_b1);
  SB[6] = FEXP_(SB[6]);
  SB[7] = FEXP_(SB[7]);
  SB[8] = FEXP_(SB[8]);
  const unsigned pw1_1_b1 = pack2(SB[2], SB[3]);
  const float t1_1_b1 = fadd_s(SB[2], SB[3]);
  const unsigned pw1_2_b1 = pack2(SB[4], SB[5]);
  const float t1_2_b1 = fadd_s(SB[4], SB[5]);
  __builtin_amdgcn_sched_barrier(0);
  O00 = MFMA(vf001_b1, P01_b1, O00);
  const float s0_2_0_b1 = fadd_s(s0_1_0_b1, s0_1_1_b1);
  SB[9] = FEXP_(SB[9]);
  SB[10] = FEXP_(SB[10]);
  SB[11] = FEXP_(SB[11]);
  const unsigned pw1_3_b1 = pack2(SB[6], SB[7]);
  const float t1_3_b1 = fadd_s(SB[6], SB[7]);
  const bf16x8 P10_b1 = __builtin_bit_cast(bf16x8, make_uint4(pw1_0_b1, pw1_1_b1, pw1_2_b1, pw1_3_b1));
  const float s1_0_0_b1 = fadd_s(t1_0_b1, t1_1_b1);
  SW_V(0, 0);
  __builtin_amdgcn_sched_barrier(0);
  SA = MFMA(kfB1_b1, Q0[1], SA);
  l0 = fadd_s(l0, s0_2_0_b1);
  SB[12] = FEXP_(SB[12]);
  SB[13] = FEXP_(SB[13]);
  const unsigned pw1_4_b1 = pack2(SB[8], SB[9]);
  const float t1_4_b1 = fadd_s(SB[8], SB[9]);
  const unsigned pw1_5_b1 = pack2(SB[10], SB[11]);
  const float t1_5_b1 = fadd_s(SB[10], SB[11]);
  const float s1_0_1_b1 = fadd_s(t1_2_b1, t1_3_b1);
  __builtin_amdgcn_sched_barrier(0);
  O01 = MFMA(vf011_b1, P01_b1, O01);
  SB[14] = FEXP_(SB[14]);
  SB[15] = FEXP_(SB[15]);
  const unsigned pw1_6_b1 = pack2(SB[12], SB[13]);
  const float t1_6_b1 = fadd_s(SB[12], SB[13]);
  const float s1_0_2_b1 = fadd_s(t1_4_b1, t1_5_b1);
  const float s1_1_0_b1 = fadd_s(s1_0_0_b1, s1_0_1_b1);
  __builtin_amdgcn_sched_barrier(0);
  O10 = MFMA(vf000_b1, P10_b1, O10);
  const bf16x8 kfN0_b1 = KFR_(KN, 0, 0);
  const unsigned pw1_7_b1 = pack2(SB[14], SB[15]);
  const float t1_7_b1 = fadd_s(SB[14], SB[15]);
  const bf16x8 P11_b1 = __builtin_bit_cast(bf16x8, make_uint4(pw1_4_b1, pw1_5_b1, pw1_6_b1, pw1_7_b1));
  SA[0] = FEXP_(SA[0]);
  SA[1] = FEXP_(SA[1]);
  SA[2] = FEXP_(SA[2]);
  __builtin_amdgcn_sched_barrier(0);
  O11 = MFMA(vf010_b1, P10_b1, O11);
  const float s1_0_3_b1 = fadd_s(t1_6_b1, t1_7_b1);
  SA[3] = FEXP_(SA[3]);
  SA[4] = FEXP_(SA[4]);
  SA[5] = FEXP_(SA[5]);
  const unsigned pw2_0_b1 = pack2(SA[0], SA[1]);
  const float t2_0_b1 = fadd_s(SA[0], SA[1]);
  LD_K(t + 4, 1);
  __builtin_amdgcn_sched_barrier(0);
  SB = MFMA(kfB0_b1, Q1[0], (f32x16)(0.f));
  const bf16x8 kfN1_b1 = KFR_(KN, 0, 1);
  const bf16x8 vf100_b1 = VFR_(0, 1, 0);
  const float s1_1_1_b1 = fadd_s(s1_0_2_b1, s1_0_3_b1);
  SA[6] = FEXP_(SA[6]);
  SA[7] = FEXP_(SA[7]);
  SA[8] = FEXP_(SA[8]);
  const unsigned pw2_1_b1 = pack2(SA[2], SA[3]);
  const float t2_1_b1 = fadd_s(SA[2], SA[3]);
  const unsigned pw2_2_b1 = pack2(SA[4], SA[5]);
  const float t2_2_b1 = fadd_s(SA[4], SA[5]);
  __builtin_amdgcn_sched_barrier(0);
  O10 = MFMA(vf001_b1, P11_b1, O10);
  const bf16x8 vf110_b1 = VFR_(1, 1, 0);
  const float s1_2_0_b1 = fadd_s(s1_1_0_b1, s1_1_1_b1);
  SA[9] = FEXP_(SA[9]);
  SA[10] = FEXP_(SA[10]);
  SA[11] = FEXP_(SA[11]);
  const unsigned pw2_3_b1 = pack2(SA[6], SA[7]);
  const float t2_3_b1 = fadd_s(SA[6], SA[7]);
  const bf16x8 P20_b1 = __builtin_bit_cast(bf16x8, make_uint4(pw2_0_b1, pw2_1_b1, pw2_2_b1, pw2_3_b1));
  const float s2_0_0_b1 = fadd_s(t2_0_b1, t2_1_b1);
  __builtin_amdgcn_sched_barrier(0);
  SB = MFMA(kfB1_b1, Q1[1], SB);
  l1 = fadd_s(l1, s1_2_0_b1);
  SA[12] = FEXP_(SA[12]);
  SA[13] = FEXP_(SA[13]);
  const unsigned pw2_4_b1 = pack2(SA[8], SA[9]);
  const float t2_4_b1 = fadd_s(SA[8], SA[9]);
  const unsigned pw2_5_b1 = pack2(SA[10], SA[11]);
  const float t2_5_b1 = fadd_s(SA[10], SA[11]);
  const float s2_0_1_b1 = fadd_s(t2_2_b1, t2_3_b1);
  __builtin_amdgcn_sched_barrier(0);
  O11 = MFMA(vf011_b1, P11_b1, O11);
  const bf16x8 vf101_b1 = VFR_(0, 1, 1);
  SA[14] = FEXP_(SA[14]);
  SA[15] = FEXP_(SA[15]);
  const unsigned pw2_6_b1 = pack2(SA[12], SA[13]);
  const float t2_6_b1 = fadd_s(SA[12], SA[13]);
  const float s2_0_2_b1 = fadd_s(t2_4_b1, t2_5_b1);
  const float s2_1_0_b1 = fadd_s(s2_0_0_b1, s2_0_1_b1);
  __builtin_amdgcn_sched_barrier(0);
  O00 = MFMA(vf100_b1, P20_b1, O00);
  const unsigned pw2_7_b1 = pack2(SA[14], SA[15]);
  const float t2_7_b1 = fadd_s(SA[14], SA[15]);
  const bf16x8 P21_b1 = __builtin_bit_cast(bf16x8, make_uint4(pw2_4_b1, pw2_5_b1, pw2_6_b1, pw2_7_b1));
  SB[0] = FEXP_(SB[0]);
  SB[1] = FEXP_(SB[1]);
  SB[2] = FEXP_(SB[2]);
  __builtin_amdgcn_sched_barrier(0);
  O01 = MFMA(vf110_b1, P20_b1, O01);
  const bf16x8 vf111_b1 = VFR_(1, 1, 1);
  const float s2_0_3_b1 = fadd_s(t2_6_b1, t2_7_b1);
  SB[3] = FEXP_(SB[3]);
  SB[4] = FEXP_(SB[4]);
  SB[5] = FEXP_(SB[5]);
  const unsigned pw3_0_b1 = pack2(SB[0], SB[1]);
  const float t3_0_b1 = fadd_s(SB[0], SB[1]);
  LD_V(t + 3, 1);
  __builtin_amdgcn_sched_barrier(0);
  SA = MFMA(kfN0_b1, Q0[0], (f32x16)(0.f));
  const float s2_1_1_b1 = fadd_s(s2_0_2_b1, s2_0_3_b1);
  SB[6] = FEXP_(SB[6]);
  SB[7] = FEXP_(SB[7]);
  SB[8] = FEXP_(SB[8]);
  const unsigned pw3_1_b1 = pack2(SB[2], SB[3]);
  const float t3_1_b1 = fadd_s(SB[2], SB[3]);
  const unsigned pw3_2_b1 = pack2(SB[4], SB[5]);
  const float t3_2_b1 = fadd_s(SB[4], SB[5]);
  __builtin_amdgcn_sched_barrier(0);
  O00 = MFMA(vf101_b1, P21_b1, O00);
  const float s2_2_0_b1 = fadd_s(s2_1_0_b1, s2_1_1_b1);
  SB[9] = FEXP_(SB[9]);
  SB[10] = FEXP_(SB[10]);
  SB[11] = FEXP_(SB[11]);
  const unsigned pw3_3_b1 = pack2(SB[6], SB[7]);
  const float t3_3_b1 = fadd_s(SB[6], SB[7]);
  const bf16x8 P30_b1 = __builtin_bit_cast(bf16x8, make_uint4(pw3_0_b1, pw3_1_b1, pw3_2_b1, pw3_3_b1));
  const float s3_0_0_b1 = fadd_s(t3_0_b1, t3_1_b1);
  __builtin_amdgcn_sched_barrier(0);
  SA = MFMA(kfN1_b1, Q0[1], SA);
  l0 = fadd_s(l0, s2_2_0_b1);
  SB[12] = FEXP_(SB[12]);
  SB[13] = FEXP_(SB[13]);
  const unsigned pw3_4_b1 = pack2(SB[8], SB[9]);
  const float t3_4_b1 = fadd_s(SB[8], SB[9]);
  const unsigned pw3_5_b1 = pack2(SB[10], SB[11]);
  const float t3_5_b1 = fadd_s(SB[10], SB[11]);
  const float s3_0_1_b1 = fadd_s(t3_2_b1, t3_3_b1);
  __builtin_amdgcn_sched_barrier(0);
  O01 = MFMA(vf111_b1, P21_b1, O01);
  SB[14] = FEXP_(SB[14]);
  SB[15] = FEXP_(SB[15]);
  const unsigned pw3_6_b1 = pack2(SB[12], SB[13]);
  const float t3_6_b1 = fadd_s(SB[12], SB[13]);
  const float s3_0_2_b1 = fadd_s(t3_4_b1, t3_5_b1);
  const float s3_1_0_b1 = fadd_s(s3_0_0_b1, s3_0_1_b1);
  __builtin_amdgcn_sched_barrier(0);
  const unsigned pw3_7_b1 = pack2(SB[14], SB[15]);
  const float t3_7_b1 = fadd_s(SB[14], SB[15]);
  const bf16x8 P31_b1 = __builtin_bit_cast(bf16x8, make_uint4(pw3_4_b1, pw3_5_b1, pw3_6_b1, pw3_7_b1));
  const float s3_0_3_b1 = fadd_s(t3_6_b1, t3_7_b1);
  const float s3_1_1_b1 = fadd_s(s3_0_2_b1, s3_0_3_b1);
  const float s3_2_0_b1 = fadd_s(s3_1_0_b1, s3_1_1_b1);
  l1 = fadd_s(l1, s3_2_0_b1);
  P3c0 = P30_b1; P3c1 = P31_b1; vfc00 = vf100_b1; vfc10 = vf110_b1; vfc01 = vf101_b1; vfc11 = vf111_b1; kfc0 = kfN0_b1; kfc1 = kfN1_b1;
  __builtin_amdgcn_sched_barrier(0);
#undef VFR_
    }
    { const int tmp_ = kcu; kcu = knx; knx = kwr; kwr = tmp_; }
    __syncthreads();
  }
  O10 = MFMA(vfc00, P3c0, O10); O11 = MFMA(vfc10, P3c0, O11); O10 = MFMA(vfc01, P3c1, O10); O11 = MFMA(vfc11, P3c1, O11);
#undef LD_K
#undef LD_V
#undef SW_K
#undef SW_V
#undef VFRX_
#undef KFR_
#undef FEXP_
  const float lt0 = l0 + __shfl_xor(l0, 32), lt1 = l1 + __shfl_xor(l1, 32);
  if (__syncthreads_or(!(lt0 < 1.0e37f) || !(lt0 > 1.0e-30f) || !(lt1 < 1.0e37f) || !(lt1 > 1.0e-30f))) return true;
  float* xch = (float*)lds + (((wave >> 1) * 2) * 64 + lane) * 33;
  if (strm == 1) {
    const float sc0 = lam_full / lt0, sc1 = lam_full / lt1;
#pragma unroll
    for (int e = 0; e < 16; ++e) {
      xch[e] = O00[e] * sc0; xch[16 + e] = O01[e] * sc0;
      xch[64 * 33 + e] = O10[e] * sc1; xch[64 * 33 + 16 + e] = O11[e] * sc1;
    }
  }
  __syncthreads();
  if (strm == 0) {
    const float* g = p.in[3] + layer * 64;
#define DIFF_FIN_(QI, OA, OB, LT) { \
      const int t_ = b * SEQ + q0 + (QI) * 32 + r; \
      const float inv1 = 1.f / (LT); \
      float ss = 0.f; \
      _Pragma("unroll") for (int e = 0; e < 16; ++e) { \
        const float oa = OA[e] * inv1 - xch[(QI) * 64 * 33 + e]; OA[e] = oa; ss += oa * oa; \
        const float ob = OB[e] * inv1 - xch[(QI) * 64 * 33 + 16 + e]; OB[e] = ob; ss += ob * ob; } \
      ss += __shfl_xor(ss, 32); \
      const float rn = rsqrtf(ss * (1.f / 64.f) + 1e-5f) * (1.f - lam_init); \
      _Pragma("unroll") for (int gq = 0; gq < 4; ++gq) \
        _Pragma("unroll") for (int bq = 0; bq < 4; ++bq) { OA[4 * gq + bq] *= rn * g[8 * gq + 4 * hh + bq]; OB[4 * gq + bq] *= rn * g[32 + 8 * gq + 4 * hh + bq]; } \
      store_tile(p.cat + (size_t)t_ * 1024 + head * 64, OA, hh); \
      store_tile(p.cat + (size_t)t_ * 1024 + head * 64 + 32, OB, hh); }
    DIFF_FIN_(0, O00, O01, lt0)
    DIFF_FIN_(1, O10, O11, lt1)
#undef DIFF_FIN_
  }
  __syncthreads();
  return false;
}

struct DilItem { int pair, bh, dil, L, cls, i0; };
DI DilItem dil_decode(int item) {
  DilItem d;
  d.pair = item / 768; const int rem = item % 768; d.bh = rem >> 4; const int sub = rem & 15;
  d.dil = (d.pair == 0) ? 1 : (d.pair == 1 ? 4 : 16);
  d.L = SEQ / d.dil;
  int blk;
  if (d.pair == 0) { d.cls = 0; blk = sub; } else if (d.pair == 1) { d.cls = sub & 3; blk = sub >> 2; } else { d.cls = sub; blk = 0; }
  d.i0 = blk * 256;
  return d;
}
DI void dil_fetch(const Params& p, const DilItem& d, int tid, uint4 (&kr)[6], uint4 (&vr)[6]) {
  const u16* kg = p.ck + (size_t)d.bh * SEQ * 64;
  const u16* vg = p.cv + (size_t)d.bh * SEQ * 64;
#pragma unroll
  for (int e = 0; e < 6; ++e) {
    const int c = tid + e * 512;
    const int row = c >> 3, ch = c & 7;
    const int kk = d.i0 - 64 + row;
    kr[e] = make_uint4(0, 0, 0, 0); vr[e] = make_uint4(0, 0, 0, 0);
    if (kk >= 0 && kk < d.L) {
      const size_t pos = (size_t)(d.cls + d.dil * kk);
      kr[e] = *(const uint4*)(kg + pos * 64 + ch * 8);
      vr[e] = *(const uint4*)(vg + pos * 64 + ch * 8);
    }
  }
}
DI void attn_dilated_items(const Params& p, char* lds) {
  const int tid = otid(p.wave), lane = tid & 63, wave = tid >> 6, r = lane & 31, hh = lane >> 5;
  constexpr int KROW = 144;
  char* Kl = lds;
  char* Vl = lds + 384 * KROW;
  uint4 kr[6], vr[6];
  int item = obid();
  if (item < 2304) { const DilItem d0 = dil_decode(item); dil_fetch(p, d0, tid, kr, vr); }
#pragma unroll 1
  for (; item < 2304; item += gridDim.x) {
  const DilItem d = dil_decode(item);
  const int pair = d.pair, bh = d.bh, dil = d.dil, L = d.L, cls = d.cls, i0 = d.i0;
#pragma unroll
  for (int e = 0; e < 6; ++e) {
    const int c = tid + e * 512;
    const int row = c >> 3, ch = c & 7;
    *(uint4*)(Kl + row * KROW + ch * 16) = kr[e];
    *(uint4*)(Vl + row * 128 + ((ch * 16) ^ (((row >> 1) & 1) << 6))) = vr[e];
  }
  if (item + (int)gridDim.x < 2304) { const DilItem dn = dil_decode(item + gridDim.x); dil_fetch(p, dn, tid, kr, vr); }
  const int qq = i0 + 32 * wave + r;
  const int pq = cls + dil * qq;
  bf16x8 Q[4];
  {
    const u16* qp = p.cq + ((size_t)bh * SEQ + pq) * 64 + hh * 8;
#pragma unroll
    for (int s = 0; s < 4; ++s) Q[s] = *(const bf16x8*)(qp + s * 16);
  }
  __syncthreads();
  f32x16 O[2];
#pragma unroll
  for (int e = 0; e < 16; ++e) { O[0][e] = 0.f; O[1][e] = 0.f; }
  float m = -1e30f, l = 0.f;
  const int tq = (lane & 15) >> 2, tp = lane & 3, tg1 = (lane >> 4) & 1, swz = (tq >> 1) & 1;
  const int voff = (4 * hh + tq) * 128 + 32 * tg1 + 8 * tp;
#pragma unroll
  for (int j = 0; j < 5; ++j) {
    const int rb = 32 * wave + 32 * j;
    f32x16 S;
#pragma unroll
    for (int e = 0; e < 16; ++e) S[e] = 0.f;
    const char* kb = Kl + (rb + r) * KROW + hh * 16;
#pragma unroll
    for (int s = 0; s < 4; ++s) S = MFMA(*(const bf16x8*)(kb + s * 32), Q[s], S);
    unsigned vmask = 0;
#pragma unroll
    for (int e = 0; e < 16; ++e) {
      const int cr = (e & 3) + 8 * (e >> 2) + 4 * hh;
      const int kk = i0 - 64 + rb + cr;
      bool ok = (kk >= 0) && (kk < L);
      if (j == 0) ok = ok && (cr >= r);
      if (j == 4) ok = ok && (cr <= r);
      vmask |= ok ? (1u << e) : 0u;
      S[e] = ok ? S[e] : -1e30f;
    }
    float mx = max16(S);
    mx = fmaxf(mx, __shfl_xor(mx, 32));
    if (__any(mx > m)) {
      const float mn = fmaxf(m, mx);
      const float al = fexp2(m - mn);
      m = mn; l *= al;
#pragma unroll
      for (int e = 0; e < 16; ++e) { O[0][e] *= al; O[1][e] *= al; }
    }
    float ps = 0.f;
#pragma unroll
    for (int e = 0; e < 16; ++e) { S[e] = ((vmask >> e) & 1) ? fexp2(S[e] - m) : 0.f; ps += S[e]; }
    l += ps;
    bf16x8 P0 = packP(S, 0), P1 = packP(S, 1);
    const char* vb = Vl + rb * 128 + voff;
#pragma unroll
    for (int i2 = 0; i2 < 2; ++i2)
#pragma unroll
      for (int s2 = 0; s2 < 2; ++s2) {
        const char* a = vb + (16 * s2) * 128 + 64 * (i2 ^ swz);
        s16x4 lo = trread(a), hi = trread(a + 8 * 128);
        bf16x8 vf = __builtin_shufflevector(lo, hi, 0, 1, 2, 3, 4, 5, 6, 7);
        O[i2] = MFMA(vf, s2 == 0 ? P0 : P1, O[i2]);
      }
  }
  const float lt = l + __shfl_xor(l, 32);
  const float inv = 1.f / lt;
  const int b = bh / 6, head = bh % 6;
  const int t = b * SEQ + pq;
#pragma unroll
  for (int i2 = 0; i2 < 2; ++i2) {
#pragma unroll
    for (int e = 0; e < 16; ++e) O[i2][e] *= inv;
    store_tile(p.dilo + ((size_t)pair * T_ALL + t) * 384 + head * 64 + i2 * 32, O[i2], hh);
  }
  if (hh == 0) p.dillse[((size_t)pair * T_ALL + t) * 6 + head] = m + __log2f(lt);
  __syncthreads();
  }
}


DI void phase_gemm1(const Params& p, int layer, char* lds) {
  EpiGemm1 E; E.aq = p.aq; E.ak = p.ak; E.av = p.av; E.bc = p.bc; E.bkr = p.bkr; E.cq = p.cq; E.ck = p.ck; E.cv = p.cv;
  E.cs32 = p.cs32; E.cs64 = p.cs64; E.sumsq = p.sumsq;
  run_gemm(p.wave, p.xb, p.winT + (size_t)layer * NPAD * 1024, NPAD, 1024, E, lds);
}
DI void phase_up_dil(const Params& p, int layer, char* lds) {
  EpiUp E; E.mq = p.mq; E.mk = p.mk; E.mv = p.mv; E.cs32 = p.cs32; E.sumsq = p.sumsq;
  run_gemm(p.wave, p.bc, p.wupT + (size_t)layer * NUP * KUP, NUP, KUP, E, lds);
  attn_dilated_items(p, lds);
}
DI void phase_attn(const Params& p, int layer, char* lds) {
  const float* lam = p.in[2] + layer * 128;
  float s1 = 0.f, s2 = 0.f;
  for (int i = 0; i < 32; ++i) { s1 += lam[i] * lam[32 + i]; s2 += lam[64 + i] * lam[96 + i]; }
  const float lam_init = 0.8f - 0.6f * expf(-0.3f * (float)(layer + 1));
  const float lam_full = expf(s1) - expf(s2) + lam_init;
  unsigned redo = 0u;
  {
    int k = 0;
    for (int item = obid(); item < 1280; item += gridDim.x, ++k) {
      bool bad;
      if (item < 768) bad = attn_mla_split(p, layer, item, lds);
      else bad = attn_diff_pipe(p, layer, item - 768, lam_full, lam_init, lds);
      redo |= bad ? (1u << k) : 0u;
    }
  }
  redo = __builtin_amdgcn_readfirstlane(redo);
  if (redo) {
    int k = 0;
    for (int item = obid(); item < 1280; item += gridDim.x, ++k) {
      if (!((redo >> k) & 1u)) continue;
      if (item < 768) attn_dense_item<true, true, 1>(p, layer, item, lam_full, lam_init, lds);
      else {
        const int j = item - 768, o = (j / 64) * 128 + ((j / 16) & 3) * 32 + 2 * (j & 15);
        attn_dense_item<false, true, 1>(p, layer, o, lam_full, lam_init, lds);
        attn_dense_item<false, true, 1>(p, layer, o + 1, lam_full, lam_init, lds);
      }
    }
  }
  for (int i = obid() * 512 + otid(p.wave); i < T_ALL * 48; i += gridDim.x * 512) {
    const int t = i / 48, c = i % 48, head = c >> 3;
    const float l0 = p.dillse[((size_t)0 * T_ALL + t) * 6 + head];
    const float l1 = p.dillse[((size_t)1 * T_ALL + t) * 6 + head];
    const float l2 = p.dillse[((size_t)2 * T_ALL + t) * 6 + head];
    const float mx = fmaxf(l0, fmaxf(l1, l2));
    float w0 = fexp2(l0 - mx), w1 = fexp2(l1 - mx), w2 = fexp2(l2 - mx);
    const float inv = 1.f / (w0 + w1 + w2);
    w0 *= inv; w1 *= inv; w2 *= inv;
    const uint4 a = *(const uint4*)(p.dilo + ((size_t)0 * T_ALL + t) * 384 + c * 8);
    const uint4 bq = *(const uint4*)(p.dilo + ((size_t)1 * T_ALL + t) * 384 + c * 8);
    const uint4 cq = *(const uint4*)(p.dilo + ((size_t)2 * T_ALL + t) * 384 + c * 8);
    uint4 o;
    o.x = pack2(w0 * bflo(a.x) + w1 * bflo(bq.x) + w2 * bflo(cq.x), w0 * bfhi(a.x) + w1 * bfhi(bq.x) + w2 * bfhi(cq.x));
    o.y = pack2(w0 * bflo(a.y) + w1 * bflo(bq.y) + w2 * bflo(cq.y), w0 * bfhi(a.y) + w1 * bfhi(bq.y) + w2 * bfhi(cq.y));
    o.z = pack2(w0 * bflo(a.z) + w1 * bflo(bq.z) + w2 * bflo(cq.z), w0 * bfhi(a.z) + w1 * bfhi(bq.z) + w2 * bfhi(cq.z));
    o.w = pack2(w0 * bflo(a.w) + w1 * bflo(bq.w) + w2 * bflo(cq.w), w0 * bfhi(a.w) + w1 * bfhi(bq.w) + w2 * bfhi(cq.w));
    *(uint4*)(p.cat + (size_t)t * 1024 + 640 + c * 8) = o;
  }
}
DI void phase_outproj(const Params& p, int layer, char* lds) {
  EpiOut E; E.xb = p.xb; E.ybuf = p.ybuf; E.stats = p.stats;
  run_gemm(p.wave, p.cat, p.woT + (size_t)layer * DM * DM, DM, DM, E, lds);
}
DI void phase_ln1(const Params& p, int layer, char* lds) {
  const int tid = otid(p.wave), lane = tid & 63, wave = tid >> 6;
  const float* g1 = p.in[9] + layer * 1024 + lane * 16;
  const float* b1 = p.in[10] + layer * 1024 + lane * 16;
  float gg[16], bb[16];
#pragma unroll
  for (int q = 0; q < 4; ++q) {
    const float4 a = *(const float4*)(g1 + 4 * q), b = *(const float4*)(b1 + 4 * q);
    gg[4 * q] = a.x; gg[4 * q + 1] = a.y; gg[4 * q + 2] = a.z; gg[4 * q + 3] = a.w;
    bb[4 * q] = b.x; bb[4 * q + 1] = b.y; bb[4 * q + 2] = b.z; bb[4 * q + 3] = b.w;
  }
  for (int t = obid() * 8 + wave; t < T_ALL; t += gridDim.x * 8) {
    const uint4* yp = (const uint4*)(p.ybuf + (size_t)t * 1024 + lane * 16);
    const uint4 v0 = yp[0], v1 = yp[1];
    float pv = (lane < 32) ? p.stats[(size_t)t * 32 + lane] : 0.f;
    pv += __shfl_xor(pv, 8); pv += __shfl_xor(pv, 4); pv += __shfl_xor(pv, 2); pv += __shfl_xor(pv, 1);
    const float mean = __shfl(pv, 0) * (1.f / 1024.f);
    const float rstd = rsqrtf(fmaxf(__shfl(pv, 16) * (1.f / 1024.f) - mean * mean, 0.f) + 1e-5f);
    const float y[16] = {bflo(v0.x), bfhi(v0.x), bflo(v0.y), bfhi(v0.y), bflo(v0.z), bfhi(v0.z), bflo(v0.w), bfhi(v0.w),
                         bflo(v1.x), bfhi(v1.x), bflo(v1.y), bfhi(v1.y), bflo(v1.z), bfhi(v1.z), bflo(v1.w), bfhi(v1.w)};
    float o[16];
#pragma unroll
    for (int e = 0; e < 16; ++e) o[e] = (y[e] - mean) * rstd * gg[e] + bb[e];
    uint4 w0, w1;
    w0.x = pack2(o[0], o[1]); w0.y = pack2(o[2], o[3]); w0.z = pack2(o[4], o[5]); w0.w = pack2(o[6], o[7]);
    w1.x = pack2(o[8], o[9]); w1.y = pack2(o[10], o[11]); w1.z = pack2(o[12], o[13]); w1.w = pack2(o[14], o[15]);
    uint4* xp = (uint4*)(p.x1 + (size_t)t * 1024 + lane * 16);
    xp[0] = w0; xp[1] = w1;
  }
}
DI void phase_qgemm(const Params& p, int layer, char* lds) {
  EpiQ E; E.qbuf = p.qbuf;
  run_gemm(p.wave, p.x1, p.wqT + (size_t)layer * 2048 * DM, 2048, DM, E, lds);
}

template <int P0>
DI void ins_from(float (&L)[16], float v) {
#pragma unroll
  for (int k = 15; k > P0; --k) L[k] = __builtin_amdgcn_fmed3f(v, L[k - 1], L[k]);
  L[P0] = fmaxf(L[P0], v);
}
template <int I, int J>
DI void cand_row(float (&C)[16], const float (&A)[16], const float (&B)[16]) {
  if constexpr ((I + 1) * (J + 1) <= 16) {
    const float sm = A[I] + B[J];
    const float v = __uint_as_float((__float_as_uint(sm) & ~255u) | (unsigned)(255 - (I * 16 + J)));
    ins_from<(I + 1) * (J + 1) - 1>(C, v);
    cand_row<I, J + 1>(C, A, B);
  }
}
template <int I>
DI void cand_all(float (&C)[16], const float (&A)[16], const float (&B)[16]) {
  if constexpr (I < 16) { cand_row<I, 0>(C, A, B); cand_all<I + 1>(C, A, B); }
}
DI void ins16(float (&L)[16], float v) {
#pragma unroll
  for (int k = 15; k >= 1; --k) L[k] = __builtin_amdgcn_fmed3f(v, L[k - 1], L[k]);
  L[0] = fmaxf(L[0], v);
}
constexpr int QS_STR = 528;

DI void phase_peer_route(const Params& p, int layer, char* lds) {
  const int tid = otid(p.wave), lane = tid & 63, wave = tid >> 6;
  const int r = lane & 31, hh = lane >> 5;
  char* Qs = lds;
  unsigned* Ls = (unsigned*)(lds + 128 * QS_STR);
  for (int item = obid(); item < 2048; item += gridDim.x) {
    const int mt = item >> 3, head = item & 7;
#pragma unroll
    for (int e = 0; e < 8; ++e) {
      const int c = tid + e * 512, row = c >> 5, ch = c & 31;
      *(uint4*)(Qs + row * QS_STR + ch * 16) = *(const uint4*)(p.qbuf + (size_t)(mt * 128 + row) * 2048 + head * 256 + ch * 8);
    }
    __syncthreads();
    {
      const int pp = wave >> 2, tg = wave & 3;
      bf16x8 Bq[8];
      const char* qrow = Qs + (tg * 32 + r) * QS_STR + (pp * 128 + hh * 8) * 2;
#pragma unroll
      for (int s = 0; s < 8; ++s) Bq[s] = *(const bf16x8*)(qrow + s * 32);
      const u16* kbase = p.keysb + ((size_t)(layer * 16 + head * 2 + pp) * 128) * 128;
      float Lst[16];
#pragma unroll
      for (int k = 0; k < 16; ++k) Lst[k] = -3.0e38f;
#pragma unroll
      for (int kt = 0; kt < 4; ++kt) {
        f32x16 S;
#pragma unroll
        for (int e = 0; e < 16; ++e) S[e] = 0.f;
        const u16* krow = kbase + (size_t)(kt * 32 + r) * 128 + hh * 8;
#pragma unroll
        for (int s = 0; s < 8; ++s) S = MFMA(*(const bf16x8*)(krow + s * 16), Bq[s], S);
#pragma unroll
        for (int e = 0; e < 16; ++e) {
          const int kidx = kt * 32 + (e & 3) + 8 * (e >> 2) + 4 * hh;
          const float v = __uint_as_float((__float_as_uint(S[e]) & ~127u) | (unsigned)(127 - kidx));
          ins16(Lst, v);
        }
      }
      float Pl[16];
#pragma unroll
      for (int k = 0; k < 16; ++k) Pl[k] = __shfl_xor(Lst[k], 32);
#pragma unroll
      for (int k = 0; k < 16; ++k) ins16(Lst, Pl[k]);
      if (hh == 0) {
        unsigned* dst = Ls + ((tg * 32 + r) * 2 + pp) * 16;
#pragma unroll
        for (int k = 0; k < 16; ++k) dst[k] = __float_as_uint(Lst[k]);
      }
    }
    __syncthreads();
    if (tid < 128) {
      const unsigned* la = Ls + (tid * 2) * 16;
      float A[16], B[16];
#pragma unroll
      for (int k = 0; k < 16; ++k) { A[k] = __uint_as_float(la[k]); B[k] = __uint_as_float(la[16 + k]); }
      float C[16];
#pragma unroll
      for (int k = 0; k < 16; ++k) C[k] = -3.0e38f;
      cand_all<0>(C, A, B);
      const int t = mt * 128 + tid;
      float e[16], sum = 0.f;
#pragma unroll
      for (int k = 0; k < 16; ++k) { e[k] = __expf(C[k] - C[0]); sum += e[k]; }
      const float inv = 1.f / sum;
      int* ed = p.experts + (size_t)t * 128 + head * 16;
      float* gd = p.gates + (size_t)t * 128 + head * 16;
#pragma unroll
      for (int k = 0; k < 16; ++k) {
        const unsigned code = 255u - (__float_as_uint(C[k]) & 255u);
        const int i1 = 127 - (int)(la[code >> 4] & 127u);
        const int i2 = 127 - (int)(la[16 + (code & 15)] & 127u);
        ed[k] = i1 * 128 + i2;
        gd[k] = e[k] * inv;
      }
    }
    __syncthreads();
  }
}


DI float gelu_exact(float d) { return 0.5f * d * (1.f + erff(d * 0.70710678118654752f)); }

DI float row_allsum(float v) {
  v += __builtin_bit_cast(float, __builtin_amdgcn_update_dpp(0, __builtin_bit_cast(int, v), 0x128, 0xf, 0xf, false));
  v += __builtin_bit_cast(float, __builtin_amdgcn_update_dpp(0, __builtin_bit_cast(int, v), 0x124, 0xf, 0xf, false));
  v += __builtin_bit_cast(float, __builtin_amdgcn_update_dpp(0, __builtin_bit_cast(int, v), 0x122, 0xf, 0xf, false));
  v += __builtin_bit_cast(float, __builtin_amdgcn_update_dpp(0, __builtin_bit_cast(int, v), 0x121, 0xf, 0xf, false));
  return v;
}

DI void phase_peer_ffn(const Params& p, int layer, char* lds) {
  const int tid = otid(p.wave), lane = tid & 63, wave = tid >> 6, grp16 = lane >> 4, l16 = lane & 15;
  uint2* list = (uint2*)(lds + wave * 4096);
  float* dl = (float*)(lds + 32768 + wave * 2048);
  const float* g2 = p.in[15] + layer * 1024;
  const float* b2 = p.in[16] + layer * 1024;
  const unsigned char* ub = p.ub + (size_t)layer * NEXP * ROWB + l16 * 48;
  const unsigned char* vb = p.vb + (size_t)layer * NEXP * ROWB + l16 * 48;
  const float* us = p.us + layer * NEXP;
  const float* vs = p.vs + layer * NEXP;
  const unsigned ltmask16 = (1u << l16) - 1u;
  uint2* mylist = list + grp16 * 128;
  float* mydl = dl + grp16 * 128;
  for (int grp = obid() * 8 + wave; grp < T_ALL / 4; grp += gridDim.x * 8) {
    const int t = grp * 4 + grp16;
    {
      int ev[8]; unsigned gv[8];
      {
        const int4 e0 = *(const int4*)(p.experts + (size_t)t * 128 + l16 * 8);
        const int4 e1 = *(const int4*)(p.experts + (size_t)t * 128 + l16 * 8 + 4);
        const uint4 g0 = *(const uint4*)(p.gates + (size_t)t * 128 + l16 * 8);
        const uint4 g1 = *(const uint4*)(p.gates + (size_t)t * 128 + l16 * 8 + 4);
        ev[0] = e0.x; ev[1] = e0.y; ev[2] = e0.z; ev[3] = e0.w; ev[4] = e1.x; ev[5] = e1.y; ev[6] = e1.z; ev[7] = e1.w;
        gv[0] = g0.x; gv[1] = g0.y; gv[2] = g0.z; gv[3] = g0.w; gv[4] = g1.x; gv[5] = g1.y; gv[6] = g1.z; gv[7] = g1.w;
      }
      int pos[8];
#pragma unroll
      for (int s2 = 0; s2 < 8; ++s2) pos[s2] = 0;
      int running = 0;
#pragma unroll 1
      for (int b = 0; b < 16; ++b) {
#pragma unroll
        for (int s2 = 0; s2 < 8; ++s2) {
          const bool mt = (ev[s2] >> 10) == b;
          const unsigned m = (unsigned)(__ballot(mt) >> (grp16 * 16)) & 0xffffu;
          if (mt) pos[s2] = running + __popc(m & ltmask16);
          running += __popc(m);
        }
      }
#pragma unroll
      for (int s2 = 0; s2 < 8; ++s2) mylist[pos[s2]] = make_uint2((unsigned)ev[s2], gv[s2]);
    }
    __builtin_amdgcn_sched_barrier(0);
#define LD_ROW(buf, tab, i)                                                                     \
  {                                                                                             \
    const unsigned char* r_ = (tab) + (size_t)mylist[(i)].x * ROWB;                             \
    buf[0] = *(const uint4*)r_; buf[1] = *(const uint4*)(r_ + 16); buf[2] = *(const uint4*)(r_ + 32); \
  }
#define ROW_Q0(buf) ((u32x6){buf[0].x, buf[0].y, buf[0].z, buf[0].w, buf[1].x, buf[1].y})
#define ROW_Q1(buf) ((u32x6){buf[1].z, buf[1].w, buf[2].x, buf[2].y, buf[2].z, buf[2].w})
    {
      unsigned xw[32];
#pragma unroll
      for (int n = 0; n < 8; ++n) {
        const uint4 xa = *(const uint4*)(p.x1 + (size_t)t * 1024 + l16 * 64 + n * 8);
        xw[4 * n] = xa.x; xw[4 * n + 1] = xa.y; xw[4 * n + 2] = xa.z; xw[4 * n + 3] = xa.w;
      }
      uint4 r0[3], r1[3], r2[3], r3[3], r4[3], r5[3];
#define PASS1(buf, i)                                                                           \
  {                                                                                             \
    u32x16 u0_ = __builtin_bit_cast(u32x16, __builtin_amdgcn_cvt_scalef32_pk32_bf16_fp6(ROW_Q0(buf), 1.0f)); \
    u32x16 u1_ = __builtin_bit_cast(u32x16, __builtin_amdgcn_cvt_scalef32_pk32_bf16_fp6(ROW_Q1(buf), 1.0f)); \
    float da_ = 0.f, db_ = 0.f;                                                                 \
    _Pragma("unroll") for (int e = 0; e < 16; ++e) {                                            \
      unsigned wa_ = u0_[e], wb_ = u1_[e];                                                      \
      asm volatile("" : "+v"(wa_), "+v"(wb_));     \
      da_ = __builtin_amdgcn_fdot2_f32_bf16(__builtin_bit_cast(bf16x2_t, wa_), __builtin_bit_cast(bf16x2_t, xw[e]), da_, false); \
      db_ = __builtin_amdgcn_fdot2_f32_bf16(__builtin_bit_cast(bf16x2_t, wb_), __builtin_bit_cast(bf16x2_t, xw[16 + e]), db_, false); \
    }                                                                                           \
    const float d_ = row_allsum(da_ + db_);                                                     \
    if (l16 == 0) mydl[(i)] = d_;                                                               \
  }
      LD_ROW(r0, ub, 0) LD_ROW(r1, ub, 1) LD_ROW(r2, ub, 2) LD_ROW(r3, ub, 3) LD_ROW(r4, ub, 4)
#pragma unroll 1
      for (int i = 0; i < 126; i += 6) {
        LD_ROW(r5, ub, i + 5)
        PASS1(r0, i)
        LD_ROW(r0, ub, i + 6)
        PASS1(r1, i + 1)
        LD_ROW(r1, ub, i + 7)
        PASS1(r2, i + 2)
        LD_ROW(r2, ub, min(i + 8, 127))
        PASS1(r3, i + 3)
        LD_ROW(r3, ub, min(i + 9, 127))
        PASS1(r4, i + 4)
        LD_ROW(r4, ub, min(i + 10, 127))
        PASS1(r5, i + 5)
      }
      PASS1(r0, 126)
      PASS1(r1, 127)
    }
    __builtin_amdgcn_sched_barrier(0);
#pragma unroll 2
    for (int k = 0; k < 8; ++k) {
      const int idx = l16 + 16 * k;
      const uint2 en = mylist[idx];
      const float d = mydl[idx] * us[en.x];
      mylist[idx].y = __float_as_uint(__uint_as_float(en.y) * gelu_exact(d) * vs[en.x]);
    }
    __builtin_amdgcn_sched_barrier(0);
    {
      f32x2 acc[32];
#pragma unroll
      for (int e = 0; e < 32; ++e) { acc[e][0] = 0.f; acc[e][1] = 0.f; }
      uint4 r0[3], r1[3], r2[3], r3[3], r4[3], r5[3];
#define PASS2(buf, i)                                                                           \
  {                                                                                             \
    const float c_ = __uint_as_float(mylist[(i)].y);                                            \
    {                                                                                           \
      f32x32 v0_ = __builtin_amdgcn_cvt_scalef32_pk32_f32_fp6(ROW_Q0(buf), 1.0f);               \
      asm volatile("" : "+v"(v0_));                                                             \
      _Pragma("unroll") for (int e = 0; e < 16; ++e) acc[e] = (f32x2){v0_[2 * e], v0_[2 * e + 1]} * c_ + acc[e]; \
    }                                                                                           \
    __builtin_amdgcn_sched_barrier(0);                                                          \
    {                                                                                           \
      f32x32 v1_ = __builtin_amdgcn_cvt_scalef32_pk32_f32_fp6(ROW_Q1(buf), 1.0f);               \
      asm volatile("" : "+v"(v1_));                                                             \
      _Pragma("unroll") for (int e = 0; e < 16; ++e) acc[16 + e] = (f32x2){v1_[2 * e], v1_[2 * e + 1]} * c_ + acc[16 + e]; \
    }                                                                                           \
    __builtin_amdgcn_sched_barrier(0);                                                          \
  }
      LD_ROW(r0, vb, 0) LD_ROW(r1, vb, 1) LD_ROW(r2, vb, 2) LD_ROW(r3, vb, 3) LD_ROW(r4, vb, 4)
#pragma unroll 1
      for (int i = 0; i < 126; i += 6) {
        LD_ROW(r5, vb, i + 5)
        PASS2(r0, i)
        LD_ROW(r0, vb, i + 6)
        PASS2(r1, i + 1)
        LD_ROW(r1, vb, i + 7)
        PASS2(r2, i + 2)
        LD_ROW(r2, vb, min(i + 8, 127))
        PASS2(r3, i + 3)
        LD_ROW(r3, vb, min(i + 9, 127))
        PASS2(r4, i + 4)
        LD_ROW(r4, vb, min(i + 10, 127))
        PASS2(r5, i + 5)
      }
      PASS2(r0, 126)
      PASS2(r1, 127)
      float sm = 0.f;
#pragma unroll
      for (int n = 0; n < 8; ++n) {
        const uint4 xa = *(const uint4*)(p.x1 + (size_t)t * 1024 + l16 * 64 + n * 8);
        const unsigned xq[4] = {xa.x, xa.y, xa.z, xa.w};
#pragma unroll
        for (int e = 0; e < 4; ++e) {
          acc[4 * n + e][0] = ALPHA * bflo(xq[e]) + acc[4 * n + e][0];
          acc[4 * n + e][1] = ALPHA * bfhi(xq[e]) + acc[4 * n + e][1];
          sm += acc[4 * n + e][0] + acc[4 * n + e][1];
        }
      }
      const float mean = row_allsum(sm) * (1.f / 1024.f);
      float vsum = 0.f;
#pragma unroll
      for (int e = 0; e < 32; ++e) {
        acc[e][0] -= mean; acc[e][1] -= mean;
        vsum += acc[e][0] * acc[e][0] + acc[e][1] * acc[e][1];
      }
      const float rstd = rsqrtf(row_allsum(vsum) * (1.f / 1024.f) + 1e-5f);
#pragma unroll
      for (int n = 0; n < 4; ++n) {
        const int d0 = l16 * 64 + n * 16;
        float o[16];
#pragma unroll
        for (int q = 0; q < 4; ++q) {
          const float4 gg = *(const float4*)(g2 + d0 + 4 * q);
          const float4 bb = *(const float4*)(b2 + d0 + 4 * q);
          o[4 * q + 0] = acc[8 * n + 2 * q][0] * rstd * gg.x + bb.x;
          o[4 * q + 1] = acc[8 * n + 2 * q][1] * rstd * gg.y + bb.y;
          o[4 * q + 2] = acc[8 * n + 2 * q + 1][0] * rstd * gg.z + bb.z;
          o[4 * q + 3] = acc[8 * n + 2 * q + 1][1] * rstd * gg.w + bb.w;
        }
        if (layer == 1) {
          float4* oa = (float4*)(p.out + (size_t)t * 1024 + d0);
          oa[0] = make_float4(o[0], o[1], o[2], o[3]); oa[1] = make_float4(o[4], o[5], o[6], o[7]);
          oa[2] = make_float4(o[8], o[9], o[10], o[11]); oa[3] = make_float4(o[12], o[13], o[14], o[15]);
        } else {
          uint4 w0, w1;
          w0.x = pack2(o[0], o[1]); w0.y = pack2(o[2], o[3]); w0.z = pack2(o[4], o[5]); w0.w = pack2(o[6], o[7]);
          w1.x = pack2(o[8], o[9]); w1.y = pack2(o[10], o[11]); w1.z = pack2(o[12], o[13]); w1.w = pack2(o[14], o[15]);
          *(uint4*)(p.xb + (size_t)t * 1024 + d0) = w0;
          *(uint4*)(p.xb + (size_t)t * 1024 + d0 + 8) = w1;
        }
        __builtin_amdgcn_sched_barrier(0);
      }
    }
  }
}

#define XB_TMO      128
#define XB_XCNT(j)  (256  + 64 * (j))
#define XB_XSUB(j)  (1280 + 64 * (j))
#define XB_XGEN(j)  (2304 + 64 * (j))
#define XB_TOP      3328
#define XB_TOPGEN   3392
#define XCD_BAR_WORDS 3456
#define XB_SPIN_CAP (1u << 22)
#define LAS __attribute__((address_space(3)))
DI unsigned xb_ld(unsigned* p) { return __hip_atomic_load(p, __ATOMIC_RELAXED, __HIP_MEMORY_SCOPE_AGENT); }
DI unsigned xb_add(unsigned* p, unsigned v) { return __hip_atomic_fetch_add(p, v, __ATOMIC_RELAXED, __HIP_MEMORY_SCOPE_AGENT); }
DI unsigned xb_xcc_id() { return (unsigned)__builtin_amdgcn_s_getreg((3 << 11) | 20) & 0xFu; }
#define XB_SPIN(cond, bar) do { unsigned _sp = 0; while (cond) { __builtin_amdgcn_s_sleep(1); \
    if ((++_sp & 255u) == 0u) { if (xb_ld(&(bar)[XB_TMO])) break; if (_sp > XB_SPIN_CAP) { atomicAdd(&(bar)[XB_TMO], 1u); break; } } } } while (0)
struct XcdBarrier { unsigned* bar; unsigned x; volatile LAS unsigned* st; };
DI XcdBarrier xcd_barrier_post(unsigned* bar, volatile LAS unsigned* st, bool leader) {
  XcdBarrier b; b.bar = bar; b.x = xb_xcc_id(); b.st = st;
  if (leader) (void)xb_add(&bar[XB_XCNT(b.x)], 1u);
  return b;
}
DI void xcd_barrier_complete(unsigned* bar, unsigned x, unsigned& nloc, unsigned& nx) {
  const unsigned G = gridDim.x;
  unsigned sum, cnt, mine, sp = 0u;
  for (;;) {
    sum = 0u; cnt = 0u; mine = 0u;
#pragma unroll
    for (unsigned j = 0; j < 16; ++j) { const unsigned c = xb_ld(&bar[XB_XCNT(j)]); sum += c; cnt += (c > 0u) ? 1u : 0u; mine = (j == x) ? c : mine; }
    if (sum == G) break;
    __builtin_amdgcn_s_sleep(1);
    if ((++sp & 255u) == 0u) { if (xb_ld(&bar[XB_TMO])) break; if (sp > XB_SPIN_CAP) { atomicAdd(&bar[XB_TMO], 1u); break; } }
  }
  nloc = mine > 0u ? mine : 1u; nx = cnt > 0u ? cnt : 1u;
}
DI void xcd_barrier(const XcdBarrier& b, bool leader) {
  asm volatile("s_waitcnt vmcnt(0)" ::: "memory");
  __syncthreads();
  if (leader) {
    unsigned* bar = b.bar;
    __builtin_amdgcn_s_waitcnt(0);
    unsigned nloc = b.st[0], nx = b.st[1];
    if (nloc == 0u) { xcd_barrier_complete(bar, b.x, nloc, nx); b.st[0] = nloc; b.st[1] = nx; }
    const unsigned old = xb_add(&bar[XB_XSUB(b.x)], 1u);
    const unsigned gen = old / nloc;
    if (old + 1u == (gen + 1u) * nloc) {
      __builtin_amdgcn_fence(__ATOMIC_RELEASE, "agent");
      asm volatile("s_waitcnt vmcnt(0)" ::: "memory");
      const unsigned og = xb_add(&bar[XB_TOP], 1u);
      const unsigned tg = og / nx;
      if (og + 1u == (tg + 1u) * nx) xb_add(&bar[XB_TOPGEN], 1u);
      else XB_SPIN(xb_ld(&bar[XB_TOPGEN]) == tg, bar);
      __builtin_amdgcn_fence(__ATOMIC_ACQUIRE, "agent");
      xb_add(&bar[XB_XGEN(b.x)], 1u);
      asm volatile("s_waitcnt vmcnt(0)" ::: "memory");
    } else {
      XB_SPIN(xb_ld(&bar[XB_XGEN(b.x)]) == gen, bar);
      __builtin_amdgcn_fence(__ATOMIC_ACQUIRE, "agent");
      asm volatile("s_waitcnt vmcnt(0)" ::: "memory");
    }
  }
  __syncthreads();
}

#ifndef REP_SUB
#define REP_SUB -1
#endif
#ifndef REP_N
#define REP_N 0
#endif
constexpr int NSUB = 8;
constexpr int NPHASE = 1 + 2 * NSUB;
template <int PH>
DI void run_phase(const Params& p, char* lds) {
  if (PH == 0) {
    phase_prep(p, lds);
  } else {
    constexpr int layer = (PH - 1) / NSUB, sub = (PH - 1) % NSUB;
    if (sub == 0) phase_gemm1(p, layer, lds);
    else if (sub == 1) phase_up_dil(p, layer, lds);
    else if (sub == 2) phase_attn(p, layer, lds);
    else if (sub == 3) phase_outproj(p, layer, lds);
    else if (sub == 4) phase_ln1(p, layer, lds);
    else if (sub == 5) phase_qgemm(p, layer, lds);
    else if (sub == 6) phase_peer_route(p, layer, lds);
    else phase_peer_ffn(p, layer, lds);
  }
}
template <int PH>
DI void do_phase(const Params& p, int ph_lo, int ph_hi, char* lds, cg::grid_group& grid, const XcdBarrier& xb) {
  if (ph_lo <= PH && PH < ph_hi) {
    constexpr int extra = (REP_SUB == 8) ? (PH == 0 ? REP_N : 0) : ((REP_SUB >= 0 && PH > 0 && (PH - 1) % NSUB == REP_SUB) ? REP_N : 0);
#pragma unroll
    for (int rp = 0; rp < 1 + extra; ++rp) {
      run_phase<PH>(p, lds);
      if (rp < extra) xcd_barrier(xb, otid(p.wave) == 0);
    }
    if (PH + 1 < ph_hi) {
      if (PH == 0) grid.sync();
      else xcd_barrier(xb, otid(p.wave) == 0);
    }
  }
}
__global__ __launch_bounds__(512) void mega(Params p, int ph_lo, int ph_hi) {
  extern __shared__ __attribute__((aligned(16))) char lds[];
  cg::grid_group grid = cg::this_grid();
  p.wave = __builtin_amdgcn_readfirstlane(threadIdx.x >> 6);
  volatile LAS unsigned* st = (volatile LAS unsigned*)(LAS char*)(lds + 131072 + 1008);
  if (threadIdx.x == 0) { st[0] = 0u; st[1] = 0u; }
  __syncthreads();
  const XcdBarrier xb = xcd_barrier_post(p.bar, st, threadIdx.x == 0);
  do_phase<0>(p, ph_lo, ph_hi, lds, grid, xb);
  do_phase<1>(p, ph_lo, ph_hi, lds, grid, xb);
  do_phase<2>(p, ph_lo, ph_hi, lds, grid, xb);
  do_phase<3>(p, ph_lo, ph_hi, lds, grid, xb);
  do_phase<4>(p, ph_lo, ph_hi, lds, grid, xb);
  do_phase<5>(p, ph_lo, ph_hi, lds, grid, xb);
  do_phase<6>(p, ph_lo, ph_hi, lds, grid, xb);
  do_phase<7>(p, ph_lo, ph_hi, lds, grid, xb);
  do_phase<8>(p, ph_lo, ph_hi, lds, grid, xb);
  do_phase<9>(p, ph_lo, ph_hi, lds, grid, xb);
  do_phase<10>(p, ph_lo, ph_hi, lds, grid, xb);
  do_phase<11>(p, ph_lo, ph_hi, lds, grid, xb);
  do_phase<12>(p, ph_lo, ph_hi, lds, grid, xb);
  do_phase<13>(p, ph_lo, ph_hi, lds, grid, xb);
  do_phase<14>(p, ph_lo, ph_hi, lds, grid, xb);
  do_phase<15>(p, ph_lo, ph_hi, lds, grid, xb);
  do_phase<16>(p, ph_lo, ph_hi, lds, grid, xb);
}

extern "C" void kernel_launch(void* const* d_in, const int* in_sizes, int n_in, void* d_out, int out_size, void* d_ws,
                              size_t ws_size, hipStream_t stream) {
  Params p;
  memset(&p, 0, sizeof(p));
  for (int i = 0; i < 17; ++i) p.in[i] = (const float*)d_in[i];
  p.out = (float*)d_out;
  char* w = (char*)d_ws;
  size_t off = 0;
  auto alloc = [&](size_t bytes) { char* r = w + off; off += (bytes + 255) & ~(size_t)255; return r; };
  p.xb = (u16*)alloc((size_t)T_ALL * DM * 2);
  p.winT = (u16*)alloc((size_t)2 * NPAD * 1024 * 2);
  p.wupT = (u16*)alloc((size_t)2 * NUP * KUP * 2);
  p.woT = (u16*)alloc((size_t)2 * 1024 * 1024 * 2);
  p.wqT = (u16*)alloc((size_t)2 * 2048 * 1024 * 2);
  p.keysb = (u16*)alloc((size_t)2 * 16 * 128 * 128 * 2);
  p.ub = (unsigned char*)alloc((size_t)2 * NEXP * ROWB);
  p.vb = (unsigned char*)alloc((size_t)2 * NEXP * ROWB);
  p.us = (float*)alloc((size_t)2 * NEXP * 4);
  p.vs = (float*)alloc((size_t)2 * NEXP * 4);
  p.cs32 = (float2*)alloc((size_t)SEQ * 16 * 8);
  p.cs64 = (float2*)alloc((size_t)SEQ * 32 * 8);
  p.sumsq = (float*)alloc((size_t)T_ALL * 12 * 4);
  p.stats = (float*)alloc((size_t)T_ALL * 32 * 4);
  p.bar = (unsigned*)alloc((size_t)XCD_BAR_WORDS * 4);
  hipMemsetAsync(p.bar, 0, (size_t)XCD_BAR_WORDS * 4, stream);
  p.cat = (u16*)alloc((size_t)T_ALL * 1024 * 2);
  const size_t r1 = off;
  p.aq = (u16*)alloc((size_t)T_ALL * 256 * 2);
  p.ak = (u16*)alloc((size_t)T_ALL * 256 * 2);
  p.av = (u16*)alloc((size_t)T_ALL * 256 * 2);
  p.bc = (u16*)alloc((size_t)T_ALL * KUP * 2);
  p.bkr = (u16*)alloc((size_t)T_ALL * 32 * 2);
  p.cq = (u16*)alloc((size_t)T_ALL * 384 * 2);
  p.ck = (u16*)alloc((size_t)T_ALL * 384 * 2);
  p.cv = (u16*)alloc((size_t)T_ALL * 384 * 2);
  p.mq = (u16*)alloc((size_t)T_ALL * 576 * 2);
  p.mk = (u16*)alloc((size_t)T_ALL * 384 * 2);
  p.mv = (u16*)alloc((size_t)T_ALL * 384 * 2);
  off = r1;
  p.ybuf = (u16*)alloc((size_t)T_ALL * 1024 * 2);
  p.x1 = (u16*)alloc((size_t)T_ALL * 1024 * 2);
  p.experts = (int*)alloc((size_t)T_ALL * 128 * 4);
  p.gates = (float*)alloc((size_t)T_ALL * 128 * 4);
  p.qbuf = (u16*)d_out;
  p.dilo = (u16*)d_out;
  p.dillse = (float*)((char*)d_out + (size_t)3 * T_ALL * 384 * 2);

#ifdef MULTI_LAUNCH
  hipFuncSetAttribute((const void*)mega, hipFuncAttributeMaxDynamicSharedMemorySize, LDS_BYTES);
  for (int ph = 0; ph < NPHASE; ++ph) {
    hipLaunchKernelGGL(mega, dim3(256), dim3(512), LDS_BYTES, stream, p, ph, ph + 1);
  }
#else
  static int grid_blocks = 0;
  if (!grid_blocks) {
    int dev = 0, cus = 0, per_cu = 0;
    hipGetDevice(&dev);
    hipDeviceGetAttribute(&cus, hipDeviceAttributeMultiprocessorCount, dev);
    hipFuncSetAttribute((const void*)mega, hipFuncAttributeMaxDynamicSharedMemorySize, LDS_BYTES);
    hipOccupancyMaxActiveBlocksPerMultiprocessor(&per_cu, mega, 512, LDS_BYTES);
    if (per_cu > 1) per_cu = 1;
    grid_blocks = cus * per_cu;
  }
  int lo = 0, hi = NPHASE;
  void* args[] = {&p, &lo, &hi};
  hipError_t e = hipLaunchCooperativeKernel((void*)mega, dim3(grid_blocks), dim3(512), args, LDS_BYTES, stream);
  if (e != hipSuccess) fprintf(stderr, "cooperative launch failed: %s (grid %d)\n", hipGetErrorString(e), grid_blocks);
#endif
}
```
